# Optimizing an MI355X kernel written in HIP

```python
import math
import jax, jax.numpy as jnp
from jax import lax
import numpy as np

D_MODEL = 1024
BATCH = 2
SEQ = 8192
DEPTH = 1

N_META = 16
D_MIX = 2 * D_MODEL
D_SSD = D_MIX // 2
SSD_HEAD_DIM = 64
SSD_HEADS = D_SSD // SSD_HEAD_DIM
SSD_GROUPS = 2
SSD_HEADS_PER_GROUP = SSD_HEADS // SSD_GROUPS
SSD_STATE = 128
SSD_CONV = 4
SSD_CHUNK = 256
D_XBC = D_SSD + 2 * SSD_GROUPS * SSD_STATE
D_S5 = D_MIX - D_SSD
S5_GROUP_WIDTH = 16
S5_GROUPS = D_S5 // S5_GROUP_WIDTH
S5_STATE = 64
D_FF = 4 * D_MODEL
D_IN_PROJ = D_SSD + D_XBC + SSD_HEADS + D_S5
NORM_EPS = 1e-5
DT_MIN = 0.001
DT_MAX = 0.1

kernel_name = 'hymba_ssd_s5_hybrid_block'


def _rmsnorm(x, g):
    xf = x.astype(jnp.float32)
    y = xf * lax.rsqrt(jnp.mean(xf * xf, axis=-1, keepdims=True) + NORM_EPS)
    return (y * g.astype(jnp.float32)).astype(x.dtype)


def _causal_depthwise_conv(x, w, b):
    k, c = w.shape
    y = lax.conv_general_dilated(x, w[:, None, :].astype(x.dtype), window_strides=(1,), padding=[(k - 1, 0)], dimension_numbers=('NWC', 'WIO', 'NWC'), feature_group_count=c)
    return y + b.astype(x.dtype)


def _ssd_mixer(xbc, dt_raw, z, dt_bias, a_log, d_skip, g_norm):
    bsz, length, _ = xbc.shape
    f32 = jnp.float32
    xbc = xbc.astype(f32)
    x_in = xbc[..., :D_SSD]
    b_in = xbc[..., D_SSD:D_SSD + SSD_GROUPS * SSD_STATE]
    c_in = xbc[..., D_SSD + SSD_GROUPS * SSD_STATE:]
    dt = jax.nn.softplus(dt_raw.astype(f32) + dt_bias.astype(f32))
    front = SSD_CHUNK - N_META
    n_real_chunks = -(-(length - N_META) // SSD_CHUNK)
    total = SSD_CHUNK * (1 + n_real_chunks)
    back = total - front - length
    pad = lambda t: jnp.pad(t, ((0, 0), (front, back), (0, 0)))
    n_chunks = total // SSD_CHUNK
    shp = (bsz, n_chunks, SSD_CHUNK, SSD_GROUPS)
    xc = pad(x_in).reshape(shp + (SSD_HEADS_PER_GROUP, SSD_HEAD_DIM))
    bc = pad(b_in).reshape(shp + (SSD_STATE,))
    cc = pad(c_in).reshape(shp + (SSD_STATE,))
    dtc = pad(dt).reshape(shp + (SSD_HEADS_PER_GROUP,))
    a = -jnp.exp(a_log.astype(f32)).reshape(SSD_GROUPS, SSD_HEADS_PER_GROUP)
    a_cs = jnp.cumsum(dtc * a, axis=2)
    xdt = xc * dtc[..., None]
    causal = jnp.tril(jnp.ones((SSD_CHUNK, SSD_CHUNK), dtype=bool))[:, :, None, None]
    seg = a_cs[:, :, :, None] - a_cs[:, :, None, :]
    decay = jnp.exp(jnp.where(causal, seg, -jnp.inf))
    cb = jnp.einsum('bclgn,bcsgn->bclsg', cc, bc)
    y_diag = jnp.einsum('bclsg,bclsgr,bcsgrp->bclgrp', cb, decay, xdt)
    decay_to_end = jnp.exp(a_cs[:, :, -1:] - a_cs)
    chunk_states = jnp.einsum('bclgn,bclgr,bclgrp->bcgrpn', bc, decay_to_end, xdt)
    chunk_decay = jnp.exp(a_cs[:, :, -1])

    def step(state, inp):
        dec, st = inp
        return state * dec[..., None, None] + st, state

    init = jnp.zeros((bsz, SSD_GROUPS, SSD_HEADS_PER_GROUP, SSD_HEAD_DIM, SSD_STATE), f32)
    _, prev = lax.scan(step, init, (jnp.moveaxis(chunk_decay, 1, 0), jnp.moveaxis(chunk_states, 1, 0)))
    prev = jnp.moveaxis(prev, 0, 1)
    y_off = jnp.einsum('bclgn,bcgrpn,bclgr->bclgrp', cc, prev, jnp.exp(a_cs))
    d = d_skip.astype(f32).reshape(SSD_GROUPS, SSD_HEADS_PER_GROUP, 1)
    y = (y_diag + y_off + xc * d).reshape(bsz, total, D_SSD)[:, front:front + length]
    y = y * jax.nn.silu(z.astype(f32))
    return _rmsnorm(y, g_norm)


def _s5_mixer(u, lam_re, lam_im, log_step, b_re, b_im, c_re, c_im, d_skip, w_glu, b_glu, g_norm):
    bsz, length, _ = u.shape
    f32 = jnp.float32
    u = u.astype(f32).reshape(bsz, length, S5_GROUPS, S5_GROUP_WIDTH)
    lr = lam_re.astype(f32)
    li = lam_im.astype(f32)
    step = jnp.exp(log_step.astype(f32))[:, None]
    mag = jnp.exp(lr * step)
    ab_re = mag * jnp.cos(li * step)
    ab_im = mag * jnp.sin(li * step)
    den = lr * lr + li * li
    coef_re = ((ab_re - 1.0) * lr + ab_im * li) / den
    coef_im = (ab_im * lr - (ab_re - 1.0) * li) / den
    br = b_re.astype(f32)
    bi = b_im.astype(f32)
    bb_re = coef_re[..., None] * br - coef_im[..., None] * bi
    bb_im = coef_re[..., None] * bi + coef_im[..., None] * br
    bu_re = jnp.einsum('blgh,gph->blgp', u, bb_re)
    bu_im = jnp.einsum('blgh,gph->blgp', u, bb_im)
    a_re = jnp.broadcast_to(ab_re, (1, length) + ab_re.shape)
    a_im = jnp.broadcast_to(ab_im, (1, length) + ab_im.shape)

    def combine(e_i, e_j):
        ar_i, ai_i, br_i, bi_i = e_i
        ar_j, ai_j, br_j, bi_j = e_j
        return (ar_j * ar_i - ai_j * ai_i,
                ar_j * ai_i + ai_j * ar_i,
                ar_j * br_i - ai_j * bi_i + br_j,
                ar_j * bi_i + ai_j * br_i + bi_j)

    _, _, s_re, s_im = lax.associative_scan(combine, (a_re, a_im, bu_re, bu_im), axis=1)
    y = (jnp.einsum('blgp,ghp->blgh', s_re, c_re.astype(f32))
         - jnp.einsum('blgp,ghp->blgh', s_im, c_im.astype(f32))
         + u * d_skip.astype(f32))
    y = jax.nn.gelu(y.reshape(bsz, length, D_S5), approximate=False)
    v = y @ w_glu.astype(f32) + b_glu.astype(f32)
    y = v[..., :D_S5] * jax.nn.sigmoid(v[..., D_S5:])
    return _rmsnorm(y, g_norm)


def setup_inputs(seed: int = 0) -> dict:
    key = jax.random.key(seed)
    ks = jax.random.split(key, 32)
    f32 = jnp.float32
    nrm = lambda k, s, sc: jax.random.normal(k, s, f32) * sc
    gain = lambda k, s: 1.0 + 0.01 * jax.random.normal(k, s, f32)
    dt = jnp.exp(jax.random.uniform(ks[6], (DEPTH, SSD_HEADS), f32) * (math.log(DT_MAX) - math.log(DT_MIN)) + math.log(DT_MIN))
    dt = jnp.maximum(dt, 1e-4)
    dt_bias = dt + jnp.log(-jnp.expm1(-dt))
    n_idx = jnp.arange(S5_STATE, dtype=f32)
    return {
        'x': nrm(ks[0], (BATCH, SEQ, D_MODEL), 1.0),
        'meta_tokens': nrm(ks[1], (N_META, D_MODEL), 1.0),
        'g_mix': gain(ks[2], (DEPTH, D_MODEL)),
        'w_in': nrm(ks[3], (DEPTH, D_MODEL, D_IN_PROJ), D_MODEL ** -0.5),
        'conv_w': nrm(ks[4], (DEPTH, SSD_CONV, D_XBC), SSD_CONV ** -0.5),
        'conv_b': nrm(ks[5], (DEPTH, D_XBC), 0.01),
        'dt_bias': dt_bias,
        'a_log': jnp.log(jax.random.uniform(ks[7], (DEPTH, SSD_HEADS), f32, 1.0, 16.0)),
        'd_ssd': gain(ks[8], (DEPTH, SSD_HEADS)),
        'g_ssd': gain(ks[9], (DEPTH, D_SSD)),
        'lam_re': -0.5 + nrm(ks[10], (DEPTH, S5_GROUPS, S5_STATE), 0.01),
        'lam_im': math.pi * n_idx + nrm(ks[11], (DEPTH, S5_GROUPS, S5_STATE), 0.01),
        'log_step': jax.random.uniform(ks[12], (DEPTH, S5_GROUPS), f32, math.log(DT_MIN), math.log(DT_MAX)),
        'b_re': nrm(ks[13], (DEPTH, S5_GROUPS, S5_STATE, S5_GROUP_WIDTH), (2 * S5_GROUP_WIDTH) ** -0.5),
        'b_im': nrm(ks[14], (DEPTH, S5_GROUPS, S5_STATE, S5_GROUP_WIDTH), (2 * S5_GROUP_WIDTH) ** -0.5),
        'c_re': nrm(ks[15], (DEPTH, S5_GROUPS, S5_GROUP_WIDTH, S5_STATE), S5_STATE ** -0.5),
        'c_im': nrm(ks[16], (DEPTH, S5_GROUPS, S5_GROUP_WIDTH, S5_STATE), S5_STATE ** -0.5),
        'd_s5': nrm(ks[17], (DEPTH, S5_GROUPS, S5_GROUP_WIDTH), 1.0),
        'w_glu': nrm(ks[18], (DEPTH, D_S5, 2 * D_S5), D_S5 ** -0.5),
        'b_glu': nrm(ks[19], (DEPTH, 2 * D_S5), 0.01),
        'g_s5': gain(ks[20], (DEPTH, D_S5)),
        'w_out': nrm(ks[21], (DEPTH, D_MIX, D_MODEL), D_MIX ** -0.5),
        'g_mlp': gain(ks[22], (DEPTH, D_MODEL)),
        'w_up': nrm(ks[23], (DEPTH, D_MODEL, D_FF), D_MODEL ** -0.5),
        'w_down': nrm(ks[24], (DEPTH, D_FF, D_MODEL), D_FF ** -0.5),
        'g_final': gain(ks[25], (D_MODEL,)),
    }


def reference(x, meta_tokens, g_mix, w_in, conv_w, conv_b, dt_bias, a_log, d_ssd, g_ssd, lam_re, lam_im, log_step, b_re, b_im, c_re, c_im, d_s5, w_glu, b_glu, g_s5, w_out, g_mlp, w_up, w_down, g_final):
    bsz = x.shape[0]
    meta = jnp.broadcast_to(meta_tokens.astype(x.dtype)[None], (bsz, N_META, D_MODEL))
    h = jnp.concatenate([meta, x], axis=1)
    o_xbc = D_SSD
    o_dt = D_SSD + D_XBC
    o_u = o_dt + SSD_HEADS
    for layer in range(DEPTH):
        n = _rmsnorm(h, g_mix[layer])
        proj = n @ w_in[layer]
        z = proj[..., :o_xbc]
        xbc = jax.nn.silu(_causal_depthwise_conv(proj[..., o_xbc:o_dt], conv_w[layer], conv_b[layer]))
        dt_raw = proj[..., o_dt:o_u]
        u = proj[..., o_u:]
        y_ssd = _ssd_mixer(xbc, dt_raw, z, dt_bias[layer], a_log[layer], d_ssd[layer], g_ssd[layer])
        y_s5 = _s5_mixer(u, lam_re[layer], lam_im[layer], log_step[layer], b_re[layer], b_im[layer], c_re[layer], c_im[layer], d_s5[layer], w_glu[layer], b_glu[layer], g_s5[layer])
        mix = jnp.concatenate([y_ssd.astype(h.dtype), y_s5.astype(h.dtype)], axis=-1)
        h = h + mix @ w_out[layer]
        m = _rmsnorm(h, g_mlp[layer]) @ w_up[layer]
        h = h + jnp.square(jax.nn.relu(m)) @ w_down[layer]
    return _rmsnorm(h, g_final)[:, N_META:].astype(x.dtype)
```

```cpp
#include <hip/hip_runtime.h>
#include <cstdio>
#include <cstdint>
namespace pg8 {
#define PG8_LAS __attribute__((address_space(3)))
typedef unsigned short bf16_t;
typedef short bf16x8 __attribute__((ext_vector_type(8)));
typedef float f32x4 __attribute__((ext_vector_type(4)));
typedef unsigned u32x4 __attribute__((ext_vector_type(4)));
constexpr int BM = 256, BK = 64, HALF = 128, HTB = HALF * BK * 2  , STAGE_BYTES = 8 * HTB, NXCD = 8, WGM = 8;

__host__ __device__ __forceinline__ int lds_byte(int r, int c) { const int st = (r >> 4) * 2 + (c >> 5), rr = r & 15, cc = c & 31, ob = rr * 64 + cc * 2; return st * 1024 + (ob ^ (((ob >> 9) & 1) << 5)); }
__host__ __device__ __forceinline__ void stage_rc(int b, int& R, int& C) { const int st = b / 1024, sb = b % 1024, swz = sb ^ (((sb >> 9) & 1) << 5); R = (st >> 1) * 16 + swz / 64; C = (st & 1) * 32 + (swz % 64) / 2; }
__host__ __device__ __forceinline__ int perm32(int rho) { const int n = rho >> 4, i = rho & 15; return 8 * (i >> 2) + 4 * n + (i & 3); }

struct Unit { int pm, pn, g, par; };
struct Gemm { const bf16_t* A; const bf16_t* Bt; int M, N, K, lda, ldb; size_t gsA, gsB; };

struct StaticOrder {
    int nM, nN, nwg, G, c;
    __host__ __device__ void init(int M, int N, int G_, int c_) { nM = M / BM; nN = N / BM; nwg = nM * nN; G = G_; c = c_; }
    __host__ __device__ bool next(int i, Unit& u) const {
        const long L = (long)i * G + c; if (L >= nwg) return false;
        int wgid = (int)L; { const int q = nwg / NXCD, r = nwg % NXCD, xcd = wgid % NXCD, off = wgid / NXCD; wgid = (xcd < r ? xcd * (q + 1) : r * (q + 1) + (xcd - r) * q) + off; }
        const int nig = WGM * nN, gid = wgid / nig, fm = gid * WGM, gsz = (nM - fm) < WGM ? (nM - fm) : WGM;
        u.pm = fm + ((wgid % nig) % gsz); u.pn = (wgid % nig) / gsz; u.g = 0; u.par = i & 1; return true;
    }
    __device__ __forceinline__ void a_ready(const Unit&) const {}
    __device__ __forceinline__ void done(const Unit&) const {}
};

__device__ __forceinline__ unsigned cvt_pk_bf16(float lo, float hi) { unsigned r; asm volatile("v_cvt_pk_bf16_f32 %0, %1, %2" : "=v"(r) : "v"(lo), "v"(hi)); return r; }
typedef float f32x2 __attribute__((ext_vector_type(2)));
__device__ __forceinline__ f32x2 gelu_pk(f32x2 v) {
    const f32x2 av = __builtin_elementwise_abs(v), d = av * 0.2316418882f + 1.0f;
    f32x2 t; t.x = __builtin_amdgcn_rcpf(d.x); t.y = __builtin_amdgcn_rcpf(d.y);
    f32x2 q = t * 0.5307027145f + (-0.7265760135f); q = q * t + 0.7107068705f; q = q * t + (-0.142248368f); q = q * t + 0.127414796f; q = q * t;
    const f32x2 s = (v * v) * (-0.72134752044f);
    f32x2 e; e.x = __builtin_amdgcn_exp2f(s.x); e.y = __builtin_amdgcn_exp2f(s.y);
    const f32x2 m = v * (q * e), r = v - m;
    f32x2 o; o.x = v.x < 0.f ? m.x : r.x; o.y = v.y < 0.f ? m.y : r.y; return o;
}

__device__ __forceinline__ int fresh_tid() { int t; asm volatile("v_mov_b32 %0, %1" : "=v"(t) : "v"((int)threadIdx.x)); return t; }
#define EPI_ROWS_COLS const int rowb = u.pm * BM + wr * 64 + fr; const int colb = wc * 32 + 8 * fq;
__device__ __forceinline__ u32x4 pack8(const f32x4 v0, const f32x4 v1) { u32x4 w; w.x = cvt_pk_bf16(v0[0], v0[1]); w.y = cvt_pk_bf16(v0[2], v0[3]); w.z = cvt_pk_bf16(v1[0], v1[1]); w.w = cvt_pk_bf16(v1[2], v1[3]); return w; }
__device__ __forceinline__ float sum8sq(const f32x4 a, const f32x4 b) { return (a[0] * a[0] + a[1] * a[1]) + (a[2] * a[2] + a[3] * a[3]) + (b[0] * b[0] + b[1] * b[1]) + (b[2] * b[2] + b[3] * b[3]); }

struct EpiInProj {
    static constexpr bool PERM = true, AFTER_DRAIN = false, HAS_MID = false;
    bf16_t* MIX; bf16_t* XBCP; bf16_t* UA; bf16_t* UMETA; float* DTRAW;
    __device__ __forceinline__ void operator()(const f32x4 (&acc)[2][2][4][2], const Unit& u, int wr, int wc, int fr, int fq) const {
        EPI_ROWS_COLS
        const int pn = u.pn;
#pragma unroll
        for (int ai = 0; ai < 2; ++ai)
#pragma unroll
            for (int m = 0; m < 4; ++m) {
                const int r = rowb + ai * HALF + m * 16;
#pragma unroll
                for (int bj = 0; bj < 2; ++bj) {
                    const int c = pn * BM + bj * HALF + colb;
                    const f32x4 v0 = acc[ai][bj][m][0], v1 = acc[ai][bj][m][1];
                    if (pn < 4) { if (r < 16384) *(u32x4*)(MIX + (size_t)r * 2048 + c) = pack8(v0, v1); }
                    else if (pn < 10) { *(u32x4*)(XBCP + (size_t)r * 1536 + (c - 1024)) = pack8(v0, v1); }
                    else if (pn < 14) {
                        const int j = c - 2560, g = j >> 4, h0 = j & 15;
                        if (r < 16384) { const int b = r >> 13, tok = r & 8191, ch = tok >> 4, t = tok & 15;
                            *(u32x4*)(UA + ((size_t)(g * 1024 + b * 512 + ch) * 384 + t * 16 + h0)) = pack8(v0, v1); }
                        else *(u32x4*)(UMETA + (size_t)(r - 16384) * 1024 + j) = pack8(v0, v1);
                    } else {
                        const int j = c - 3584;
                        if (j < 16) { float* d = DTRAW + (size_t)r * 16 + j; *(f32x4*)d = v0; *(f32x4*)(d + 4) = v1; }
                    }
                }
            }
    }
};
struct EpiS5a {
    static constexpr bool PERM = true, AFTER_DRAIN = false, HAS_MID = false;
    float* SEND;
    __device__ __forceinline__ void operator()(const f32x4 (&acc)[2][2][4][2], const Unit& u, int wr, int wc, int fr, int fq) const {
        EPI_ROWS_COLS
#pragma unroll
        for (int ai = 0; ai < 2; ++ai)
#pragma unroll
            for (int m = 0; m < 4; ++m) {
                const int r = rowb + ai * HALF + m * 16;
                float* d = SEND + ((size_t)(u.g * 1024 + r) * 128 + colb);
                *(f32x4*)d = acc[ai][0][m][0]; *(f32x4*)(d + 4) = acc[ai][0][m][1];
            }
    }
};
struct EpiS5b {
    static constexpr bool PERM = true, AFTER_DRAIN = false, HAS_MID = false;
    bf16_t* Y5;
    __device__ __forceinline__ void operator()(const f32x4 (&acc)[2][2][4][2], const Unit& u, int wr, int wc, int fr, int fq) const {
        { const int t2 = fresh_tid(); const int w2 = t2 >> 6, l2 = t2 & 63; wr = w2 >> 2; wc = w2 & 3; fr = l2 & 15; fq = l2 >> 4; }
        const unsigned lane_off = (unsigned)((((u.pm >> 1) * 8192 + (((u.pm & 1) * 256 + wr * 64 + fr) * 16) + (wc * 2 + (fq >> 1))) * 1024 + u.g * 16 + (fq & 1) * 8) * 2);
        char* base = (char*)Y5;
#pragma unroll
        for (int ai = 0; ai < 2; ++ai)
#pragma unroll
            for (int m = 0; m < 4; ++m)
#pragma unroll
                for (int bj = 0; bj < 2; ++bj) {
                    const f32x4 v0 = acc[ai][bj][m][0], v1 = acc[ai][bj][m][1]; u32x4 w;
                    { const f32x2 a = gelu_pk((f32x2){v0[0], v0[1]}); w.x = cvt_pk_bf16(a.x, a.y); } __builtin_amdgcn_sched_barrier(0);
                    { const f32x2 a = gelu_pk((f32x2){v0[2], v0[3]}); w.y = cvt_pk_bf16(a.x, a.y); } __builtin_amdgcn_sched_barrier(0);
                    { const f32x2 a = gelu_pk((f32x2){v1[0], v1[1]}); w.z = cvt_pk_bf16(a.x, a.y); } __builtin_amdgcn_sched_barrier(0);
                    { const f32x2 a = gelu_pk((f32x2){v1[2], v1[3]}); w.w = cvt_pk_bf16(a.x, a.y); } __builtin_amdgcn_sched_barrier(0);
                    const unsigned off = lane_off + (unsigned)(ai * 4194304 + m * 524288 + bj * 16384);
                    *(u32x4*)(base + off) = w;
                }
    }
};
__device__ __forceinline__ float sigm(float x) { return __builtin_amdgcn_rcpf(1.0f + __builtin_amdgcn_exp2f(-1.44269504f * x)); }
struct EpiGlu {
    static constexpr bool PERM = true, AFTER_DRAIN = false, HAS_MID = false;
    bf16_t* MIX; const float* bglu; float* SS5;
    __device__ __forceinline__ void operator()(const f32x4 (&acc)[2][2][4][2], const Unit& u, int wr, int wc, int fr, int fq) const {
        EPI_ROWS_COLS
        const int oc = u.pn * 128 + colb;
        const f32x4 ba0 = *(const f32x4*)(bglu + oc), ba1 = *(const f32x4*)(bglu + oc + 4), bg0 = *(const f32x4*)(bglu + 1024 + oc), bg1 = *(const f32x4*)(bglu + 1024 + oc + 4);
#pragma unroll
        for (int ai = 0; ai < 2; ++ai)
#pragma unroll
            for (int m = 0; m < 4; ++m) {
                const int r = rowb + ai * HALF + m * 16;
                f32x4 a0 = acc[ai][0][m][0] + ba0, a1 = acc[ai][0][m][1] + ba1; const f32x4 g0 = acc[ai][1][m][0] + bg0, g1 = acc[ai][1][m][1] + bg1;
#pragma unroll
                for (int e = 0; e < 4; ++e) { a0[e] *= sigm(g0[e]); a1[e] *= sigm(g1[e]); }
                *(u32x4*)(MIX + (size_t)r * 2048 + 1024 + oc) = pack8(a0, a1);
                float s = sum8sq(a0, a1); s += __shfl_xor(s, 16); s += __shfl_xor(s, 32);
                if (fq == 0) atomicAdd(SS5 + r, s);
            }
    }
};
template <bool SECOND> struct EpiOut {
    static constexpr bool PERM = true, AFTER_DRAIN = false, HAS_MID = false;
    const float* X; float* H1; bf16_t* H1B; const float* SSX; float* SSM;
    __device__ __forceinline__ void operator()(const f32x4 (&acc)[2][2][4][2], const Unit& u, int wr, int wc, int fr, int fq) const {
        EPI_ROWS_COLS
        const unsigned lane_off = (unsigned)(rowb * 1024 + u.pn * BM + colb);
        const char* xb = (const char*)X; char* hb = (char*)H1; char* bb = (char*)H1B;
#pragma unroll
        for (int ai = 0; ai < 2; ++ai)
#pragma unroll
            for (int m = 0; m < 4; ++m) {
                const int r = rowb + ai * HALF + m * 16;
                const float rs = 1.0f / sqrtf(SSX[r] * (1.0f / 1024.0f) + 1e-5f);
                float s = 0.f;
#pragma unroll
                for (int bj = 0; bj < 2; ++bj) {
                    const unsigned off = lane_off + (unsigned)(ai * 131072 + m * 16384 + bj * 128);
                    const f32x4 v0 = *(const f32x4*)(xb + off * 4u) + acc[ai][bj][m][0] * rs, v1 = *(const f32x4*)(xb + off * 4u + 16u) + acc[ai][bj][m][1] * rs;
                    *(f32x4*)(hb + off * 4u) = v0; *(f32x4*)(hb + off * 4u + 16u) = v1;
                    if (SECOND) { *(u32x4*)(bb + off * 2u) = pack8(v0, v1); s += sum8sq(v0, v1); }
                }
                if (SECOND) { s += __shfl_xor(s, 16); s += __shfl_xor(s, 32);
                    if (fq == 0) atomicAdd(SSM + r, s); }
                asm volatile("" ::: "memory");
            }
    }
};
struct EpiUp {
    static constexpr bool PERM = true, AFTER_DRAIN = false, HAS_MID = false;
    bf16_t* HB; const float* SSM;
    __device__ __forceinline__ void operator()(const f32x4 (&acc)[2][2][4][2], const Unit& u, int wr, int wc, int fr, int fq) const {
        EPI_ROWS_COLS
#pragma unroll
        for (int ai = 0; ai < 2; ++ai)
#pragma unroll
            for (int m = 0; m < 4; ++m) {
                const int r = rowb + ai * HALF + m * 16;
                const float rs = 1.0f / sqrtf(SSM[r] * (1.0f / 1024.0f) + 1e-5f);
#pragma unroll
                for (int bj = 0; bj < 2; ++bj) {
                    f32x4 v0 = acc[ai][bj][m][0] * rs, v1 = acc[ai][bj][m][1] * rs;
#pragma unroll
                    for (int e = 0; e < 4; ++e) { const float p = fmaxf(v0[e], 0.f), q = fmaxf(v1[e], 0.f); v0[e] = p * p; v1[e] = q * q; }
                    *(u32x4*)(HB + (size_t)r * 4096 + u.pn * BM + bj * HALF + colb) = pack8(v0, v1);
                }
            }
    }
};
struct EpiDown {
    static constexpr bool PERM = true, AFTER_DRAIN = false, HAS_MID = false;
    float* H; float* SSF;
    __device__ __forceinline__ void operator()(const f32x4 (&acc)[2][2][4][2], const Unit& u, int wr, int wc, int fr, int fq) const {
        EPI_ROWS_COLS
#pragma unroll
        for (int ai = 0; ai < 2; ++ai)
#pragma unroll
            for (int m = 0; m < 4; ++m) {
                const int r = rowb + ai * HALF + m * 16;
                float s = 0.f;
#pragma unroll
                for (int bj = 0; bj < 2; ++bj) {
                    const size_t off = (size_t)r * 1024 + u.pn * BM + bj * HALF + colb;
                    const f32x4 v0 = *(const f32x4*)(H + off) + acc[ai][bj][m][0], v1 = *(const f32x4*)(H + off + 4) + acc[ai][bj][m][1];
                    *(f32x4*)(H + off) = v0; *(f32x4*)(H + off + 4) = v1;
                    s += sum8sq(v0, v1);
                }
                s += __shfl_xor(s, 16); s += __shfl_xor(s, 32);
                if (fq == 0) atomicAdd(SSF + r, s);
            }
    }
};
struct BatchOrder {
    int nU, per_g, Ge, ce;
    __host__ __device__ void init(int nU_, int per_g_, int G, int w0, int c) { nU = nU_; per_g = per_g_; Ge = G - w0; ce = c - w0; }
    __device__ bool next(int i, Unit& u) const {
        if (ce < 0) return false;
        const long L = (long)i * Ge + ce; if (L >= nU) return false;
        u.g = __builtin_amdgcn_readfirstlane((int)L / per_g); u.pm = __builtin_amdgcn_readfirstlane((int)L % per_g); u.pn = 0; u.par = i & 1; return true;
    }
    __device__ __forceinline__ void a_ready(const Unit&) const {}
    __device__ __forceinline__ void done(const Unit&) const {}
};
template <class Epi, class Sched, bool ALIGN_EPI = false, bool SP2 = false>
__device__ __forceinline__ void gemm_phase(PG8_LAS unsigned char* lds, const Gemm g, const Sched& S, const Epi& E) {
    const int tid = threadIdx.x, wid = __builtin_amdgcn_readfirstlane(tid >> 6), lane = tid & 63, wr = wid >> 2, wc = wid & 3, fr = lane & 15, fq = lane >> 4;
    const int K = g.K, nt = K / BK;
    unsigned voffA[2], voffB[2];
#pragma unroll
    for (int i = 0; i < 2; ++i) { int R, C; stage_rc(tid * 16 + i * 8192, R, C); const int Rb = Epi::PERM ? ((R & ~31) + perm32(R & 31)) : R;
        voffA[i] = (unsigned)(R * g.lda + C) * 2u; voffB[i] = (unsigned)(Rb * g.ldb + C) * 2u; }
    const size_t kstep = (size_t)(BK * 2);
    const size_t hstepA = (size_t)HALF * g.lda * 2, hstepB = (size_t)HALF * g.ldb * 2;
    const size_t tstepA = 2 * hstepA, tstepB = 2 * hstepB;
    const unsigned ldsw = (unsigned)wid * 1024u;
    const int aoff = lds_byte(wr * 64 + fr, fq * 8), boff = lds_byte(wc * 32 + fr, fq * 8);
#define PG8_SA(b, h) (((b) * 2 + (h)) * HTB)
#define PG8_SB(b, h) ((4 + (b) * 2 + (h)) * HTB)
#define PG8_STAGE(bufoff, gbase, voff) do { _Pragma("unroll") for (int _i = 0; _i < 2; ++_i) \
        __builtin_amdgcn_global_load_lds((const unsigned*)((const char*)(gbase) + (voff)[_i]), (PG8_LAS unsigned*)(lds + (bufoff) + ldsw + _i * 8192), 16, 0, 0); } while (0)
#define PG8_LDA(dst, b, h) do { _Pragma("unroll") for (int m = 0; m < 4; ++m) _Pragma("unroll") for (int k = 0; k < 2; ++k) dst[m][k] = *(const PG8_LAS bf16x8*)(lds + PG8_SA(b, h) + aoff + m * 2048 + k * 1024); } while (0)
#define PG8_LDB(dst, b, h) do { _Pragma("unroll") for (int n = 0; n < 2; ++n) _Pragma("unroll") for (int k = 0; k < 2; ++k) dst[n][k] = *(const PG8_LAS bf16x8*)(lds + PG8_SB(b, h) + boff + n * 2048 + k * 1024); } while (0)
#define PG8_MMA(ai, bj, At, Bt) do { __builtin_amdgcn_s_setprio(1); _Pragma("unroll") for (int m = 0; m < 4; ++m) _Pragma("unroll") for (int n = 0; n < 2; ++n) _Pragma("unroll") for (int k = 0; k < 2; ++k) \
        acc[ai][bj][m][n] = __builtin_amdgcn_mfma_f32_16x16x32_bf16(Bt[n][k], At[m][k], acc[ai][bj][m][n], 0, 0, 0); __builtin_amdgcn_s_setprio(0); } while (0)
#define PG8_WAIT_V(n) asm volatile("s_waitcnt vmcnt(" #n ")" ::: "memory")
#define PG8_WAIT_L(n) asm volatile("s_waitcnt lgkmcnt(" #n ")" ::: "memory")
#define PG8_BAR __builtin_amdgcn_s_barrier()
#define PG8_SCHED __builtin_amdgcn_sched_barrier(0)
    Unit cur, nxt; int ui = 0;
    if (!S.next(0, cur)) return;
    f32x4 acc[2][2][4][2];
#pragma unroll
    for (int a = 0; a < 2; ++a)
#pragma unroll
        for (int b = 0; b < 2; ++b)
#pragma unroll
            for (int m = 0; m < 4; ++m)
#pragma unroll
                for (int n = 0; n < 2; ++n) acc[a][b][m][n] = (f32x4){0.f, 0.f, 0.f, 0.f};
    bf16x8 At[4][2], B0[2][2], B1[2][2];
    const char* cA = (const char*)g.A + (size_t)cur.g * g.gsA + (size_t)cur.pm * tstepA; const char* cB = (const char*)g.Bt + (size_t)cur.g * g.gsB + (size_t)cur.pn * tstepB;
    S.a_ready(cur);
    if constexpr (SP2) {
        PG8_STAGE(PG8_SB(0, 0), cB, voffB); PG8_STAGE(PG8_SB(0, 1), cB + hstepB, voffB); PG8_STAGE(PG8_SA(0, 0), cA, voffA); PG8_STAGE(PG8_SA(0, 1), cA + hstepA, voffA);
        if (wr == 1) PG8_BAR;
        PG8_WAIT_V(2); PG8_BAR;
        PG8_STAGE(PG8_SB(1, 0), cB + kstep, voffB); PG8_STAGE(PG8_SA(1, 0), cA + kstep, voffA); PG8_STAGE(PG8_SB(1, 1), cB + hstepB + kstep, voffB);
        PG8_WAIT_V(6); PG8_BAR;
    } else {
        PG8_STAGE(PG8_SB(0, 0), cB, voffB); PG8_STAGE(PG8_SA(0, 0), cA, voffA); PG8_STAGE(PG8_SB(0, 1), cB + hstepB, voffB); PG8_STAGE(PG8_SA(0, 1), cA + hstepA, voffA);
        if (wr == 1) PG8_BAR;
        PG8_WAIT_V(4); PG8_BAR;
        PG8_STAGE(PG8_SB(1, 0), cB + kstep, voffB); PG8_STAGE(PG8_SA(1, 0), cA + kstep, voffA); PG8_STAGE(PG8_SB(1, 1), cB + hstepB + kstep, voffB);
        PG8_WAIT_V(6); PG8_BAR;
    }
    for (;;) {
        const bool has_next = S.next(ui + 1, nxt);
        const char* nA = has_next ? (const char*)g.A + (size_t)nxt.g * g.gsA + (size_t)nxt.pm * tstepA : cA; const char* nB = has_next ? (const char*)g.Bt + (size_t)nxt.g * g.gsB + (size_t)nxt.pn * tstepB : cB;
        for (int t = 0; t < nt; t += 2) {
            if constexpr (Epi::HAS_MID) { if (t == 0) E.begin(cur, tid); if (t == (nt >> 1)) E.mid(acc, cur, wr, wc, fr, fq); }
            const bool last = (t == nt - 2);
            const char* a1 = cA + (size_t)(t + 1) * kstep;
            const char* a2 = last ? nA : cA + (size_t)(t + 2) * kstep; const char* b2 = last ? nB : cB + (size_t)(t + 2) * kstep;
            const char* a3 = a2 + kstep; const char* b3 = b2 + kstep;
            if (last && has_next) S.a_ready(nxt);
            if constexpr (SP2) {
            PG8_LDB(B0, 0, 0); PG8_LDB(B1, 0, 1); PG8_SCHED; PG8_LDA(At, 0, 0); PG8_STAGE(PG8_SA(1, 1), a1 + hstepA, voffA);
            PG8_WAIT_V(8); PG8_WAIT_L(0); PG8_BAR; PG8_MMA(0, 0, At, B0); PG8_MMA(0, 1, At, B1); PG8_BAR; PG8_SCHED;
            PG8_LDA(At, 0, 1); PG8_STAGE(PG8_SB(0, 0), b2, voffB); PG8_STAGE(PG8_SB(0, 1), b2 + hstepB, voffB); PG8_STAGE(PG8_SA(0, 0), a2, voffA);
            PG8_WAIT_V(8); PG8_WAIT_L(0); PG8_BAR; PG8_MMA(1, 0, At, B0); PG8_MMA(1, 1, At, B1); PG8_BAR; PG8_SCHED;
            PG8_LDB(B0, 1, 0); PG8_LDB(B1, 1, 1); PG8_SCHED; PG8_LDA(At, 1, 0); PG8_STAGE(PG8_SA(0, 1), a2 + hstepA, voffA);
            PG8_WAIT_V(8); PG8_WAIT_L(0); PG8_BAR; PG8_MMA(0, 0, At, B0); PG8_MMA(0, 1, At, B1); PG8_BAR; PG8_SCHED;
            PG8_LDA(At, 1, 1); PG8_STAGE(PG8_SB(1, 0), b3, voffB); PG8_STAGE(PG8_SB(1, 1), b3 + hstepB, voffB); PG8_STAGE(PG8_SA(1, 0), a3, voffA);
            PG8_WAIT_V(8); PG8_WAIT_L(0); PG8_BAR; PG8_MMA(1, 0, At, B0); PG8_MMA(1, 1, At, B1); PG8_BAR; PG8_SCHED;
            } else {
            PG8_LDB(B0, 0, 0); PG8_SCHED; PG8_LDA(At, 0, 0); PG8_STAGE(PG8_SA(1, 1), a1 + hstepA, voffA);
            PG8_WAIT_L(8); PG8_BAR; PG8_WAIT_L(0); PG8_MMA(0, 0, At, B0); PG8_BAR; PG8_SCHED;
            PG8_LDB(B1, 0, 1); PG8_STAGE(PG8_SB(0, 0), b2, voffB);
            PG8_BAR; PG8_WAIT_L(0); PG8_MMA(0, 1, At, B1); PG8_BAR;
            PG8_LDA(At, 0, 1); PG8_STAGE(PG8_SA(0, 0), a2, voffA);
            PG8_BAR; PG8_WAIT_L(0); PG8_MMA(1, 0, At, B0); PG8_BAR; PG8_SCHED;
            PG8_STAGE(PG8_SB(0, 1), b2 + hstepB, voffB);
            PG8_WAIT_V(6); PG8_BAR; PG8_MMA(1, 1, At, B1); PG8_BAR;
            PG8_LDB(B0, 1, 0); PG8_SCHED; PG8_LDA(At, 1, 0); PG8_STAGE(PG8_SA(0, 1), a2 + hstepA, voffA);
            PG8_WAIT_L(8); PG8_BAR; PG8_WAIT_L(0); PG8_MMA(0, 0, At, B0); PG8_BAR; PG8_SCHED;
            PG8_LDB(B1, 1, 1); PG8_STAGE(PG8_SB(1, 0), b3, voffB);
            PG8_BAR; PG8_WAIT_L(0); PG8_MMA(0, 1, At, B1); PG8_BAR;
            PG8_LDA(At, 1, 1); PG8_STAGE(PG8_SA(1, 0), a3, voffA);
            PG8_BAR; PG8_WAIT_L(0); PG8_MMA(1, 0, At, B0); PG8_BAR; PG8_SCHED;
            PG8_STAGE(PG8_SB(1, 1), b3 + hstepB, voffB);
            PG8_WAIT_V(6); PG8_BAR; PG8_MMA(1, 1, At, B1); PG8_BAR;
            }
        }
        if constexpr (ALIGN_EPI) { if (wr == 0) PG8_BAR; }
        if constexpr (!Epi::AFTER_DRAIN) { E(acc, cur, wr, wc, fr, fq); S.done(cur); }
        if (!has_next) break;
#pragma unroll
        for (int a = 0; a < 2; ++a)
#pragma unroll
            for (int b = 0; b < 2; ++b)
#pragma unroll
                for (int m = 0; m < 4; ++m)
#pragma unroll
                    for (int n = 0; n < 2; ++n) acc[a][b][m][n] = (f32x4){0.f, 0.f, 0.f, 0.f};
        cur = nxt; cA = nA; cB = nB; ++ui;
        if constexpr (ALIGN_EPI) { if (wr == 1) PG8_BAR; }
    }
    PG8_WAIT_V(0);
    if constexpr (!ALIGN_EPI) { if (wr == 0) PG8_BAR; }
    PG8_BAR;
    if constexpr (Epi::AFTER_DRAIN) { E.fused(acc, cur, wr, wc, fr, fq, lds, wid, lane); S.done(cur); }
#undef PG8_SA
#undef PG8_SB
#undef PG8_STAGE
#undef PG8_LDA
#undef PG8_LDB
#undef PG8_MMA
#undef PG8_WAIT_V
#undef PG8_WAIT_L
#undef PG8_BAR
#undef PG8_SCHED
}
}

#include <hip/hip_cooperative_groups.h>
namespace cg = cooperative_groups;
typedef unsigned short bf16;
typedef unsigned v4u __attribute__((ext_vector_type(4)));
typedef unsigned v2u __attribute__((ext_vector_type(2)));
typedef float f32x4 __attribute__((ext_vector_type(4)));
typedef float f32x2 __attribute__((ext_vector_type(2)));
typedef short bf16x8 __attribute__((ext_vector_type(8)));

constexpr int NT = 512, NWAVES = 8;
constexpr int MR = 16384, MP = 16640;
constexpr int NIN = 3840;
constexpr int NQ = 65;
constexpr float EPS = 1e-5f;
constexpr size_t MiB = 1u << 20;
constexpr size_t WS_SS    = 0;
constexpr size_t WS_DEC   = 256 * 1024;
constexpr size_t WS_A1    = 288 * 1024;
constexpr size_t WS_A16   = 320 * 1024;
constexpr size_t WS_BAR   = 384 * 1024;
constexpr size_t WS_BBAR  = 512 * 1024;
constexpr size_t WS_UMETA = 1 * MiB;
constexpr size_t WS_DTRAW = 1 * MiB + 512 * 1024;
constexpr size_t WS_DT    = 2 * MiB + 640 * 1024;
constexpr size_t WS_ACS   = 254 * MiB + 512 * 1024;
static_assert(WS_DTRAW + 16640 * 16 * 4 <= WS_DT && WS_DT + 65 * 16 * 256 * 4 <= 4 * MiB && WS_ACS + 65 * 16 * 256 * 4 <= 256 * MiB, "smalls");
constexpr size_t WS_WGLU  = 4 * MiB;
constexpr size_t WS_TB5   = 8 * MiB;
constexpr size_t WS_TE5   = 20 * MiB;
constexpr size_t WS_WIN   = 28 * MiB;
constexpr size_t WS_PREV  = 20 * MiB;
constexpr size_t WS_WOUT  = 8 * MiB, WS_WUP = 12 * MiB, WS_WDN = 20 * MiB;
constexpr size_t WS_MIX   = 36 * MiB;
constexpr size_t WS_UA    = 100 * MiB;
constexpr size_t WS_XBCP  = 148 * MiB;
constexpr size_t WS_SEND  = 148 * MiB;
constexpr size_t WS_ST    = 180 * MiB;
constexpr size_t WS_Y5    = 148 * MiB;
constexpr size_t WS_XN    = 197 * MiB;
constexpr size_t WS_XF    = 197 * MiB;
constexpr size_t WS_H1B   = 197 * MiB;
constexpr size_t WS_CT    = 230 * MiB;
constexpr size_t WS_BTK   = WS_CT + 65 * 65536 * 2;
constexpr size_t WS_BF    = WS_BTK + 65 * 65536 * 2;
constexpr size_t WS_HB    = 36 * MiB;
static_assert(WS_BF + 65 * 65536 * 2 <= WS_ACS, "ws");
constexpr int LDS_BYTES = 155648;

__device__ __forceinline__ unsigned f2bf(float f) { unsigned u = __builtin_bit_cast(unsigned, f); return (u + 0x7fffu + ((u >> 16) & 1u)) >> 16; }
__device__ __forceinline__ unsigned pk2(float lo, float hi) { return f2bf(lo) | (f2bf(hi) << 16); }
__device__ __forceinline__ float bf2f(unsigned short h) { return __builtin_bit_cast(float, (unsigned)h << 16); }
__device__ __forceinline__ float bflo(unsigned w) { return __builtin_bit_cast(float, w << 16); }
__device__ __forceinline__ float bfhi(unsigned w) { return __builtin_bit_cast(float, w & 0xffff0000u); }
__device__ __forceinline__ float ex2(float x) { return __builtin_amdgcn_exp2f(x); }
__device__ __forceinline__ float expf_(float x) { return __builtin_amdgcn_exp2f(1.44269504f * x); }
__device__ __forceinline__ float wave_sum(float v) {
#pragma unroll
    for (int o = 1; o < 64; o <<= 1) v += __shfl_xor(v, o);
    return v;
}

#define LAS __attribute__((address_space(3)))
#define XB_TMO      128
#define XB_XCNT(j)  (256  + 64 * (j))
#define XB_XSUB(j)  (1280 + 64 * (j))
#define XB_XGEN(j)  (2304 + 64 * (j))
#define XB_TOP      3328
#define XB_TOPGEN   3392
#define XCD_BAR_WORDS 3456
#define XB_SPIN_CAP (1u << 18)

__device__ __forceinline__ unsigned xb_ld(unsigned* p)              { return __hip_atomic_load(p, __ATOMIC_RELAXED, __HIP_MEMORY_SCOPE_AGENT); }
__device__ __forceinline__ unsigned xb_add(unsigned* p, unsigned v) { return __hip_atomic_fetch_add(p, v, __ATOMIC_RELAXED, __HIP_MEMORY_SCOPE_AGENT); }
__device__ __forceinline__ unsigned xb_xcc_id() { return (unsigned)__builtin_amdgcn_s_getreg((3 << 11) | 20) & 0xFu; }
#define XB_SPIN(cond, bar) do { unsigned _sp = 0; while (cond) { __builtin_amdgcn_s_sleep(1); \
    if ((++_sp & 255u) == 0u) { if (xb_ld(&(bar)[XB_TMO])) break; if (_sp > XB_SPIN_CAP) { atomicAdd(&(bar)[XB_TMO], 1u); break; } } } } while (0)

struct XcdBarrier {
    unsigned* bar; unsigned x;
    volatile LAS unsigned* st;
};

__device__ __forceinline__ XcdBarrier xcd_barrier_post(unsigned* bar, volatile LAS unsigned* st) {
    XcdBarrier b; b.bar = bar; b.x = xb_xcc_id(); b.st = st;
    if (threadIdx.x == 0) (void)xb_add(&bar[XB_XCNT(b.x)], 1u);
    return b;
}
__device__ __forceinline__ void xcd_barrier_complete(unsigned* bar, unsigned x, unsigned& nloc, unsigned& nx) {
    const unsigned G = gridDim.x * gridDim.y * gridDim.z;
    unsigned sum, cnt, mine, sp = 0u;
    for (;;) {
        sum = 0u; cnt = 0u; mine = 0u;
#pragma unroll
        for (unsigned j = 0; j < 16; ++j) { const unsigned c = xb_ld(&bar[XB_XCNT(j)]); sum += c; cnt += (c > 0u) ? 1u : 0u; mine = (j == x) ? c : mine; }
        if (sum == G) break;
        __builtin_amdgcn_s_sleep(1);
        if ((++sp & 255u) == 0u) { if (xb_ld(&bar[XB_TMO])) break; if (sp > XB_SPIN_CAP) { atomicAdd(&bar[XB_TMO], 1u); break; } }
    }
    nloc = mine > 0u ? mine : 1u; nx = cnt > 0u ? cnt : 1u;
}

__device__ __forceinline__ void xcd_barrier(const XcdBarrier& b) {
    asm volatile("s_waitcnt vmcnt(0)" ::: "memory");
    __syncthreads();
    if (threadIdx.x == 0) {
        unsigned* bar = b.bar;
        __builtin_amdgcn_s_waitcnt(0);
        unsigned nloc = b.st[0], nx = b.st[1];
        if (nloc == 0u) { xcd_barrier_complete(bar, b.x, nloc, nx); b.st[0] = nloc; b.st[1] = nx; }
        const unsigned old = xb_add(&bar[XB_XSUB(b.x)], 1u);
        const unsigned gen = old / nloc;
        if (old + 1u == (gen + 1u) * nloc) {
            __builtin_amdgcn_fence(__ATOMIC_RELEASE, "agent");
            asm volatile("s_waitcnt vmcnt(0)" ::: "memory");
            const unsigned og = xb_add(&bar[XB_TOP], 1u);
            const unsigned tg = og / nx;
            if (og + 1u == (tg + 1u) * nx) xb_add(&bar[XB_TOPGEN], 1u);
            else XB_SPIN(xb_ld(&bar[XB_TOPGEN]) == tg, bar);
            __builtin_amdgcn_fence(__ATOMIC_ACQUIRE, "agent");
            xb_add(&bar[XB_XGEN(b.x)], 1u);
            asm volatile("s_waitcnt vmcnt(0)" ::: "memory");
        } else {
            XB_SPIN(xb_ld(&bar[XB_XGEN(b.x)]) == gen, bar);
            __builtin_amdgcn_fence(__ATOMIC_ACQUIRE, "agent");
            asm volatile("s_waitcnt vmcnt(0)" ::: "memory");
        }
    }
    __syncthreads();
}

struct Args {
    const float* in[26]; float* out; unsigned char* ws; int ph_lo, ph_hi;
};
enum { I_X = 0, I_META, I_GMIX, I_WIN, I_CONVW, I_CONVB, I_DTB, I_ALOG, I_DSSD, I_GSSD, I_LRE, I_LIM, I_LSTEP, I_BRE, I_BIM, I_CRE, I_CIM, I_DS5, I_WGLU, I_BGLU, I_GS5, I_WOUT, I_GMLP, I_WUP, I_WDN, I_GFIN };

template <int MODE> __device__ __forceinline__ int colmap(int j) {
    if (MODE == 1) { if (j < 2560) return j; if (j < 3584) return j + 16; if (j < 3600) return j - 1024; return -1; }
    if (MODE == 2) { const int pn = j >> 8, r = j & 255; return r < 128 ? pn * 128 + r : 1024 + pn * 128 + (r - 128); }
    return j;
}
template <int MODE> __device__ __forceinline__ void transpose_item(const float* W, int K, int N, bf16* WT, const float* ks0, const float* ks1, float* scr, int item, int nblk, int lane) {
    const int kb = item / nblk, nb = item % nblk, k0 = 64 * kb, n0 = 32 * nb;
    const int src = colmap<MODE>(n0 + (lane & 31));
#pragma unroll 8
    for (int i = 0; i < 32; ++i) { const int kk = 2 * i + (lane >> 5); const int k = k0 + kk;
        float v = src >= 0 ? W[(size_t)k * N + src] : 0.f;
        if (ks0) v *= (k < 1024 ? ks0[k] : ks1[k - 1024]);
        scr[kk * 33 + (lane & 31)] = v; }
    asm volatile("s_waitcnt lgkmcnt(0)" ::: "memory");
    const int c = lane & 7;
#pragma unroll
    for (int j = 0; j < 4; ++j) { const int n = (lane >> 3) + 8 * j; const float* s = scr + (8 * c) * 33 + n;
        v4u o; o.x = pk2(s[0 * 33], s[1 * 33]); o.y = pk2(s[2 * 33], s[3 * 33]); o.z = pk2(s[4 * 33], s[5 * 33]); o.w = pk2(s[6 * 33], s[7 * 33]);
        *(v4u*)(WT + (size_t)(n0 + n) * K + k0 + 8 * c) = o; }
    asm volatile("s_waitcnt lgkmcnt(0)" ::: "memory");
}

__device__ __forceinline__ void sincos_d(double th, float& sn, float& cs) {
    const double k = rint(th * 0.15915494309189535); const double r = fma(-k, 6.283185307179586, th);
    const double t = r * 0.125, t2 = t * t;
    double s = t * (1.0 + t2 * (-1.0 / 6 + t2 * (1.0 / 120 + t2 * (-1.0 / 5040 + t2 * (1.0 / 362880 + t2 * (-1.0 / 39916800))))));
    double c = 1.0 + t2 * (-0.5 + t2 * (1.0 / 24 + t2 * (-1.0 / 720 + t2 * (1.0 / 40320 + t2 * (-1.0 / 3628800 + t2 * (1.0 / 479001600))))));
#pragma unroll
    for (int i = 0; i < 3; ++i) { const double s2 = 2.0 * s * c, c2 = 1.0 - 2.0 * s * s; s = s2; c = c2; }
    sn = (float)s; cs = (float)c;
}

__device__ __forceinline__ void s5_tables(const Args& a, int g, unsigned char* lds, int tid) {
    f32x2* pw = (f32x2*)lds;
    f32x2* Cc = pw + 17 * 64;
    f32x2* Bb = Cc + 16 * 64;
    float* Kt = (float*)(Bb + 64 * 16);
    unsigned char* ws = a.ws;
    if (tid < 64) {
        const int p = tid; const float lr = a.in[I_LRE][g * 64 + p], li = a.in[I_LIM][g * 64 + p]; const float st = expf(a.in[I_LSTEP][g]);
        float are = 1.f, aim = 0.f;
        for (int tau = 0; tau <= 16; ++tau) {
            const float mag = expf(lr * st * (float)tau); float sn, cs; sincos_d((double)li * (double)st * (double)tau, sn, cs);
            pw[tau * 64 + p] = (f32x2){mag * cs, mag * sn};
            if (tau == 1) { are = mag * cs; aim = mag * sn; ((f32x2*)(ws + WS_A1))[g * 64 + p] = (f32x2){are, aim}; }
            if (tau == 16) ((f32x2*)(ws + WS_A16))[g * 64 + p] = (f32x2){mag * cs, mag * sn};
        }
        const float den = lr * lr + li * li;
        const float cre = ((are - 1.0f) * lr + aim * li) / den, cim = (aim * lr - (are - 1.0f) * li) / den;
        for (int h = 0; h < 16; ++h) { const float br = a.in[I_BRE][(g * 64 + p) * 16 + h], bi = a.in[I_BIM][(g * 64 + p) * 16 + h];
            const f32x2 v = (f32x2){cre * br - cim * bi, cre * bi + cim * br}; Bb[p * 16 + h] = v; ((f32x2*)(ws + WS_BBAR))[(g * 64 + p) * 16 + h] = v; }
    }
    for (int e = tid; e < 1024; e += NT) Cc[e] = (f32x2){a.in[I_CRE][g * 1024 + e], a.in[I_CIM][g * 1024 + e]};
    __syncthreads();
    {
        const int tau = tid >> 5, h = (tid >> 1) & 15, h0 = (tid & 1) * 8; float acc[8];
#pragma unroll
        for (int j = 0; j < 8; ++j) acc[j] = 0.f;
        for (int p = 0; p < 64; ++p) { const f32x2 c = Cc[h * 64 + p], w = pw[tau * 64 + p]; const float tr = c.x * w.x - c.y * w.y, ti = c.x * w.y + c.y * w.x;
#pragma unroll
            for (int j = 0; j < 8; ++j) { const f32x2 b = Bb[p * 16 + h0 + j]; acc[j] += tr * b.x - ti * b.y; } }
        if (tau == 0) {
#pragma unroll
            for (int j = 0; j < 8; ++j) if (h0 + j == h) acc[j] += a.in[I_DS5][g * 16 + h];
        }
#pragma unroll
        for (int j = 0; j < 8; ++j) Kt[(tau * 16 + h) * 16 + h0 + j] = acc[j];
    }
    __syncthreads();
    bf16* TB = (bf16*)(ws + WS_TB5) + (size_t)g * 256 * 384;
    for (int pc = tid; pc < 256 * 48; pc += NT) {
        const int row = pc / 48, c8 = (pc % 48) * 8, t = row >> 4, h = row & 15; float v[8];
        if (c8 < 256) { const int s = c8 >> 4, h0 = c8 & 15;
#pragma unroll
            for (int j = 0; j < 8; ++j) v[j] = s <= t ? Kt[((t - s) * 16 + h) * 16 + h0 + j] : 0.f;
        } else { const int p0 = (c8 - 256) >> 1;
#pragma unroll
            for (int j = 0; j < 4; ++j) { const f32x2 c = Cc[h * 64 + p0 + j], w = pw[(t + 1) * 64 + p0 + j]; v[2 * j] = c.x * w.x - c.y * w.y; v[2 * j + 1] = -(c.x * w.y + c.y * w.x); }
        }
        v4u o; o.x = pk2(v[0], v[1]); o.y = pk2(v[2], v[3]); o.z = pk2(v[4], v[5]); o.w = pk2(v[6], v[7]);
        *(v4u*)(TB + (size_t)row * 384 + c8) = o;
    }
    bf16* TE = (bf16*)(ws + WS_TE5) + (size_t)g * 256 * 256;
    for (int pc = tid; pc < 256 * 32; pc += NT) {
        const int row = pc >> 5, c8 = (pc & 31) * 8; float v[8];
        if (row < 128) { const int p = row >> 1, ri = row & 1, s = c8 >> 4, h0 = c8 & 15; const f32x2 w = pw[(15 - s) * 64 + p];
#pragma unroll
            for (int j = 0; j < 8; ++j) { const f32x2 b = Bb[p * 16 + h0 + j]; v[j] = ri ? (w.x * b.y + w.y * b.x) : (w.x * b.x - w.y * b.y); }
        } else {
#pragma unroll
            for (int j = 0; j < 8; ++j) v[j] = 0.f;
        }
        v4u o; o.x = pk2(v[0], v[1]); o.y = pk2(v[2], v[3]); o.z = pk2(v[4], v[5]); o.w = pk2(v[6], v[7]);
        *(v4u*)(TE + (size_t)row * 256 + c8) = o;
    }
    __syncthreads();
}

__device__ __forceinline__ void rms_row_to_bf16(const float* xrow, const float* gain, bf16* orow, int lane) {
    unsigned long long* o8 = (unsigned long long*)orow + lane;
    if (!xrow) {
#pragma unroll
        for (int j = 0; j < 4; ++j) o8[64 * j] = 0ull;
        return; }
    const f32x4* xr = (const f32x4*)xrow + lane; const f32x4* gr = (const f32x4*)gain + lane;
    f32x4 v[4]; float s = 0.f;
#pragma unroll
    for (int j = 0; j < 4; ++j) { v[j] = xr[64 * j]; s += (v[j].x * v[j].x + v[j].y * v[j].y) + (v[j].z * v[j].z + v[j].w * v[j].w); }
    const float rstd = 1.f / sqrtf(wave_sum(s) * (1.f / 1024.f) + EPS);
#pragma unroll
    for (int j = 0; j < 4; ++j) { const f32x4 gg = gr[64 * j]; const f32x4 w = v[j] * rstd * gg; o8[64 * j] = (unsigned long long)pk2(w.x, w.y) | ((unsigned long long)pk2(w.z, w.w) << 32); }
}

__device__ __forceinline__ void p0_prologue(const Args& a, unsigned char* lds, int tid, int G) {
    unsigned char* ws = a.ws; const int lane = tid & 63, wave = tid >> 6;
    const int gw = blockIdx.x * NWAVES + wave, NGW = G * NWAVES;
    for (int i = blockIdx.x * NT + tid; i < 4 * 16384; i += G * NT) ((float*)(ws + WS_SS))[i] = 0.f;
    for (int g = (G - 1 - (int)blockIdx.x); g < 64; g += G) s5_tables(a, g, lds, tid);
    __syncthreads();
    float* scr = (float*)(lds + wave * 16384);
    constexpr int NB_IN = NIN / 32, NB_GL = 2048 / 32;
    constexpr int I_IN = 16 * NB_IN, I_GL = 16 * NB_GL;
    for (int it = gw; it < I_IN + I_GL; it += NGW) {
        if (it < I_IN) transpose_item<1>(a.in[I_WIN], 1024, 3600, (bf16*)(ws + WS_WIN), nullptr, nullptr, scr, it, NB_IN, lane);
        else transpose_item<2>(a.in[I_WGLU], 1024, 2048, (bf16*)(ws + WS_WGLU), nullptr, nullptr, scr, it - I_IN, NB_GL, lane);
    }
    for (int m = gw; m < MP; m += NGW) {
        const float* src = m < MR ? a.in[I_X] + (size_t)m * 1024 : (m < MR + 16 ? a.in[I_META] + (size_t)(m - MR) * 1024 : nullptr);
        rms_row_to_bf16(src, a.in[I_GMIX], (bf16*)(ws + WS_XN) + (size_t)m * 1024, lane);
    }
}
__device__ __forceinline__ void p6_weights(const Args& a, unsigned char* lds, int tid, int G) {
    unsigned char* ws = a.ws; const int lane = tid & 63, wave = tid >> 6;
    const int gw = blockIdx.x * NWAVES + wave, NGW = G * NWAVES;
    float* scr = (float*)(lds + wave * 16384);
    constexpr int I_O = 32 * 32, I_U = 16 * 128, I_D = 64 * 32;
    for (int it = gw; it < I_O + I_U + I_D; it += NGW) {
        if (it < I_O) transpose_item<0>(a.in[I_WOUT], 2048, 1024, (bf16*)(ws + WS_WOUT), a.in[I_GSSD], a.in[I_GS5], scr, it, 32, lane);
        else if (it < I_O + I_U) transpose_item<0>(a.in[I_WUP], 1024, 4096, (bf16*)(ws + WS_WUP), a.in[I_GMLP], a.in[I_GMLP], scr, it - I_O, 128, lane);
        else transpose_item<0>(a.in[I_WDN], 4096, 1024, (bf16*)(ws + WS_WDN), nullptr, nullptr, scr, it - I_O - I_U, 32, lane);
    }
    __syncthreads();
}

__device__ __forceinline__ int chunk_row(int q, int tok) {
    if (q == 0) return tok < 240 ? -1 : MR + (tok - 240);
    const int b = (q - 1) >> 5, c = (q - 1) & 31;
    if (tok < 0 && c == 0) return MR + 16 + tok;
    return b * 8192 + c * 256 + tok;
}
__device__ __forceinline__ float silu_(float x) { return x * __builtin_amdgcn_rcpf(1.0f + ex2(-1.44269504f * x)); }
__device__ __forceinline__ void p2_conv_unit(const Args& a, int q, int blk, unsigned char* lds, int tid) {
    unsigned char* ws = a.ws;
    bf16* IN = (bf16*)lds;
    bf16* OT = (bf16*)(lds + 40960);
    const bf16* XBCP = (const bf16*)(ws + WS_XBCP);
    const int ch0 = blk * 64;
    for (int pc = tid; pc < 259 * 8; pc += NT) { const int rr = pc >> 3, c8 = (pc & 7) * 8; const int row = chunk_row(q, rr - 3);
        v4u v = (v4u){0u, 0u, 0u, 0u}; if (row >= 0) v = *(const v4u*)(XBCP + (size_t)row * 1536 + ch0 + c8);
        *(v4u*)(IN + rr * 64 + c8) = v; }
    __syncthreads();
    const float* cw = a.in[I_CONVW]; const float* cb = a.in[I_CONVB];
    const bool is_x = blk < 16, is_b = blk >= 16 && blk < 20;
    if (!is_x) {
        bf16* dst = (bf16*)(ws + (is_b ? WS_BTK : WS_CT)) + (size_t)q * 65536 + (is_b ? (blk - 16) : (blk - 20)) * 64;
        for (int pc = tid; pc < 256 * 8; pc += NT) { const int tok = pc >> 3, c8 = (pc & 7) * 8; float o[8];
            const bool zero = (q == 0 && tok < 240);
#pragma unroll
            for (int j = 0; j < 8; ++j) o[j] = cb[ch0 + c8 + j];
#pragma unroll
            for (int k = 0; k < 4; ++k) { const v4u v = *(const v4u*)(IN + (tok + k) * 64 + c8); const unsigned w[4] = {v.x, v.y, v.z, v.w};
#pragma unroll
                for (int j = 0; j < 4; ++j) { o[2 * j] += cw[k * 1536 + ch0 + c8 + 2 * j] * bflo(w[j]); o[2 * j + 1] += cw[k * 1536 + ch0 + c8 + 2 * j + 1] * bfhi(w[j]); } }
#pragma unroll
            for (int j = 0; j < 8; ++j) o[j] = zero ? 0.f : silu_(o[j]);
            v4u ov; ov.x = pk2(o[0], o[1]); ov.y = pk2(o[2], o[3]); ov.z = pk2(o[4], o[5]); ov.w = pk2(o[6], o[7]);
            *(v4u*)(dst + (size_t)tok * 256 + c8) = ov; }
    }
    if (is_x || is_b) {
        for (int it = tid; it < 64 * 32; it += NT) { const int ch = it & 63, t0 = (it >> 6) * 8; float wk[4], in[11], o[8]; const float bias = cb[ch0 + ch];
#pragma unroll
            for (int k = 0; k < 4; ++k) wk[k] = cw[k * 1536 + ch0 + ch];
#pragma unroll
            for (int j = 0; j < 11; ++j) in[j] = bf2f(IN[(t0 + j) * 64 + ch]);
#pragma unroll
            for (int j = 0; j < 8; ++j) { const float v = bias + wk[0] * in[j] + wk[1] * in[j + 1] + wk[2] * in[j + 2] + wk[3] * in[j + 3]; o[j] = (q == 0 && t0 + j < 240) ? 0.f : silu_(v); }
            v4u ov; ov.x = pk2(o[0], o[1]); ov.y = pk2(o[2], o[3]); ov.z = pk2(o[4], o[5]); ov.w = pk2(o[6], o[7]);
            *(v4u*)(OT + ch * 264 + t0) = ov; }
        __syncthreads();
        bf16* dst = is_x ? (bf16*)(ws + WS_XF) + ((size_t)q * 1024 + ch0) * 256 : (bf16*)(ws + WS_BF) + ((size_t)q * 256 + (blk - 16) * 64) * 256;
        for (int pc = tid; pc < 64 * 32; pc += NT) { const int ch = pc >> 5, t8 = (pc & 31) * 8; *(v4u*)(dst + (size_t)ch * 256 + t8) = *(const v4u*)(OT + ch * 264 + t8); }
    }
    __syncthreads();
}
__device__ __forceinline__ void p2_dt_item(const Args& a, int q, int h, int lane) {
    unsigned char* ws = a.ws; const float* DTRAW = (const float*)(ws + WS_DTRAW);
    const float bias = a.in[I_DTB][h], A = -expf(a.in[I_ALOG][h]);
    float dt[4], cs[4]; float run = 0.f;
#pragma unroll
    for (int j = 0; j < 4; ++j) { const int tok = 4 * lane + j; const int row = chunk_row(q, tok);
        float d = 0.f; if (row >= 0) { const float x = DTRAW[(size_t)row * 16 + h] + bias; d = fmaxf(x, 0.f) + __logf(1.0f + expf_(-fabsf(x))); }
        dt[j] = d; run += d * A; cs[j] = run; }
    float incl = run;
#pragma unroll
    for (int o = 1; o < 64; o <<= 1) { const float t = __shfl_up(incl, o); if (lane >= o) incl += t; }
    const float excl = incl - run;
    float* DT = (float*)(ws + WS_DT) + ((size_t)q * 16 + h) * 256 + 4 * lane; float* ACS = (float*)(ws + WS_ACS) + ((size_t)q * 16 + h) * 256 + 4 * lane;
    *(f32x4*)DT = (f32x4){dt[0], dt[1], dt[2], dt[3]}; *(f32x4*)ACS = (f32x4){cs[0] + excl, cs[1] + excl, cs[2] + excl, cs[3] + excl};
    if (lane == 63) ((float*)(ws + WS_DEC))[q * 16 + h] = expf_(cs[3] + excl);
}

#define MFMA16(A, B, C) __builtin_amdgcn_mfma_f32_16x16x32_bf16(A, B, C, 0, 0, 0)
__device__ __forceinline__ void p3_states_unit(const Args& a, int q, int g, int tid) {
    unsigned char* ws = a.ws; const int lane = tid & 63, r = tid >> 6, h = g * 8 + r, fr = lane & 15, fq = lane >> 4;
    const bf16* XF = (const bf16*)(ws + WS_XF) + ((size_t)q * 1024 + h * 64) * 256;
    const bf16* BF = (const bf16*)(ws + WS_BF) + ((size_t)q * 256 + g * 128) * 256;
    const float* DT = (const float*)(ws + WS_DT) + ((size_t)q * 16 + h) * 256; const float* ACS = (const float*)(ws + WS_ACS) + ((size_t)q * 16 + h) * 256;
    const float alast = ACS[255];
    bf16* ST = (bf16*)(ws + WS_ST) + ((size_t)q * 16 + h) * 8192;
#pragma unroll 1
    for (int nh = 0; nh < 2; ++nh) {
        f32x4 acc[4][4];
#pragma unroll
        for (int i = 0; i < 4; ++i)
#pragma unroll
            for (int j = 0; j < 4; ++j) acc[i][j] = (f32x4){0.f, 0.f, 0.f, 0.f};
#pragma unroll 1
        for (int kb = 0; kb < 8; ++kb) {
            const int s0 = kb * 32 + fq * 8;
            float w[8];
            { const f32x4 d0 = *(const f32x4*)(DT + s0), d1 = *(const f32x4*)(DT + s0 + 4), c0 = *(const f32x4*)(ACS + s0), c1 = *(const f32x4*)(ACS + s0 + 4);
#pragma unroll
              for (int j = 0; j < 4; ++j) { w[j] = expf_(alast - c0[j]) * d0[j]; w[4 + j] = expf_(alast - c1[j]) * d1[j]; } }
            bf16x8 Af[4], Bf[4];
#pragma unroll
            for (int i = 0; i < 4; ++i) { const v4u v = *(const v4u*)(XF + (size_t)(i * 16 + fr) * 256 + s0);
                v4u o; o.x = pk2(bflo(v.x) * w[0], bfhi(v.x) * w[1]); o.y = pk2(bflo(v.y) * w[2], bfhi(v.y) * w[3]); o.z = pk2(bflo(v.z) * w[4], bfhi(v.z) * w[5]); o.w = pk2(bflo(v.w) * w[6], bfhi(v.w) * w[7]);
                Af[i] = __builtin_bit_cast(bf16x8, o); }
#pragma unroll
            for (int j = 0; j < 4; ++j) Bf[j] = *(const bf16x8*)(BF + (size_t)((nh * 4 + j) * 16 + fr) * 256 + s0);
#pragma unroll
            for (int i = 0; i < 4; ++i)
#pragma unroll
                for (int j = 0; j < 4; ++j) acc[i][j] = MFMA16(Af[i], Bf[j], acc[i][j]);
        }
#pragma unroll
        for (int i = 0; i < 4; ++i)
#pragma unroll
            for (int j = 0; j < 4; ++j)
#pragma unroll
                for (int e = 0; e < 4; ++e) ST[(i * 16 + fq * 4 + e) * 128 + (nh * 4 + j) * 16 + fr] = (bf16)f2bf(acc[i][j][e]);
    }
}

__device__ __forceinline__ void p4_ssd_scan_item(const Args& a, int item, int tid) {
    unsigned char* ws = a.ws; const int e = item * 2048 + tid * 4;
    const int b = e >> 17, hpn = e & 131071, h = hpn >> 13;
    const bf16* ST = (const bf16*)(ws + WS_ST); bf16* PREV = (bf16*)(ws + WS_PREV); const float* DEC = (const float*)(ws + WS_DEC);
    v2u v = *(const v2u*)(ST + hpn);
    float s0 = bflo(v.x), s1 = bfhi(v.x), s2 = bflo(v.y), s3 = bfhi(v.y);
    for (int c = 0; c < 32; ++c) {
        const int q = 1 + b * 32 + c;
        v2u o; o.x = pk2(s0, s1); o.y = pk2(s2, s3); *(v2u*)(PREV + (size_t)(b * 32 + c) * 131072 + hpn) = o;
        const float d = DEC[q * 16 + h]; v = *(const v2u*)(ST + (size_t)q * 131072 + hpn);
        s0 = s0 * d + bflo(v.x); s1 = s1 * d + bfhi(v.x); s2 = s2 * d + bflo(v.y); s3 = s3 * d + bfhi(v.y);
    }
}
__device__ __forceinline__ void p4_s5_scan_item(const Args& a, int item, int tid) {
    unsigned char* ws = a.ws; const int e = item * NT + tid;
    const int b = e >> 12, g = (e >> 6) & 63, p = e & 63;
    const f32x2 a1 = ((const f32x2*)(ws + WS_A1))[g * 64 + p], a16 = ((const f32x2*)(ws + WS_A16))[g * 64 + p];
    const f32x2* Bb = (const f32x2*)(ws + WS_BBAR) + (size_t)(g * 64 + p) * 16;
    const bf16* UM = (const bf16*)(ws + WS_UMETA);
    float sr = 0.f, si = 0.f;
    for (int s = 0; s < 16; ++s) { float br = 0.f, bi = 0.f;
#pragma unroll
        for (int h = 0; h < 16; ++h) { const float u = bf2f(UM[s * 1024 + g * 16 + h]); const f32x2 bb = Bb[h]; br += bb.x * u; bi += bb.y * u; }
        const float nr = a1.x * sr - a1.y * si + br, ni = a1.x * si + a1.y * sr + bi; sr = nr; si = ni; }
    const f32x2* SE = (const f32x2*)(ws + WS_SEND) + ((size_t)(g * 1024 + b * 512) * 64 + p);
    unsigned* UA = (unsigned*)((bf16*)(ws + WS_UA) + ((size_t)(g * 1024 + b * 512) * 384 + 256 + 2 * p));
    for (int c0 = 0; c0 < 512; c0 += 8) {
        f32x2 se[8];
#pragma unroll
        for (int j = 0; j < 8; ++j) se[j] = SE[(size_t)(c0 + j) * 64];
#pragma unroll
        for (int j = 0; j < 8; ++j) { UA[(size_t)(c0 + j) * 192] = pk2(sr, si);
            const float nr = a16.x * sr - a16.y * si + se[j].x, ni = a16.x * si + a16.y * sr + se[j].y; sr = nr; si = ni; }
    }
}

__device__ __forceinline__ void p5_ssd_out_unit(const Args& a, int q, int g, unsigned char* lds, int tid) {
    unsigned char* ws = a.ws; const int lane = tid & 63, r = tid >> 6, h = g * 8 + r, fr = lane & 15, fq = lane >> 4;
    bf16* CBs = (bf16*)lds;
    float* ACSs = (float*)(lds + 256 * 264 * 2);
    float* DTs = ACSs + 8 * 256;
    const bf16* CT = (const bf16*)(ws + WS_CT) + (size_t)q * 65536 + g * 128;
    const bf16* BTK = (const bf16*)(ws + WS_BTK) + (size_t)q * 65536 + g * 128;
    for (int i = tid; i < 2048; i += NT) { ACSs[i] = ((const float*)(ws + WS_ACS))[((size_t)q * 16 + g * 8) * 256 + i]; DTs[i] = ((const float*)(ws + WS_DT))[((size_t)q * 16 + g * 8) * 256 + i]; }
#pragma unroll 1
    for (int half = 0; half < 2; ++half) {
        const int lt = half ? 15 - r : r;
        bf16x8 Af[4];
#pragma unroll
        for (int k = 0; k < 4; ++k) Af[k] = *(const bf16x8*)(CT + (size_t)(lt * 16 + fr) * 256 + k * 32 + fq * 8);
        for (int stl = 0; stl <= lt; ++stl) {
            f32x4 c = (f32x4){0.f, 0.f, 0.f, 0.f};
#pragma unroll
            for (int k = 0; k < 4; ++k) { const bf16x8 Bf = *(const bf16x8*)(BTK + (size_t)(stl * 16 + fr) * 256 + k * 32 + fq * 8); c = MFMA16(Af[k], Bf, c); }
#pragma unroll
            for (int e = 0; e < 4; ++e) CBs[(lt * 16 + fq * 4 + e) * 264 + stl * 16 + fr] = (bf16)f2bf(c[e]);
        }
    }
    __syncthreads();
    const bf16* XF = (const bf16*)(ws + WS_XF) + ((size_t)q * 1024 + h * 64) * 256;
    const bf16* PREV = (const bf16*)(ws + WS_PREV) + ((size_t)(q - 1) * 16 + h) * 8192;
    const float* acs = ACSs + r * 256; const float* dts = DTs + r * 256;
    const float dsk = a.in[I_DSSD][h];
    const int b = (q - 1) >> 5, c = (q - 1) & 31; const int m0 = b * 8192 + c * 256;
    bf16* MIX = (bf16*)(ws + WS_MIX); float* SSS = (float*)(ws + WS_SS);
#pragma unroll 1
    for (int lb = 0; lb < 4; ++lb) {
        f32x4 acc[4][4];
#pragma unroll
        for (int i = 0; i < 4; ++i)
#pragma unroll
            for (int j = 0; j < 4; ++j) acc[i][j] = (f32x4){0.f, 0.f, 0.f, 0.f};
#pragma unroll 1
        for (int k = 0; k < 4; ++k) { bf16x8 Af[4], Bf[4];
#pragma unroll
            for (int i = 0; i < 4; ++i) Af[i] = *(const bf16x8*)(CT + (size_t)(lb * 64 + i * 16 + fr) * 256 + k * 32 + fq * 8);
#pragma unroll
            for (int j = 0; j < 4; ++j) Bf[j] = *(const bf16x8*)(PREV + (size_t)(j * 16 + fr) * 128 + k * 32 + fq * 8);
#pragma unroll
            for (int i = 0; i < 4; ++i)
#pragma unroll
                for (int j = 0; j < 4; ++j) acc[i][j] = MFMA16(Af[i], Bf[j], acc[i][j]); }
#pragma unroll
        for (int i = 0; i < 4; ++i)
#pragma unroll
            for (int e = 0; e < 4; ++e) { const float sc = expf_(acs[lb * 64 + i * 16 + fq * 4 + e]);
#pragma unroll
                for (int j = 0; j < 4; ++j) acc[i][j][e] *= sc; }
        const int nsb = 2 * lb + 2;
#pragma unroll 1
        for (int sb = 0; sb < nsb; ++sb) {
            const int s0 = sb * 32 + fq * 8;
            bf16x8 Bf[4];
#pragma unroll
            for (int j = 0; j < 4; ++j) Bf[j] = *(const bf16x8*)(XF + (size_t)(j * 16 + fr) * 256 + s0);
            float as[8], ds[8];
#pragma unroll
            for (int j = 0; j < 8; ++j) { as[j] = acs[s0 + j]; ds[j] = dts[s0 + j]; }
#pragma unroll
            for (int i = 0; i < 4; ++i) {
                const int l = lb * 64 + i * 16 + fr;
                if (sb * 32 > lb * 64 + i * 16 + 15) continue;
                const float al = acs[l];
                const v4u v = *(const v4u*)(CBs + l * 264 + s0); const unsigned w4[4] = {v.x, v.y, v.z, v.w}; float pv[8];
#pragma unroll
                for (int j = 0; j < 4; ++j) {
                    const float p0 = bflo(w4[j]) * expf_(fminf(al - as[2 * j], 0.f)) * ds[2 * j], p1 = bfhi(w4[j]) * expf_(fminf(al - as[2 * j + 1], 0.f)) * ds[2 * j + 1];
                    pv[2 * j] = (s0 + 2 * j <= l) ? p0 : 0.f; pv[2 * j + 1] = (s0 + 2 * j + 1 <= l) ? p1 : 0.f; }
                v4u o; o.x = pk2(pv[0], pv[1]); o.y = pk2(pv[2], pv[3]); o.z = pk2(pv[4], pv[5]); o.w = pk2(pv[6], pv[7]);
                const bf16x8 Af = __builtin_bit_cast(bf16x8, o);
#pragma unroll
                for (int j = 0; j < 4; ++j) acc[i][j] = MFMA16(Af, Bf[j], acc[i][j]);
            }
        }
#pragma unroll
        for (int i = 0; i < 4; ++i) {
            const int l0 = lb * 64 + i * 16 + fq * 4; float ssq[4] = {0.f, 0.f, 0.f, 0.f};
#pragma unroll
            for (int j = 0; j < 4; ++j) {
                const int p = j * 16 + fr; const v2u xv = *(const v2u*)(XF + (size_t)p * 256 + l0);
                const float xs[4] = {bflo(xv.x), bfhi(xv.x), bflo(xv.y), bfhi(xv.y)};
#pragma unroll
                for (int e = 0; e < 4; ++e) { bf16* zp = MIX + (size_t)(m0 + l0 + e) * 2048 + h * 64 + p; const float z = bf2f(*zp);
                    const float y = (acc[i][j][e] + dsk * xs[e]) * silu_(z); *zp = (bf16)f2bf(y); ssq[e] += y * y; }
            }
#pragma unroll
            for (int e = 0; e < 4; ++e) { float s = ssq[e]; s += __shfl_xor(s, 1); s += __shfl_xor(s, 2); s += __shfl_xor(s, 4); s += __shfl_xor(s, 8);
                if (fr == 0) atomicAdd(SSS + m0 + l0 + e, s); }
        }
    }
    __syncthreads();
}

__device__ __forceinline__ void p10_final(const Args& a, int tid, int G) {
    const int lane = tid & 63, wave = tid >> 6; const int gw = blockIdx.x * NWAVES + wave, NGW = G * NWAVES;
    const float* SSF = (const float*)(a.ws + WS_SS) + 3 * 16384; const f32x4* gf = (const f32x4*)a.in[I_GFIN] + lane;
    for (int m = gw; m < MR; m += NGW) { f32x4* row = (f32x4*)(a.out + (size_t)m * 1024) + lane; const float rs = 1.0f / sqrtf(SSF[m] * (1.0f / 1024.0f) + EPS);
#pragma unroll
        for (int j = 0; j < 4; ++j) row[64 * j] = row[64 * j] * rs * gf[64 * j]; }
}

__global__ void __launch_bounds__(NT, 2) fwd_kernel(Args args) {
    extern __shared__ __attribute__((aligned(16))) unsigned char lds[];
    cg::grid_group grid = cg::this_grid();
    const int tid = threadIdx.x, G = gridDim.x, bx = blockIdx.x;
    unsigned char* ws = args.ws;
    PG8_LAS unsigned char* ldsl = (PG8_LAS unsigned char*)lds;
    const int lo = args.ph_lo, hi = args.ph_hi;
#ifndef SKIPMASK
#define SKIPMASK 0
#endif
#define IN(k) (!((SKIPMASK >> (k)) & 1) && lo <= (k) && (k) < hi)
    volatile LAS unsigned* bst = (volatile LAS unsigned*)(ldsl + 155136);
    if (tid < 2) bst[tid] = 0u;
    __syncthreads();
    XcdBarrier xbar = xcd_barrier_post((unsigned*)(ws + WS_BAR), bst);
#define SEAM(k) do { if (IN(k) && IN((k) + 1)) { if ((k) == 0) grid.sync(); else xcd_barrier(xbar); } } while (0)
    float* SS = (float*)(ws + WS_SS);
    if (IN(0)) { const int tid = pg8::fresh_tid(); p0_prologue(args, lds, tid, G); }
    SEAM(0);
    if (IN(1)) {
        pg8::Gemm g{(const bf16*)(ws + WS_XN), (const bf16*)(ws + WS_WIN), MP, NIN, 1024, 1024, 1024, 0, 0}; pg8::StaticOrder S; S.init(MP, NIN, G, bx);
        pg8::EpiInProj E{(bf16*)(ws + WS_MIX), (bf16*)(ws + WS_XBCP), (bf16*)(ws + WS_UA), (bf16*)(ws + WS_UMETA), (float*)(ws + WS_DTRAW)};
        pg8::gemm_phase<pg8::EpiInProj, pg8::StaticOrder, true, true>(ldsl, g, S, E);
    }
    SEAM(1);
    if (IN(2)) {
        const int tid = pg8::fresh_tid(), wave = tid >> 6, lane = tid & 63;
        for (int u = bx; u < NQ * 24; u += G) p2_conv_unit(args, u / 24, u % 24, lds, tid);
        for (int it = bx * NWAVES + wave; it < NQ * 16; it += G * NWAVES) p2_dt_item(args, it >> 4, it & 15, lane);
    }
    SEAM(2);
    const int nS3 = (G / 2 < 130) ? G / 2 : 130;
    if (IN(3)) {
        const int tid = pg8::fresh_tid();
        if (bx < nS3) { for (int u = bx; u < 130; u += nS3) p3_states_unit(args, u >> 1, u & 1, tid); }
        pg8::Gemm g{(const bf16*)(ws + WS_UA), (const bf16*)(ws + WS_TE5), 1024, 256, 256, 384, 256, (size_t)1024 * 384 * 2, (size_t)256 * 256 * 2};
        pg8::BatchOrder S; S.init(256, 4, G, nS3, bx);
        pg8::EpiS5a E{(float*)(ws + WS_SEND)};
        pg8::gemm_phase<pg8::EpiS5a, pg8::BatchOrder, true, true>(ldsl, g, S, E);
    }
    SEAM(3);
    if (IN(4)) {
        const int tid = pg8::fresh_tid();
        for (int it = bx; it < 144; it += G) { if (it < 128) p4_ssd_scan_item(args, it, tid); else p4_s5_scan_item(args, it - 128, tid); }
    }
    SEAM(4);
    const int nS5 = (G / 2 < 128) ? G / 2 : 128;
    if (IN(5)) {
        const int tid = pg8::fresh_tid();
#ifndef NO_SSDOUT
        if (bx < nS5) { for (int u = bx; u < 128; u += nS5) p5_ssd_out_unit(args, 1 + (u >> 1), u & 1, lds, tid); }
#endif
        pg8::Gemm g{(const bf16*)(ws + WS_UA), (const bf16*)(ws + WS_TB5), 1024, 256, 384, 384, 384, (size_t)1024 * 384 * 2, (size_t)256 * 384 * 2};
        pg8::BatchOrder S; S.init(256, 4, G, nS5, bx);
        pg8::EpiS5b E{(bf16*)(ws + WS_Y5)};
        pg8::gemm_phase<pg8::EpiS5b, pg8::BatchOrder, true, true>(ldsl, g, S, E);
    }
    SEAM(5);
    if (IN(6)) {
        const int tid = pg8::fresh_tid();
        p6_weights(args, lds, tid, G);
        pg8::Gemm g{(const bf16*)(ws + WS_Y5), (const bf16*)(ws + WS_WGLU), MR, 2048, 1024, 1024, 1024, 0, 0}; pg8::StaticOrder S; S.init(MR, 2048, G, bx);
        pg8::EpiGlu E{(bf16*)(ws + WS_MIX), args.in[I_BGLU], SS + 16384};
        pg8::gemm_phase<pg8::EpiGlu, pg8::StaticOrder, true, true>(ldsl, g, S, E);
    }
    SEAM(6);
    if (IN(7)) {
        pg8::StaticOrder S; S.init(MR, 1024, G, bx);
        { pg8::Gemm g{(const bf16*)(ws + WS_MIX), (const bf16*)(ws + WS_WOUT), MR, 1024, 1024, 2048, 2048, 0, 0};
          pg8::EpiOut<false> E{args.in[I_X], args.out, (bf16*)(ws + WS_H1B), SS, SS + 2 * 16384};
          pg8::gemm_phase<pg8::EpiOut<false>, pg8::StaticOrder, true, true>(ldsl, g, S, E); }
        { pg8::Gemm g{(const bf16*)(ws + WS_MIX) + 1024, (const bf16*)(ws + WS_WOUT) + 1024, MR, 1024, 1024, 2048, 2048, 0, 0};
          pg8::EpiOut<true> E{args.out, args.out, (bf16*)(ws + WS_H1B), SS + 16384, SS + 2 * 16384};
          pg8::gemm_phase<pg8::EpiOut<true>, pg8::StaticOrder, true, true>(ldsl, g, S, E); }
    }
    SEAM(7);
    if (IN(8)) {
        pg8::Gemm g{(const bf16*)(ws + WS_H1B), (const bf16*)(ws + WS_WUP), MR, 4096, 1024, 1024, 1024, 0, 0}; pg8::StaticOrder S; S.init(MR, 4096, G, bx);
        pg8::EpiUp E{(bf16*)(ws + WS_HB), SS + 2 * 16384};
        pg8::gemm_phase<pg8::EpiUp, pg8::StaticOrder, true, true>(ldsl, g, S, E);
    }
    SEAM(8);
    if (IN(9)) {
        pg8::Gemm g{(const bf16*)(ws + WS_HB), (const bf16*)(ws + WS_WDN), MR, 1024, 4096, 4096, 4096, 0, 0}; pg8::StaticOrder S; S.init(MR, 1024, G, bx);
        pg8::EpiDown E{args.out, SS + 3 * 16384};
        pg8::gemm_phase<pg8::EpiDown, pg8::StaticOrder, true, true>(ldsl, g, S, E);
    }
    SEAM(9);
    if (IN(10)) { const int tid = pg8::fresh_tid(); p10_final(args, tid, G); }
#undef IN
#undef SEAM
}

#ifndef N_LAUNCHES
#define N_LAUNCHES 1
#endif
extern "C" void kernel_launch(void* const* d_in, const int* in_sizes, int n_in, void* d_out, int out_size, void* d_ws, size_t ws_size, hipStream_t stream) {
    static int grid = 0;
    if (grid == 0) {
        int dev = 0, cus = 0, per_cu = 0;
        hipGetDevice(&dev); hipDeviceGetAttribute(&cus, hipDeviceAttributeMultiprocessorCount, dev);
        hipFuncSetAttribute((const void*)fwd_kernel, hipFuncAttributeMaxDynamicSharedMemorySize, LDS_BYTES);
        hipOccupancyMaxActiveBlocksPerMultiprocessor(&per_cu, (const void*)fwd_kernel, NT, LDS_BYTES);
        if (per_cu < 1) { fprintf(stderr, "occupancy query says %d blocks per CU\n", per_cu); per_cu = 1; }
        grid = cus * 1;
        (void)hipGetLastError();
    }
    hipMemsetAsync((char*)d_ws + WS_BAR, 0, 16384, stream);
    Args a{};
    for (int i = 0; i < 26; ++i) a.in[i] = (const float*)d_in[i];
    a.out = (float*)d_out; a.ws = (unsigned char*)d_ws;
    if (N_LAUNCHES == 1) {
        a.ph_lo = 0; a.ph_hi = 11;
        void* args[] = {&a};
        hipError_t e = hipLaunchCooperativeKernel((const void*)fwd_kernel, dim3(grid), dim3(NT), args, LDS_BYTES, stream);
        if (e != hipSuccess) fprintf(stderr, "cooperative launch failed: %s (grid %d)\n", hipGetErrorString(e), grid);
    } else {
        for (int p = 0; p < 11; ++p) { a.ph_lo = p; a.ph_hi = p + 1; hipLaunchKernelGGL(fwd_kernel, dim3(grid), dim3(NT), LDS_BYTES, stream, a); }
    }
}
```

```cpp
#include <hip/hip_runtime.h>
#include <cstdio>
#include <cstdint>
namespace pg8 {
#define PG8_LAS __attribute__((address_space(3)))
typedef unsigned short bf16_t;
typedef short bf16x8 __attribute__((ext_vector_type(8)));
typedef float f32x4 __attribute__((ext_vector_type(4)));
typedef unsigned u32x4 __attribute__((ext_vector_type(4)));
constexpr int BM = 256, BK = 64, HALF = 128, HTB = HALF * BK * 2  , STAGE_BYTES = 8 * HTB, NXCD = 8, WGM = 8;

__host__ __device__ __forceinline__ int lds_byte(int r, int c) { const int st = (r >> 4) * 2 + (c >> 5), rr = r & 15, cc = c & 31, ob = rr * 64 + cc * 2; return st * 1024 + (ob ^ (((ob >> 9) & 1) << 5)); }
__host__ __device__ __forceinline__ void stage_rc(int b, int& R, int& C) { const int st = b / 1024, sb = b % 1024, swz = sb ^ (((sb >> 9) & 1) << 5); R = (st >> 1) * 16 + swz / 64; C = (st & 1) * 32 + (swz % 64) / 2; }
__host__ __device__ __forceinline__ int perm32(int rho) { const int n = rho >> 4, i = rho & 15; return 8 * (i >> 2) + 4 * n + (i & 3); }

struct Unit { int pm, pn, g, par; };
struct Gemm { const bf16_t* A; const bf16_t* Bt; int M, N, K, lda, ldb; size_t gsA, gsB; };

struct StaticOrder {
    int nM, nN, nwg, G, c;
    __host__ __device__ void init(int M, int N, int G_, int c_) { nM = M / BM; nN = N / BM; nwg = nM * nN; G = G_; c = c_; }
    __host__ __device__ bool next(int i, Unit& u) const {
        const long L = (long)i * G + c; if (L >= nwg) return false;
        int wgid = (int)L; { const int q = nwg / NXCD, r = nwg % NXCD, xcd = wgid % NXCD, off = wgid / NXCD; wgid = (xcd < r ? xcd * (q + 1) : r * (q + 1) + (xcd - r) * q) + off; }
        const int nig = WGM * nN, gid = wgid / nig, fm = gid * WGM, gsz = (nM - fm) < WGM ? (nM - fm) : WGM;
        u.pm = fm + ((wgid % nig) % gsz); u.pn = (wgid % nig) / gsz; u.g = 0; u.par = i & 1; return true;
    }
    __device__ __forceinline__ void a_ready(const Unit&) const {}
    __device__ __forceinline__ void done(const Unit&) const {}
};

__device__ __forceinline__ unsigned cvt_pk_bf16(float lo, float hi) { unsigned r; asm volatile("v_cvt_pk_bf16_f32 %0, %1, %2" : "=v"(r) : "v"(lo), "v"(hi)); return r; }
typedef float f32x2 __attribute__((ext_vector_type(2)));
__device__ __forceinline__ f32x2 gelu_pk(f32x2 v) {
    const f32x2 av = __builtin_elementwise_abs(v), d = av * 0.2316418882f + 1.0f;
    f32x2 t; t.x = __builtin_amdgcn_rcpf(d.x); t.y = __builtin_amdgcn_rcpf(d.y);
    f32x2 q = t * 0.5307027145f + (-0.7265760135f); q = q * t + 0.7107068705f; q = q * t + (-0.142248368f); q = q * t + 0.127414796f; q = q * t;
    const f32x2 s = (v * v) * (-0.72134752044f);
    f32x2 e; e.x = __builtin_amdgcn_exp2f(s.x); e.y = __builtin_amdgcn_exp2f(s.y);
    const f32x2 m = v * (q * e), r = v - m;
    f32x2 o; o.x = v.x < 0.f ? m.x : r.x; o.y = v.y < 0.f ? m.y : r.y; return o;
}

__device__ __forceinline__ int fresh_tid() { int t; asm volatile("v_mov_b32 %0, %1" : "=v"(t) : "v"((int)threadIdx.x)); return t; }
#define EPI_ROWS_COLS const int rowb = u.pm * BM + wr * 64 + fr; const int colb = wc * 32 + 8 * fq;
__device__ __forceinline__ u32x4 pack8(const f32x4 v0, const f32x4 v1) { u32x4 w; w.x = cvt_pk_bf16(v0[0], v0[1]); w.y = cvt_pk_bf16(v0[2], v0[3]); w.z = cvt_pk_bf16(v1[0], v1[1]); w.w = cvt_pk_bf16(v1[2], v1[3]); return w; }
__device__ __forceinline__ float sum8sq(const f32x4 a, const f32x4 b) { return (a[0] * a[0] + a[1] * a[1]) + (a[2] * a[2] + a[3] * a[3]) + (b[0] * b[0] + b[1] * b[1]) + (b[2] * b[2] + b[3] * b[3]); }

struct EpiInProj {
    static constexpr bool PERM = true, AFTER_DRAIN = false, HAS_MID = false;
    bf16_t* MIX; bf16_t* XBCP; bf16_t* UA; bf16_t* UMETA; float* DTRAW;
    __device__ __forceinline__ void operator()(const f32x4 (&acc)[2][2][4][2], const Unit& u, int wr, int wc, int fr, int fq) const {
        EPI_ROWS_COLS
        const int pn = u.pn;
#pragma unroll
        for (int ai = 0; ai < 2; ++ai)
#pragma unroll
            for (int m = 0; m < 4; ++m) {
                const int r = rowb + ai * HALF + m * 16;
#pragma unroll
                for (int bj = 0; bj < 2; ++bj) {
                    const int c = pn * BM + bj * HALF + colb;
                    const f32x4 v0 = acc[ai][bj][m][0], v1 = acc[ai][bj][m][1];
                    if (pn < 4) { if (r < 16384) *(u32x4*)(MIX + (size_t)r * 2048 + c) = pack8(v0, v1); }
                    else if (pn < 10) { *(u32x4*)(XBCP + (size_t)r * 1536 + (c - 1024)) = pack8(v0, v1); }
                    else if (pn < 14) {
                        const int j = c - 2560, g = j >> 4, h0 = j & 15;
                        if (r < 16384) { const int b = r >> 13, tok = r & 8191, ch = tok >> 4, t = tok & 15;
                            *(u32x4*)(UA + ((size_t)(g * 1024 + b * 512 + ch) * 384 + t * 16 + h0)) = pack8(v0, v1); }
                        else *(u32x4*)(UMETA + (size_t)(r - 16384) * 1024 + j) = pack8(v0, v1);
                    } else {
                        const int j = c - 3584;
                        if (j < 16) { float* d = DTRAW + (size_t)r * 16 + j; *(f32x4*)d = v0; *(f32x4*)(d + 4) = v1; }
                    }
                }
            }
    }
};
struct EpiS5a {
    static constexpr bool PERM = true, AFTER_DRAIN = false, HAS_MID = false;
    float* SEND;
    __device__ __forceinline__ void operator()(const f32x4 (&acc)[2][2][4][2], const Unit& u, int wr, int wc, int fr, int fq) const {
        EPI_ROWS_COLS
#pragma unroll
        for (int ai = 0; ai < 2; ++ai)
#pragma unroll
            for (int m = 0; m < 4; ++m) {
                const int r = rowb + ai * HALF + m * 16;
                float* d = SEND + ((size_t)(u.g * 1024 + r) * 128 + colb);
                *(f32x4*)d = acc[ai][0][m][0]; *(f32x4*)(d + 4) = acc[ai][0][m][1];
            }
    }
};
struct EpiS5b {
    static constexpr bool PERM = true, AFTER_DRAIN = false, HAS_MID = false;
    bf16_t* Y5;
    __device__ __forceinline__ void operator()(const f32x4 (&acc)[2][2][4][2], const Unit& u, int wr, int wc, int fr, int fq) const {
        { const int t2 = fresh_tid(); const int w2 = t2 >> 6, l2 = t2 & 63; wr = w2 >> 2; wc = w2 & 3; fr = l2 & 15; fq = l2 >> 4; }
        const unsigned lane_off = (unsigned)((((u.pm >> 1) * 8192 + (((u.pm & 1) * 256 + wr * 64 + fr) * 16) + (wc * 2 + (fq >> 1))) * 1024 + u.g * 16 + (fq & 1) * 8) * 2);
        char* base = (char*)Y5;
#pragma unroll
        for (int ai = 0; ai < 2; ++ai)
#pragma unroll
            for (int m = 0; m < 4; ++m)
#pragma unroll
                for (int bj = 0; bj < 2; ++bj) {
                    const f32x4 v0 = acc[ai][bj][m][0], v1 = acc[ai][bj][m][1]; u32x4 w;
                    { const f32x2 a = gelu_pk((f32x2){v0[0], v0[1]}); w.x = cvt_pk_bf16(a.x, a.y); } __builtin_amdgcn_sched_barrier(0);
                    { const f32x2 a = gelu_pk((f32x2){v0[2], v0[3]}); w.y = cvt_pk_bf16(a.x, a.y); } __builtin_amdgcn_sched_barrier(0);
                    { const f32x2 a = gelu_pk((f32x2){v1[0], v1[1]}); w.z = cvt_pk_bf16(a.x, a.y); } __builtin_amdgcn_sched_barrier(0);
                    { const f32x2 a = gelu_pk((f32x2){v1[2], v1[3]}); w.w = cvt_pk_bf16(a.x, a.y); } __builtin_amdgcn_sched_barrier(0);
                    const unsigned off = lane_off + (unsigned)(ai * 4194304 + m * 524288 + bj * 16384);
                    *(u32x4*)(base + off) = w;
                }
    }
};
__device__ __forceinline__ float sigm(float x) { return __builtin_amdgcn_rcpf(1.0f + __builtin_amdgcn_exp2f(-1.44269504f * x)); }
struct EpiGlu {
    static constexpr bool PERM = true, AFTER_DRAIN = false, HAS_MID = false;
    bf16_t* MIX; const float* bglu; float* SS5;
    __device__ __forceinline__ void operator()(const f32x4 (&acc)[2][2][4][2], const Unit& u, int wr, int wc, int fr, int fq) const {
        EPI_ROWS_COLS
        const int oc = u.pn * 128 + colb;
        const f32x4 ba0 = *(const f32x4*)(bglu + oc), ba1 = *(const f32x4*)(bglu + oc + 4), bg0 = *(const f32x4*)(bglu + 1024 + oc), bg1 = *(const f32x4*)(bglu + 1024 + oc + 4);
#pragma unroll
        for (int ai = 0; ai < 2; ++ai)
#pragma unroll
            for (int m = 0; m < 4; ++m) {
                const int r = rowb + ai * HALF + m * 16;
                f32x4 a0 = acc[ai][0][m][0] + ba0, a1 = acc[ai][0][m][1] + ba1; const f32x4 g0 = acc[ai][1][m][0] + bg0, g1 = acc[ai][1][m][1] + bg1;
#pragma unroll
                for (int e = 0; e < 4; ++e) { a0[e] *= sigm(g0[e]); a1[e] *= sigm(g1[e]); }
                *(u32x4*)(MIX + (size_t)r * 2048 + 1024 + oc) = pack8(a0, a1);
                float s = sum8sq(a0, a1); s += __shfl_xor(s, 16); s += __shfl_xor(s, 32);
                if (fq == 0) atomicAdd(SS5 + r, s);
            }
    }
};
template <bool SECOND> struct EpiOut {
    static constexpr bool PERM = true, AFTER_DRAIN = false, HAS_MID = false;
    const float* X; float* H1; bf16_t* H1B; const float* SSX; float* SSM;
    __device__ __forceinline__ void operator()(const f32x4 (&acc)[2][2][4][2], const Unit& u, int wr, int wc, int fr, int fq) const {
        EPI_ROWS_COLS
        const unsigned lane_off = (unsigned)(rowb * 1024 + u.pn * BM + colb);
        const char* xb = (const char*)X; char* hb = (char*)H1; char* bb = (char*)H1B;
#pragma unroll
        for (int ai = 0; ai < 2; ++ai)
#pragma unroll
            for (int m = 0; m < 4; ++m) {
                const int r = rowb + ai * HALF + m * 16;
                const float rs = 1.0f / sqrtf(SSX[r] * (1.0f / 1024.0f) + 1e-5f);
                float s = 0.f;
#pragma unroll
                for (int bj = 0; bj < 2; ++bj) {
                    const unsigned off = lane_off + (unsigned)(ai * 131072 + m * 16384 + bj * 128);
                    const f32x4 v0 = *(const f32x4*)(xb + off * 4u) + acc[ai][bj][m][0] * rs, v1 = *(const f32x4*)(xb + off * 4u + 16u) + acc[ai][bj][m][1] * rs;
                    *(f32x4*)(hb + off * 4u) = v0; *(f32x4*)(hb + off * 4u + 16u) = v1;
                    if (SECOND) { *(u32x4*)(bb + off * 2u) = pack8(v0, v1); s += sum8sq(v0, v1); }
                }
                if (SECOND) { s += __shfl_xor(s, 16); s += __shfl_xor(s, 32);
                    if (fq == 0) atomicAdd(SSM + r, s); }
                asm volatile("" ::: "memory");
            }
    }
};
struct EpiUp {
    static constexpr bool PERM = true, AFTER_DRAIN = false, HAS_MID = false;
    bf16_t* HB; const float* SSM;
    __device__ __forceinline__ void operator()(const f32x4 (&acc)[2][2][4][2], const Unit& u, int wr, int wc, int fr, int fq) const {
        EPI_ROWS_COLS
#pragma unroll
        for (int ai = 0; ai < 2; ++ai)
#pragma unroll
            for (int m = 0; m < 4; ++m) {
                const int r = rowb + ai * HALF + m * 16;
                const float rs = 1.0f / sqrtf(SSM[r] * (1.0f / 1024.0f) + 1e-5f);
#pragma unroll
                for (int bj = 0; bj < 2; ++bj) {
                    f32x4 v0 = acc[ai][bj][m][0] * rs, v1 = acc[ai][bj][m][1] * rs;
#pragma unroll
                    for (int e = 0; e < 4; ++e) { const float p = fmaxf(v0[e], 0.f), q = fmaxf(v1[e], 0.f); v0[e] = p * p; v1[e] = q * q; }
                    *(u32x4*)(HB + (size_t)r * 4096 + u.pn * BM + bj * HALF + colb) = pack8(v0, v1);
                }
            }
    }
};
struct EpiDown {
    static constexpr bool PERM = true, AFTER_DRAIN = false, HAS_MID = false;
    float* H; float* SSF;
    __device__ __forceinline__ void operator()(const f32x4 (&acc)[2][2][4][2], const Unit& u, int wr, int wc, int fr, int fq) const {
        EPI_ROWS_COLS
#pragma unroll
        for (int ai = 0; ai < 2; ++ai)
#pragma unroll
            for (int m = 0; m < 4; ++m) {
                const int r = rowb + ai * HALF + m * 16;
                float s = 0.f;
#pragma unroll
                for (int bj = 0; bj < 2; ++bj) {
                    const size_t off = (size_t)r * 1024 + u.pn * BM + bj * HALF + colb;
                    const f32x4 v0 = *(const f32x4*)(H + off) + acc[ai][bj][m][0], v1 = *(const f32x4*)(H + off + 4) + acc[ai][bj][m][1];
                    *(f32x4*)(H + off) = v0; *(f32x4*)(H + off + 4) = v1;
                    s += sum8sq(v0, v1);
                }
                s += __shfl_xor(s, 16); s += __shfl_xor(s, 32);
                if (fq == 0) atomicAdd(SSF + r, s);
            }
    }
};
struct BatchOrder {
    int nU, per_g, Ge, ce;
    __host__ __device__ void init(int nU_, int per_g_, int G, int w0, int c) { nU = nU_; per_g = per_g_; Ge = G - w0; ce = c - w0; }
    __device__ bool next(int i, Unit& u) const {
        if (ce < 0) return false;
        const long L = (long)i * Ge + ce; if (L >= nU) return false;
        u.g = __builtin_amdgcn_readfirstlane((int)L / per_g); u.pm = __builtin_amdgcn_readfirstlane((int)L % per_g); u.pn = 0; u.par = i & 1; return true;
    }
    __device__ __forceinline__ void a_ready(const Unit&) const {}
    __device__ __forceinline__ void done(const Unit&) const {}
};
template <class Epi, class Sched, bool ALIGN_EPI = false, bool SP2 = false>
__device__ __forceinline__ void gemm_phase(PG8_LAS unsigned char* lds, const Gemm g, const Sched& S, const Epi& E) {
    const int tid = threadIdx.x, wid = __builtin_amdgcn_readfirstlane(tid >> 6), lane = tid & 63, wr = wid >> 2, wc = wid & 3, fr = lane & 15, fq = lane >> 4;
    const int K = g.K, nt = K / BK;
    unsigned voffA[2], voffB[2];
#pragma unroll
    for (int i = 0; i < 2; ++i) { int R, C; stage_rc(tid * 16 + i * 8192, R, C); const int Rb = Epi::PERM ? ((R & ~31) + perm32(R & 31)) : R;
        voffA[i] = (unsigned)(R * g.lda + C) * 2u; voffB[i] = (unsigned)(Rb * g.ldb + C) * 2u; }
    const size_t kstep = (size_t)(BK * 2);
    const size_t hstepA = (size_t)HALF * g.lda * 2, hstepB = (size_t)HALF * g.ldb * 2;
    const size_t tstepA = 2 * hstepA, tstepB = 2 * hstepB;
    const unsigned ldsw = (unsigned)wid * 1024u;
    const int aoff = lds_byte(wr * 64 + fr, fq * 8), boff = lds_byte(wc * 32 + fr, fq * 8);
#define PG8_SA(b, h) (((b) * 2 + (h)) * HTB)
#define PG8_SB(b, h) ((4 + (b) * 2 + (h)) * HTB)
#define PG8_STAGE(bufoff, gbase, voff) do { _Pragma("unroll") for (int _i = 0; _i < 2; ++_i) \
        __builtin_amdgcn_global_load_lds((const unsigned*)((const char*)(gbase) + (voff)[_i]), (PG8_LAS unsigned*)(lds + (bufoff) + ldsw + _i * 8192), 16, 0, 0); } while (0)
#define PG8_LDA(dst, b, h) do { _Pragma("unroll") for (int m = 0; m < 4; ++m) _Pragma("unroll") for (int k = 0; k < 2; ++k) dst[m][k] = *(const PG8_LAS bf16x8*)(lds + PG8_SA(b, h) + aoff + m * 2048 + k * 1024); } while (0)
#define PG8_LDB(dst, b, h) do { _Pragma("unroll") for (int n = 0; n < 2; ++n) _Pragma("unroll") for (int k = 0; k < 2; ++k) dst[n][k] = *(const PG8_LAS bf16x8*)(lds + PG8_SB(b, h) + boff + n * 2048 + k * 1024); } while (0)
#define PG8_MMA(ai, bj, At, Bt) do { __builtin_amdgcn_s_setprio(1); _Pragma("unroll") for (int m = 0; m < 4; ++m) _Pragma("unroll") for (int n = 0; n < 2; ++n) _Pragma("unroll") for (int k = 0; k < 2; ++k) \
        acc[ai][bj][m][n] = __builtin_amdgcn_mfma_f32_16x16x32_bf16(Bt[n][k], At[m][k], acc[ai][bj][m][n], 0, 0, 0); __builtin_amdgcn_s_setprio(0); } while (0)
#define PG8_WAIT_V(n) asm volatile("s_waitcnt vmcnt(" #n ")" ::: "memory")
#define PG8_WAIT_L(n) asm volatile("s_waitcnt lgkmcnt(" #n ")" ::: "memory")
#define PG8_BAR __builtin_amdgcn_s_barrier()
#define PG8_SCHED __builtin_amdgcn_sched_barrier(0)
    Unit cur, nxt; int ui = 0;
    if (!S.next(0, cur)) return;
    f32x4 acc[2][2][4][2];
#pragma unroll
    for (int a = 0; a < 2; ++a)
#pragma unroll
        for (int b = 0; b < 2; ++b)
#pragma unroll
            for (int m = 0; m < 4; ++m)
#pragma unroll
                for (int n = 0; n < 2; ++n) acc[a][b][m][n] = (f32x4){0.f, 0.f, 0.f, 0.f};
    bf16x8 At[4][2], B0[2][2], B1[2][2];
    const char* cA = (const char*)g.A + (size_t)cur.g * g.gsA + (size_t)cur.pm * tstepA; const char* cB = (const char*)g.Bt + (size_t)cur.g * g.gsB + (size_t)cur.pn * tstepB;
    S.a_ready(cur);
    if constexpr (SP2) {
        PG8_STAGE(PG8_SB(0, 0), cB, voffB); PG8_STAGE(PG8_SB(0, 1), cB + hstepB, voffB); PG8_STAGE(PG8_SA(0, 0), cA, voffA); PG8_STAGE(PG8_SA(0, 1), cA + hstepA, voffA);
        if (wr == 1) PG8_BAR;
        PG8_WAIT_V(2); PG8_BAR;
        PG8_STAGE(PG8_SB(1, 0), cB + kstep, voffB); PG8_STAGE(PG8_SA(1, 0), cA + kstep, voffA); PG8_STAGE(PG8_SB(1, 1), cB + hstepB + kstep, voffB);
        PG8_WAIT_V(6); PG8_BAR;
    } else {
        PG8_STAGE(PG8_SB(0, 0), cB, voffB); PG8_STAGE(PG8_SA(0, 0), cA, voffA); PG8_STAGE(PG8_SB(0, 1), cB + hstepB, voffB); PG8_STAGE(PG8_SA(0, 1), cA + hstepA, voffA);
        if (wr == 1) PG8_BAR;
        PG8_WAIT_V(4); PG8_BAR;
        PG8_STAGE(PG8_SB(1, 0), cB + kstep, voffB); PG8_STAGE(PG8_SA(1, 0), cA + kstep, voffA); PG8_STAGE(PG8_SB(1, 1), cB + hstepB + kstep, voffB);
        PG8_WAIT_V(6); PG8_BAR;
    }
    for (;;) {
        const bool has_next = S.next(ui + 1, nxt);
        const char* nA = has_next ? (const char*)g.A + (size_t)nxt.g * g.gsA + (size_t)nxt.pm * tstepA : cA; const char* nB = has_next ? (const char*)g.Bt + (size_t)nxt.g * g.gsB + (size_t)nxt.pn * tstepB : cB;
        for (int t = 0; t < nt; t += 2) {
            if constexpr (Epi::HAS_MID) { if (t == 0) E.begin(cur, tid); if (t == (nt >> 1)) E.mid(acc, cur, wr, wc, fr, fq); }
            const bool last = (t == nt - 2);
            const char* a1 = cA + (size_t)(t + 1) * kstep;
            const char* a2 = last ? nA : cA + (size_t)(t + 2) * kstep; const char* b2 = last ? nB : cB + (size_t)(t + 2) * kstep;
            const char* a3 = a2 + kstep; const char* b3 = b2 + kstep;
            if (last && has_next) S.a_ready(nxt);
            if constexpr (SP2) {
            PG8_LDB(B0, 0, 0); PG8_LDB(B1, 0, 1); PG8_SCHED; PG8_LDA(At, 0, 0); PG8_STAGE(PG8_SA(1, 1), a1 + hstepA, voffA);
            PG8_WAIT_V(8); PG8_WAIT_L(0); PG8_BAR; PG8_MMA(0, 0, At, B0); PG8_MMA(0, 1, At, B1); PG8_BAR; PG8_SCHED;
            PG8_LDA(At, 0, 1); PG8_STAGE(PG8_SB(0, 0), b2, voffB); PG8_STAGE(PG8_SB(0, 1), b2 + hstepB, voffB); PG8_STAGE(PG8_SA(0, 0), a2, voffA);
            PG8_WAIT_V(8); PG8_WAIT_L(0); PG8_BAR; PG8_MMA(1, 0, At, B0); PG8_MMA(1, 1, At, B1); PG8_BAR; PG8_SCHED;
            PG8_LDB(B0, 1, 0); PG8_LDB(B1, 1, 1); PG8_SCHED; PG8_LDA(At, 1, 0); PG8_STAGE(PG8_SA(0, 1), a2 + hstepA, voffA);
            PG8_WAIT_V(8); PG8_WAIT_L(0); PG8_BAR; PG8_MMA(0, 0, At, B0); PG8_MMA(0, 1, At, B1); PG8_BAR; PG8_SCHED;
            PG8_LDA(At, 1, 1); PG8_STAGE(PG8_SB(1, 0), b3, voffB); PG8_STAGE(PG8_SB(1, 1), b3 + hstepB, voffB); PG8_STAGE(PG8_SA(1, 0), a3, voffA);
            PG8_WAIT_V(8); PG8_WAIT_L(0); PG8_BAR; PG8_MMA(1, 0, At, B0); PG8_MMA(1, 1, At, B1); PG8_BAR; PG8_SCHED;
            } else {
            PG8_LDB(B0, 0, 0); PG8_SCHED; PG8_LDA(At, 0, 0); PG8_STAGE(PG8_SA(1, 1), a1 + hstepA, voffA);
            PG8_WAIT_L(8); PG8_BAR; PG8_WAIT_L(0); PG8_MMA(0, 0, At, B0); PG8_BAR; PG8_SCHED;
            PG8_LDB(B1, 0, 1); PG8_STAGE(PG8_SB(0, 0), b2, voffB);
            PG8_BAR; PG8_WAIT_L(0); PG8_MMA(0, 1, At, B1); PG8_BAR;
            PG8_LDA(At, 0, 1); PG8_STAGE(PG8_SA(0, 0), a2, voffA);
            PG8_BAR; PG8_WAIT_L(0); PG8_MMA(1, 0, At, B0); PG8_BAR; PG8_SCHED;
            PG8_STAGE(PG8_SB(0, 1), b2 + hstepB, voffB);
            PG8_WAIT_V(6); PG8_BAR; PG8_MMA(1, 1, At, B1); PG8_BAR;
            PG8_LDB(B0, 1, 0); PG8_SCHED; PG8_LDA(At, 1, 0); PG8_STAGE(PG8_SA(0, 1), a2 + hstepA, voffA);
            PG8_WAIT_L(8); PG8_BAR; PG8_WAIT_L(0); PG8_MMA(0, 0, At, B0); PG8_BAR; PG8_SCHED;
            PG8_LDB(B1, 1, 1); PG8_STAGE(PG8_SB(1, 0), b3, voffB);
            PG8_BAR; PG8_WAIT_L(0); PG8_MMA(0, 1, At, B1); PG8_BAR;
            PG8_LDA(At, 1, 1); PG8_STAGE(PG8_SA(1, 0), a3, voffA);
            PG8_BAR; PG8_WAIT_L(0); PG8_MMA(1, 0, At, B0); PG8_BAR; PG8_SCHED;
            PG8_STAGE(PG8_SB(1, 1), b3 + hstepB, voffB);
            PG8_WAIT_V(6); PG8_BAR; PG8_MMA(1, 1, At, B1); PG8_BAR;
            }
        }
        if constexpr (ALIGN_EPI) { if (wr == 0) PG8_BAR; }
        if constexpr (!Epi::AFTER_DRAIN) { E(acc, cur, wr, wc, fr, fq); S.done(cur); }
        if (!has_next) break;
#pragma unroll
        for (int a = 0; a < 2; ++a)
#pragma unroll
            for (int b = 0; b < 2; ++b)
#pragma unroll
                for (int m = 0; m < 4; ++m)
#pragma unroll
                    for (int n = 0; n < 2; ++n) acc[a][b][m][n] = (f32x4){0.f, 0.f, 0.f, 0.f};
        cur = nxt; cA = nA; cB = nB; ++ui;
        if constexpr (ALIGN_EPI) { if (wr == 1) PG8_BAR; }
    }
    PG8_WAIT_V(0);
    if constexpr (!ALIGN_EPI) { if (wr == 0) PG8_BAR; }
    PG8_BAR;
    if constexpr (Epi::AFTER_DRAIN) { E.fused(acc, cur, wr, wc, fr, fq, lds, wid, lane); S.done(cur); }
#undef PG8_SA
#undef PG8_SB
#undef PG8_STAGE
#undef PG8_LDA
#undef PG8_LDB
#undef PG8_MMA
#undef PG8_WAIT_V
#undef PG8_WAIT_L
#undef PG8_BAR
#undef PG8_SCHED
}
}

#include <hip/hip_cooperative_groups.h>
namespace cg = cooperative_groups;
typedef unsigned short bf16;
typedef unsigned v4u __attribute__((ext_vector_type(4)));
typedef unsigned v2u __attribute__((ext_vector_type(2)));
typedef float f32x4 __attribute__((ext_vector_type(4)));
typedef float f32x2 __attribute__((ext_vector_type(2)));
typedef short bf16x8 __attribute__((ext_vector_type(8)));

constexpr int NT = 512, NWAVES = 8;
constexpr int MR = 16384, MP = 16640;
constexpr int NIN = 3840;
constexpr int NQ = 65;
constexpr float EPS = 1e-5f;
constexpr size_t MiB = 1u << 20;
constexpr size_t WS_SS    = 0;
constexpr size_t WS_DEC   = 256 * 1024;
constexpr size_t WS_A1    = 288 * 1024;
constexpr size_t WS_A16   = 320 * 1024;
constexpr size_t WS_BAR   = 384 * 1024;
constexpr size_t WS_BBAR  = 512 * 1024;
constexpr size_t WS_UMETA = 1 * MiB;
constexpr size_t WS_DTRAW = 1 * MiB + 512 * 1024;
constexpr size_t WS_DT    = 2 * MiB + 640 * 1024;
constexpr size_t WS_ACS   = 254 * MiB + 512 * 1024;
static_assert(WS_DTRAW + 16640 * 16 * 4 <= WS_DT && WS_DT + 65 * 16 * 256 * 4 <= 4 * MiB && WS_ACS + 65 * 16 * 256 * 4 <= 256 * MiB, "smalls");
constexpr size_t WS_WGLU  = 4 * MiB;
constexpr size_t WS_TB5   = 8 * MiB;
constexpr size_t WS_TE5   = 20 * MiB;
constexpr size_t WS_WIN   = 28 * MiB;
constexpr size_t WS_PREV  = 20 * MiB;
constexpr size_t WS_WOUT  = 8 * MiB, WS_WUP = 12 * MiB, WS_WDN = 20 * MiB;
constexpr size_t WS_MIX   = 36 * MiB;
constexpr size_t WS_UA    = 100 * MiB;
constexpr size_t WS_XBCP  = 148 * MiB;
constexpr size_t WS_SEND  = 148 * MiB;
constexpr size_t WS_ST    = 180 * MiB;
constexpr size_t WS_Y5    = 148 * MiB;
constexpr size_t WS_XN    = 197 * MiB;
constexpr size_t WS_XF    = 197 * MiB;
constexpr size_t WS_H1B   = 197 * MiB;
constexpr size_t WS_CT    = 230 * MiB;
constexpr size_t WS_BTK   = WS_CT + 65 * 65536 * 2;
constexpr size_t WS_BF    = WS_BTK + 65 * 65536 * 2;
constexpr size_t WS_HB    = 36 * MiB;
static_assert(WS_BF + 65 * 65536 * 2 <= WS_ACS, "ws");
constexpr int LDS_BYTES = 155648;

__device__ __forceinline__ unsigned f2bf(float f) { unsigned u = __builtin_bit_cast(unsigned, f); return (u + 0x7fffu + ((u >> 16) & 1u)) >> 16; }
__device__ __forceinline__ unsigned pk2(float lo, float hi) { return f2bf(lo) | (f2bf(hi) << 16); }
__device__ __forceinline__ float bf2f(unsigned short h) { return __builtin_bit_cast(float, (unsigned)h << 16); }
__device__ __forceinline__ float bflo(unsigned w) { return __builtin_bit_cast(float, w << 16); }
__device__ __forceinline__ float bfhi(unsigned w) { return __builtin_bit_cast(float, w & 0xffff0000u); }
__device__ __forceinline__ float ex2(float x) { return __builtin_amdgcn_exp2f(x); }
__device__ __forceinline__ float expf_(float x) { return __builtin_amdgcn_exp2f(1.44269504f * x); }
__device__ __forceinline__ float wave_sum(float v) {
#pragma unroll
    for (int o = 1; o < 64; o <<= 1) v += __shfl_xor(v, o);
    return v;
}

#define LAS __attribute__((address_space(3)))
#define XB_TMO      128
#define XB_XCNT(j)  (256  + 64 * (j))
#define XB_XSUB(j)  (1280 + 64 * (j))
#define XB_XGEN(j)  (2304 + 64 * (j))
#define XB_TOP      3328
#define XB_TOPGEN   3392
#define XCD_BAR_WORDS 3456
#define XB_SPIN_CAP (1u << 18)

__device__ __forceinline__ unsigned xb_ld(unsigned* p)              { return __hip_atomic_load(p, __ATOMIC_RELAXED, __HIP_MEMORY_SCOPE_AGENT); }
__device__ __forceinline__ unsigned xb_add(unsigned* p, unsigned v) { return __hip_atomic_fetch_add(p, v, __ATOMIC_RELAXED, __HIP_MEMORY_SCOPE_AGENT); }
__device__ __forceinline__ unsigned xb_xcc_id() { return (unsigned)__builtin_amdgcn_s_getreg((3 << 11) | 20) & 0xFu; }
#define XB_SPIN(cond, bar) do { unsigned _sp = 0; while (cond) { __builtin_amdgcn_s_sleep(1); \
    if ((++_sp & 255u) == 0u) { if (xb_ld(&(bar)[XB_TMO])) break; if (_sp > XB_SPIN_CAP) { atomicAdd(&(bar)[XB_TMO], 1u); break; } } } } while (0)

struct XcdBarrier {
    unsigned* bar; unsigned x;
    volatile LAS unsigned* st;
};

__device__ __forceinline__ XcdBarrier xcd_barrier_post(unsigned* bar, volatile LAS unsigned* st) {
    XcdBarrier b; b.bar = bar; b.x = xb_xcc_id(); b.st = st;
    if (threadIdx.x == 0) (void)xb_add(&bar[XB_XCNT(b.x)], 1u);
    return b;
}
__device__ __forceinline__ void xcd_barrier_complete(unsigned* bar, unsigned x, unsigned& nloc, unsigned& nx) {
    const unsigned G = gridDim.x * gridDim.y * gridDim.z;
    unsigned sum, cnt, mine, sp = 0u;
    for (;;) {
        sum = 0u; cnt = 0u; mine = 0u;
#pragma unroll
        for (unsigned j = 0; j < 16; ++j) { const unsigned c = xb_ld(&bar[XB_XCNT(j)]); sum += c; cnt += (c > 0u) ? 1u : 0u; mine = (j == x) ? c : mine; }
        if (sum == G) break;
        __builtin_amdgcn_s_sleep(1);
        if ((++sp & 255u) == 0u) { if (xb_ld(&bar[XB_TMO])) break; if (sp > XB_SPIN_CAP) { atomicAdd(&bar[XB_TMO], 1u); break; } }
    }
    nloc = mine > 0u ? mine : 1u; nx = cnt > 0u ? cnt : 1u;
}

__device__ __forceinline__ void xcd_barrier(const XcdBarrier& b) {
    asm volatile("s_waitcnt vmcnt(0)" ::: "memory");
    __syncthreads();
    if (threadIdx.x == 0) {
        unsigned* bar = b.bar;
        __builtin_amdgcn_s_waitcnt(0);
        unsigned nloc = b.st[0], nx = b.st[1];
        if (nloc == 0u) { xcd_barrier_complete(bar, b.x, nloc, nx); b.st[0] = nloc; b.st[1] = nx; }
        const unsigned old = xb_add(&bar[XB_XSUB(b.x)], 1u);
        const unsigned gen = old / nloc;
        if (old + 1u == (gen + 1u) * nloc) {
            __builtin_amdgcn_fence(__ATOMIC_RELEASE, "agent");
            asm volatile("s_waitcnt vmcnt(0)" ::: "memory");
            const unsigned og = xb_add(&bar[XB_TOP], 1u);
            const unsigned tg = og / nx;
            if (og + 1u == (tg + 1u) * nx) xb_add(&bar[XB_TOPGEN], 1u);
            else XB_SPIN(xb_ld(&bar[XB_TOPGEN]) == tg, bar);
            __builtin_amdgcn_fence(__ATOMIC_ACQUIRE, "agent");
            xb_add(&bar[XB_XGEN(b.x)], 1u);
            asm volatile("s_waitcnt vmcnt(0)" ::: "memory");
        } else {
            XB_SPIN(xb_ld(&bar[XB_XGEN(b.x)]) == gen, bar);
            __builtin_amdgcn_fence(__ATOMIC_ACQUIRE, "agent");
            asm volatile("s_waitcnt vmcnt(0)" ::: "memory");
        }
    }
    __syncthreads();
}

struct Args {
    const float* in[26]; float* out; unsigned char* ws; int ph_lo, ph_hi;
};
enum { I_X = 0, I_META, I_GMIX, I_WIN, I_CONVW, I_CONVB, I_DTB, I_ALOG, I_DSSD, I_GSSD, I_LRE, I_LIM, I_LSTEP, I_BRE, I_BIM, I_CRE, I_CIM, I_DS5, I_WGLU, I_BGLU, I_GS5, I_WOUT, I_GMLP, I_WUP, I_WDN, I_GFIN };

template <int MODE> __device__ __forceinline__ int colmap(int j) {
    if (MODE == 1) { if (j < 2560) return j; if (j < 3584) return j + 16; if (j < 3600) return j - 1024; return -1; }
    if (MODE == 2) { const int pn = j >> 8, r = j & 255; return r < 128 ? pn * 128 + r : 1024 + pn * 128 + (r - 128); }
    return j;
}
template <int MODE> __device__ __forceinline__ void transpose_item(const float* W, int K, int N, bf16* WT, const float* ks0, const float* ks1, float* scr, int item, int nblk, int lane) {
    const int kb = item / nblk, nb = item % nblk, k0 = 64 * kb, n0 = 32 * nb;
    const int src = colmap<MODE>(n0 + (lane & 31));
#pragma unroll 8
    for (int i = 0; i < 32; ++i) { const int kk = 2 * i + (lane >> 5); const int k = k0 + kk;
        float v = src >= 0 ? W[(size_t)k * N + src] : 0.f;
        if (ks0) v *= (k < 1024 ? ks0[k] : ks1[k - 1024]);
        scr[kk * 33 + (lane & 31)] = v; }
    asm volatile("s_waitcnt lgkmcnt(0)" ::: "memory");
    const int c = lane & 7;
#pragma unroll
    for (int j = 0; j < 4; ++j) { const int n = (lane >> 3) + 8 * j; const float* s = scr + (8 * c) * 33 + n;
        v4u o; o.x = pk2(s[0 * 33], s[1 * 33]); o.y = pk2(s[2 * 33], s[3 * 33]); o.z = pk2(s[4 * 33], s[5 * 33]); o.w = pk2(s[6 * 33], s[7 * 33]);
        *(v4u*)(WT + (size_t)(n0 + n) * K + k0 + 8 * c) = o; }
    asm volatile("s_waitcnt lgkmcnt(0)" ::: "memory");
}

__device__ __forceinline__ void sincos_d(double th, float& sn, float& cs) {
    const double k = rint(th * 0.15915494309189535); const double r = fma(-k, 6.283185307179586, th);
    const double t = r * 0.125, t2 = t * t;
    double s = t * (1.0 + t2 * (-1.0 / 6 + t2 * (1.0 / 120 + t2 * (-1.0 / 5040 + t2 * (1.0 / 362880 + t2 * (-1.0 / 39916800))))));
    double c = 1.0 + t2 * (-0.5 + t2 * (1.0 / 24 + t2 * (-1.0 / 720 + t2 * (1.0 / 40320 + t2 * (-1.0 / 3628800 + t2 * (1.0 / 479001600))))));
#pragma unroll
    for (int i = 0; i < 3; ++i) { const double s2 = 2.0 * s * c, c2 = 1.0 - 2.0 * s * s; s = s2; c = c2; }
    sn = (float)s; cs = (float)c;
}

__device__ __forceinline__ void s5_tables(const Args& a, int g, unsigned char* lds, int tid) {
    f32x2* pw = (f32x2*)lds;
    f32x2* Cc = pw + 17 * 64;
    f32x2* Bb = Cc + 16 * 64;
    float* Kt = (float*)(Bb + 64 * 16);
    unsigned char* ws = a.ws;
    if (tid < 64) {
        const int p = tid; const float lr = a.in[I_LRE][g * 64 + p], li = a.in[I_LIM][g * 64 + p]; const float st = expf(a.in[I_LSTEP][g]);
        float are = 1.f, aim = 0.f;
        for (int tau = 0; tau <= 16; ++tau) {
            const float mag = expf(lr * st * (float)tau); float sn, cs; sincos_d((double)li * (double)st * (double)tau, sn, cs);
            pw[tau * 64 + p] = (f32x2){mag * cs, mag * sn};
            if (tau == 1) { are = mag * cs; aim = mag * sn; ((f32x2*)(ws + WS_A1))[g * 64 + p] = (f32x2){are, aim}; }
            if (tau == 16) ((f32x2*)(ws + WS_A16))[g * 64 + p] = (f32x2){mag * cs, mag * sn};
        }
        const float den = lr * lr + li * li;
        const float cre = ((are - 1.0f) * lr + aim * li) / den, cim = (aim * lr - (are - 1.0f) * li) / den;
        for (int h = 0; h < 16; ++h) { const float br = a.in[I_BRE][(g * 64 + p) * 16 + h], bi = a.in[I_BIM][(g * 64 + p) * 16 + h];
            const f32x2 v = (f32x2){cre * br - cim * bi, cre * bi + cim * br}; Bb[p * 16 + h] = v; ((f32x2*)(ws + WS_BBAR))[(g * 64 + p) * 16 + h] = v; }
    }
    for (int e = tid; e < 1024; e += NT) Cc[e] = (f32x2){a.in[I_CRE][g * 1024 + e], a.in[I_CIM][g * 1024 + e]};
    __syncthreads();
    {
        const int tau = tid >> 5, h = (tid >> 1) & 15, h0 = (tid & 1) * 8; float acc[8];
#pragma unroll
        for (int j = 0; j < 8; ++j) acc[j] = 0.f;
        for (int p = 0; p < 64; ++p) { const f32x2 c = Cc[h * 64 + p], w = pw[tau * 64 + p]; const float tr = c.x * w.x - c.y * w.y, ti = c.x * w.y + c.y * w.x;
#pragma unroll
            for (int j = 0; j < 8; ++j) { const f32x2 b = Bb[p * 16 + h0 + j]; acc[j] += tr * b.x - ti * b.y; } }
        if (tau == 0) {
#pragma unroll
            for (int j = 0; j < 8; ++j) if (h0 + j == h) acc[j] += a.in[I_DS5][g * 16 + h];
        }
#pragma unroll
        for (int j = 0; j < 8; ++j) Kt[(tau * 16 + h) * 16 + h0 + j] = acc[j];
    }
    __syncthreads();
    bf16* TB = (bf16*)(ws + WS_TB5) + (size_t)g * 256 * 384;
    for (int pc = tid; pc < 256 * 48; pc += NT) {
        const int row = pc / 48, c8 = (pc % 48) * 8, t = row >> 4, h = row & 15; float v[8];
        if (c8 < 256) { const int s = c8 >> 4, h0 = c8 & 15;
#pragma unroll
            for (int j = 0; j < 8; ++j) v[j] = s <= t ? Kt[((t - s) * 16 + h) * 16 + h0 + j] : 0.f;
        } else { const int p0 = (c8 - 256) >> 1;
#pragma unroll
            for (int j = 0; j < 4; ++j) { const f32x2 c = Cc[h * 64 + p0 + j], w = pw[(t + 1) * 64 + p0 + j]; v[2 * j] = c.x * w.x - c.y * w.y; v[2 * j + 1] = -(c.x * w.y + c.y * w.x); }
        }
        v4u o; o.x = pk2(v[0], v[1]); o.y = pk2(v[2], v[3]); o.z = pk2(v[4], v[5]); o.w = pk2(v[6], v[7]);
        *(v4u*)(TB + (size_t)row * 384 + c8) = o;
    }
    bf16* TE = (bf16*)(ws + WS_TE5) + (size_t)g * 256 * 256;
    for (int pc = tid; pc < 256 * 32; pc += NT) {
        const int row = pc >> 5, c8 = (pc & 31) * 8; float v[8];
        if (row < 128) { const int p = row >> 1, ri = row & 1, s = c8 >> 4, h0 = c8 & 15; const f32x2 w = pw[(15 - s) * 64 + p];
#pragma unroll
            for (int j = 0; j < 8; ++j) { const f32x2 b = Bb[p * 16 + h0 + j]; v[j] = ri ? (w.x * b.y + w.y * b.x) : (w.x * b.x - w.y * b.y); }
        } else {
#pragma unroll
            for (int j = 0; j < 8; ++j) v[j] = 0.f;
        }
        v4u o; o.x = pk2(v[0], v[1]); o.y = pk2(v[2], v[3]); o.z = pk2(v[4], v[5]); o.w = pk2(v[6], v[7]);
        *(v4u*)(TE + (size_t)row * 256 + c8) = o;
    }
    __syncthreads();
}

__device__ __forceinline__ void rms_row_to_bf16(const float* xrow, const float* gain, bf16* orow, int lane) {
    unsigned long long* o8 = (unsigned long long*)orow + lane;
    if (!xrow) {
#pragma unroll
        for (int j = 0; j < 4; ++j) o8[64 * j] = 0ull;
        return; }
    const f32x4* xr = (const f32x4*)xrow + lane; const f32x4* gr = (const f32x4*)gain + lane;
    f32x4 v[4]; float s = 0.f;
#pragma unroll
    for (int j = 0; j < 4; ++j) { v[j] = xr[64 * j]; s += (v[j].x * v[j].x + v[j].y * v[j].y) + (v[j].z * v[j].z + v[j].w * v[j].w); }
    const float rstd = 1.f / sqrtf(wave_sum(s) * (1.f / 1024.f) + EPS);
#pragma unroll
    for (int j = 0; j < 4; ++j) { const f32x4 gg = gr[64 * j]; const f32x4 w = v[j] * rstd * gg; o8[64 * j] = (unsigned long long)pk2(w.x, w.y) | ((unsigned long long)pk2(w.z, w.w) << 32); }
}

__device__ __forceinline__ void p0_prologue(const Args& a, unsigned char* lds, int tid, int G) {
    unsigned char* ws = a.ws; const int lane = tid & 63, wave = tid >> 6;
    const int gw = blockIdx.x * NWAVES + wave, NGW = G * NWAVES;
    for (int i = blockIdx.x * NT + tid; i < 4 * 16384; i += G * NT) ((float*)(ws + WS_SS))[i] = 0.f;
    for (int g = (G - 1 - (int)blockIdx.x); g < 64; g += G) s5_tables(a, g, lds, tid);
    __syncthreads();
    float* scr = (float*)(lds + wave * 16384);
    constexpr int NB_IN = NIN / 32, NB_GL = 2048 / 32;
    constexpr int I_IN = 16 * NB_IN, I_GL = 16 * NB_GL;
    for (int it = gw; it < I_IN + I_GL; it += NGW) {
        if (it < I_IN) transpose_item<1>(a.in[I_WIN], 1024, 3600, (bf16*)(ws + WS_WIN), nullptr, nullptr, scr, it, NB_IN, lane);
        else transpose_item<2>(a.in[I_WGLU], 1024, 2048, (bf16*)(ws + WS_WGLU), nullptr, nullptr, scr, it - I_IN, NB_GL, lane);
    }
    for (int m = gw; m < MP; m += NGW) {
        const float* src = m < MR ? a.in[I_X] + (size_t)m * 1024 : (m < MR + 16 ? a.in[I_META] + (size_t)(m - MR) * 1024 : nullptr);
        rms_row_to_bf16(src, a.in[I_GMIX], (bf16*)(ws + WS_XN) + (size_t)m * 1024, lane);
    }
}
__device__ __forceinline__ void p6_weights(const Args& a, unsigned char* lds, int tid, int G) {
    unsigned char* ws = a.ws; const int lane = tid & 63, wave = tid >> 6;
    const int gw = blockIdx.x * NWAVES + wave, NGW = G * NWAVES;
    float* scr = (float*)(lds + wave * 16384);
    constexpr int I_O = 32 * 32, I_U = 16 * 128, I_D = 64 * 32;
    for (int it = gw; it < I_O + I_U + I_D; it += NGW) {
        if (it < I_O) transpose_item<0>(a.in[I_WOUT], 2048, 1024, (bf16*)(ws + WS_WOUT), a.in[I_GSSD], a.in[I_GS5], scr, it, 32, lane);
        else if (it < I_O + I_U) transpose_item<0>(a.in[I_WUP], 1024, 4096, (bf16*)(ws + WS_WUP), a.in[I_GMLP], a.in[I_GMLP], scr, it - I_O, 128, lane);
        else transpose_item<0>(a.in[I_WDN], 4096, 1024, (bf16*)(ws + WS_WDN), nullptr, nullptr, scr, it - I_O - I_U, 32, lane);
    }
    __syncthreads();
}

__device__ __forceinline__ int chunk_row(int q, int tok) {
    if (q == 0) return tok < 240 ? -1 : MR + (tok - 240);
    const int b = (q - 1) >> 5, c = (q - 1) & 31;
    if (tok < 0 && c == 0) return MR + 16 + tok;
    return b * 8192 + c * 256 + tok;
}
__device__ __forceinline__ float silu_(float x) { return x * __builtin_amdgcn_rcpf(1.0f + ex2(-1.44269504f * x)); }
__device__ __forceinline__ void p2_conv_unit(const Args& a, int q, int blk, unsigned char* lds, int tid) {
    unsigned char* ws = a.ws;
    bf16* IN = (bf16*)lds;
    bf16* OT = (bf16*)(lds + 40960);
    const bf16* XBCP = (const bf16*)(ws + WS_XBCP);
    const int ch0 = blk * 64;
    for (int pc = tid; pc < 259 * 8; pc += NT) { const int rr = pc >> 3, c8 = (pc & 7) * 8; const int row = chunk_row(q, rr - 3);
        v4u v = (v4u){0u, 0u, 0u, 0u}; if (row >= 0) v = *(const v4u*)(XBCP + (size_t)row * 1536 + ch0 + c8);
        *(v4u*)(IN + rr * 64 + c8) = v; }
    __syncthreads();
    const float* cw = a.in[I_CONVW]; const float* cb = a.in[I_CONVB];
    const bool is_x = blk < 16, is_b = blk >= 16 && blk < 20;
    if (!is_x) {
        bf16* dst = (bf16*)(ws + (is_b ? WS_BTK : WS_CT)) + (size_t)q * 65536 + (is_b ? (blk - 16) : (blk - 20)) * 64;
        for (int pc = tid; pc < 256 * 8; pc += NT) { const int tok = pc >> 3, c8 = (pc & 7) * 8; float o[8];
            const bool zero = (q == 0 && tok < 240);
#pragma unroll
            for (int j = 0; j < 8; ++j) o[j] = cb[ch0 + c8 + j];
#pragma unroll
            for (int k = 0; k < 4; ++k) { const v4u v = *(const v4u*)(IN + (tok + k) * 64 + c8); const unsigned w[4] = {v.x, v.y, v.z, v.w};
#pragma unroll
                for (int j = 0; j < 4; ++j) { o[2 * j] += cw[k * 1536 + ch0 + c8 + 2 * j] * bflo(w[j]); o[2 * j + 1] += cw[k * 1536 + ch0 + c8 + 2 * j + 1] * bfhi(w[j]); } }
#pragma unroll
            for (int j = 0; j < 8; ++j) o[j] = zero ? 0.f : silu_(o[j]);
            v4u ov; ov.x = pk2(o[0], o[1]); ov.y = pk2(o[2], o[3]); ov.z = pk2(o[4], o[5]); ov.w = pk2(o[6], o[7]);
            *(v4u*)(dst + (size_t)tok * 256 + c8) = ov; }
    }
    if (is_x || is_b) {
        for (int it = tid; it < 64 * 32; it += NT) { const int ch = it & 63, t0 = (it >> 6) * 8; float wk[4], in[11], o[8]; const float bias = cb[ch0 + ch];
#pragma unroll
            for (int k = 0; k < 4; ++k) wk[k] = cw[k * 1536 + ch0 + ch];
#pragma unroll
            for (int j = 0; j < 11; ++j) in[j] = bf2f(IN[(t0 + j) * 64 + ch]);
#pragma unroll
            for (int j = 0; j < 8; ++j) { const float v = bias + wk[0] * in[j] + wk[1] * in[j + 1] + wk[2] * in[j + 2] + wk[3] * in[j + 3]; o[j] = (q == 0 && t0 + j < 240) ? 0.f : silu_(v); }
            v4u ov; ov.x = pk2(o[0], o[1]); ov.y = pk2(o[2], o[3]); ov.z = pk2(o[4], o[5]); ov.w = pk2(o[6], o[7]);
            *(v4u*)(OT + ch * 264 + t0) = ov; }
        __syncthreads();
        bf16* dst = is_x ? (bf16*)(ws + WS_XF) + ((size_t)q * 1024 + ch0) * 256 : (bf16*)(ws + WS_BF) + ((size_t)q * 256 + (blk - 16) * 64) * 256;
        for (int pc = tid; pc < 64 * 32; pc += NT) { const int ch = pc >> 5, t8 = (pc & 31) * 8; *(v4u*)(dst + (size_t)ch * 256 + t8) = *(const v4u*)(OT + ch * 264 + t8); }
    }
    __syncthreads();
}
__device__ __forceinline__ void p2_dt_item(const Args& a, int q, int h, int lane) {
    unsigned char* ws = a.ws; const float* DTRAW = (const float*)(ws + WS_DTRAW);
    const float bias = a.in[I_DTB][h], A = -expf(a.in[I_ALOG][h]);
    float dt[4], cs[4]; float run = 0.f;
#pragma unroll
    for (int j = 0; j < 4; ++j) { const int tok = 4 * lane + j; const int row = chunk_row(q, tok);
        float d = 0.f; if (row >= 0) { const float x = DTRAW[(size_t)row * 16 + h] + bias; d = fmaxf(x, 0.f) + __logf(1.0f + expf_(-fabsf(x))); }
        dt[j] = d; run += d * A; cs[j] = run; }
    float incl = run;
#pragma unroll
    for (int o = 1; o < 64; o <<= 1) { const float t = __shfl_up(incl, o); if (lane >= o) incl += t; }
    const float excl = incl - run;
    float* DT = (float*)(ws + WS_DT) + ((size_t)q * 16 + h) * 256 + 4 * lane; float* ACS = (float*)(ws + WS_ACS) + ((size_t)q * 16 + h) * 256 + 4 * lane;
    *(f32x4*)DT = (f32x4){dt[0], dt[1], dt[2], dt[3]}; *(f32x4*)ACS = (f32x4){cs[0] + excl, cs[1] + excl, cs[2] + excl, cs[3] + excl};
    if (lane == 63) ((float*)(ws + WS_DEC))[q * 16 + h] = expf_(cs[3] + excl);
}

#define MFMA16(A, B, C) __builtin_amdgcn_mfma_f32_16x16x32_bf16(A, B, C, 0, 0, 0)
__device__ __forceinline__ void p3_states_unit(const Args& a, int q, int g, int tid) {
    unsigned char* ws = a.ws; const int lane = tid & 63, r = tid >> 6, h = g * 8 + r, fr = lane & 15, fq = lane >> 4;
    const bf16* XF = (const bf16*)(ws + WS_XF) + ((size_t)q * 1024 + h * 64) * 256;
    const bf16* BF = (const bf16*)(ws + WS_BF) + ((size_t)q * 256 + g * 128) * 256;
    const float* DT = (const float*)(ws + WS_DT) + ((size_t)q * 16 + h) * 256; const float* ACS = (const float*)(ws + WS_ACS) + ((size_t)q * 16 + h) * 256;
    const float alast = ACS[255];
    bf16* ST = (bf16*)(ws + WS_ST) + ((size_t)q * 16 + h) * 8192;
#pragma unroll 1
    for (int nh = 0; nh < 2; ++nh) {
        f32x4 acc[4][4];
#pragma unroll
        for (int i = 0; i < 4; ++i)
#pragma unroll
            for (int j = 0; j < 4; ++j) acc[i][j] = (f32x4){0.f, 0.f, 0.f, 0.f};
#pragma unroll 1
        for (int kb = 0; kb < 8; ++kb) {
            const int s0 = kb * 32 + fq * 8;
            float w[8];
            { const f32x4 d0 = *(const f32x4*)(DT + s0), d1 = *(const f32x4*)(DT + s0 + 4), c0 = *(const f32x4*)(ACS + s0), c1 = *(const f32x4*)(ACS + s0 + 4);
#pragma unroll
              for (int j = 0; j < 4; ++j) { w[j] = expf_(alast - c0[j]) * d0[j]; w[4 + j] = expf_(alast - c1[j]) * d1[j]; } }
            bf16x8 Af[4], Bf[4];
#pragma unroll
            for (int i = 0; i < 4; ++i) { const v4u v = *(const v4u*)(XF + (size_t)(i * 16 + fr) * 256 + s0);
                v4u o; o.x = pk2(bflo(v.x) * w[0], bfhi(v.x) * w[1]); o.y = pk2(bflo(v.y) * w[2], bfhi(v.y) * w[3]); o.z = pk2(bflo(v.z) * w[4], bfhi(v.z) * w[5]); o.w = pk2(bflo(v.w) * w[6], bfhi(v.w) * w[7]);
                Af[i] = __builtin_bit_cast(bf16x8, o); }
#pragma unroll
            for (int j = 0; j < 4; ++j) Bf[j] = *(const bf16x8*)(BF + (size_t)((nh * 4 + j) * 16 + fr) * 256 + s0);
#pragma unroll
            for (int i = 0; i < 4; ++i)
#pragma unroll
                for (int j = 0; j < 4; ++j) acc[i][j] = MFMA16(Af[i], Bf[j], acc[i][j]);
        }
#pragma unroll
        for (int i = 0; i < 4; ++i)
#pragma unroll
            for (int j = 0; j < 4; ++j)
#pragma unroll
                for (int e = 0; e < 4; ++e) ST[(i * 16 + fq * 4 + e) * 128 + (nh * 4 + j) * 16 + fr] = (bf16)f2bf(acc[i][j][e]);
    }
}

__device__ __forceinline__ void p4_ssd_scan_item(const Args& a, int item, int tid) {
    unsigned char* ws = a.ws; const int e = item * 2048 + tid * 4;
    const int b = e >> 17, hpn = e & 131071, h = hpn >> 13;
    const bf16* ST = (const bf16*)(ws + WS_ST); bf16* PREV = (bf16*)(ws + WS_PREV); const float* DEC = (const float*)(ws + WS_DEC);
    v2u st[32]; float dec[32];
    st[0] = *(const v2u*)(ST + hpn); dec[0] = 0.f;
#pragma unroll
    for (int k = 1; k < 32; ++k) { const int q = b * 32 + k; st[k] = *(const v2u*)(ST + (size_t)q * 131072 + hpn); dec[k] = DEC[q * 16 + h]; }
    float s0 = bflo(st[0].x), s1 = bfhi(st[0].x), s2 = bflo(st[0].y), s3 = bfhi(st[0].y);
#pragma unroll
    for (int c = 0; c < 32; ++c) {
        v2u o; o.x = pk2(s0, s1); o.y = pk2(s2, s3); *(v2u*)(PREV + (size_t)(b * 32 + c) * 131072 + hpn) = o;
        if (c < 31) { const float d = dec[c + 1]; const v2u v = st[c + 1];
            s0 = s0 * d + bflo(v.x); s1 = s1 * d + bfhi(v.x); s2 = s2 * d + bflo(v.y); s3 = s3 * d + bfhi(v.y); }
    }
}
__device__ __forceinline__ void p4_s5_scan_item(const Args& a, int item, unsigned char* lds, int tid) {
    unsigned char* ws = a.ws; const int b = item >> 7, g = (item >> 1) & 63, p = (item & 1) * 32 + (tid & 31), seg = tid >> 5;
    const f32x2 a1 = ((const f32x2*)(ws + WS_A1))[g * 64 + p], a16 = ((const f32x2*)(ws + WS_A16))[g * 64 + p];
    const f32x2* Bb = (const f32x2*)(ws + WS_BBAR) + (size_t)(g * 64 + p) * 16;
    const bf16* UM = (const bf16*)(ws + WS_UMETA);
    const f32x2* SE = (const f32x2*)(ws + WS_SEND) + ((size_t)(g * 1024 + b * 512 + seg * 32) * 64 + p);
    f32x2 se[32];
#pragma unroll
    for (int j = 0; j < 32; ++j) se[j] = SE[(size_t)j * 64];
    float sr = 0.f, si = 0.f;
    for (int s = 0; s < 16; ++s) { float br = 0.f, bi = 0.f;
#pragma unroll
        for (int h = 0; h < 16; ++h) { const float u = bf2f(UM[s * 1024 + g * 16 + h]); const f32x2 bb = Bb[h]; br += bb.x * u; bi += bb.y * u; }
        const float nr = a1.x * sr - a1.y * si + br, ni = a1.x * si + a1.y * sr + bi; sr = nr; si = ni; }
    float er = 0.f, ei = 0.f;
#pragma unroll
    for (int j = 0; j < 32; ++j) { const float nr = a16.x * er - a16.y * ei + se[j].x, ni = a16.x * ei + a16.y * er + se[j].y; er = nr; ei = ni; }
    f32x2* EL = (f32x2*)lds;
    EL[seg * 32 + (tid & 31)] = (f32x2){er, ei};
    float pr = a16.x, pi = a16.y;
#pragma unroll
    for (int k = 0; k < 5; ++k) { const float nr = pr * pr - pi * pi, ni = 2.f * pr * pi; pr = nr; pi = ni; }
    __syncthreads();
    for (int k = 0; k < seg; ++k) { const f32x2 ek = EL[k * 32 + (tid & 31)]; const float nr = pr * sr - pi * si + ek.x, ni = pr * si + pi * sr + ek.y; sr = nr; si = ni; }
    unsigned* UA = (unsigned*)((bf16*)(ws + WS_UA) + ((size_t)(g * 1024 + b * 512 + seg * 32) * 384 + 256 + 2 * p));
#pragma unroll
    for (int j = 0; j < 32; ++j) { UA[(size_t)j * 192] = pk2(sr, si);
        const float nr = a16.x * sr - a16.y * si + se[j].x, ni = a16.x * si + a16.y * sr + se[j].y; sr = nr; si = ni; }
    __syncthreads();
}

__device__ __forceinline__ void p5_ssd_out_unit(const Args& a, int q, int g, int half, unsigned char* lds, int tid) {
    unsigned char* ws = a.ws; const int lane = tid & 63, r = tid >> 6, h = g * 8 + r, fr = lane & 15, fq = lane >> 4;
    bf16* CBs = (bf16*)lds;
    float* ACSs = (float*)(lds + 256 * 264 * 2);
    float* DTs = ACSs + 8 * 256;
    const bf16* CT = (const bf16*)(ws + WS_CT) + (size_t)q * 65536 + g * 128;
    const bf16* BTK = (const bf16*)(ws + WS_BTK) + (size_t)q * 65536 + g * 128;
    for (int i = tid; i < 2048; i += NT) { ACSs[i] = ((const float*)(ws + WS_ACS))[((size_t)q * 16 + g * 8) * 256 + i]; DTs[i] = ((const float*)(ws + WS_DT))[((size_t)q * 16 + g * 8) * 256 + i]; }
    {
        int cnt = 0;
#pragma unroll 1
        for (int ti = 0; ti < 8; ++ti) {
            const int lt = half ? 4 + ti : (ti < 4 ? ti : 8 + ti);
#pragma unroll 1
            for (int stl = 0; stl <= lt; ++stl, ++cnt) {
                if ((cnt & 7) != r) continue;
                f32x4 c = (f32x4){0.f, 0.f, 0.f, 0.f};
#pragma unroll
                for (int k = 0; k < 4; ++k) { const bf16x8 Af = *(const bf16x8*)(CT + (size_t)(lt * 16 + fr) * 256 + k * 32 + fq * 8);
                    const bf16x8 Bf = *(const bf16x8*)(BTK + (size_t)(stl * 16 + fr) * 256 + k * 32 + fq * 8); c = MFMA16(Af, Bf, c); }
#pragma unroll
                for (int e = 0; e < 4; ++e) CBs[(lt * 16 + fq * 4 + e) * 264 + stl * 16 + fr] = (bf16)f2bf(c[e]);
            }
        }
    }
    __syncthreads();
    const bf16* XF = (const bf16*)(ws + WS_XF) + ((size_t)q * 1024 + h * 64) * 256;
    const bf16* PREV = (const bf16*)(ws + WS_PREV) + ((size_t)(q - 1) * 16 + h) * 8192;
    const float* acs = ACSs + r * 256; const float* dts = DTs + r * 256;
    const float dsk = a.in[I_DSSD][h];
    const int b = (q - 1) >> 5, c = (q - 1) & 31; const int m0 = b * 8192 + c * 256;
    bf16* MIX = (bf16*)(ws + WS_MIX); float* SSS = (float*)(ws + WS_SS);
#pragma unroll 1
    for (int lbi = 0; lbi < 2; ++lbi) {
        const int lb = half ? 1 + lbi : 3 * lbi;
        f32x4 acc[4][4];
#pragma unroll
        for (int i = 0; i < 4; ++i)
#pragma unroll
            for (int j = 0; j < 4; ++j) acc[i][j] = (f32x4){0.f, 0.f, 0.f, 0.f};
#pragma unroll 1
        for (int k = 0; k < 4; ++k) { bf16x8 Af[4], Bf[4];
#pragma unroll
            for (int i = 0; i < 4; ++i) Af[i] = *(const bf16x8*)(CT + (size_t)(lb * 64 + i * 16 + fr) * 256 + k * 32 + fq * 8);
#pragma unroll
            for (int j = 0; j < 4; ++j) Bf[j] = *(const bf16x8*)(PREV + (size_t)(j * 16 + fr) * 128 + k * 32 + fq * 8);
#pragma unroll
            for (int i = 0; i < 4; ++i)
#pragma unroll
                for (int j = 0; j < 4; ++j) acc[i][j] = MFMA16(Af[i], Bf[j], acc[i][j]); }
#pragma unroll
        for (int i = 0; i < 4; ++i)
#pragma unroll
            for (int e = 0; e < 4; ++e) { const float sc = expf_(acs[lb * 64 + i * 16 + fq * 4 + e]);
#pragma unroll
                for (int j = 0; j < 4; ++j) acc[i][j][e] *= sc; }
        const int nsb = 2 * lb + 2;
#pragma unroll 1
        for (int sb = 0; sb < nsb; ++sb) {
            const int s0 = sb * 32 + fq * 8;
            bf16x8 Bf[4];
#pragma unroll
            for (int j = 0; j < 4; ++j) Bf[j] = *(const bf16x8*)(XF + (size_t)(j * 16 + fr) * 256 + s0);
            float as[8], ds[8];
#pragma unroll
            for (int j = 0; j < 8; ++j) { as[j] = acs[s0 + j]; ds[j] = dts[s0 + j]; }
#pragma unroll
            for (int i = 0; i < 4; ++i) {
                const int l = lb * 64 + i * 16 + fr;
                if (sb * 32 > lb * 64 + i * 16 + 15) continue;
                const float al = acs[l];
                const v4u v = *(const v4u*)(CBs + l * 264 + s0); const unsigned w4[4] = {v.x, v.y, v.z, v.w}; float pv[8];
#pragma unroll
                for (int j = 0; j < 4; ++j) {
                    const float p0 = bflo(w4[j]) * expf_(fminf(al - as[2 * j], 0.f)) * ds[2 * j], p1 = bfhi(w4[j]) * expf_(fminf(al - as[2 * j + 1], 0.f)) * ds[2 * j + 1];
                    pv[2 * j] = (s0 + 2 * j <= l) ? p0 : 0.f; pv[2 * j + 1] = (s0 + 2 * j + 1 <= l) ? p1 : 0.f; }
                v4u o; o.x = pk2(pv[0], pv[1]); o.y = pk2(pv[2], pv[3]); o.z = pk2(pv[4], pv[5]); o.w = pk2(pv[6], pv[7]);
                const bf16x8 Af = __builtin_bit_cast(bf16x8, o);
#pragma unroll
                for (int j = 0; j < 4; ++j) acc[i][j] = MFMA16(Af, Bf[j], acc[i][j]);
            }
        }
#pragma unroll
        for (int i = 0; i < 4; ++i) {
            const int l0 = lb * 64 + i * 16 + fq * 4; float ssq[4] = {0.f, 0.f, 0.f, 0.f};
#pragma unroll
            for (int j = 0; j < 4; ++j) {
                const int p = j * 16 + fr; const v2u xv = *(const v2u*)(XF + (size_t)p * 256 + l0);
                const float xs[4] = {bflo(xv.x), bfhi(xv.x), bflo(xv.y), bfhi(xv.y)};
#pragma unroll
                for (int e = 0; e < 4; ++e) { bf16* zp = MIX + (size_t)(m0 + l0 + e) * 2048 + h * 64 + p; const float z = bf2f(*zp);
                    const float y = (acc[i][j][e] + dsk * xs[e]) * silu_(z); *zp = (bf16)f2bf(y); ssq[e] += y * y; }
            }
#pragma unroll
            for (int e = 0; e < 4; ++e) { float s = ssq[e]; s += __shfl_xor(s, 1); s += __shfl_xor(s, 2); s += __shfl_xor(s, 4); s += __shfl_xor(s, 8);
                if (fr == 0) atomicAdd(SSS + m0 + l0 + e, s); }
        }
    }
    __syncthreads();
}

__device__ __forceinline__ void p10_final(const Args& a, int tid, int G) {
    const int lane = tid & 63, wave = tid >> 6; const int gw = blockIdx.x * NWAVES + wave, NGW = G * NWAVES;
    const float* SSF = (const float*)(a.ws + WS_SS) + 3 * 16384; const f32x4* gf = (const f32x4*)a.in[I_GFIN] + lane;
    for (int m = gw; m < MR; m += NGW) { f32x4* row = (f32x4*)(a.out + (size_t)m * 1024) + lane; const float rs = 1.0f / sqrtf(SSF[m] * (1.0f / 1024.0f) + EPS);
#pragma unroll
        for (int j = 0; j < 4; ++j) row[64 * j] = row[64 * j] * rs * gf[64 * j]; }
}

__global__ void __launch_bounds__(NT, 2) fwd_kernel(Args args) {
    extern __shared__ __attribute__((aligned(16))) unsigned char lds[];
    cg::grid_group grid = cg::this_grid();
    const int tid = threadIdx.x, G = gridDim.x, bx = blockIdx.x;
    unsigned char* ws = args.ws;
    PG8_LAS unsigned char* ldsl = (PG8_LAS unsigned char*)lds;
    const int lo = args.ph_lo, hi = args.ph_hi;
#ifndef SKIPMASK
#define SKIPMASK 0
#endif
#define IN(k) (!((SKIPMASK >> (k)) & 1) && lo <= (k) && (k) < hi)
    volatile LAS unsigned* bst = (volatile LAS unsigned*)(ldsl + 155136);
    if (tid < 2) bst[tid] = 0u;
    __syncthreads();
    XcdBarrier xbar = xcd_barrier_post((unsigned*)(ws + WS_BAR), bst);
#define SEAM(k) do { if (IN(k) && IN((k) + 1)) { if ((k) == 0) grid.sync(); else xcd_barrier(xbar); } } while (0)
    float* SS = (float*)(ws + WS_SS);
    if (IN(0)) { const int tid = pg8::fresh_tid(); p0_prologue(args, lds, tid, G); }
    SEAM(0);
    if (IN(1)) {
        pg8::Gemm g{(const bf16*)(ws + WS_XN), (const bf16*)(ws + WS_WIN), MP, NIN, 1024, 1024, 1024, 0, 0}; pg8::StaticOrder S; S.init(MP, NIN, G, bx);
        pg8::EpiInProj E{(bf16*)(ws + WS_MIX), (bf16*)(ws + WS_XBCP), (bf16*)(ws + WS_UA), (bf16*)(ws + WS_UMETA), (float*)(ws + WS_DTRAW)};
        pg8::gemm_phase<pg8::EpiInProj, pg8::StaticOrder, true, true>(ldsl, g, S, E);
    }
    SEAM(1);
    if (IN(2)) {
        const int tid = pg8::fresh_tid(), wave = tid >> 6, lane = tid & 63;
        for (int u = bx; u < NQ * 24; u += G) p2_conv_unit(args, u / 24, u % 24, lds, tid);
        for (int it = bx * NWAVES + wave; it < NQ * 16; it += G * NWAVES) p2_dt_item(args, it >> 4, it & 15, lane);
    }
    SEAM(2);
    const int nS3 = (G / 2 < 126) ? G / 2 : 126;
    if (IN(3)) {
        const int tid = pg8::fresh_tid();
        if (bx < nS3) { for (int u = bx; u < 126; u += nS3) { const int qi = u >> 1; p3_states_unit(args, qi < 32 ? qi : qi + 1, u & 1, tid); } }
        pg8::Gemm g{(const bf16*)(ws + WS_UA), (const bf16*)(ws + WS_TE5), 1024, 256, 256, 384, 256, (size_t)1024 * 384 * 2, (size_t)256 * 256 * 2};
        pg8::BatchOrder S; S.init(256, 4, G, nS3, bx);
        pg8::EpiS5a E{(float*)(ws + WS_SEND)};
        pg8::gemm_phase<pg8::EpiS5a, pg8::BatchOrder, true, true>(ldsl, g, S, E);
    }
    SEAM(3);
    if (IN(4)) {
        const int tid = pg8::fresh_tid();
        for (int it = bx; it < 384; it += G) { if (it < 256) p4_s5_scan_item(args, it, lds, tid); else p4_ssd_scan_item(args, it - 256, tid); }
    }
    SEAM(4);
    if (IN(5)) {
        const int tid = pg8::fresh_tid();
#ifndef NO_SSDOUT
        for (int u = bx; u < 256; u += G) p5_ssd_out_unit(args, 1 + (u >> 2), (u >> 1) & 1, u & 1, lds, tid);
        __syncthreads();
#endif
        pg8::Gemm g{(const bf16*)(ws + WS_UA), (const bf16*)(ws + WS_TB5), 1024, 256, 384, 384, 384, (size_t)1024 * 384 * 2, (size_t)256 * 384 * 2};
        pg8::BatchOrder S; S.init(256, 4, G, 0, bx);
        pg8::EpiS5b E{(bf16*)(ws + WS_Y5)};
        pg8::gemm_phase<pg8::EpiS5b, pg8::BatchOrder, true, true>(ldsl, g, S, E);
    }
    SEAM(5);
    if (IN(6)) {
        const int tid = pg8::fresh_tid();
        p6_weights(args, lds, tid, G);
        pg8::Gemm g{(const bf16*)(ws + WS_Y5), (const bf16*)(ws + WS_WGLU), MR, 2048, 1024, 1024, 1024, 0, 0}; pg8::StaticOrder S; S.init(MR, 2048, G, bx);
        pg8::EpiGlu E{(bf16*)(ws + WS_MIX), args.in[I_BGLU], SS + 16384};
        pg8::gemm_phase<pg8::EpiGlu, pg8::StaticOrder, true, true>(ldsl, g, S, E);
    }
    SEAM(6);
    if (IN(7)) {
        pg8::StaticOrder S; S.init(MR, 1024, G, bx);
        { pg8::Gemm g{(const bf16*)(ws + WS_MIX), (const bf16*)(ws + WS_WOUT), MR, 1024, 1024, 2048, 2048, 0, 0};
          pg8::EpiOut<false> E{args.in[I_X], args.out, (bf16*)(ws + WS_H1B), SS, SS + 2 * 16384};
          pg8::gemm_phase<pg8::EpiOut<false>, pg8::StaticOrder, true, true>(ldsl, g, S, E); }
        { pg8::Gemm g{(const bf16*)(ws + WS_MIX) + 1024, (const bf16*)(ws + WS_WOUT) + 1024, MR, 1024, 1024, 2048, 2048, 0, 0};
          pg8::EpiOut<true> E{args.out, args.out, (bf16*)(ws + WS_H1B), SS + 16384, SS + 2 * 16384};
          pg8::gemm_phase<pg8::EpiOut<true>, pg8::StaticOrder, true, true>(ldsl, g, S, E); }
    }
    SEAM(7);
    if (IN(8)) {
        pg8::Gemm g{(const bf16*)(ws + WS_H1B), (const bf16*)(ws + WS_WUP), MR, 4096, 1024, 1024, 1024, 0, 0}; pg8::StaticOrder S; S.init(MR, 4096, G, bx);
        pg8::EpiUp E{(bf16*)(ws + WS_HB), SS + 2 * 16384};
        pg8::gemm_phase<pg8::EpiUp, pg8::StaticOrder, true, true>(ldsl, g, S, E);
    }
    SEAM(8);
    if (IN(9)) {
        pg8::Gemm g{(const bf16*)(ws + WS_HB), (const bf16*)(ws + WS_WDN), MR, 1024, 4096, 4096, 4096, 0, 0}; pg8::StaticOrder S; S.init(MR, 1024, G, bx);
        pg8::EpiDown E{args.out, SS + 3 * 16384};
        pg8::gemm_phase<pg8::EpiDown, pg8::StaticOrder, true, true>(ldsl, g, S, E);
    }
    SEAM(9);
    if (IN(10)) { const int tid = pg8::fresh_tid(); p10_final(args, tid, G); }
#undef IN
#undef SEAM
}

#ifndef N_LAUNCHES
#define N_LAUNCHES 1
#endif
extern "C" void kernel_launch(void* const* d_in, const int* in_sizes, int n_in, void* d_out, int out_size, void* d_ws, size_t ws_size, hipStream_t stream) {
    static int grid = 0;
    if (grid == 0) {
        int dev = 0, cus = 0, per_cu = 0;
        hipGetDevice(&dev); hipDeviceGetAttribute(&cus, hipDeviceAttributeMultiprocessorCount, dev);
        hipFuncSetAttribute((const void*)fwd_kernel, hipFuncAttributeMaxDynamicSharedMemorySize, LDS_BYTES);
        hipOccupancyMaxActiveBlocksPerMultiprocessor(&per_cu, (const void*)fwd_kernel, NT, LDS_BYTES);
        if (per_cu < 1) { fprintf(stderr, "occupancy query says %d blocks per CU\n", per_cu); per_cu = 1; }
        grid = cus * 1;
        (void)hipGetLastError();
    }
    hipMemsetAsync((char*)d_ws + WS_BAR, 0, 16384, stream);
    Args a{};
    for (int i = 0; i < 26; ++i) a.in[i] = (const float*)d_in[i];
    a.out = (float*)d_out; a.ws = (unsigned char*)d_ws;
    if (N_LAUNCHES == 1) {
        a.ph_lo = 0; a.ph_hi = 11;
        void* args[] = {&a};
        hipError_t e = hipLaunchCooperativeKernel((const void*)fwd_kernel, dim3(grid), dim3(NT), args, LDS_BYTES, stream);
        if (e != hipSuccess) fprintf(stderr, "cooperative launch failed: %s (grid %d)\n", hipGetErrorString(e), grid);
    } else {
        for (int p = 0; p < 11; ++p) { a.ph_lo = p; a.ph_hi = p + 1; hipLaunchKernelGGL(fwd_kernel, dim3(grid), dim3(NT), LDS_BYTES, stream, a); }
    }
}
```

```cpp
#include <hip/hip_runtime.h>
#include <cstdio>
#include <cstdint>
namespace pg8 {
#define PG8_LAS __attribute__((address_space(3)))
typedef unsigned short bf16_t;
typedef short bf16x8 __attribute__((ext_vector_type(8)));
typedef float f32x4 __attribute__((ext_vector_type(4)));
typedef unsigned u32x4 __attribute__((ext_vector_type(4)));
constexpr int BM = 256, BK = 64, HALF = 128, HTB = HALF * BK * 2  , STAGE_BYTES = 8 * HTB, NXCD = 8, WGM = 8;

__host__ __device__ __forceinline__ int lds_byte(int r, int c) { const int st = (r >> 4) * 2 + (c >> 5), rr = r & 15, cc = c & 31, ob = rr * 64 + cc * 2; return st * 1024 + (ob ^ (((ob >> 9) & 1) << 5)); }
__host__ __device__ __forceinline__ void stage_rc(int b, int& R, int& C) { const int st = b / 1024, sb = b % 1024, swz = sb ^ (((sb >> 9) & 1) << 5); R = (st >> 1) * 16 + swz / 64; C = (st & 1) * 32 + (swz % 64) / 2; }
__host__ __device__ __forceinline__ int perm32(int rho) { const int n = rho >> 4, i = rho & 15; return 8 * (i >> 2) + 4 * n + (i & 3); }

struct Unit { int pm, pn, g, par, kh; };
struct Gemm { const bf16_t* A; const bf16_t* Bt; int M, N, K, lda, ldb; size_t gsA, gsB; size_t khA = 0, khB = 0; };

struct StaticOrder {
    int nM, nN, nwg, G, c;
    __host__ __device__ void init(int M, int N, int G_, int c_) { nM = M / BM; nN = N / BM; nwg = nM * nN; G = G_; c = c_; }
    __host__ __device__ bool next(int i, Unit& u) const {
        const long L = (long)i * G + c; if (L >= nwg) return false;
        int wgid = (int)L; { const int q = nwg / NXCD, r = nwg % NXCD, xcd = wgid % NXCD, off = wgid / NXCD; wgid = (xcd < r ? xcd * (q + 1) : r * (q + 1) + (xcd - r) * q) + off; }
        const int nig = WGM * nN, gid = wgid / nig, fm = gid * WGM, gsz = (nM - fm) < WGM ? (nM - fm) : WGM;
        u.pm = fm + ((wgid % nig) % gsz); u.pn = (wgid % nig) / gsz; u.g = 0; u.par = i & 1; u.kh = 0; return true;
    }
    __device__ __forceinline__ void a_ready(const Unit&) const {}
    __device__ __forceinline__ void done(const Unit&) const {}
};

__device__ __forceinline__ unsigned cvt_pk_bf16(float lo, float hi) { unsigned r; asm volatile("v_cvt_pk_bf16_f32 %0, %1, %2" : "=v"(r) : "v"(lo), "v"(hi)); return r; }
typedef float f32x2 __attribute__((ext_vector_type(2)));
__device__ __forceinline__ f32x2 gelu_pk(f32x2 v) {
    const f32x2 av = __builtin_elementwise_abs(v), d = av * 0.2316418882f + 1.0f;
    f32x2 t; t.x = __builtin_amdgcn_rcpf(d.x); t.y = __builtin_amdgcn_rcpf(d.y);
    f32x2 q = t * 0.5307027145f + (-0.7265760135f); q = q * t + 0.7107068705f; q = q * t + (-0.142248368f); q = q * t + 0.127414796f; q = q * t;
    const f32x2 s = (v * v) * (-0.72134752044f);
    f32x2 e; e.x = __builtin_amdgcn_exp2f(s.x); e.y = __builtin_amdgcn_exp2f(s.y);
    const f32x2 m = v * (q * e), r = v - m;
    f32x2 o; o.x = v.x < 0.f ? m.x : r.x; o.y = v.y < 0.f ? m.y : r.y; return o;
}

__device__ __forceinline__ int fresh_tid() { int t; asm volatile("v_mov_b32 %0, %1" : "=v"(t) : "v"((int)threadIdx.x)); return t; }
#define EPI_ROWS_COLS const int rowb = u.pm * BM + wr * 64 + fr; const int colb = wc * 32 + 8 * fq;
__device__ __forceinline__ u32x4 pack8(const f32x4 v0, const f32x4 v1) { u32x4 w; w.x = cvt_pk_bf16(v0[0], v0[1]); w.y = cvt_pk_bf16(v0[2], v0[3]); w.z = cvt_pk_bf16(v1[0], v1[1]); w.w = cvt_pk_bf16(v1[2], v1[3]); return w; }
__device__ __forceinline__ float sum8sq(const f32x4 a, const f32x4 b) { return (a[0] * a[0] + a[1] * a[1]) + (a[2] * a[2] + a[3] * a[3]) + (b[0] * b[0] + b[1] * b[1]) + (b[2] * b[2] + b[3] * b[3]); }

struct EpiInProj {
    static constexpr bool PERM = true, AFTER_DRAIN = false, HAS_MID = false;
    bf16_t* MIX; bf16_t* XBCP; bf16_t* UA; bf16_t* UMETA; float* DTRAW;
    __device__ __forceinline__ void operator()(const f32x4 (&acc)[2][2][4][2], const Unit& u, int wr, int wc, int fr, int fq) const {
        EPI_ROWS_COLS
        const int pn = u.pn;
#pragma unroll
        for (int ai = 0; ai < 2; ++ai)
#pragma unroll
            for (int m = 0; m < 4; ++m) {
                const int r = rowb + ai * HALF + m * 16;
#pragma unroll
                for (int bj = 0; bj < 2; ++bj) {
                    const int c = pn * BM + bj * HALF + colb;
                    const f32x4 v0 = acc[ai][bj][m][0], v1 = acc[ai][bj][m][1];
                    if (pn < 4) { if (r < 16384) *(u32x4*)(MIX + (size_t)r * 2048 + c) = pack8(v0, v1); }
                    else if (pn < 10) { *(u32x4*)(XBCP + (size_t)r * 1536 + (c - 1024)) = pack8(v0, v1); }
                    else if (pn < 14) {
                        const int j = c - 2560, g = j >> 4, h0 = j & 15;
                        if (r < 16384) { const int b = r >> 13, tok = r & 8191, ch = tok >> 4, t = tok & 15;
                            *(u32x4*)(UA + ((size_t)(g * 1024 + b * 512 + ch) * 384 + t * 16 + h0)) = pack8(v0, v1); }
                        else *(u32x4*)(UMETA + (size_t)(r - 16384) * 1024 + j) = pack8(v0, v1);
                    } else {
                        const int j = c - 3584;
                        if (j < 16) { float* d = DTRAW + (size_t)r * 16 + j; *(f32x4*)d = v0; *(f32x4*)(d + 4) = v1; }
                    }
                }
            }
    }
};
struct EpiS5a {
    static constexpr bool PERM = true, AFTER_DRAIN = false, HAS_MID = false;
    float* SEND;
    __device__ __forceinline__ void operator()(const f32x4 (&acc)[2][2][4][2], const Unit& u, int wr, int wc, int fr, int fq) const {
        EPI_ROWS_COLS
#pragma unroll
        for (int ai = 0; ai < 2; ++ai)
#pragma unroll
            for (int m = 0; m < 4; ++m) {
                const int r = rowb + ai * HALF + m * 16;
                float* d = SEND + ((size_t)(u.g * 1024 + r) * 128 + colb);
                *(f32x4*)d = acc[ai][0][m][0]; *(f32x4*)(d + 4) = acc[ai][0][m][1];
            }
    }
};
struct EpiS5b {
    static constexpr bool PERM = true, AFTER_DRAIN = false, HAS_MID = false;
    bf16_t* Y5;
    __device__ __forceinline__ void operator()(const f32x4 (&acc)[2][2][4][2], const Unit& u, int wr, int wc, int fr, int fq) const {
        { const int t2 = fresh_tid(); const int w2 = t2 >> 6, l2 = t2 & 63; wr = w2 >> 2; wc = w2 & 3; fr = l2 & 15; fq = l2 >> 4; }
        const unsigned lane_off = (unsigned)((((u.pm >> 1) * 8192 + (((u.pm & 1) * 256 + wr * 64 + fr) * 16) + (wc * 2 + (fq >> 1))) * 1024 + u.g * 16 + (fq & 1) * 8) * 2);
        char* base = (char*)Y5;
#pragma unroll
        for (int ai = 0; ai < 2; ++ai)
#pragma unroll
            for (int m = 0; m < 4; ++m)
#pragma unroll
                for (int bj = 0; bj < 2; ++bj) {
                    const f32x4 v0 = acc[ai][bj][m][0], v1 = acc[ai][bj][m][1]; u32x4 w;
                    { const f32x2 a = gelu_pk((f32x2){v0[0], v0[1]}); w.x = cvt_pk_bf16(a.x, a.y); } __builtin_amdgcn_sched_barrier(0);
                    { const f32x2 a = gelu_pk((f32x2){v0[2], v0[3]}); w.y = cvt_pk_bf16(a.x, a.y); } __builtin_amdgcn_sched_barrier(0);
                    { const f32x2 a = gelu_pk((f32x2){v1[0], v1[1]}); w.z = cvt_pk_bf16(a.x, a.y); } __builtin_amdgcn_sched_barrier(0);
                    { const f32x2 a = gelu_pk((f32x2){v1[2], v1[3]}); w.w = cvt_pk_bf16(a.x, a.y); } __builtin_amdgcn_sched_barrier(0);
                    const unsigned off = lane_off + (unsigned)(ai * 4194304 + m * 524288 + bj * 16384);
                    *(u32x4*)(base + off) = w;
                }
    }
};
__device__ __forceinline__ float sigm(float x) { return __builtin_amdgcn_rcpf(1.0f + __builtin_amdgcn_exp2f(-1.44269504f * x)); }
struct EpiGlu {
    static constexpr bool PERM = true, AFTER_DRAIN = false, HAS_MID = false;
    bf16_t* MIX; const float* bglu; float* SS5;
    __device__ __forceinline__ void operator()(const f32x4 (&acc)[2][2][4][2], const Unit& u, int wr, int wc, int fr, int fq) const {
        EPI_ROWS_COLS
        const int oc = u.pn * 128 + colb;
        const f32x4 ba0 = *(const f32x4*)(bglu + oc), ba1 = *(const f32x4*)(bglu + oc + 4), bg0 = *(const f32x4*)(bglu + 1024 + oc), bg1 = *(const f32x4*)(bglu + 1024 + oc + 4);
#pragma unroll
        for (int ai = 0; ai < 2; ++ai)
#pragma unroll
            for (int m = 0; m < 4; ++m) {
                const int r = rowb + ai * HALF + m * 16;
                f32x4 a0 = acc[ai][0][m][0] + ba0, a1 = acc[ai][0][m][1] + ba1; const f32x4 g0 = acc[ai][1][m][0] + bg0, g1 = acc[ai][1][m][1] + bg1;
#pragma unroll
                for (int e = 0; e < 4; ++e) { a0[e] *= sigm(g0[e]); a1[e] *= sigm(g1[e]); }
                *(u32x4*)(MIX + (size_t)r * 2048 + 1024 + oc) = pack8(a0, a1);
                float s = sum8sq(a0, a1); s += __shfl_xor(s, 16); s += __shfl_xor(s, 32);
                if (fq == 0) atomicAdd(SS5 + r, s);
            }
    }
};
struct EpiOut {
    static constexpr bool PERM = true, AFTER_DRAIN = false, HAS_MID = true;
    const float* X; float* H1; bf16_t* H1B; const float* SSS; const float* SS5; float* SSM;
    __device__ __forceinline__ void mid(f32x4 (&acc)[2][2][4][2], const Unit& u, int wr, int wc, int fr, int fq) const {
        const int rowb = u.pm * BM + wr * 64 + fr;
#pragma unroll
        for (int ai = 0; ai < 2; ++ai)
#pragma unroll
            for (int m = 0; m < 4; ++m) {
                const int r = rowb + ai * HALF + m * 16;
                const float ratio = sqrtf((SS5[r] * (1.0f / 1024.0f) + 1e-5f) / (SSS[r] * (1.0f / 1024.0f) + 1e-5f));
#pragma unroll
                for (int bj = 0; bj < 2; ++bj)
#pragma unroll
                    for (int n = 0; n < 2; ++n) acc[ai][bj][m][n] *= ratio;
                asm volatile("" ::: "memory");
            }
    }
    __device__ __forceinline__ void operator()(const f32x4 (&acc)[2][2][4][2], const Unit& u, int wr, int wc, int fr, int fq) const {
        EPI_ROWS_COLS
        const unsigned lane_off = (unsigned)(rowb * 1024 + u.pn * BM + colb);
        const char* xb = (const char*)X; char* hb = (char*)H1; char* bb = (char*)H1B;
#pragma unroll
        for (int ai = 0; ai < 2; ++ai)
#pragma unroll
            for (int m = 0; m < 4; ++m) {
                const int r = rowb + ai * HALF + m * 16;
                const float rs = 1.0f / sqrtf(SS5[r] * (1.0f / 1024.0f) + 1e-5f);
                float s = 0.f;
#pragma unroll
                for (int bj = 0; bj < 2; ++bj) {
                    const unsigned off = lane_off + (unsigned)(ai * 131072 + m * 16384 + bj * 128);
                    const f32x4 v0 = *(const f32x4*)(xb + off * 4u) + acc[ai][bj][m][0] * rs, v1 = *(const f32x4*)(xb + off * 4u + 16u) + acc[ai][bj][m][1] * rs;
                    *(f32x4*)(hb + off * 4u) = v0; *(f32x4*)(hb + off * 4u + 16u) = v1;
                    *(u32x4*)(bb + off * 2u) = pack8(v0, v1); s += sum8sq(v0, v1);
                }
                s += __shfl_xor(s, 16); s += __shfl_xor(s, 32);
                if (fq == 0) atomicAdd(SSM + r, s);
                asm volatile("" ::: "memory");
            }
    }
};
struct SplitKOrder {
    StaticOrder base;
    __device__ bool next(int i, Unit& u) const { if (!base.next(i >> 1, u)) return false; u.kh = i & 1; u.par = i & 1; return true; }
    __device__ __forceinline__ void a_ready(const Unit&) const {}
    __device__ __forceinline__ void done(const Unit&) const {}
};
struct EpiUp {
    static constexpr bool PERM = true, AFTER_DRAIN = false, HAS_MID = false;
    bf16_t* HB; const float* SSM;
    __device__ __forceinline__ void operator()(const f32x4 (&acc)[2][2][4][2], const Unit& u, int wr, int wc, int fr, int fq) const {
        EPI_ROWS_COLS
#pragma unroll
        for (int ai = 0; ai < 2; ++ai)
#pragma unroll
            for (int m = 0; m < 4; ++m) {
                const int r = rowb + ai * HALF + m * 16;
                const float rs = 1.0f / sqrtf(SSM[r] * (1.0f / 1024.0f) + 1e-5f);
#pragma unroll
                for (int bj = 0; bj < 2; ++bj) {
                    f32x4 v0 = acc[ai][bj][m][0] * rs, v1 = acc[ai][bj][m][1] * rs;
#pragma unroll
                    for (int e = 0; e < 4; ++e) { const float p = fmaxf(v0[e], 0.f), q = fmaxf(v1[e], 0.f); v0[e] = p * p; v1[e] = q * q; }
                    *(u32x4*)(HB + (size_t)r * 4096 + u.pn * BM + bj * HALF + colb) = pack8(v0, v1);
                }
            }
    }
};
struct EpiDown {
    static constexpr bool PERM = true, AFTER_DRAIN = false, HAS_MID = false;
    float* H; float* SSF;
    __device__ __forceinline__ void operator()(const f32x4 (&acc)[2][2][4][2], const Unit& u, int wr, int wc, int fr, int fq) const {
        EPI_ROWS_COLS
#pragma unroll
        for (int ai = 0; ai < 2; ++ai)
#pragma unroll
            for (int m = 0; m < 4; ++m) {
                const int r = rowb + ai * HALF + m * 16;
                float s = 0.f;
#pragma unroll
                for (int bj = 0; bj < 2; ++bj) {
                    const size_t off = (size_t)r * 1024 + u.pn * BM + bj * HALF + colb;
                    const f32x4 v0 = *(const f32x4*)(H + off) + acc[ai][bj][m][0], v1 = *(const f32x4*)(H + off + 4) + acc[ai][bj][m][1];
                    *(f32x4*)(H + off) = v0; *(f32x4*)(H + off + 4) = v1;
                    s += sum8sq(v0, v1);
                }
                s += __shfl_xor(s, 16); s += __shfl_xor(s, 32);
                if (fq == 0) atomicAdd(SSF + r, s);
            }
    }
};
struct BatchOrder {
    int nU, per_g, Ge, ce;
    __host__ __device__ void init(int nU_, int per_g_, int G, int w0, int c) { nU = nU_; per_g = per_g_; Ge = G - w0; ce = c - w0; }
    __device__ bool next(int i, Unit& u) const {
        if (ce < 0) return false;
        const long L = (long)i * Ge + ce; if (L >= nU) return false;
        u.g = __builtin_amdgcn_readfirstlane((int)L / per_g); u.pm = __builtin_amdgcn_readfirstlane((int)L % per_g); u.pn = 0; u.par = i & 1; u.kh = 0; return true;
    }
    __device__ __forceinline__ void a_ready(const Unit&) const {}
    __device__ __forceinline__ void done(const Unit&) const {}
};
template <class Epi, class Sched, bool ALIGN_EPI = false, bool SP2 = false>
__device__ __forceinline__ void gemm_phase(PG8_LAS unsigned char* lds, const Gemm g, const Sched& S, const Epi& E) {
    const int tid = threadIdx.x, wid = __builtin_amdgcn_readfirstlane(tid >> 6), lane = tid & 63, wr = wid >> 2, wc = wid & 3, fr = lane & 15, fq = lane >> 4;
    const int K = g.K, nt = K / BK;
    unsigned voffA[2], voffB[2];
#pragma unroll
    for (int i = 0; i < 2; ++i) { int R, C; stage_rc(tid * 16 + i * 8192, R, C); const int Rb = Epi::PERM ? ((R & ~31) + perm32(R & 31)) : R;
        voffA[i] = (unsigned)(R * g.lda + C) * 2u; voffB[i] = (unsigned)(Rb * g.ldb + C) * 2u; }
    const size_t kstep = (size_t)(BK * 2);
    const size_t hstepA = (size_t)HALF * g.lda * 2, hstepB = (size_t)HALF * g.ldb * 2;
    const size_t tstepA = 2 * hstepA, tstepB = 2 * hstepB;
    const unsigned ldsw = (unsigned)wid * 1024u;
    const int aoff = lds_byte(wr * 64 + fr, fq * 8), boff = lds_byte(wc * 32 + fr, fq * 8);
#define PG8_SA(b, h) (((b) * 2 + (h)) * HTB)
#define PG8_SB(b, h) ((4 + (b) * 2 + (h)) * HTB)
#define PG8_STAGE(bufoff, gbase, voff) do { _Pragma("unroll") for (int _i = 0; _i < 2; ++_i) \
        __builtin_amdgcn_global_load_lds((const unsigned*)((const char*)(gbase) + (voff)[_i]), (PG8_LAS unsigned*)(lds + (bufoff) + ldsw + _i * 8192), 16, 0, 0); } while (0)
#define PG8_LDA(dst, b, h) do { _Pragma("unroll") for (int m = 0; m < 4; ++m) _Pragma("unroll") for (int k = 0; k < 2; ++k) dst[m][k] = *(const PG8_LAS bf16x8*)(lds + PG8_SA(b, h) + aoff + m * 2048 + k * 1024); } while (0)
#define PG8_LDB(dst, b, h) do { _Pragma("unroll") for (int n = 0; n < 2; ++n) _Pragma("unroll") for (int k = 0; k < 2; ++k) dst[n][k] = *(const PG8_LAS bf16x8*)(lds + PG8_SB(b, h) + boff + n * 2048 + k * 1024); } while (0)
#define PG8_MMA(ai, bj, At, Bt) do { __builtin_amdgcn_s_setprio(1); _Pragma("unroll") for (int m = 0; m < 4; ++m) _Pragma("unroll") for (int n = 0; n < 2; ++n) _Pragma("unroll") for (int k = 0; k < 2; ++k) \
        acc[ai][bj][m][n] = __builtin_amdgcn_mfma_f32_16x16x32_bf16(Bt[n][k], At[m][k], acc[ai][bj][m][n], 0, 0, 0); __builtin_amdgcn_s_setprio(0); } while (0)
#define PG8_WAIT_V(n) asm volatile("s_waitcnt vmcnt(" #n ")" ::: "memory")
#define PG8_WAIT_L(n) asm volatile("s_waitcnt lgkmcnt(" #n ")" ::: "memory")
#define PG8_BAR __builtin_amdgcn_s_barrier()
#define PG8_SCHED __builtin_amdgcn_sched_barrier(0)
    Unit cur, nxt; int ui = 0;
    if (!S.next(0, cur)) return;
    f32x4 acc[2][2][4][2];
#pragma unroll
    for (int a = 0; a < 2; ++a)
#pragma unroll
        for (int b = 0; b < 2; ++b)
#pragma unroll
            for (int m = 0; m < 4; ++m)
#pragma unroll
                for (int n = 0; n < 2; ++n) acc[a][b][m][n] = (f32x4){0.f, 0.f, 0.f, 0.f};
    bf16x8 At[4][2], B0[2][2], B1[2][2];
    const char* cA = (const char*)g.A + (size_t)cur.g * g.gsA + (size_t)cur.pm * tstepA + (size_t)cur.kh * g.khA; const char* cB = (const char*)g.Bt + (size_t)cur.g * g.gsB + (size_t)cur.pn * tstepB + (size_t)cur.kh * g.khB;
    S.a_ready(cur);
    if constexpr (SP2) {
        PG8_STAGE(PG8_SB(0, 0), cB, voffB); PG8_STAGE(PG8_SB(0, 1), cB + hstepB, voffB); PG8_STAGE(PG8_SA(0, 0), cA, voffA); PG8_STAGE(PG8_SA(0, 1), cA + hstepA, voffA);
        if (wr == 1) PG8_BAR;
        PG8_WAIT_V(2); PG8_BAR;
        PG8_STAGE(PG8_SB(1, 0), cB + kstep, voffB); PG8_STAGE(PG8_SA(1, 0), cA + kstep, voffA); PG8_STAGE(PG8_SB(1, 1), cB + hstepB + kstep, voffB);
        PG8_WAIT_V(6); PG8_BAR;
    } else {
        PG8_STAGE(PG8_SB(0, 0), cB, voffB); PG8_STAGE(PG8_SA(0, 0), cA, voffA); PG8_STAGE(PG8_SB(0, 1), cB + hstepB, voffB); PG8_STAGE(PG8_SA(0, 1), cA + hstepA, voffA);
        if (wr == 1) PG8_BAR;
        PG8_WAIT_V(4); PG8_BAR;
        PG8_STAGE(PG8_SB(1, 0), cB + kstep, voffB); PG8_STAGE(PG8_SA(1, 0), cA + kstep, voffA); PG8_STAGE(PG8_SB(1, 1), cB + hstepB + kstep, voffB);
        PG8_WAIT_V(6); PG8_BAR;
    }
    for (;;) {
        const bool has_next = S.next(ui + 1, nxt);
        const char* nA = has_next ? (const char*)g.A + (size_t)nxt.g * g.gsA + (size_t)nxt.pm * tstepA + (size_t)nxt.kh * g.khA : cA; const char* nB = has_next ? (const char*)g.Bt + (size_t)nxt.g * g.gsB + (size_t)nxt.pn * tstepB + (size_t)nxt.kh * g.khB : cB;
        for (int t = 0; t < nt; t += 2) {
            const bool last = (t == nt - 2);
            const char* a1 = cA + (size_t)(t + 1) * kstep;
            const char* a2 = last ? nA : cA + (size_t)(t + 2) * kstep; const char* b2 = last ? nB : cB + (size_t)(t + 2) * kstep;
            const char* a3 = a2 + kstep; const char* b3 = b2 + kstep;
            if (last && has_next) S.a_ready(nxt);
            if constexpr (SP2) {
            PG8_LDB(B0, 0, 0); PG8_LDB(B1, 0, 1); PG8_SCHED; PG8_LDA(At, 0, 0); PG8_STAGE(PG8_SA(1, 1), a1 + hstepA, voffA);
            PG8_WAIT_V(8); PG8_WAIT_L(0); PG8_BAR; PG8_MMA(0, 0, At, B0); PG8_MMA(0, 1, At, B1); PG8_BAR; PG8_SCHED;
            PG8_LDA(At, 0, 1); PG8_STAGE(PG8_SB(0, 0), b2, voffB); PG8_STAGE(PG8_SB(0, 1), b2 + hstepB, voffB); PG8_STAGE(PG8_SA(0, 0), a2, voffA);
            PG8_WAIT_V(8); PG8_WAIT_L(0); PG8_BAR; PG8_MMA(1, 0, At, B0); PG8_MMA(1, 1, At, B1); PG8_BAR; PG8_SCHED;
            PG8_LDB(B0, 1, 0); PG8_LDB(B1, 1, 1); PG8_SCHED; PG8_LDA(At, 1, 0); PG8_STAGE(PG8_SA(0, 1), a2 + hstepA, voffA);
            PG8_WAIT_V(8); PG8_WAIT_L(0); PG8_BAR; PG8_MMA(0, 0, At, B0); PG8_MMA(0, 1, At, B1); PG8_BAR; PG8_SCHED;
            PG8_LDA(At, 1, 1); PG8_STAGE(PG8_SB(1, 0), b3, voffB); PG8_STAGE(PG8_SB(1, 1), b3 + hstepB, voffB); PG8_STAGE(PG8_SA(1, 0), a3, voffA);
            PG8_WAIT_V(8); PG8_WAIT_L(0); PG8_BAR; PG8_MMA(1, 0, At, B0); PG8_MMA(1, 1, At, B1); PG8_BAR; PG8_SCHED;
            } else {
            PG8_LDB(B0, 0, 0); PG8_SCHED; PG8_LDA(At, 0, 0); PG8_STAGE(PG8_SA(1, 1), a1 + hstepA, voffA);
            PG8_WAIT_L(8); PG8_BAR; PG8_WAIT_L(0); PG8_MMA(0, 0, At, B0); PG8_BAR; PG8_SCHED;
            PG8_LDB(B1, 0, 1); PG8_STAGE(PG8_SB(0, 0), b2, voffB);
            PG8_BAR; PG8_WAIT_L(0); PG8_MMA(0, 1, At, B1); PG8_BAR;
            PG8_LDA(At, 0, 1); PG8_STAGE(PG8_SA(0, 0), a2, voffA);
            PG8_BAR; PG8_WAIT_L(0); PG8_MMA(1, 0, At, B0); PG8_BAR; PG8_SCHED;
            PG8_STAGE(PG8_SB(0, 1), b2 + hstepB, voffB);
            PG8_WAIT_V(6); PG8_BAR; PG8_MMA(1, 1, At, B1); PG8_BAR;
            PG8_LDB(B0, 1, 0); PG8_SCHED; PG8_LDA(At, 1, 0); PG8_STAGE(PG8_SA(0, 1), a2 + hstepA, voffA);
            PG8_WAIT_L(8); PG8_BAR; PG8_WAIT_L(0); PG8_MMA(0, 0, At, B0); PG8_BAR; PG8_SCHED;
            PG8_LDB(B1, 1, 1); PG8_STAGE(PG8_SB(1, 0), b3, voffB);
            PG8_BAR; PG8_WAIT_L(0); PG8_MMA(0, 1, At, B1); PG8_BAR;
            PG8_LDA(At, 1, 1); PG8_STAGE(PG8_SA(1, 0), a3, voffA);
            PG8_BAR; PG8_WAIT_L(0); PG8_MMA(1, 0, At, B0); PG8_BAR; PG8_SCHED;
            PG8_STAGE(PG8_SB(1, 1), b3 + hstepB, voffB);
            PG8_WAIT_V(6); PG8_BAR; PG8_MMA(1, 1, At, B1); PG8_BAR;
            }
        }
        if constexpr (ALIGN_EPI) { if (wr == 0) PG8_BAR; }
        bool keep = false;
        if constexpr (Epi::HAS_MID) { if (cur.kh == 0) { E.mid(acc, cur, wr, wc, fr, fq); keep = true; } }
        if (!keep) { if constexpr (!Epi::AFTER_DRAIN) { E(acc, cur, wr, wc, fr, fq); S.done(cur); } }
        if (!has_next) break;
        if (!keep)
#pragma unroll
        for (int a = 0; a < 2; ++a)
#pragma unroll
            for (int b = 0; b < 2; ++b)
#pragma unroll
                for (int m = 0; m < 4; ++m)
#pragma unroll
                    for (int n = 0; n < 2; ++n) acc[a][b][m][n] = (f32x4){0.f, 0.f, 0.f, 0.f};
        cur = nxt; cA = nA; cB = nB; ++ui;
        if constexpr (ALIGN_EPI) { if (wr == 1) PG8_BAR; }
    }
    PG8_WAIT_V(0);
    if constexpr (!ALIGN_EPI) { if (wr == 0) PG8_BAR; }
    PG8_BAR;
    if constexpr (Epi::AFTER_DRAIN) { E.fused(acc, cur, wr, wc, fr, fq, lds, wid, lane); S.done(cur); }
#undef PG8_SA
#undef PG8_SB
#undef PG8_STAGE
#undef PG8_LDA
#undef PG8_LDB
#undef PG8_MMA
#undef PG8_WAIT_V
#undef PG8_WAIT_L
#undef PG8_BAR
#undef PG8_SCHED
}
}

#include <hip/hip_cooperative_groups.h>
namespace cg = cooperative_groups;
typedef unsigned short bf16;
typedef unsigned v4u __attribute__((ext_vector_type(4)));
typedef unsigned v2u __attribute__((ext_vector_type(2)));
typedef float f32x4 __attribute__((ext_vector_type(4)));
typedef float f32x2 __attribute__((ext_vector_type(2)));
typedef short bf16x8 __attribute__((ext_vector_type(8)));

constexpr int NT = 512, NWAVES = 8;
constexpr int MR = 16384, MP = 16640;
constexpr int NIN = 3840;
constexpr int NQ = 65;
constexpr float EPS = 1e-5f;
constexpr size_t MiB = 1u << 20;
constexpr size_t WS_SS    = 0;
constexpr size_t WS_DEC   = 256 * 1024;
constexpr size_t WS_A1    = 288 * 1024;
constexpr size_t WS_A16   = 320 * 1024;
constexpr size_t WS_BAR   = 384 * 1024;
constexpr size_t WS_BBAR  = 512 * 1024;
constexpr size_t WS_UMETA = 1 * MiB;
constexpr size_t WS_DTRAW = 1 * MiB + 512 * 1024;
constexpr size_t WS_DT    = 2 * MiB + 640 * 1024;
constexpr size_t WS_ACS   = 254 * MiB + 512 * 1024;
static_assert(WS_DTRAW + 16640 * 16 * 4 <= WS_DT && WS_DT + 65 * 16 * 256 * 4 <= 4 * MiB && WS_ACS + 65 * 16 * 256 * 4 <= 256 * MiB, "smalls");
constexpr size_t WS_WGLU  = 4 * MiB;
constexpr size_t WS_TB5   = 8 * MiB;
constexpr size_t WS_TE5   = 20 * MiB;
constexpr size_t WS_WIN   = 28 * MiB;
constexpr size_t WS_PREV  = 20 * MiB;
constexpr size_t WS_WOUT  = 8 * MiB, WS_WUP = 12 * MiB, WS_WDN = 20 * MiB;
constexpr size_t WS_MIX   = 36 * MiB;
constexpr size_t WS_UA    = 100 * MiB;
constexpr size_t WS_XBCP  = 148 * MiB;
constexpr size_t WS_SEND  = 148 * MiB;
constexpr size_t WS_ST    = 180 * MiB;
constexpr size_t WS_Y5    = 148 * MiB;
constexpr size_t WS_XN    = 197 * MiB;
constexpr size_t WS_XF    = 197 * MiB;
constexpr size_t WS_H1B   = 197 * MiB;
constexpr size_t WS_CT    = 230 * MiB;
constexpr size_t WS_BTK   = WS_CT + 65 * 65536 * 2;
constexpr size_t WS_BF    = WS_BTK + 65 * 65536 * 2;
constexpr size_t WS_HB    = 36 * MiB;
static_assert(WS_BF + 65 * 65536 * 2 <= WS_ACS, "ws");
constexpr int LDS_BYTES = 155648;

__device__ __forceinline__ unsigned f2bf(float f) { unsigned u = __builtin_bit_cast(unsigned, f); return (u + 0x7fffu + ((u >> 16) & 1u)) >> 16; }
__device__ __forceinline__ unsigned pk2(float lo, float hi) { return f2bf(lo) | (f2bf(hi) << 16); }
__device__ __forceinline__ float bf2f(unsigned short h) { return __builtin_bit_cast(float, (unsigned)h << 16); }
__device__ __forceinline__ float bflo(unsigned w) { return __builtin_bit_cast(float, w << 16); }
__device__ __forceinline__ float bfhi(unsigned w) { return __builtin_bit_cast(float, w & 0xffff0000u); }
__device__ __forceinline__ float ex2(float x) { return __builtin_amdgcn_exp2f(x); }
__device__ __forceinline__ float expf_(float x) { return __builtin_amdgcn_exp2f(1.44269504f * x); }
__device__ __forceinline__ float wave_sum(float v) {
#pragma unroll
    for (int o = 1; o < 64; o <<= 1) v += __shfl_xor(v, o);
    return v;
}

#define LAS __attribute__((address_space(3)))
#define XB_TMO      128
#define XB_XCNT(j)  (256  + 64 * (j))
#define XB_XSUB(j)  (1280 + 64 * (j))
#define XB_XGEN(j)  (2304 + 64 * (j))
#define XB_TOP      3328
#define XB_TOPGEN   3392
#define XCD_BAR_WORDS 3456
#define XB_SPIN_CAP (1u << 18)

__device__ __forceinline__ unsigned xb_ld(unsigned* p)              { return __hip_atomic_load(p, __ATOMIC_RELAXED, __HIP_MEMORY_SCOPE_AGENT); }
__device__ __forceinline__ unsigned xb_add(unsigned* p, unsigned v) { return __hip_atomic_fetch_add(p, v, __ATOMIC_RELAXED, __HIP_MEMORY_SCOPE_AGENT); }
__device__ __forceinline__ unsigned xb_xcc_id() { return (unsigned)__builtin_amdgcn_s_getreg((3 << 11) | 20) & 0xFu; }
#define XB_SPIN(cond, bar) do { unsigned _sp = 0; while (cond) { __builtin_amdgcn_s_sleep(1); \
    if ((++_sp & 255u) == 0u) { if (xb_ld(&(bar)[XB_TMO])) break; if (_sp > XB_SPIN_CAP) { atomicAdd(&(bar)[XB_TMO], 1u); break; } } } } while (0)

struct XcdBarrier {
    unsigned* bar; unsigned x;
    volatile LAS unsigned* st;
};

__device__ __forceinline__ XcdBarrier xcd_barrier_post(unsigned* bar, volatile LAS unsigned* st) {
    XcdBarrier b; b.bar = bar; b.x = xb_xcc_id(); b.st = st;
    if (threadIdx.x == 0) (void)xb_add(&bar[XB_XCNT(b.x)], 1u);
    return b;
}
__device__ __forceinline__ void xcd_barrier_complete(unsigned* bar, unsigned x, unsigned& nloc, unsigned& nx) {
    const unsigned G = gridDim.x * gridDim.y * gridDim.z;
    unsigned sum, cnt, mine, sp = 0u;
    for (;;) {
        sum = 0u; cnt = 0u; mine = 0u;
#pragma unroll
        for (unsigned j = 0; j < 16; ++j) { const unsigned c = xb_ld(&bar[XB_XCNT(j)]); sum += c; cnt += (c > 0u) ? 1u : 0u; mine = (j == x) ? c : mine; }
        if (sum == G) break;
        __builtin_amdgcn_s_sleep(1);
        if ((++sp & 255u) == 0u) { if (xb_ld(&bar[XB_TMO])) break; if (sp > XB_SPIN_CAP) { atomicAdd(&bar[XB_TMO], 1u); break; } }
    }
    nloc = mine > 0u ? mine : 1u; nx = cnt > 0u ? cnt : 1u;
}

__device__ __forceinline__ void xcd_barrier(const XcdBarrier& b) {
    asm volatile("s_waitcnt vmcnt(0)" ::: "memory");
    __syncthreads();
    if (threadIdx.x == 0) {
        unsigned* bar = b.bar;
        __builtin_amdgcn_s_waitcnt(0);
        unsigned nloc = b.st[0], nx = b.st[1];
        if (nloc == 0u) { xcd_barrier_complete(bar, b.x, nloc, nx); b.st[0] = nloc; b.st[1] = nx; }
        const unsigned old = xb_add(&bar[XB_XSUB(b.x)], 1u);
        const unsigned gen = old / nloc;
        if (old + 1u == (gen + 1u) * nloc) {
            __builtin_amdgcn_fence(__ATOMIC_RELEASE, "agent");
            asm volatile("s_waitcnt vmcnt(0)" ::: "memory");
            const unsigned og = xb_add(&bar[XB_TOP], 1u);
            const unsigned tg = og / nx;
            if (og + 1u == (tg + 1u) * nx) xb_add(&bar[XB_TOPGEN], 1u);
            else XB_SPIN(xb_ld(&bar[XB_TOPGEN]) == tg, bar);
            __builtin_amdgcn_fence(__ATOMIC_ACQUIRE, "agent");
            xb_add(&bar[XB_XGEN(b.x)], 1u);
            asm volatile("s_waitcnt vmcnt(0)" ::: "memory");
        } else {
            XB_SPIN(xb_ld(&bar[XB_XGEN(b.x)]) == gen, bar);
            __builtin_amdgcn_fence(__ATOMIC_ACQUIRE, "agent");
            asm volatile("s_waitcnt vmcnt(0)" ::: "memory");
        }
    }
    __syncthreads();
}

struct Args {
    const float* in[26]; float* out; unsigned char* ws; int ph_lo, ph_hi;
};
enum { I_X = 0, I_META, I_GMIX, I_WIN, I_CONVW, I_CONVB, I_DTB, I_ALOG, I_DSSD, I_GSSD, I_LRE, I_LIM, I_LSTEP, I_BRE, I_BIM, I_CRE, I_CIM, I_DS5, I_WGLU, I_BGLU, I_GS5, I_WOUT, I_GMLP, I_WUP, I_WDN, I_GFIN };

template <int MODE> __device__ __forceinline__ int colmap(int j) {
    if (MODE == 1) { if (j < 2560) return j; if (j < 3584) return j + 16; if (j < 3600) return j - 1024; return -1; }
    if (MODE == 2) { const int pn = j >> 8, r = j & 255; return r < 128 ? pn * 128 + r : 1024 + pn * 128 + (r - 128); }
    return j;
}
template <int MODE> __device__ __forceinline__ void transpose_item(const float* W, int K, int N, bf16* WT, const float* ks0, const float* ks1, float* scr, int item, int nblk, int lane) {
    const int kb = item / nblk, nb = item % nblk, k0 = 64 * kb, n0 = 32 * nb;
    const int src = colmap<MODE>(n0 + (lane & 31));
#pragma unroll 8
    for (int i = 0; i < 32; ++i) { const int kk = 2 * i + (lane >> 5); const int k = k0 + kk;
        float v = src >= 0 ? W[(size_t)k * N + src] : 0.f;
        if (ks0) v *= (k < 1024 ? ks0[k] : ks1[k - 1024]);
        scr[kk * 33 + (lane & 31)] = v; }
    asm volatile("s_waitcnt lgkmcnt(0)" ::: "memory");
    const int c = lane & 7;
#pragma unroll
    for (int j = 0; j < 4; ++j) { const int n = (lane >> 3) + 8 * j; const float* s = scr + (8 * c) * 33 + n;
        v4u o; o.x = pk2(s[0 * 33], s[1 * 33]); o.y = pk2(s[2 * 33], s[3 * 33]); o.z = pk2(s[4 * 33], s[5 * 33]); o.w = pk2(s[6 * 33], s[7 * 33]);
        *(v4u*)(WT + (size_t)(n0 + n) * K + k0 + 8 * c) = o; }
    asm volatile("s_waitcnt lgkmcnt(0)" ::: "memory");
}

__device__ __forceinline__ void sincos_d(double th, float& sn, float& cs) {
    const double k = rint(th * 0.15915494309189535); const double r = fma(-k, 6.283185307179586, th);
    const double t = r * 0.125, t2 = t * t;
    double s = t * (1.0 + t2 * (-1.0 / 6 + t2 * (1.0 / 120 + t2 * (-1.0 / 5040 + t2 * (1.0 / 362880 + t2 * (-1.0 / 39916800))))));
    double c = 1.0 + t2 * (-0.5 + t2 * (1.0 / 24 + t2 * (-1.0 / 720 + t2 * (1.0 / 40320 + t2 * (-1.0 / 3628800 + t2 * (1.0 / 479001600))))));
#pragma unroll
    for (int i = 0; i < 3; ++i) { const double s2 = 2.0 * s * c, c2 = 1.0 - 2.0 * s * s; s = s2; c = c2; }
    sn = (float)s; cs = (float)c;
}

__device__ __forceinline__ void s5_tables(const Args& a, int g, unsigned char* lds, int tid) {
    f32x2* pw = (f32x2*)lds;
    f32x2* Cc = pw + 17 * 64;
    f32x2* Bb = Cc + 16 * 64;
    float* Kt = (float*)(Bb + 64 * 16);
    unsigned char* ws = a.ws;
    if (tid < 64) {
        const int p = tid; const float lr = a.in[I_LRE][g * 64 + p], li = a.in[I_LIM][g * 64 + p]; const float st = expf(a.in[I_LSTEP][g]);
        float are = 1.f, aim = 0.f;
        for (int tau = 0; tau <= 16; ++tau) {
            const float mag = expf(lr * st * (float)tau); float sn, cs; sincos_d((double)li * (double)st * (double)tau, sn, cs);
            pw[tau * 64 + p] = (f32x2){mag * cs, mag * sn};
            if (tau == 1) { are = mag * cs; aim = mag * sn; ((f32x2*)(ws + WS_A1))[g * 64 + p] = (f32x2){are, aim}; }
            if (tau == 16) ((f32x2*)(ws + WS_A16))[g * 64 + p] = (f32x2){mag * cs, mag * sn};
        }
        const float den = lr * lr + li * li;
        const float cre = ((are - 1.0f) * lr + aim * li) / den, cim = (aim * lr - (are - 1.0f) * li) / den;
        for (int h = 0; h < 16; ++h) { const float br = a.in[I_BRE][(g * 64 + p) * 16 + h], bi = a.in[I_BIM][(g * 64 + p) * 16 + h];
            const f32x2 v = (f32x2){cre * br - cim * bi, cre * bi + cim * br}; Bb[p * 16 + h] = v; ((f32x2*)(ws + WS_BBAR))[(g * 64 + p) * 16 + h] = v; }
    }
    for (int e = tid; e < 1024; e += NT) Cc[e] = (f32x2){a.in[I_CRE][g * 1024 + e], a.in[I_CIM][g * 1024 + e]};
    __syncthreads();
    {
        const int tau = tid >> 5, h = (tid >> 1) & 15, h0 = (tid & 1) * 8; float acc[8];
#pragma unroll
        for (int j = 0; j < 8; ++j) acc[j] = 0.f;
        for (int p = 0; p < 64; ++p) { const f32x2 c = Cc[h * 64 + p], w = pw[tau * 64 + p]; const float tr = c.x * w.x - c.y * w.y, ti = c.x * w.y + c.y * w.x;
#pragma unroll
            for (int j = 0; j < 8; ++j) { const f32x2 b = Bb[p * 16 + h0 + j]; acc[j] += tr * b.x - ti * b.y; } }
        if (tau == 0) {
#pragma unroll
            for (int j = 0; j < 8; ++j) if (h0 + j == h) acc[j] += a.in[I_DS5][g * 16 + h];
        }
#pragma unroll
        for (int j = 0; j < 8; ++j) Kt[(tau * 16 + h) * 16 + h0 + j] = acc[j];
    }
    __syncthreads();
    bf16* TB = (bf16*)(ws + WS_TB5) + (size_t)g * 256 * 384;
    for (int pc = tid; pc < 256 * 48; pc += NT) {
        const int row = pc / 48, c8 = (pc % 48) * 8, t = row >> 4, h = row & 15; float v[8];
        if (c8 < 256) { const int s = c8 >> 4, h0 = c8 & 15;
#pragma unroll
            for (int j = 0; j < 8; ++j) v[j] = s <= t ? Kt[((t - s) * 16 + h) * 16 + h0 + j] : 0.f;
        } else { const int p0 = (c8 - 256) >> 1;
#pragma unroll
            for (int j = 0; j < 4; ++j) { const f32x2 c = Cc[h * 64 + p0 + j], w = pw[(t + 1) * 64 + p0 + j]; v[2 * j] = c.x * w.x - c.y * w.y; v[2 * j + 1] = -(c.x * w.y + c.y * w.x); }
        }
        v4u o; o.x = pk2(v[0], v[1]); o.y = pk2(v[2], v[3]); o.z = pk2(v[4], v[5]); o.w = pk2(v[6], v[7]);
        *(v4u*)(TB + (size_t)row * 384 + c8) = o;
    }
    bf16* TE = (bf16*)(ws + WS_TE5) + (size_t)g * 256 * 256;
    for (int pc = tid; pc < 256 * 32; pc += NT) {
        const int row = pc >> 5, c8 = (pc & 31) * 8; float v[8];
        if (row < 128) { const int p = row >> 1, ri = row & 1, s = c8 >> 4, h0 = c8 & 15; const f32x2 w = pw[(15 - s) * 64 + p];
#pragma unroll
            for (int j = 0; j < 8; ++j) { const f32x2 b = Bb[p * 16 + h0 + j]; v[j] = ri ? (w.x * b.y + w.y * b.x) : (w.x * b.x - w.y * b.y); }
        } else {
#pragma unroll
            for (int j = 0; j < 8; ++j) v[j] = 0.f;
        }
        v4u o; o.x = pk2(v[0], v[1]); o.y = pk2(v[2], v[3]); o.z = pk2(v[4], v[5]); o.w = pk2(v[6], v[7]);
        *(v4u*)(TE + (size_t)row * 256 + c8) = o;
    }
    __syncthreads();
}

__device__ __forceinline__ void rms_row_to_bf16(const float* xrow, const float* gain, bf16* orow, int lane) {
    unsigned long long* o8 = (unsigned long long*)orow + lane;
    if (!xrow) {
#pragma unroll
        for (int j = 0; j < 4; ++j) o8[64 * j] = 0ull;
        return; }
    const f32x4* xr = (const f32x4*)xrow + lane; const f32x4* gr = (const f32x4*)gain + lane;
    f32x4 v[4]; float s = 0.f;
#pragma unroll
    for (int j = 0; j < 4; ++j) { v[j] = xr[64 * j]; s += (v[j].x * v[j].x + v[j].y * v[j].y) + (v[j].z * v[j].z + v[j].w * v[j].w); }
    const float rstd = 1.f / sqrtf(wave_sum(s) * (1.f / 1024.f) + EPS);
#pragma unroll
    for (int j = 0; j < 4; ++j) { const f32x4 gg = gr[64 * j]; const f32x4 w = v[j] * rstd * gg; o8[64 * j] = (unsigned long long)pk2(w.x, w.y) | ((unsigned long long)pk2(w.z, w.w) << 32); }
}

__device__ __forceinline__ void p0_prologue(const Args& a, unsigned char* lds, int tid, int G) {
    unsigned char* ws = a.ws; const int lane = tid & 63, wave = tid >> 6;
    const int gw = blockIdx.x * NWAVES + wave, NGW = G * NWAVES;
    for (int i = blockIdx.x * NT + tid; i < 4 * 16384; i += G * NT) ((float*)(ws + WS_SS))[i] = 0.f;
    for (int g = (G - 1 - (int)blockIdx.x); g < 64; g += G) s5_tables(a, g, lds, tid);
    __syncthreads();
    float* scr = (float*)(lds + wave * 16384);
    constexpr int NB_IN = NIN / 32, NB_GL = 2048 / 32;
    constexpr int I_IN = 16 * NB_IN, I_GL = 16 * NB_GL;
    for (int it = gw; it < I_IN + I_GL; it += NGW) {
        if (it < I_IN) transpose_item<1>(a.in[I_WIN], 1024, 3600, (bf16*)(ws + WS_WIN), nullptr, nullptr, scr, it, NB_IN, lane);
        else transpose_item<2>(a.in[I_WGLU], 1024, 2048, (bf16*)(ws + WS_WGLU), nullptr, nullptr, scr, it - I_IN, NB_GL, lane);
    }
    for (int m = gw; m < MP; m += NGW) {
        const float* src = m < MR ? a.in[I_X] + (size_t)m * 1024 : (m < MR + 16 ? a.in[I_META] + (size_t)(m - MR) * 1024 : nullptr);
        rms_row_to_bf16(src, a.in[I_GMIX], (bf16*)(ws + WS_XN) + (size_t)m * 1024, lane);
    }
}
__device__ __forceinline__ void p6_weights(const Args& a, unsigned char* lds, int tid, int G) {
    unsigned char* ws = a.ws; const int lane = tid & 63, wave = tid >> 6;
    const int gw = blockIdx.x * NWAVES + wave, NGW = G * NWAVES;
    float* scr = (float*)(lds + wave * 16384);
    constexpr int I_O = 32 * 32, I_U = 16 * 128, I_D = 64 * 32;
    for (int it = gw; it < I_O + I_U + I_D; it += NGW) {
        if (it < I_O) transpose_item<0>(a.in[I_WOUT], 2048, 1024, (bf16*)(ws + WS_WOUT), a.in[I_GSSD], a.in[I_GS5], scr, it, 32, lane);
        else if (it < I_O + I_U) transpose_item<0>(a.in[I_WUP], 1024, 4096, (bf16*)(ws + WS_WUP), a.in[I_GMLP], a.in[I_GMLP], scr, it - I_O, 128, lane);
        else transpose_item<0>(a.in[I_WDN], 4096, 1024, (bf16*)(ws + WS_WDN), nullptr, nullptr, scr, it - I_O - I_U, 32, lane);
    }
    __syncthreads();
}

__device__ __forceinline__ int chunk_row(int q, int tok) {
    if (q == 0) return tok < 240 ? -1 : MR + (tok - 240);
    const int b = (q - 1) >> 5, c = (q - 1) & 31;
    if (tok < 0 && c == 0) return MR + 16 + tok;
    return b * 8192 + c * 256 + tok;
}
__device__ __forceinline__ float silu_(float x) { return x * __builtin_amdgcn_rcpf(1.0f + ex2(-1.44269504f * x)); }
__device__ __forceinline__ void p2_conv_unit(const Args& a, int q, int blk, unsigned char* lds, int tid) {
    unsigned char* ws = a.ws;
    bf16* IN = (bf16*)lds;
    bf16* OT = (bf16*)(lds + 40960);
    const bf16* XBCP = (const bf16*)(ws + WS_XBCP);
    const int ch0 = blk * 64;
    for (int pc = tid; pc < 259 * 8; pc += NT) { const int rr = pc >> 3, c8 = (pc & 7) * 8; const int row = chunk_row(q, rr - 3);
        v4u v = (v4u){0u, 0u, 0u, 0u}; if (row >= 0) v = *(const v4u*)(XBCP + (size_t)row * 1536 + ch0 + c8);
        *(v4u*)(IN + rr * 64 + c8) = v; }
    __syncthreads();
    const float* cw = a.in[I_CONVW]; const float* cb = a.in[I_CONVB];
    const bool is_x = blk < 16, is_b = blk >= 16 && blk < 20;
    if (!is_x) {
        bf16* dst = (bf16*)(ws + (is_b ? WS_BTK : WS_CT)) + (size_t)q * 65536 + (is_b ? (blk - 16) : (blk - 20)) * 64;
        for (int pc = tid; pc < 256 * 8; pc += NT) { const int tok = pc >> 3, c8 = (pc & 7) * 8; float o[8];
            const bool zero = (q == 0 && tok < 240);
#pragma unroll
            for (int j = 0; j < 8; ++j) o[j] = cb[ch0 + c8 + j];
#pragma unroll
            for (int k = 0; k < 4; ++k) { const v4u v = *(const v4u*)(IN + (tok + k) * 64 + c8); const unsigned w[4] = {v.x, v.y, v.z, v.w};
#pragma unroll
                for (int j = 0; j < 4; ++j) { o[2 * j] += cw[k * 1536 + ch0 + c8 + 2 * j] * bflo(w[j]); o[2 * j + 1] += cw[k * 1536 + ch0 + c8 + 2 * j + 1] * bfhi(w[j]); } }
#pragma unroll
            for (int j = 0; j < 8; ++j) o[j] = zero ? 0.f : silu_(o[j]);
            v4u ov; ov.x = pk2(o[0], o[1]); ov.y = pk2(o[2], o[3]); ov.z = pk2(o[4], o[5]); ov.w = pk2(o[6], o[7]);
            *(v4u*)(dst + (size_t)tok * 256 + c8) = ov; }
    }
    if (is_x || is_b) {
        for (int it = tid; it < 64 * 32; it += NT) { const int ch = it & 63, t0 = (it >> 6) * 8; float wk[4], in[11], o[8]; const float bias = cb[ch0 + ch];
#pragma unroll
            for (int k = 0; k < 4; ++k) wk[k] = cw[k * 1536 + ch0 + ch];
#pragma unroll
            for (int j = 0; j < 11; ++j) in[j] = bf2f(IN[(t0 + j) * 64 + ch]);
#pragma unroll
            for (int j = 0; j < 8; ++j) { const float v = bias + wk[0] * in[j] + wk[1] * in[j + 1] + wk[2] * in[j + 2] + wk[3] * in[j + 3]; o[j] = (q == 0 && t0 + j < 240) ? 0.f : silu_(v); }
            v4u ov; ov.x = pk2(o[0], o[1]); ov.y = pk2(o[2], o[3]); ov.z = pk2(o[4], o[5]); ov.w = pk2(o[6], o[7]);
            *(v4u*)(OT + ch * 264 + t0) = ov; }
        __syncthreads();
        bf16* dst = is_x ? (bf16*)(ws + WS_XF) + ((size_t)q * 1024 + ch0) * 256 : (bf16*)(ws + WS_BF) + ((size_t)q * 256 + (blk - 16) * 64) * 256;
        for (int pc = tid; pc < 64 * 32; pc += NT) { const int ch = pc >> 5, t8 = (pc & 31) * 8; *(v4u*)(dst + (size_t)ch * 256 + t8) = *(const v4u*)(OT + ch * 264 + t8); }
    }
    __syncthreads();
}
__device__ __forceinline__ void p2_dt_item(const Args& a, int q, int h, int lane) {
    unsigned char* ws = a.ws; const float* DTRAW = (const float*)(ws + WS_DTRAW);
    const float bias = a.in[I_DTB][h], A = -expf(a.in[I_ALOG][h]);
    float dt[4], cs[4]; float run = 0.f;
#pragma unroll
    for (int j = 0; j < 4; ++j) { const int tok = 4 * lane + j; const int row = chunk_row(q, tok);
        float d = 0.f; if (row >= 0) { const float x = DTRAW[(size_t)row * 16 + h] + bias; d = fmaxf(x, 0.f) + __logf(1.0f + expf_(-fabsf(x))); }
        dt[j] = d; run += d * A; cs[j] = run; }
    float incl = run;
#pragma unroll
    for (int o = 1; o < 64; o <<= 1) { const float t = __shfl_up(incl, o); if (lane >= o) incl += t; }
    const float excl = incl - run;
    float* DT = (float*)(ws + WS_DT) + ((size_t)q * 16 + h) * 256 + 4 * lane; float* ACS = (float*)(ws + WS_ACS) + ((size_t)q * 16 + h) * 256 + 4 * lane;
    *(f32x4*)DT = (f32x4){dt[0], dt[1], dt[2], dt[3]}; *(f32x4*)ACS = (f32x4){cs[0] + excl, cs[1] + excl, cs[2] + excl, cs[3] + excl};
    if (lane == 63) ((float*)(ws + WS_DEC))[q * 16 + h] = expf_(cs[3] + excl);
}

#define MFMA16(A, B, C) __builtin_amdgcn_mfma_f32_16x16x32_bf16(A, B, C, 0, 0, 0)
__device__ __forceinline__ void p3_states_unit(const Args& a, int q, int g, int tid) {
    unsigned char* ws = a.ws; const int lane = tid & 63, r = tid >> 6, h = g * 8 + r, fr = lane & 15, fq = lane >> 4;
    const bf16* XF = (const bf16*)(ws + WS_XF) + ((size_t)q * 1024 + h * 64) * 256;
    const bf16* BF = (const bf16*)(ws + WS_BF) + ((size_t)q * 256 + g * 128) * 256;
    const float* DT = (const float*)(ws + WS_DT) + ((size_t)q * 16 + h) * 256; const float* ACS = (const float*)(ws + WS_ACS) + ((size_t)q * 16 + h) * 256;
    const float alast = ACS[255];
    bf16* ST = (bf16*)(ws + WS_ST) + ((size_t)q * 16 + h) * 8192;
#pragma unroll 1
    for (int nh = 0; nh < 2; ++nh) {
        f32x4 acc[4][4];
#pragma unroll
        for (int i = 0; i < 4; ++i)
#pragma unroll
            for (int j = 0; j < 4; ++j) acc[i][j] = (f32x4){0.f, 0.f, 0.f, 0.f};
#pragma unroll 1
        for (int kb = 0; kb < 8; ++kb) {
            const int s0 = kb * 32 + fq * 8;
            float w[8];
            { const f32x4 d0 = *(const f32x4*)(DT + s0), d1 = *(const f32x4*)(DT + s0 + 4), c0 = *(const f32x4*)(ACS + s0), c1 = *(const f32x4*)(ACS + s0 + 4);
#pragma unroll
              for (int j = 0; j < 4; ++j) { w[j] = expf_(alast - c0[j]) * d0[j]; w[4 + j] = expf_(alast - c1[j]) * d1[j]; } }
            bf16x8 Af[4], Bf[4];
#pragma unroll
            for (int i = 0; i < 4; ++i) { const v4u v = *(const v4u*)(XF + (size_t)(i * 16 + fr) * 256 + s0);
                v4u o; o.x = pk2(bflo(v.x) * w[0], bfhi(v.x) * w[1]); o.y = pk2(bflo(v.y) * w[2], bfhi(v.y) * w[3]); o.z = pk2(bflo(v.z) * w[4], bfhi(v.z) * w[5]); o.w = pk2(bflo(v.w) * w[6], bfhi(v.w) * w[7]);
                Af[i] = __builtin_bit_cast(bf16x8, o); }
#pragma unroll
            for (int j = 0; j < 4; ++j) Bf[j] = *(const bf16x8*)(BF + (size_t)((nh * 4 + j) * 16 + fr) * 256 + s0);
#pragma unroll
            for (int i = 0; i < 4; ++i)
#pragma unroll
                for (int j = 0; j < 4; ++j) acc[i][j] = MFMA16(Af[i], Bf[j], acc[i][j]);
        }
#pragma unroll
        for (int i = 0; i < 4; ++i)
#pragma unroll
            for (int j = 0; j < 4; ++j)
#pragma unroll
                for (int e = 0; e < 4; ++e) ST[(i * 16 + fq * 4 + e) * 128 + (nh * 4 + j) * 16 + fr] = (bf16)f2bf(acc[i][j][e]);
    }
}

__device__ __forceinline__ void p4_ssd_scan_item(const Args& a, int item, int tid) {
    unsigned char* ws = a.ws; const int e = item * 2048 + tid * 4;
    const int b = e >> 17, hpn = e & 131071, h = hpn >> 13;
    const bf16* ST = (const bf16*)(ws + WS_ST); bf16* PREV = (bf16*)(ws + WS_PREV); const float* DEC = (const float*)(ws + WS_DEC);
    v2u st[32]; float dec[32];
    st[0] = *(const v2u*)(ST + hpn); dec[0] = 0.f;
#pragma unroll
    for (int k = 1; k < 32; ++k) { const int q = b * 32 + k; st[k] = *(const v2u*)(ST + (size_t)q * 131072 + hpn); dec[k] = DEC[q * 16 + h]; }
    float s0 = bflo(st[0].x), s1 = bfhi(st[0].x), s2 = bflo(st[0].y), s3 = bfhi(st[0].y);
#pragma unroll
    for (int c = 0; c < 32; ++c) {
        v2u o; o.x = pk2(s0, s1); o.y = pk2(s2, s3); *(v2u*)(PREV + (size_t)(b * 32 + c) * 131072 + hpn) = o;
        if (c < 31) { const float d = dec[c + 1]; const v2u v = st[c + 1];
            s0 = s0 * d + bflo(v.x); s1 = s1 * d + bfhi(v.x); s2 = s2 * d + bflo(v.y); s3 = s3 * d + bfhi(v.y); }
    }
}
__device__ __forceinline__ void p4_s5_scan_item(const Args& a, int item, unsigned char* lds, int tid) {
    unsigned char* ws = a.ws; const int b = item >> 7, g = (item >> 1) & 63, p = (item & 1) * 32 + (tid & 31), seg = tid >> 5;
    const f32x2 a1 = ((const f32x2*)(ws + WS_A1))[g * 64 + p], a16 = ((const f32x2*)(ws + WS_A16))[g * 64 + p];
    const f32x2* Bb = (const f32x2*)(ws + WS_BBAR) + (size_t)(g * 64 + p) * 16;
    const bf16* UM = (const bf16*)(ws + WS_UMETA);
    const f32x2* SE = (const f32x2*)(ws + WS_SEND) + ((size_t)(g * 1024 + b * 512 + seg * 32) * 64 + p);
    f32x2 se[32];
#pragma unroll
    for (int j = 0; j < 32; ++j) se[j] = SE[(size_t)j * 64];
    float sr = 0.f, si = 0.f;
    for (int s = 0; s < 16; ++s) { float br = 0.f, bi = 0.f;
#pragma unroll
        for (int h = 0; h < 16; ++h) { const float u = bf2f(UM[s * 1024 + g * 16 + h]); const f32x2 bb = Bb[h]; br += bb.x * u; bi += bb.y * u; }
        const float nr = a1.x * sr - a1.y * si + br, ni = a1.x * si + a1.y * sr + bi; sr = nr; si = ni; }
    float er = 0.f, ei = 0.f;
#pragma unroll
    for (int j = 0; j < 32; ++j) { const float nr = a16.x * er - a16.y * ei + se[j].x, ni = a16.x * ei + a16.y * er + se[j].y; er = nr; ei = ni; }
    f32x2* EL = (f32x2*)lds;
    EL[seg * 32 + (tid & 31)] = (f32x2){er, ei};
    float pr = a16.x, pi = a16.y;
#pragma unroll
    for (int k = 0; k < 5; ++k) { const float nr = pr * pr - pi * pi, ni = 2.f * pr * pi; pr = nr; pi = ni; }
    __syncthreads();
    for (int k = 0; k < seg; ++k) { const f32x2 ek = EL[k * 32 + (tid & 31)]; const float nr = pr * sr - pi * si + ek.x, ni = pr * si + pi * sr + ek.y; sr = nr; si = ni; }
    unsigned* UA = (unsigned*)((bf16*)(ws + WS_UA) + ((size_t)(g * 1024 + b * 512 + seg * 32) * 384 + 256 + 2 * p));
#pragma unroll
    for (int j = 0; j < 32; ++j) { UA[(size_t)j * 192] = pk2(sr, si);
        const float nr = a16.x * sr - a16.y * si + se[j].x, ni = a16.x * si + a16.y * sr + se[j].y; sr = nr; si = ni; }
    __syncthreads();
}

__device__ __forceinline__ void p5_ssd_out_unit(const Args& a, int q, int g, int half, unsigned char* lds, int tid) {
    unsigned char* ws = a.ws; const int lane = tid & 63, r = tid >> 6, h = g * 8 + r, fr = lane & 15, fq = lane >> 4;
    bf16* CBs = (bf16*)lds;
    float* ACSs = (float*)(lds + 256 * 264 * 2);
    float* DTs = ACSs + 8 * 256;
    const bf16* CT = (const bf16*)(ws + WS_CT) + (size_t)q * 65536 + g * 128;
    const bf16* BTK = (const bf16*)(ws + WS_BTK) + (size_t)q * 65536 + g * 128;
    for (int i = tid; i < 2048; i += NT) { ACSs[i] = ((const float*)(ws + WS_ACS))[((size_t)q * 16 + g * 8) * 256 + i]; DTs[i] = ((const float*)(ws + WS_DT))[((size_t)q * 16 + g * 8) * 256 + i]; }
    {
        int cnt = 0;
#pragma unroll 1
        for (int ti = 0; ti < 8; ++ti) {
            const int lt = half ? 4 + ti : (ti < 4 ? ti : 8 + ti);
#pragma unroll 1
            for (int stl = 0; stl <= lt; ++stl, ++cnt) {
                if ((cnt & 7) != r) continue;
                f32x4 c = (f32x4){0.f, 0.f, 0.f, 0.f};
#pragma unroll
                for (int k = 0; k < 4; ++k) { const bf16x8 Af = *(const bf16x8*)(CT + (size_t)(lt * 16 + fr) * 256 + k * 32 + fq * 8);
                    const bf16x8 Bf = *(const bf16x8*)(BTK + (size_t)(stl * 16 + fr) * 256 + k * 32 + fq * 8); c = MFMA16(Af, Bf, c); }
#pragma unroll
                for (int e = 0; e < 4; ++e) CBs[(lt * 16 + fq * 4 + e) * 264 + stl * 16 + fr] = (bf16)f2bf(c[e]);
            }
        }
    }
    __syncthreads();
    const bf16* XF = (const bf16*)(ws + WS_XF) + ((size_t)q * 1024 + h * 64) * 256;
    const bf16* PREV = (const bf16*)(ws + WS_PREV) + ((size_t)(q - 1) * 16 + h) * 8192;
    const float* acs = ACSs + r * 256; const float* dts = DTs + r * 256;
    const float dsk = a.in[I_DSSD][h];
    const int b = (q - 1) >> 5, c = (q - 1) & 31; const int m0 = b * 8192 + c * 256;
    bf16* MIX = (bf16*)(ws + WS_MIX); float* SSS = (float*)(ws + WS_SS);
#pragma unroll 1
    for (int lbi = 0; lbi < 2; ++lbi) {
        const int lb = half ? 1 + lbi : 3 * lbi;
        f32x4 acc[4][4];
#pragma unroll
        for (int i = 0; i < 4; ++i)
#pragma unroll
            for (int j = 0; j < 4; ++j) acc[i][j] = (f32x4){0.f, 0.f, 0.f, 0.f};
#pragma unroll 1
        for (int k = 0; k < 4; ++k) { bf16x8 Af[4], Bf[4];
#pragma unroll
            for (int i = 0; i < 4; ++i) Af[i] = *(const bf16x8*)(CT + (size_t)(lb * 64 + i * 16 + fr) * 256 + k * 32 + fq * 8);
#pragma unroll
            for (int j = 0; j < 4; ++j) Bf[j] = *(const bf16x8*)(PREV + (size_t)(j * 16 + fr) * 128 + k * 32 + fq * 8);
#pragma unroll
            for (int i = 0; i < 4; ++i)
#pragma unroll
                for (int j = 0; j < 4; ++j) acc[i][j] = MFMA16(Af[i], Bf[j], acc[i][j]); }
#pragma unroll
        for (int i = 0; i < 4; ++i)
#pragma unroll
            for (int e = 0; e < 4; ++e) { const float sc = expf_(acs[lb * 64 + i * 16 + fq * 4 + e]);
#pragma unroll
                for (int j = 0; j < 4; ++j) acc[i][j][e] *= sc; }
        const int nsb = 2 * lb + 2;
#pragma unroll 1
        for (int sb = 0; sb < nsb; ++sb) {
            const int s0 = sb * 32 + fq * 8;
            bf16x8 Bf[4];
#pragma unroll
            for (int j = 0; j < 4; ++j) Bf[j] = *(const bf16x8*)(XF + (size_t)(j * 16 + fr) * 256 + s0);
            float as[8], ds[8];
#pragma unroll
            for (int j = 0; j < 8; ++j) { as[j] = acs[s0 + j]; ds[j] = dts[s0 + j]; }
#pragma unroll
            for (int i = 0; i < 4; ++i) {
                const int l = lb * 64 + i * 16 + fr;
                if (sb * 32 > lb * 64 + i * 16 + 15) continue;
                const float al = acs[l];
                const v4u v = *(const v4u*)(CBs + l * 264 + s0); const unsigned w4[4] = {v.x, v.y, v.z, v.w}; float pv[8];
#pragma unroll
                for (int j = 0; j < 4; ++j) {
                    const float p0 = bflo(w4[j]) * expf_(fminf(al - as[2 * j], 0.f)) * ds[2 * j], p1 = bfhi(w4[j]) * expf_(fminf(al - as[2 * j + 1], 0.f)) * ds[2 * j + 1];
                    pv[2 * j] = (s0 + 2 * j <= l) ? p0 : 0.f; pv[2 * j + 1] = (s0 + 2 * j + 1 <= l) ? p1 : 0.f; }
                v4u o; o.x = pk2(pv[0], pv[1]); o.y = pk2(pv[2], pv[3]); o.z = pk2(pv[4], pv[5]); o.w = pk2(pv[6], pv[7]);
                const bf16x8 Af = __builtin_bit_cast(bf16x8, o);
#pragma unroll
                for (int j = 0; j < 4; ++j) acc[i][j] = MFMA16(Af, Bf[j], acc[i][j]);
            }
        }
#pragma unroll
        for (int i = 0; i < 4; ++i) {
            const int l0 = lb * 64 + i * 16 + fq * 4; float ssq[4] = {0.f, 0.f, 0.f, 0.f};
#pragma unroll
            for (int j = 0; j < 4; ++j) {
                const int p = j * 16 + fr; const v2u xv = *(const v2u*)(XF + (size_t)p * 256 + l0);
                const float xs[4] = {bflo(xv.x), bfhi(xv.x), bflo(xv.y), bfhi(xv.y)};
#pragma unroll
                for (int e = 0; e < 4; ++e) { bf16* zp = MIX + (size_t)(m0 + l0 + e) * 2048 + h * 64 + p; const float z = bf2f(*zp);
                    const float y = (acc[i][j][e] + dsk * xs[e]) * silu_(z); *zp = (bf16)f2bf(y); ssq[e] += y * y; }
            }
#pragma unroll
            for (int e = 0; e < 4; ++e) { float s = ssq[e]; s += __shfl_xor(s, 1); s += __shfl_xor(s, 2); s += __shfl_xor(s, 4); s += __shfl_xor(s, 8);
                if (fr == 0) atomicAdd(SSS + m0 + l0 + e, s); }
        }
    }
    __syncthreads();
}

__device__ __forceinline__ void p10_final(const Args& a, int tid, int G) {
    const int lane = tid & 63, wave = tid >> 6; const int gw = blockIdx.x * NWAVES + wave, NGW = G * NWAVES;
    const float* SSF = (const float*)(a.ws + WS_SS) + 3 * 16384; const f32x4* gf = (const f32x4*)a.in[I_GFIN] + lane;
    for (int m = gw; m < MR; m += NGW) { f32x4* row = (f32x4*)(a.out + (size_t)m * 1024) + lane; const float rs = 1.0f / sqrtf(SSF[m] * (1.0f / 1024.0f) + EPS);
#pragma unroll
        for (int j = 0; j < 4; ++j) row[64 * j] = row[64 * j] * rs * gf[64 * j]; }
}

__global__ void __launch_bounds__(NT, 2) fwd_kernel(Args args) {
    extern __shared__ __attribute__((aligned(16))) unsigned char lds[];
    cg::grid_group grid = cg::this_grid();
    const int tid = threadIdx.x, G = gridDim.x, bx = blockIdx.x;
    unsigned char* ws = args.ws;
    PG8_LAS unsigned char* ldsl = (PG8_LAS unsigned char*)lds;
    const int lo = args.ph_lo, hi = args.ph_hi;
#ifndef SKIPMASK
#define SKIPMASK 0
#endif
#define IN(k) (!((SKIPMASK >> (k)) & 1) && lo <= (k) && (k) < hi)
    volatile LAS unsigned* bst = (volatile LAS unsigned*)(ldsl + 155136);
    if (tid < 2) bst[tid] = 0u;
    __syncthreads();
    XcdBarrier xbar = xcd_barrier_post((unsigned*)(ws + WS_BAR), bst);
#define SEAM(k) do { if (IN(k) && IN((k) + 1)) { if ((k) == 0) grid.sync(); else xcd_barrier(xbar); } } while (0)
    float* SS = (float*)(ws + WS_SS);
    if (IN(0)) { const int tid = pg8::fresh_tid(); p0_prologue(args, lds, tid, G); }
    SEAM(0);
    if (IN(1)) {
        pg8::Gemm g{(const bf16*)(ws + WS_XN), (const bf16*)(ws + WS_WIN), MP, NIN, 1024, 1024, 1024, 0, 0}; pg8::StaticOrder S; S.init(MP, NIN, G, bx);
        pg8::EpiInProj E{(bf16*)(ws + WS_MIX), (bf16*)(ws + WS_XBCP), (bf16*)(ws + WS_UA), (bf16*)(ws + WS_UMETA), (float*)(ws + WS_DTRAW)};
        pg8::gemm_phase<pg8::EpiInProj, pg8::StaticOrder, true, true>(ldsl, g, S, E);
    }
    SEAM(1);
    if (IN(2)) {
        const int tid = pg8::fresh_tid(), wave = tid >> 6, lane = tid & 63;
        for (int u = bx; u < NQ * 24; u += G) p2_conv_unit(args, u / 24, u % 24, lds, tid);
        for (int it = bx * NWAVES + wave; it < NQ * 16; it += G * NWAVES) p2_dt_item(args, it >> 4, it & 15, lane);
    }
    SEAM(2);
    const int nS3 = (G / 2 < 126) ? G / 2 : 126;
    if (IN(3)) {
        const int tid = pg8::fresh_tid();
        if (bx < nS3) { for (int u = bx; u < 126; u += nS3) { const int qi = u >> 1; p3_states_unit(args, qi < 32 ? qi : qi + 1, u & 1, tid); } }
        pg8::Gemm g{(const bf16*)(ws + WS_UA), (const bf16*)(ws + WS_TE5), 1024, 256, 256, 384, 256, (size_t)1024 * 384 * 2, (size_t)256 * 256 * 2};
        pg8::BatchOrder S; S.init(256, 4, G, nS3, bx);
        pg8::EpiS5a E{(float*)(ws + WS_SEND)};
        pg8::gemm_phase<pg8::EpiS5a, pg8::BatchOrder, true, true>(ldsl, g, S, E);
    }
    SEAM(3);
    if (IN(4)) {
        const int tid = pg8::fresh_tid();
        for (int it = bx; it < 384; it += G) { if (it < 256) p4_s5_scan_item(args, it, lds, tid); else p4_ssd_scan_item(args, it - 256, tid); }
    }
    SEAM(4);
    if (IN(5)) {
        const int tid = pg8::fresh_tid();
#ifndef NO_SSDOUT
        for (int u = bx; u < 256; u += G) p5_ssd_out_unit(args, 1 + (u >> 2), (u >> 1) & 1, u & 1, lds, tid);
        __syncthreads();
#endif
        pg8::Gemm g{(const bf16*)(ws + WS_UA), (const bf16*)(ws + WS_TB5), 1024, 256, 384, 384, 384, (size_t)1024 * 384 * 2, (size_t)256 * 384 * 2};
        pg8::BatchOrder S; S.init(256, 4, G, 0, bx);
        pg8::EpiS5b E{(bf16*)(ws + WS_Y5)};
        pg8::gemm_phase<pg8::EpiS5b, pg8::BatchOrder, true, true>(ldsl, g, S, E);
    }
    SEAM(5);
    if (IN(6)) {
        const int tid = pg8::fresh_tid();
        p6_weights(args, lds, tid, G);
        pg8::Gemm g{(const bf16*)(ws + WS_Y5), (const bf16*)(ws + WS_WGLU), MR, 2048, 1024, 1024, 1024, 0, 0}; pg8::StaticOrder S; S.init(MR, 2048, G, bx);
        pg8::EpiGlu E{(bf16*)(ws + WS_MIX), args.in[I_BGLU], SS + 16384};
        pg8::gemm_phase<pg8::EpiGlu, pg8::StaticOrder, true, true>(ldsl, g, S, E);
    }
    SEAM(6);
    if (IN(7)) {
        pg8::Gemm g{(const bf16*)(ws + WS_MIX), (const bf16*)(ws + WS_WOUT), MR, 1024, 1024, 2048, 2048, 0, 0, (size_t)1024 * 2, (size_t)1024 * 2};
        pg8::SplitKOrder S; S.base.init(MR, 1024, G, bx);
        pg8::EpiOut E{args.in[I_X], args.out, (bf16*)(ws + WS_H1B), SS, SS + 16384, SS + 2 * 16384};
        pg8::gemm_phase<pg8::EpiOut, pg8::SplitKOrder, true, true>(ldsl, g, S, E);
    }
    SEAM(7);
    if (IN(8)) {
        pg8::Gemm g{(const bf16*)(ws + WS_H1B), (const bf16*)(ws + WS_WUP), MR, 4096, 1024, 1024, 1024, 0, 0}; pg8::StaticOrder S; S.init(MR, 4096, G, bx);
        pg8::EpiUp E{(bf16*)(ws + WS_HB), SS + 2 * 16384};
        pg8::gemm_phase<pg8::EpiUp, pg8::StaticOrder, true, true>(ldsl, g, S, E);
    }
    SEAM(8);
    if (IN(9)) {
        pg8::Gemm g{(const bf16*)(ws + WS_HB), (const bf16*)(ws + WS_WDN), MR, 1024, 4096, 4096, 4096, 0, 0}; pg8::StaticOrder S; S.init(MR, 1024, G, bx);
        pg8::EpiDown E{args.out, SS + 3 * 16384};
        pg8::gemm_phase<pg8::EpiDown, pg8::StaticOrder, true, true>(ldsl, g, S, E);
    }
    SEAM(9);
    if (IN(10)) { const int tid = pg8::fresh_tid(); p10_final(args, tid, G); }
#undef IN
#undef SEAM
}

#ifndef N_LAUNCHES
#define N_LAUNCHES 1
#endif
extern "C" void kernel_launch(void* const* d_in, const int* in_sizes, int n_in, void* d_out, int out_size, void* d_ws, size_t ws_size, hipStream_t stream) {
    static int grid = 0;
    if (grid == 0) {
        int dev = 0, cus = 0, per_cu = 0;
        hipGetDevice(&dev); hipDeviceGetAttribute(&cus, hipDeviceAttributeMultiprocessorCount, dev);
        hipFuncSetAttribute((const void*)fwd_kernel, hipFuncAttributeMaxDynamicSharedMemorySize, LDS_BYTES);
        hipOccupancyMaxActiveBlocksPerMultiprocessor(&per_cu, (const void*)fwd_kernel, NT, LDS_BYTES);
        if (per_cu < 1) { fprintf(stderr, "occupancy query says %d blocks per CU\n", per_cu); per_cu = 1; }
        grid = cus * 1;
        (void)hipGetLastError();
    }
    hipMemsetAsync((char*)d_ws + WS_BAR, 0, 16384, stream);
    Args a{};
    for (int i = 0; i < 26; ++i) a.in[i] = (const float*)d_in[i];
    a.out = (float*)d_out; a.ws = (unsigned char*)d_ws;
    if (N_LAUNCHES == 1) {
        a.ph_lo = 0; a.ph_hi = 11;
        void* args[] = {&a};
        hipError_t e = hipLaunchCooperativeKernel((const void*)fwd_kernel, dim3(grid), dim3(NT), args, LDS_BYTES, stream);
        if (e != hipSuccess) fprintf(stderr, "cooperative launch failed: %s (grid %d)\n", hipGetErrorString(e), grid);
    } else {
        for (int p = 0; p < 11; ++p) { a.ph_lo = p; a.ph_hi = p + 1; hipLaunchKernelGGL(fwd_kernel, dim3(grid), dim3(NT), LDS_BYTES, stream, a); }
    }
}
```

```cpp
#include <hip/hip_runtime.h>
#include <cstdio>
#include <cstdint>
namespace pg8 {
#define PG8_LAS __attribute__((address_space(3)))
typedef unsigned short bf16_t;
typedef short bf16x8 __attribute__((ext_vector_type(8)));
typedef float f32x4 __attribute__((ext_vector_type(4)));
typedef unsigned u32x4 __attribute__((ext_vector_type(4)));
constexpr int BM = 256, BK = 64, HALF = 128, HTB = HALF * BK * 2  , STAGE_BYTES = 8 * HTB, NXCD = 8, WGM = 8;

__host__ __device__ __forceinline__ int lds_byte(int r, int c) { const int st = (r >> 4) * 2 + (c >> 5), rr = r & 15, cc = c & 31, ob = rr * 64 + cc * 2; return st * 1024 + (ob ^ (((ob >> 9) & 1) << 5)); }
__host__ __device__ __forceinline__ void stage_rc(int b, int& R, int& C) { const int st = b / 1024, sb = b % 1024, swz = sb ^ (((sb >> 9) & 1) << 5); R = (st >> 1) * 16 + swz / 64; C = (st & 1) * 32 + (swz % 64) / 2; }
__host__ __device__ __forceinline__ int perm32(int rho) { const int n = rho >> 4, i = rho & 15; return 8 * (i >> 2) + 4 * n + (i & 3); }

struct Unit { int pm, pn, g, par, kh; };
struct Gemm { const bf16_t* A; const bf16_t* Bt; int M, N, K, lda, ldb; size_t gsA, gsB; size_t khA = 0, khB = 0; };

struct StaticOrder {
    int nM, nN, nwg, G, c;
    __host__ __device__ void init(int M, int N, int G_, int c_) { nM = M / BM; nN = N / BM; nwg = nM * nN; G = G_; c = c_; }
    __host__ __device__ bool next(int i, Unit& u) const {
        const long L = (long)i * G + c; if (L >= nwg) return false;
        int wgid = (int)L; { const int q = nwg / NXCD, r = nwg % NXCD, xcd = wgid % NXCD, off = wgid / NXCD; wgid = (xcd < r ? xcd * (q + 1) : r * (q + 1) + (xcd - r) * q) + off; }
        const int nig = WGM * nN, gid = wgid / nig, fm = gid * WGM, gsz = (nM - fm) < WGM ? (nM - fm) : WGM;
        u.pm = fm + ((wgid % nig) % gsz); u.pn = (wgid % nig) / gsz; u.g = 0; u.par = i & 1; u.kh = 0; return true;
    }
    __device__ __forceinline__ void a_ready(const Unit&) const {}
    __device__ __forceinline__ void done(const Unit&) const {}
};

__device__ __forceinline__ unsigned cvt_pk_bf16(float lo, float hi) { unsigned r; asm volatile("v_cvt_pk_bf16_f32 %0, %1, %2" : "=v"(r) : "v"(lo), "v"(hi)); return r; }
typedef float f32x2 __attribute__((ext_vector_type(2)));
__device__ __forceinline__ f32x2 gelu_pk(f32x2 v) {
    const f32x2 av = __builtin_elementwise_abs(v), d = av * 0.2316418882f + 1.0f;
    f32x2 t; t.x = __builtin_amdgcn_rcpf(d.x); t.y = __builtin_amdgcn_rcpf(d.y);
    f32x2 q = t * 0.5307027145f + (-0.7265760135f); q = q * t + 0.7107068705f; q = q * t + (-0.142248368f); q = q * t + 0.127414796f; q = q * t;
    const f32x2 s = (v * v) * (-0.72134752044f);
    f32x2 e; e.x = __builtin_amdgcn_exp2f(s.x); e.y = __builtin_amdgcn_exp2f(s.y);
    const f32x2 m = v * (q * e), r = v - m;
    f32x2 o; o.x = v.x < 0.f ? m.x : r.x; o.y = v.y < 0.f ? m.y : r.y; return o;
}

__device__ __forceinline__ int fresh_tid() { int t; asm volatile("v_mov_b32 %0, %1" : "=v"(t) : "v"((int)threadIdx.x)); return t; }
#define EPI_ROWS_COLS const int rowb = u.pm * BM + wr * 64 + fr; const int colb = wc * 32 + 8 * fq;
__device__ __forceinline__ u32x4 pack8(const f32x4 v0, const f32x4 v1) { u32x4 w; w.x = cvt_pk_bf16(v0[0], v0[1]); w.y = cvt_pk_bf16(v0[2], v0[3]); w.z = cvt_pk_bf16(v1[0], v1[1]); w.w = cvt_pk_bf16(v1[2], v1[3]); return w; }
__device__ __forceinline__ float sum8sq(const f32x4 a, const f32x4 b) { return (a[0] * a[0] + a[1] * a[1]) + (a[2] * a[2] + a[3] * a[3]) + (b[0] * b[0] + b[1] * b[1]) + (b[2] * b[2] + b[3] * b[3]); }

struct EpiInProj {
    static constexpr bool PERM = true, AFTER_DRAIN = false, HAS_MID = false;
    bf16_t* MIX; bf16_t* XBCP; bf16_t* UA; bf16_t* UMETA; float* DTRAW;
    __device__ __forceinline__ void operator()(const f32x4 (&acc)[2][2][4][2], const Unit& u, int wr, int wc, int fr, int fq) const {
        EPI_ROWS_COLS
        const int pn = u.pn;
#pragma unroll
        for (int ai = 0; ai < 2; ++ai)
#pragma unroll
            for (int m = 0; m < 4; ++m) {
                const int r = rowb + ai * HALF + m * 16;
#pragma unroll
                for (int bj = 0; bj < 2; ++bj) {
                    const int c = pn * BM + bj * HALF + colb;
                    const f32x4 v0 = acc[ai][bj][m][0], v1 = acc[ai][bj][m][1];
                    if (pn < 4) { if (r < 16384) *(u32x4*)(MIX + (size_t)r * 2048 + c) = pack8(v0, v1); }
                    else if (pn < 10) { *(u32x4*)(XBCP + (size_t)r * 1536 + (c - 1024)) = pack8(v0, v1); }
                    else if (pn < 14) {
                        const int j = c - 2560, g = j >> 4, h0 = j & 15;
                        if (r < 16384) { const int b = r >> 13, tok = r & 8191, ch = tok >> 4, t = tok & 15;
                            *(u32x4*)(UA + ((size_t)(g * 1024 + b * 512 + ch) * 384 + t * 16 + h0)) = pack8(v0, v1); }
                        else *(u32x4*)(UMETA + (size_t)(r - 16384) * 1024 + j) = pack8(v0, v1);
                    } else {
                        const int j = c - 3584;
                        if (j < 16) { float* d = DTRAW + (size_t)r * 16 + j; *(f32x4*)d = v0; *(f32x4*)(d + 4) = v1; }
                    }
                }
            }
    }
};
struct EpiS5a {
    static constexpr bool PERM = true, AFTER_DRAIN = false, HAS_MID = false;
    float* SEND;
    __device__ __forceinline__ void operator()(const f32x4 (&acc)[2][2][4][2], const Unit& u, int wr, int wc, int fr, int fq) const {
        EPI_ROWS_COLS
#pragma unroll
        for (int ai = 0; ai < 2; ++ai)
#pragma unroll
            for (int m = 0; m < 4; ++m) {
                const int r = rowb + ai * HALF + m * 16;
                float* d = SEND + ((size_t)(u.g * 1024 + r) * 128 + colb);
                *(f32x4*)d = acc[ai][0][m][0]; *(f32x4*)(d + 4) = acc[ai][0][m][1];
            }
    }
};
struct EpiS5b {
    static constexpr bool PERM = true, AFTER_DRAIN = false, HAS_MID = false;
    bf16_t* Y5;
    __device__ __forceinline__ void operator()(const f32x4 (&acc)[2][2][4][2], const Unit& u, int wr, int wc, int fr, int fq) const {
        { const int t2 = fresh_tid(); const int w2 = t2 >> 6, l2 = t2 & 63; wr = w2 >> 2; wc = w2 & 3; fr = l2 & 15; fq = l2 >> 4; }
        const unsigned lane_off = (unsigned)((((u.pm >> 1) * 8192 + (((u.pm & 1) * 256 + wr * 64 + fr) * 16) + (wc * 2 + (fq >> 1))) * 1024 + u.g * 16 + (fq & 1) * 8) * 2);
        char* base = (char*)Y5;
#pragma unroll
        for (int ai = 0; ai < 2; ++ai)
#pragma unroll
            for (int m = 0; m < 4; ++m)
#pragma unroll
                for (int bj = 0; bj < 2; ++bj) {
                    const f32x4 v0 = acc[ai][bj][m][0], v1 = acc[ai][bj][m][1]; u32x4 w;
                    { const f32x2 a = gelu_pk((f32x2){v0[0], v0[1]}); w.x = cvt_pk_bf16(a.x, a.y); } __builtin_amdgcn_sched_barrier(0);
                    { const f32x2 a = gelu_pk((f32x2){v0[2], v0[3]}); w.y = cvt_pk_bf16(a.x, a.y); } __builtin_amdgcn_sched_barrier(0);
                    { const f32x2 a = gelu_pk((f32x2){v1[0], v1[1]}); w.z = cvt_pk_bf16(a.x, a.y); } __builtin_amdgcn_sched_barrier(0);
                    { const f32x2 a = gelu_pk((f32x2){v1[2], v1[3]}); w.w = cvt_pk_bf16(a.x, a.y); } __builtin_amdgcn_sched_barrier(0);
                    const unsigned off = lane_off + (unsigned)(ai * 4194304 + m * 524288 + bj * 16384);
                    *(u32x4*)(base + off) = w;
                }
    }
};
__device__ __forceinline__ float sigm(float x) { return __builtin_amdgcn_rcpf(1.0f + __builtin_amdgcn_exp2f(-1.44269504f * x)); }
struct EpiGlu {
    static constexpr bool PERM = true, AFTER_DRAIN = false, HAS_MID = false;
    bf16_t* MIX; const float* bglu; float* SS5;
    __device__ __forceinline__ void operator()(const f32x4 (&acc)[2][2][4][2], const Unit& u, int wr, int wc, int fr, int fq) const {
        EPI_ROWS_COLS
        const int oc = u.pn * 128 + colb;
        const f32x4 ba0 = *(const f32x4*)(bglu + oc), ba1 = *(const f32x4*)(bglu + oc + 4), bg0 = *(const f32x4*)(bglu + 1024 + oc), bg1 = *(const f32x4*)(bglu + 1024 + oc + 4);
#pragma unroll
        for (int ai = 0; ai < 2; ++ai)
#pragma unroll
            for (int m = 0; m < 4; ++m) {
                const int r = rowb + ai * HALF + m * 16;
                f32x4 a0 = acc[ai][0][m][0] + ba0, a1 = acc[ai][0][m][1] + ba1; const f32x4 g0 = acc[ai][1][m][0] + bg0, g1 = acc[ai][1][m][1] + bg1;
#pragma unroll
                for (int e = 0; e < 4; ++e) { a0[e] *= sigm(g0[e]); a1[e] *= sigm(g1[e]); }
                *(u32x4*)(MIX + (size_t)r * 2048 + 1024 + oc) = pack8(a0, a1);
                float s = sum8sq(a0, a1); s += __shfl_xor(s, 16); s += __shfl_xor(s, 32);
                if (fq == 0) atomicAdd(SS5 + r, s);
            }
    }
};
struct EpiOut {
    static constexpr bool PERM = true, AFTER_DRAIN = false, HAS_MID = true;
    const float* X; float* H1; bf16_t* H1B; const float* SSS; const float* SS5; float* SSM;
    __device__ __forceinline__ void mid(f32x4 (&acc)[2][2][4][2], const Unit& u, int wr, int wc, int fr, int fq) const {
        const int rowb = u.pm * BM + wr * 64 + fr;
#pragma unroll
        for (int ai = 0; ai < 2; ++ai)
#pragma unroll
            for (int m = 0; m < 4; ++m) {
                const int r = rowb + ai * HALF + m * 16;
                const float ratio = sqrtf((SS5[r] * (1.0f / 1024.0f) + 1e-5f) / (SSS[r] * (1.0f / 1024.0f) + 1e-5f));
#pragma unroll
                for (int bj = 0; bj < 2; ++bj)
#pragma unroll
                    for (int n = 0; n < 2; ++n) acc[ai][bj][m][n] *= ratio;
                asm volatile("" ::: "memory");
            }
    }
    __device__ __forceinline__ void operator()(const f32x4 (&acc)[2][2][4][2], const Unit& u, int wr, int wc, int fr, int fq) const {
        EPI_ROWS_COLS
        const unsigned lane_off = (unsigned)(rowb * 1024 + u.pn * BM + colb);
        const char* xb = (const char*)X; char* hb = (char*)H1; char* bb = (char*)H1B;
#pragma unroll
        for (int ai = 0; ai < 2; ++ai)
#pragma unroll
            for (int m = 0; m < 4; ++m) {
                const int r = rowb + ai * HALF + m * 16;
                const float rs = 1.0f / sqrtf(SS5[r] * (1.0f / 1024.0f) + 1e-5f);
                float s = 0.f;
#pragma unroll
                for (int bj = 0; bj < 2; ++bj) {
                    const unsigned off = lane_off + (unsigned)(ai * 131072 + m * 16384 + bj * 128);
                    const f32x4 v0 = *(const f32x4*)(xb + off * 4u) + acc[ai][bj][m][0] * rs, v1 = *(const f32x4*)(xb + off * 4u + 16u) + acc[ai][bj][m][1] * rs;
                    *(f32x4*)(hb + off * 4u) = v0; *(f32x4*)(hb + off * 4u + 16u) = v1;
                    *(u32x4*)(bb + off * 2u) = pack8(v0, v1); s += sum8sq(v0, v1);
                }
                s += __shfl_xor(s, 16); s += __shfl_xor(s, 32);
                if (fq == 0) atomicAdd(SSM + r, s);
                asm volatile("" ::: "memory");
            }
    }
};
struct SplitKOrder {
    StaticOrder base;
    __device__ bool next(int i, Unit& u) const { if (!base.next(i >> 1, u)) return false; u.kh = i & 1; u.par = i & 1; return true; }
    __device__ __forceinline__ void a_ready(const Unit&) const {}
    __device__ __forceinline__ void done(const Unit&) const {}
};
struct EpiUp {
    static constexpr bool PERM = true, AFTER_DRAIN = false, HAS_MID = false;
    bf16_t* HB; const float* SSM;
    __device__ __forceinline__ void operator()(const f32x4 (&acc)[2][2][4][2], const Unit& u, int wr, int wc, int fr, int fq) const {
        EPI_ROWS_COLS
#pragma unroll
        for (int ai = 0; ai < 2; ++ai)
#pragma unroll
            for (int m = 0; m < 4; ++m) {
                const int r = rowb + ai * HALF + m * 16;
                const float rs = 1.0f / sqrtf(SSM[r] * (1.0f / 1024.0f) + 1e-5f);
#pragma unroll
                for (int bj = 0; bj < 2; ++bj) {
                    f32x4 v0 = acc[ai][bj][m][0] * rs, v1 = acc[ai][bj][m][1] * rs;
#pragma unroll
                    for (int e = 0; e < 4; ++e) { const float p = fmaxf(v0[e], 0.f), q = fmaxf(v1[e], 0.f); v0[e] = p * p; v1[e] = q * q; }
                    *(u32x4*)(HB + (size_t)r * 4096 + u.pn * BM + bj * HALF + colb) = pack8(v0, v1);
                }
            }
    }
};
struct EpiDown {
    static constexpr bool PERM = true, AFTER_DRAIN = false, HAS_MID = false;
    float* H; float* SSF; unsigned* pcnt; const float* gfin; int fused;
    __device__ __forceinline__ void operator()(const f32x4 (&acc_)[2][2][4][2], const Unit& u, int wr, int wc, int fr, int fq) const {
        f32x4 (&acc)[2][2][4][2] = const_cast<f32x4 (&)[2][2][4][2]>(acc_);
        EPI_ROWS_COLS
        const unsigned lane_off = (unsigned)(rowb * 1024 + u.pn * BM + colb);
        char* hb = (char*)H;
#pragma unroll
        for (int ai = 0; ai < 2; ++ai)
#pragma unroll
            for (int m = 0; m < 4; ++m) {
                const int r = rowb + ai * HALF + m * 16;
                float s = 0.f;
#pragma unroll
                for (int bj = 0; bj < 2; ++bj) {
                    const unsigned off = lane_off + (unsigned)(ai * 131072 + m * 16384 + bj * 128);
                    const f32x4 v0 = *(const f32x4*)(hb + off * 4u) + acc[ai][bj][m][0], v1 = *(const f32x4*)(hb + off * 4u + 16u) + acc[ai][bj][m][1];
                    if (fused) { acc[ai][bj][m][0] = v0; acc[ai][bj][m][1] = v1; } else { *(f32x4*)(hb + off * 4u) = v0; *(f32x4*)(hb + off * 4u + 16u) = v1; }
                    s += sum8sq(v0, v1);
                }
                s += __shfl_xor(s, 16); s += __shfl_xor(s, 32);
                if (fq == 0) atomicAdd(SSF + r, s);
                asm volatile("" ::: "memory");
            }
        if (!fused) return;
        asm volatile("s_waitcnt vmcnt(0)" ::: "memory");
        unsigned* cw = pcnt + 4 * u.pm;
        if (fr == 0 && fq == 0) __hip_atomic_fetch_add(cw, 1u, __ATOMIC_RELAXED, __HIP_MEMORY_SCOPE_AGENT);
        while (__hip_atomic_load(cw, __ATOMIC_RELAXED, __HIP_MEMORY_SCOPE_AGENT) < 32u) __builtin_amdgcn_s_sleep(4);
        asm volatile("" ::: "memory");
        f32x4 gv[2][2];
#pragma unroll
        for (int bj = 0; bj < 2; ++bj) { gv[bj][0] = *(const f32x4*)(gfin + u.pn * BM + bj * HALF + colb); gv[bj][1] = *(const f32x4*)(gfin + u.pn * BM + bj * HALF + colb + 4); }
#pragma unroll
        for (int ai = 0; ai < 2; ++ai)
#pragma unroll
            for (int m = 0; m < 4; ++m) {
                const int r = rowb + ai * HALF + m * 16;
                const float ssum = __builtin_bit_cast(float, __hip_atomic_load((const unsigned*)(SSF + r), __ATOMIC_RELAXED, __HIP_MEMORY_SCOPE_AGENT));
                const float rs = 1.0f / sqrtf(ssum * (1.0f / 1024.0f) + 1e-5f);
#pragma unroll
                for (int bj = 0; bj < 2; ++bj) {
                    const unsigned off = lane_off + (unsigned)(ai * 131072 + m * 16384 + bj * 128);
                    *(f32x4*)(hb + off * 4u) = acc[ai][bj][m][0] * rs * gv[bj][0]; *(f32x4*)(hb + off * 4u + 16u) = acc[ai][bj][m][1] * rs * gv[bj][1];
                }
            }
    }
};
struct BatchOrder {
    int nU, per_g, Ge, ce;
    __host__ __device__ void init(int nU_, int per_g_, int G, int w0, int c) { nU = nU_; per_g = per_g_; Ge = G - w0; ce = c - w0; }
    __device__ bool next(int i, Unit& u) const {
        if (ce < 0) return false;
        const long L = (long)i * Ge + ce; if (L >= nU) return false;
        u.g = __builtin_amdgcn_readfirstlane((int)L / per_g); u.pm = __builtin_amdgcn_readfirstlane((int)L % per_g); u.pn = 0; u.par = i & 1; u.kh = 0; return true;
    }
    __device__ __forceinline__ void a_ready(const Unit&) const {}
    __device__ __forceinline__ void done(const Unit&) const {}
};
template <class Epi, class Sched, bool ALIGN_EPI = false, bool SP2 = false>
__device__ __forceinline__ void gemm_phase(PG8_LAS unsigned char* lds, const Gemm g, const Sched& S, const Epi& E) {
    const int tid = threadIdx.x, wid = __builtin_amdgcn_readfirstlane(tid >> 6), lane = tid & 63, wr = wid >> 2, wc = wid & 3, fr = lane & 15, fq = lane >> 4;
    const int K = g.K, nt = K / BK;
    unsigned voffA[2], voffB[2];
#pragma unroll
    for (int i = 0; i < 2; ++i) { int R, C; stage_rc(tid * 16 + i * 8192, R, C); const int Rb = Epi::PERM ? ((R & ~31) + perm32(R & 31)) : R;
        voffA[i] = (unsigned)(R * g.lda + C) * 2u; voffB[i] = (unsigned)(Rb * g.ldb + C) * 2u; }
    const size_t kstep = (size_t)(BK * 2);
    const size_t hstepA = (size_t)HALF * g.lda * 2, hstepB = (size_t)HALF * g.ldb * 2;
    const size_t tstepA = 2 * hstepA, tstepB = 2 * hstepB;
    const unsigned ldsw = (unsigned)wid * 1024u;
    const int aoff = lds_byte(wr * 64 + fr, fq * 8), boff = lds_byte(wc * 32 + fr, fq * 8);
#define PG8_SA(b, h) (((b) * 2 + (h)) * HTB)
#define PG8_SB(b, h) ((4 + (b) * 2 + (h)) * HTB)
#define PG8_STAGE(bufoff, gbase, voff) do { _Pragma("unroll") for (int _i = 0; _i < 2; ++_i) \
        __builtin_amdgcn_global_load_lds((const unsigned*)((const char*)(gbase) + (voff)[_i]), (PG8_LAS unsigned*)(lds + (bufoff) + ldsw + _i * 8192), 16, 0, 0); } while (0)
#define PG8_LDA(dst, b, h) do { _Pragma("unroll") for (int m = 0; m < 4; ++m) _Pragma("unroll") for (int k = 0; k < 2; ++k) dst[m][k] = *(const PG8_LAS bf16x8*)(lds + PG8_SA(b, h) + aoff + m * 2048 + k * 1024); } while (0)
#define PG8_LDB(dst, b, h) do { _Pragma("unroll") for (int n = 0; n < 2; ++n) _Pragma("unroll") for (int k = 0; k < 2; ++k) dst[n][k] = *(const PG8_LAS bf16x8*)(lds + PG8_SB(b, h) + boff + n * 2048 + k * 1024); } while (0)
#define PG8_MMA(ai, bj, At, Bt) do { __builtin_amdgcn_s_setprio(1); _Pragma("unroll") for (int m = 0; m < 4; ++m) _Pragma("unroll") for (int n = 0; n < 2; ++n) _Pragma("unroll") for (int k = 0; k < 2; ++k) \
        acc[ai][bj][m][n] = __builtin_amdgcn_mfma_f32_16x16x32_bf16(Bt[n][k], At[m][k], acc[ai][bj][m][n], 0, 0, 0); __builtin_amdgcn_s_setprio(0); } while (0)
#define PG8_WAIT_V(n) asm volatile("s_waitcnt vmcnt(" #n ")" ::: "memory")
#define PG8_WAIT_L(n) asm volatile("s_waitcnt lgkmcnt(" #n ")" ::: "memory")
#define PG8_BAR __builtin_amdgcn_s_barrier()
#define PG8_SCHED __builtin_amdgcn_sched_barrier(0)
    Unit cur, nxt; int ui = 0;
    if (!S.next(0, cur)) return;
    f32x4 acc[2][2][4][2];
#pragma unroll
    for (int a = 0; a < 2; ++a)
#pragma unroll
        for (int b = 0; b < 2; ++b)
#pragma unroll
            for (int m = 0; m < 4; ++m)
#pragma unroll
                for (int n = 0; n < 2; ++n) acc[a][b][m][n] = (f32x4){0.f, 0.f, 0.f, 0.f};
    bf16x8 At[4][2], B0[2][2], B1[2][2];
    const char* cA = (const char*)g.A + (size_t)cur.g * g.gsA + (size_t)cur.pm * tstepA + (size_t)cur.kh * g.khA; const char* cB = (const char*)g.Bt + (size_t)cur.g * g.gsB + (size_t)cur.pn * tstepB + (size_t)cur.kh * g.khB;
    S.a_ready(cur);
    if constexpr (SP2) {
        PG8_STAGE(PG8_SB(0, 0), cB, voffB); PG8_STAGE(PG8_SB(0, 1), cB + hstepB, voffB); PG8_STAGE(PG8_SA(0, 0), cA, voffA); PG8_STAGE(PG8_SA(0, 1), cA + hstepA, voffA);
        if (wr == 1) PG8_BAR;
        PG8_WAIT_V(2); PG8_BAR;
        PG8_STAGE(PG8_SB(1, 0), cB + kstep, voffB); PG8_STAGE(PG8_SA(1, 0), cA + kstep, voffA); PG8_STAGE(PG8_SB(1, 1), cB + hstepB + kstep, voffB);
        PG8_WAIT_V(6); PG8_BAR;
    } else {
        PG8_STAGE(PG8_SB(0, 0), cB, voffB); PG8_STAGE(PG8_SA(0, 0), cA, voffA); PG8_STAGE(PG8_SB(0, 1), cB + hstepB, voffB); PG8_STAGE(PG8_SA(0, 1), cA + hstepA, voffA);
        if (wr == 1) PG8_BAR;
        PG8_WAIT_V(4); PG8_BAR;
        PG8_STAGE(PG8_SB(1, 0), cB + kstep, voffB); PG8_STAGE(PG8_SA(1, 0), cA + kstep, voffA); PG8_STAGE(PG8_SB(1, 1), cB + hstepB + kstep, voffB);
        PG8_WAIT_V(6); PG8_BAR;
    }
    for (;;) {
        const bool has_next = S.next(ui + 1, nxt);
        const char* nA = has_next ? (const char*)g.A + (size_t)nxt.g * g.gsA + (size_t)nxt.pm * tstepA + (size_t)nxt.kh * g.khA : cA; const char* nB = has_next ? (const char*)g.Bt + (size_t)nxt.g * g.gsB + (size_t)nxt.pn * tstepB + (size_t)nxt.kh * g.khB : cB;
        for (int t = 0; t < nt; t += 2) {
            const bool last = (t == nt - 2);
            const char* a1 = cA + (size_t)(t + 1) * kstep;
            const char* a2 = last ? nA : cA + (size_t)(t + 2) * kstep; const char* b2 = last ? nB : cB + (size_t)(t + 2) * kstep;
            const char* a3 = a2 + kstep; const char* b3 = b2 + kstep;
            if (last && has_next) S.a_ready(nxt);
            if constexpr (SP2) {
            PG8_LDB(B0, 0, 0); PG8_LDB(B1, 0, 1); PG8_SCHED; PG8_LDA(At, 0, 0); PG8_STAGE(PG8_SA(1, 1), a1 + hstepA, voffA);
            PG8_WAIT_V(8); PG8_WAIT_L(0); PG8_BAR; PG8_MMA(0, 0, At, B0); PG8_MMA(0, 1, At, B1); PG8_BAR; PG8_SCHED;
            PG8_LDA(At, 0, 1); PG8_STAGE(PG8_SB(0, 0), b2, voffB); PG8_STAGE(PG8_SB(0, 1), b2 + hstepB, voffB); PG8_STAGE(PG8_SA(0, 0), a2, voffA);
            PG8_WAIT_V(8); PG8_WAIT_L(0); PG8_BAR; PG8_MMA(1, 0, At, B0); PG8_MMA(1, 1, At, B1); PG8_BAR; PG8_SCHED;
            PG8_LDB(B0, 1, 0); PG8_LDB(B1, 1, 1); PG8_SCHED; PG8_LDA(At, 1, 0); PG8_STAGE(PG8_SA(0, 1), a2 + hstepA, voffA);
            PG8_WAIT_V(8); PG8_WAIT_L(0); PG8_BAR; PG8_MMA(0, 0, At, B0); PG8_MMA(0, 1, At, B1); PG8_BAR; PG8_SCHED;
            PG8_LDA(At, 1, 1); PG8_STAGE(PG8_SB(1, 0), b3, voffB); PG8_STAGE(PG8_SB(1, 1), b3 + hstepB, voffB); PG8_STAGE(PG8_SA(1, 0), a3, voffA);
            PG8_WAIT_V(8); PG8_WAIT_L(0); PG8_BAR; PG8_MMA(1, 0, At, B0); PG8_MMA(1, 1, At, B1); PG8_BAR; PG8_SCHED;
            } else {
            PG8_LDB(B0, 0, 0); PG8_SCHED; PG8_LDA(At, 0, 0); PG8_STAGE(PG8_SA(1, 1), a1 + hstepA, voffA);
            PG8_WAIT_L(8); PG8_BAR; PG8_WAIT_L(0); PG8_MMA(0, 0, At, B0); PG8_BAR; PG8_SCHED;
            PG8_LDB(B1, 0, 1); PG8_STAGE(PG8_SB(0, 0), b2, voffB);
            PG8_BAR; PG8_WAIT_L(0); PG8_MMA(0, 1, At, B1); PG8_BAR;
            PG8_LDA(At, 0, 1); PG8_STAGE(PG8_SA(0, 0), a2, voffA);
            PG8_BAR; PG8_WAIT_L(0); PG8_MMA(1, 0, At, B0); PG8_BAR; PG8_SCHED;
            PG8_STAGE(PG8_SB(0, 1), b2 + hstepB, voffB);
            PG8_WAIT_V(6); PG8_BAR; PG8_MMA(1, 1, At, B1); PG8_BAR;
            PG8_LDB(B0, 1, 0); PG8_SCHED; PG8_LDA(At, 1, 0); PG8_STAGE(PG8_SA(0, 1), a2 + hstepA, voffA);
            PG8_WAIT_L(8); PG8_BAR; PG8_WAIT_L(0); PG8_MMA(0, 0, At, B0); PG8_BAR; PG8_SCHED;
            PG8_LDB(B1, 1, 1); PG8_STAGE(PG8_SB(1, 0), b3, voffB);
            PG8_BAR; PG8_WAIT_L(0); PG8_MMA(0, 1, At, B1); PG8_BAR;
            PG8_LDA(At, 1, 1); PG8_STAGE(PG8_SA(1, 0), a3, voffA);
            PG8_BAR; PG8_WAIT_L(0); PG8_MMA(1, 0, At, B0); PG8_BAR; PG8_SCHED;
            PG8_STAGE(PG8_SB(1, 1), b3 + hstepB, voffB);
            PG8_WAIT_V(6); PG8_BAR; PG8_MMA(1, 1, At, B1); PG8_BAR;
            }
        }
        if constexpr (ALIGN_EPI) { if (wr == 0) PG8_BAR; }
        bool keep = false;
        if constexpr (Epi::HAS_MID) { if (cur.kh == 0) { E.mid(acc, cur, wr, wc, fr, fq); keep = true; } }
        if (!keep) { if constexpr (!Epi::AFTER_DRAIN) { E(acc, cur, wr, wc, fr, fq); S.done(cur); } }
        if (!has_next) break;
        if (!keep)
#pragma unroll
        for (int a = 0; a < 2; ++a)
#pragma unroll
            for (int b = 0; b < 2; ++b)
#pragma unroll
                for (int m = 0; m < 4; ++m)
#pragma unroll
                    for (int n = 0; n < 2; ++n) acc[a][b][m][n] = (f32x4){0.f, 0.f, 0.f, 0.f};
        cur = nxt; cA = nA; cB = nB; ++ui;
        if constexpr (ALIGN_EPI) { if (wr == 1) PG8_BAR; }
    }
    PG8_WAIT_V(0);
    if constexpr (!ALIGN_EPI) { if (wr == 0) PG8_BAR; }
    PG8_BAR;
    if constexpr (Epi::AFTER_DRAIN) { E.fused(acc, cur, wr, wc, fr, fq, lds, wid, lane); S.done(cur); }
#undef PG8_SA
#undef PG8_SB
#undef PG8_STAGE
#undef PG8_LDA
#undef PG8_LDB
#undef PG8_MMA
#undef PG8_WAIT_V
#undef PG8_WAIT_L
#undef PG8_BAR
#undef PG8_SCHED
}
}

#include <hip/hip_cooperative_groups.h>
namespace cg = cooperative_groups;
typedef unsigned short bf16;
typedef unsigned v4u __attribute__((ext_vector_type(4)));
typedef unsigned v2u __attribute__((ext_vector_type(2)));
typedef float f32x4 __attribute__((ext_vector_type(4)));
typedef float f32x2 __attribute__((ext_vector_type(2)));
typedef short bf16x8 __attribute__((ext_vector_type(8)));

constexpr int NT = 512, NWAVES = 8;
constexpr int MR = 16384, MP = 16640;
constexpr int NIN = 3840;
constexpr int NQ = 65;
constexpr float EPS = 1e-5f;
constexpr size_t MiB = 1u << 20;
constexpr size_t WS_SS    = 0;
constexpr size_t WS_DEC   = 256 * 1024;
constexpr size_t WS_A1    = 288 * 1024;
constexpr size_t WS_A16   = 320 * 1024;
constexpr size_t WS_BAR   = 384 * 1024;
constexpr size_t WS_BBAR  = 512 * 1024;
constexpr size_t WS_UMETA = 1 * MiB;
constexpr size_t WS_DTRAW = 1 * MiB + 512 * 1024;
constexpr size_t WS_DT    = 2 * MiB + 640 * 1024;
constexpr size_t WS_ACS   = 254 * MiB + 512 * 1024;
static_assert(WS_DTRAW + 16640 * 16 * 4 <= WS_DT && WS_DT + 65 * 16 * 256 * 4 <= 4 * MiB && WS_ACS + 65 * 16 * 256 * 4 <= 256 * MiB, "smalls");
constexpr size_t WS_WGLU  = 4 * MiB;
constexpr size_t WS_TB5   = 8 * MiB;
constexpr size_t WS_TE5   = 20 * MiB;
constexpr size_t WS_WIN   = 28 * MiB;
constexpr size_t WS_PREV  = 20 * MiB;
constexpr size_t WS_WOUT  = 8 * MiB, WS_WUP = 12 * MiB, WS_WDN = 20 * MiB;
constexpr size_t WS_MIX   = 36 * MiB;
constexpr size_t WS_UA    = 100 * MiB;
constexpr size_t WS_XBCP  = 148 * MiB;
constexpr size_t WS_SEND  = 148 * MiB;
constexpr size_t WS_ST    = 180 * MiB;
constexpr size_t WS_Y5    = 148 * MiB;
constexpr size_t WS_XN    = 197 * MiB;
constexpr size_t WS_XF    = 197 * MiB;
constexpr size_t WS_H1B   = 197 * MiB;
constexpr size_t WS_CT    = 230 * MiB;
constexpr size_t WS_BTK   = WS_CT + 65 * 65536 * 2;
constexpr size_t WS_BF    = WS_BTK + 65 * 65536 * 2;
constexpr size_t WS_HB    = 36 * MiB;
static_assert(WS_BF + 65 * 65536 * 2 <= WS_ACS, "ws");
constexpr int LDS_BYTES = 155648;

__device__ __forceinline__ unsigned f2bf(float f) { unsigned u = __builtin_bit_cast(unsigned, f); return (u + 0x7fffu + ((u >> 16) & 1u)) >> 16; }
__device__ __forceinline__ unsigned pk2(float lo, float hi) { return f2bf(lo) | (f2bf(hi) << 16); }
__device__ __forceinline__ float bf2f(unsigned short h) { return __builtin_bit_cast(float, (unsigned)h << 16); }
__device__ __forceinline__ float bflo(unsigned w) { return __builtin_bit_cast(float, w << 16); }
__device__ __forceinline__ float bfhi(unsigned w) { return __builtin_bit_cast(float, w & 0xffff0000u); }
__device__ __forceinline__ float ex2(float x) { return __builtin_amdgcn_exp2f(x); }
__device__ __forceinline__ float expf_(float x) { return __builtin_amdgcn_exp2f(1.44269504f * x); }
__device__ __forceinline__ float wave_sum(float v) {
#pragma unroll
    for (int o = 1; o < 64; o <<= 1) v += __shfl_xor(v, o);
    return v;
}

#define LAS __attribute__((address_space(3)))
#define XB_TMO      128
#define XB_XCNT(j)  (256  + 64 * (j))
#define XB_XSUB(j)  (1280 + 64 * (j))
#define XB_XGEN(j)  (2304 + 64 * (j))
#define XB_TOP      3328
#define XB_TOPGEN   3392
#define XCD_BAR_WORDS 3456
#define XB_SPIN_CAP (1u << 18)

__device__ __forceinline__ unsigned xb_ld(unsigned* p)              { return __hip_atomic_load(p, __ATOMIC_RELAXED, __HIP_MEMORY_SCOPE_AGENT); }
__device__ __forceinline__ unsigned xb_add(unsigned* p, unsigned v) { return __hip_atomic_fetch_add(p, v, __ATOMIC_RELAXED, __HIP_MEMORY_SCOPE_AGENT); }
__device__ __forceinline__ unsigned xb_xcc_id() { return (unsigned)__builtin_amdgcn_s_getreg((3 << 11) | 20) & 0xFu; }
#define XB_SPIN(cond, bar) do { unsigned _sp = 0; while (cond) { __builtin_amdgcn_s_sleep(1); \
    if ((++_sp & 255u) == 0u) { if (xb_ld(&(bar)[XB_TMO])) break; if (_sp > XB_SPIN_CAP) { atomicAdd(&(bar)[XB_TMO], 1u); break; } } } } while (0)

struct XcdBarrier {
    unsigned* bar; unsigned x;
    volatile LAS unsigned* st;
};

__device__ __forceinline__ XcdBarrier xcd_barrier_post(unsigned* bar, volatile LAS unsigned* st) {
    XcdBarrier b; b.bar = bar; b.x = xb_xcc_id(); b.st = st;
    if (threadIdx.x == 0) (void)xb_add(&bar[XB_XCNT(b.x)], 1u);
    return b;
}
__device__ __forceinline__ void xcd_barrier_complete(unsigned* bar, unsigned x, unsigned& nloc, unsigned& nx) {
    const unsigned G = gridDim.x * gridDim.y * gridDim.z;
    unsigned sum, cnt, mine, sp = 0u;
    for (;;) {
        sum = 0u; cnt = 0u; mine = 0u;
#pragma unroll
        for (unsigned j = 0; j < 16; ++j) { const unsigned c = xb_ld(&bar[XB_XCNT(j)]); sum += c; cnt += (c > 0u) ? 1u : 0u; mine = (j == x) ? c : mine; }
        if (sum == G) break;
        __builtin_amdgcn_s_sleep(1);
        if ((++sp & 255u) == 0u) { if (xb_ld(&bar[XB_TMO])) break; if (sp > XB_SPIN_CAP) { atomicAdd(&bar[XB_TMO], 1u); break; } }
    }
    nloc = mine > 0u ? mine : 1u; nx = cnt > 0u ? cnt : 1u;
}

__device__ __forceinline__ void xcd_barrier(const XcdBarrier& b) {
    asm volatile("s_waitcnt vmcnt(0)" ::: "memory");
    __syncthreads();
    if (threadIdx.x == 0) {
        unsigned* bar = b.bar;
        __builtin_amdgcn_s_waitcnt(0);
        unsigned nloc = b.st[0], nx = b.st[1];
        if (nloc == 0u) { xcd_barrier_complete(bar, b.x, nloc, nx); b.st[0] = nloc; b.st[1] = nx; }
        const unsigned old = xb_add(&bar[XB_XSUB(b.x)], 1u);
        const unsigned gen = old / nloc;
        if (old + 1u == (gen + 1u) * nloc) {
            __builtin_amdgcn_fence(__ATOMIC_RELEASE, "agent");
            asm volatile("s_waitcnt vmcnt(0)" ::: "memory");
            const unsigned og = xb_add(&bar[XB_TOP], 1u);
            const unsigned tg = og / nx;
            if (og + 1u == (tg + 1u) * nx) xb_add(&bar[XB_TOPGEN], 1u);
            else XB_SPIN(xb_ld(&bar[XB_TOPGEN]) == tg, bar);
            __builtin_amdgcn_fence(__ATOMIC_ACQUIRE, "agent");
            xb_add(&bar[XB_XGEN(b.x)], 1u);
            asm volatile("s_waitcnt vmcnt(0)" ::: "memory");
        } else {
            XB_SPIN(xb_ld(&bar[XB_XGEN(b.x)]) == gen, bar);
            __builtin_amdgcn_fence(__ATOMIC_ACQUIRE, "agent");
            asm volatile("s_waitcnt vmcnt(0)" ::: "memory");
        }
    }
    __syncthreads();
}

struct Args {
    const float* in[26]; float* out; unsigned char* ws; int ph_lo, ph_hi;
};
enum { I_X = 0, I_META, I_GMIX, I_WIN, I_CONVW, I_CONVB, I_DTB, I_ALOG, I_DSSD, I_GSSD, I_LRE, I_LIM, I_LSTEP, I_BRE, I_BIM, I_CRE, I_CIM, I_DS5, I_WGLU, I_BGLU, I_GS5, I_WOUT, I_GMLP, I_WUP, I_WDN, I_GFIN };

template <int MODE> __device__ __forceinline__ int colmap(int j) {
    if (MODE == 1) { if (j < 2560) return j; if (j < 3584) return j + 16; if (j < 3600) return j - 1024; return -1; }
    if (MODE == 2) { const int pn = j >> 8, r = j & 255; return r < 128 ? pn * 128 + r : 1024 + pn * 128 + (r - 128); }
    return j;
}
template <int MODE> __device__ __forceinline__ void transpose_item(const float* W, int K, int N, bf16* WT, const float* ks0, const float* ks1, float* scr, int item, int nblk, int lane) {
    const int kb = item / nblk, nb = item % nblk, k0 = 64 * kb, n0 = 32 * nb;
    const int src = colmap<MODE>(n0 + (lane & 31));
#pragma unroll 8
    for (int i = 0; i < 32; ++i) { const int kk = 2 * i + (lane >> 5); const int k = k0 + kk;
        float v = src >= 0 ? W[(size_t)k * N + src] : 0.f;
        if (ks0) v *= (k < 1024 ? ks0[k] : ks1[k - 1024]);
        scr[kk * 33 + (lane & 31)] = v; }
    asm volatile("s_waitcnt lgkmcnt(0)" ::: "memory");
    const int c = lane & 7;
#pragma unroll
    for (int j = 0; j < 4; ++j) { const int n = (lane >> 3) + 8 * j; const float* s = scr + (8 * c) * 33 + n;
        v4u o; o.x = pk2(s[0 * 33], s[1 * 33]); o.y = pk2(s[2 * 33], s[3 * 33]); o.z = pk2(s[4 * 33], s[5 * 33]); o.w = pk2(s[6 * 33], s[7 * 33]);
        *(v4u*)(WT + (size_t)(n0 + n) * K + k0 + 8 * c) = o; }
    asm volatile("s_waitcnt lgkmcnt(0)" ::: "memory");
}

__device__ __forceinline__ void sincos_d(double th, float& sn, float& cs) {
    const double k = rint(th * 0.15915494309189535); const double r = fma(-k, 6.283185307179586, th);
    const double t = r * 0.125, t2 = t * t;
    double s = t * (1.0 + t2 * (-1.0 / 6 + t2 * (1.0 / 120 + t2 * (-1.0 / 5040 + t2 * (1.0 / 362880 + t2 * (-1.0 / 39916800))))));
    double c = 1.0 + t2 * (-0.5 + t2 * (1.0 / 24 + t2 * (-1.0 / 720 + t2 * (1.0 / 40320 + t2 * (-1.0 / 3628800 + t2 * (1.0 / 479001600))))));
#pragma unroll
    for (int i = 0; i < 3; ++i) { const double s2 = 2.0 * s * c, c2 = 1.0 - 2.0 * s * s; s = s2; c = c2; }
    sn = (float)s; cs = (float)c;
}

__device__ __forceinline__ void s5_tables(const Args& a, int g, unsigned char* lds, int tid) {
    f32x2* pw = (f32x2*)lds;
    f32x2* Cc = pw + 17 * 64;
    f32x2* Bb = Cc + 16 * 64;
    float* Kt = (float*)(Bb + 64 * 16);
    unsigned char* ws = a.ws;
    if (tid < 64) {
        const int p = tid; const float lr = a.in[I_LRE][g * 64 + p], li = a.in[I_LIM][g * 64 + p]; const float st = expf(a.in[I_LSTEP][g]);
        float are = 1.f, aim = 0.f;
        for (int tau = 0; tau <= 16; ++tau) {
            const float mag = expf(lr * st * (float)tau); float sn, cs; sincos_d((double)li * (double)st * (double)tau, sn, cs);
            pw[tau * 64 + p] = (f32x2){mag * cs, mag * sn};
            if (tau == 1) { are = mag * cs; aim = mag * sn; ((f32x2*)(ws + WS_A1))[g * 64 + p] = (f32x2){are, aim}; }
            if (tau == 16) ((f32x2*)(ws + WS_A16))[g * 64 + p] = (f32x2){mag * cs, mag * sn};
        }
        const float den = lr * lr + li * li;
        const float cre = ((are - 1.0f) * lr + aim * li) / den, cim = (aim * lr - (are - 1.0f) * li) / den;
        for (int h = 0; h < 16; ++h) { const float br = a.in[I_BRE][(g * 64 + p) * 16 + h], bi = a.in[I_BIM][(g * 64 + p) * 16 + h];
            const f32x2 v = (f32x2){cre * br - cim * bi, cre * bi + cim * br}; Bb[p * 16 + h] = v; ((f32x2*)(ws + WS_BBAR))[(g * 64 + p) * 16 + h] = v; }
    }
    for (int e = tid; e < 1024; e += NT) Cc[e] = (f32x2){a.in[I_CRE][g * 1024 + e], a.in[I_CIM][g * 1024 + e]};
    __syncthreads();
    {
        const int tau = tid >> 5, h = (tid >> 1) & 15, h0 = (tid & 1) * 8; float acc[8];
#pragma unroll
        for (int j = 0; j < 8; ++j) acc[j] = 0.f;
        for (int p = 0; p < 64; ++p) { const f32x2 c = Cc[h * 64 + p], w = pw[tau * 64 + p]; const float tr = c.x * w.x - c.y * w.y, ti = c.x * w.y + c.y * w.x;
#pragma unroll
            for (int j = 0; j < 8; ++j) { const f32x2 b = Bb[p * 16 + h0 + j]; acc[j] += tr * b.x - ti * b.y; } }
        if (tau == 0) {
#pragma unroll
            for (int j = 0; j < 8; ++j) if (h0 + j == h) acc[j] += a.in[I_DS5][g * 16 + h];
        }
#pragma unroll
        for (int j = 0; j < 8; ++j) Kt[(tau * 16 + h) * 16 + h0 + j] = acc[j];
    }
    __syncthreads();
    bf16* TB = (bf16*)(ws + WS_TB5) + (size_t)g * 256 * 384;
    for (int pc = tid; pc < 256 * 48; pc += NT) {
        const int row = pc / 48, c8 = (pc % 48) * 8, t = row >> 4, h = row & 15; float v[8];
        if (c8 < 256) { const int s = c8 >> 4, h0 = c8 & 15;
#pragma unroll
            for (int j = 0; j < 8; ++j) v[j] = s <= t ? Kt[((t - s) * 16 + h) * 16 + h0 + j] : 0.f;
        } else { const int p0 = (c8 - 256) >> 1;
#pragma unroll
            for (int j = 0; j < 4; ++j) { const f32x2 c = Cc[h * 64 + p0 + j], w = pw[(t + 1) * 64 + p0 + j]; v[2 * j] = c.x * w.x - c.y * w.y; v[2 * j + 1] = -(c.x * w.y + c.y * w.x); }
        }
        v4u o; o.x = pk2(v[0], v[1]); o.y = pk2(v[2], v[3]); o.z = pk2(v[4], v[5]); o.w = pk2(v[6], v[7]);
        *(v4u*)(TB + (size_t)row * 384 + c8) = o;
    }
    bf16* TE = (bf16*)(ws + WS_TE5) + (size_t)g * 256 * 256;
    for (int pc = tid; pc < 256 * 32; pc += NT) {
        const int row = pc >> 5, c8 = (pc & 31) * 8; float v[8];
        if (row < 128) { const int p = row >> 1, ri = row & 1, s = c8 >> 4, h0 = c8 & 15; const f32x2 w = pw[(15 - s) * 64 + p];
#pragma unroll
            for (int j = 0; j < 8; ++j) { const f32x2 b = Bb[p * 16 + h0 + j]; v[j] = ri ? (w.x * b.y + w.y * b.x) : (w.x * b.x - w.y * b.y); }
        } else {
#pragma unroll
            for (int j = 0; j < 8; ++j) v[j] = 0.f;
        }
        v4u o; o.x = pk2(v[0], v[1]); o.y = pk2(v[2], v[3]); o.z = pk2(v[4], v[5]); o.w = pk2(v[6], v[7]);
        *(v4u*)(TE + (size_t)row * 256 + c8) = o;
    }
    __syncthreads();
}

__device__ __forceinline__ void rms_row_to_bf16(const float* xrow, const float* gain, bf16* orow, int lane) {
    unsigned long long* o8 = (unsigned long long*)orow + lane;
    if (!xrow) {
#pragma unroll
        for (int j = 0; j < 4; ++j) o8[64 * j] = 0ull;
        return; }
    const f32x4* xr = (const f32x4*)xrow + lane; const f32x4* gr = (const f32x4*)gain + lane;
    f32x4 v[4]; float s = 0.f;
#pragma unroll
    for (int j = 0; j < 4; ++j) { v[j] = xr[64 * j]; s += (v[j].x * v[j].x + v[j].y * v[j].y) + (v[j].z * v[j].z + v[j].w * v[j].w); }
    const float rstd = 1.f / sqrtf(wave_sum(s) * (1.f / 1024.f) + EPS);
#pragma unroll
    for (int j = 0; j < 4; ++j) { const f32x4 gg = gr[64 * j]; const f32x4 w = v[j] * rstd * gg; o8[64 * j] = (unsigned long long)pk2(w.x, w.y) | ((unsigned long long)pk2(w.z, w.w) << 32); }
}

__device__ __forceinline__ void p0_prologue(const Args& a, unsigned char* lds, int tid, int G) {
    unsigned char* ws = a.ws; const int lane = tid & 63, wave = tid >> 6;
    const int gw = blockIdx.x * NWAVES + wave, NGW = G * NWAVES;
    for (int i = blockIdx.x * NT + tid; i < 4 * 16384; i += G * NT) ((float*)(ws + WS_SS))[i] = 0.f;
    for (int g = (G - 1 - (int)blockIdx.x); g < 64; g += G) s5_tables(a, g, lds, tid);
    __syncthreads();
    float* scr = (float*)(lds + wave * 16384);
    constexpr int NB_IN = NIN / 32, NB_GL = 2048 / 32;
    constexpr int I_IN = 16 * NB_IN, I_GL = 16 * NB_GL;
    for (int it = gw; it < I_IN + I_GL; it += NGW) {
        if (it < I_IN) transpose_item<1>(a.in[I_WIN], 1024, 3600, (bf16*)(ws + WS_WIN), nullptr, nullptr, scr, it, NB_IN, lane);
        else transpose_item<2>(a.in[I_WGLU], 1024, 2048, (bf16*)(ws + WS_WGLU), nullptr, nullptr, scr, it - I_IN, NB_GL, lane);
    }
    for (int m = gw; m < MP; m += NGW) {
        const float* src = m < MR ? a.in[I_X] + (size_t)m * 1024 : (m < MR + 16 ? a.in[I_META] + (size_t)(m - MR) * 1024 : nullptr);
        rms_row_to_bf16(src, a.in[I_GMIX], (bf16*)(ws + WS_XN) + (size_t)m * 1024, lane);
    }
}
__device__ __forceinline__ void p6_weights(const Args& a, unsigned char* lds, int tid, int G) {
    unsigned char* ws = a.ws; const int lane = tid & 63, wave = tid >> 6;
    const int gw = blockIdx.x * NWAVES + wave, NGW = G * NWAVES;
    float* scr = (float*)(lds + wave * 16384);
    constexpr int I_O = 32 * 32, I_U = 16 * 128, I_D = 64 * 32;
    for (int it = gw; it < I_O + I_U + I_D; it += NGW) {
        if (it < I_O) transpose_item<0>(a.in[I_WOUT], 2048, 1024, (bf16*)(ws + WS_WOUT), a.in[I_GSSD], a.in[I_GS5], scr, it, 32, lane);
        else if (it < I_O + I_U) transpose_item<0>(a.in[I_WUP], 1024, 4096, (bf16*)(ws + WS_WUP), a.in[I_GMLP], a.in[I_GMLP], scr, it - I_O, 128, lane);
        else transpose_item<0>(a.in[I_WDN], 4096, 1024, (bf16*)(ws + WS_WDN), nullptr, nullptr, scr, it - I_O - I_U, 32, lane);
    }
    __syncthreads();
}

__device__ __forceinline__ int chunk_row(int q, int tok) {
    if (q == 0) return tok < 240 ? -1 : MR + (tok - 240);
    const int b = (q - 1) >> 5, c = (q - 1) & 31;
    if (tok < 0 && c == 0) return MR + 16 + tok;
    return b * 8192 + c * 256 + tok;
}
__device__ __forceinline__ float silu_(float x) { return x * __builtin_amdgcn_rcpf(1.0f + ex2(-1.44269504f * x)); }
__device__ __forceinline__ void p2_conv_unit(const Args& a, int q, int blk, unsigned char* lds, int tid) {
    unsigned char* ws = a.ws;
    bf16* IN = (bf16*)lds;
    bf16* OT = (bf16*)(lds + 40960);
    const bf16* XBCP = (const bf16*)(ws + WS_XBCP);
    const int ch0 = blk * 64;
    for (int pc = tid; pc < 259 * 8; pc += NT) { const int rr = pc >> 3, c8 = (pc & 7) * 8; const int row = chunk_row(q, rr - 3);
        v4u v = (v4u){0u, 0u, 0u, 0u}; if (row >= 0) v = *(const v4u*)(XBCP + (size_t)row * 1536 + ch0 + c8);
        *(v4u*)(IN + rr * 64 + c8) = v; }
    __syncthreads();
    const float* cw = a.in[I_CONVW]; const float* cb = a.in[I_CONVB];
    const bool is_x = blk < 16, is_b = blk >= 16 && blk < 20;
    if (!is_x) {
        bf16* dst = (bf16*)(ws + (is_b ? WS_BTK : WS_CT)) + (size_t)q * 65536 + (is_b ? (blk - 16) : (blk - 20)) * 64;
        for (int pc = tid; pc < 256 * 8; pc += NT) { const int tok = pc >> 3, c8 = (pc & 7) * 8; float o[8];
            const bool zero = (q == 0 && tok < 240);
#pragma unroll
            for (int j = 0; j < 8; ++j) o[j] = cb[ch0 + c8 + j];
#pragma unroll
            for (int k = 0; k < 4; ++k) { const v4u v = *(const v4u*)(IN + (tok + k) * 64 + c8); const unsigned w[4] = {v.x, v.y, v.z, v.w};
#pragma unroll
                for (int j = 0; j < 4; ++j) { o[2 * j] += cw[k * 1536 + ch0 + c8 + 2 * j] * bflo(w[j]); o[2 * j + 1] += cw[k * 1536 + ch0 + c8 + 2 * j + 1] * bfhi(w[j]); } }
#pragma unroll
            for (int j = 0; j < 8; ++j) o[j] = zero ? 0.f : silu_(o[j]);
            v4u ov; ov.x = pk2(o[0], o[1]); ov.y = pk2(o[2], o[3]); ov.z = pk2(o[4], o[5]); ov.w = pk2(o[6], o[7]);
            *(v4u*)(dst + (size_t)tok * 256 + c8) = ov; }
    }
    if (is_x || is_b) {
        for (int it = tid; it < 64 * 32; it += NT) { const int ch = it & 63, t0 = (it >> 6) * 8; float wk[4], in[11], o[8]; const float bias = cb[ch0 + ch];
#pragma unroll
            for (int k = 0; k < 4; ++k) wk[k] = cw[k * 1536 + ch0 + ch];
#pragma unroll
            for (int j = 0; j < 11; ++j) in[j] = bf2f(IN[(t0 + j) * 64 + ch]);
#pragma unroll
            for (int j = 0; j < 8; ++j) { const float v = bias + wk[0] * in[j] + wk[1] * in[j + 1] + wk[2] * in[j + 2] + wk[3] * in[j + 3]; o[j] = (q == 0 && t0 + j < 240) ? 0.f : silu_(v); }
            v4u ov; ov.x = pk2(o[0], o[1]); ov.y = pk2(o[2], o[3]); ov.z = pk2(o[4], o[5]); ov.w = pk2(o[6], o[7]);
            *(v4u*)(OT + ch * 264 + t0) = ov; }
        __syncthreads();
        bf16* dst = is_x ? (bf16*)(ws + WS_XF) + ((size_t)q * 1024 + ch0) * 256 : (bf16*)(ws + WS_BF) + ((size_t)q * 256 + (blk - 16) * 64) * 256;
        for (int pc = tid; pc < 64 * 32; pc += NT) { const int ch = pc >> 5, t8 = (pc & 31) * 8; *(v4u*)(dst + (size_t)ch * 256 + t8) = *(const v4u*)(OT + ch * 264 + t8); }
    }
    __syncthreads();
}
__device__ __forceinline__ void p2_dt_item(const Args& a, int q, int h, int lane) {
    unsigned char* ws = a.ws; const float* DTRAW = (const float*)(ws + WS_DTRAW);
    const float bias = a.in[I_DTB][h], A = -expf(a.in[I_ALOG][h]);
    float dt[4], cs[4]; float run = 0.f;
#pragma unroll
    for (int j = 0; j < 4; ++j) { const int tok = 4 * lane + j; const int row = chunk_row(q, tok);
        float d = 0.f; if (row >= 0) { const float x = DTRAW[(size_t)row * 16 + h] + bias; d = fmaxf(x, 0.f) + __logf(1.0f + expf_(-fabsf(x))); }
        dt[j] = d; run += d * A; cs[j] = run; }
    float incl = run;
#pragma unroll
    for (int o = 1; o < 64; o <<= 1) { const float t = __shfl_up(incl, o); if (lane >= o) incl += t; }
    const float excl = incl - run;
    float* DT = (float*)(ws + WS_DT) + ((size_t)q * 16 + h) * 256 + 4 * lane; float* ACS = (float*)(ws + WS_ACS) + ((size_t)q * 16 + h) * 256 + 4 * lane;
    *(f32x4*)DT = (f32x4){dt[0], dt[1], dt[2], dt[3]}; *(f32x4*)ACS = (f32x4){cs[0] + excl, cs[1] + excl, cs[2] + excl, cs[3] + excl};
    if (lane == 63) ((float*)(ws + WS_DEC))[q * 16 + h] = expf_(cs[3] + excl);
}

#define MFMA16(A, B, C) __builtin_amdgcn_mfma_f32_16x16x32_bf16(A, B, C, 0, 0, 0)
__device__ __forceinline__ void p3_states_unit(const Args& a, int q, int g, int tid) {
    unsigned char* ws = a.ws; const int lane = tid & 63, r = tid >> 6, h = g * 8 + r, fr = lane & 15, fq = lane >> 4;
    const bf16* XF = (const bf16*)(ws + WS_XF) + ((size_t)q * 1024 + h * 64) * 256;
    const bf16* BF = (const bf16*)(ws + WS_BF) + ((size_t)q * 256 + g * 128) * 256;
    const float* DT = (const float*)(ws + WS_DT) + ((size_t)q * 16 + h) * 256; const float* ACS = (const float*)(ws + WS_ACS) + ((size_t)q * 16 + h) * 256;
    const float alast = ACS[255];
    bf16* ST = (bf16*)(ws + WS_ST) + ((size_t)q * 16 + h) * 8192;
#pragma unroll 1
    for (int nh = 0; nh < 2; ++nh) {
        f32x4 acc[4][4];
#pragma unroll
        for (int i = 0; i < 4; ++i)
#pragma unroll
            for (int j = 0; j < 4; ++j) acc[i][j] = (f32x4){0.f, 0.f, 0.f, 0.f};
#pragma unroll 2
        for (int kb = 0; kb < 8; ++kb) {
            const int s0 = kb * 32 + fq * 8;
            float w[8];
            { const f32x4 d0 = *(const f32x4*)(DT + s0), d1 = *(const f32x4*)(DT + s0 + 4), c0 = *(const f32x4*)(ACS + s0), c1 = *(const f32x4*)(ACS + s0 + 4);
#pragma unroll
              for (int j = 0; j < 4; ++j) { w[j] = expf_(alast - c0[j]) * d0[j]; w[4 + j] = expf_(alast - c1[j]) * d1[j]; } }
            bf16x8 Af[4], Bf[4];
#pragma unroll
            for (int i = 0; i < 4; ++i) { const v4u v = *(const v4u*)(XF + (size_t)(i * 16 + fr) * 256 + s0);
                v4u o; o.x = pk2(bflo(v.x) * w[0], bfhi(v.x) * w[1]); o.y = pk2(bflo(v.y) * w[2], bfhi(v.y) * w[3]); o.z = pk2(bflo(v.z) * w[4], bfhi(v.z) * w[5]); o.w = pk2(bflo(v.w) * w[6], bfhi(v.w) * w[7]);
                Af[i] = __builtin_bit_cast(bf16x8, o); }
#pragma unroll
            for (int j = 0; j < 4; ++j) Bf[j] = *(const bf16x8*)(BF + (size_t)((nh * 4 + j) * 16 + fr) * 256 + s0);
#pragma unroll
            for (int i = 0; i < 4; ++i)
#pragma unroll
                for (int j = 0; j < 4; ++j) acc[i][j] = MFMA16(Bf[j], Af[i], acc[i][j]);
        }
#pragma unroll
        for (int i = 0; i < 4; ++i)
#pragma unroll
            for (int j = 0; j < 4; ++j) { v2u o; o.x = pk2(acc[i][j][0], acc[i][j][1]); o.y = pk2(acc[i][j][2], acc[i][j][3]);
                *(v2u*)(ST + (i * 16 + fr) * 128 + (nh * 4 + j) * 16 + fq * 4) = o; }
    }
}

__device__ __forceinline__ void p4_ssd_scan_item(const Args& a, int item, int tid) {
    unsigned char* ws = a.ws; const int e = item * 2048 + tid * 4;
    const int b = e >> 17, hpn = e & 131071, h = hpn >> 13;
    const bf16* ST = (const bf16*)(ws + WS_ST); bf16* PREV = (bf16*)(ws + WS_PREV); const float* DEC = (const float*)(ws + WS_DEC);
    v2u st[32]; float dec[32];
    st[0] = *(const v2u*)(ST + hpn); dec[0] = 0.f;
#pragma unroll
    for (int k = 1; k < 32; ++k) { const int q = b * 32 + k; st[k] = *(const v2u*)(ST + (size_t)q * 131072 + hpn); dec[k] = DEC[q * 16 + h]; }
    float s0 = bflo(st[0].x), s1 = bfhi(st[0].x), s2 = bflo(st[0].y), s3 = bfhi(st[0].y);
#pragma unroll
    for (int c = 0; c < 32; ++c) {
        v2u o; o.x = pk2(s0, s1); o.y = pk2(s2, s3); *(v2u*)(PREV + (size_t)(b * 32 + c) * 131072 + hpn) = o;
        if (c < 31) { const float d = dec[c + 1]; const v2u v = st[c + 1];
            s0 = s0 * d + bflo(v.x); s1 = s1 * d + bfhi(v.x); s2 = s2 * d + bflo(v.y); s3 = s3 * d + bfhi(v.y); }
    }
}
__device__ __forceinline__ void p4_s5_scan_item(const Args& a, int item, unsigned char* lds, int tid) {
    unsigned char* ws = a.ws; const int b = item >> 7, g = (item >> 1) & 63, p = (item & 1) * 32 + (tid & 31), seg = tid >> 5;
    const f32x2 a1 = ((const f32x2*)(ws + WS_A1))[g * 64 + p], a16 = ((const f32x2*)(ws + WS_A16))[g * 64 + p];
    const f32x2* Bb = (const f32x2*)(ws + WS_BBAR) + (size_t)(g * 64 + p) * 16;
    const bf16* UM = (const bf16*)(ws + WS_UMETA);
    const f32x2* SE = (const f32x2*)(ws + WS_SEND) + ((size_t)(g * 1024 + b * 512 + seg * 32) * 64 + p);
    f32x2 se[32];
#pragma unroll
    for (int j = 0; j < 32; ++j) se[j] = SE[(size_t)j * 64];
    float sr = 0.f, si = 0.f;
    f32x2 bbv[16];
#pragma unroll
    for (int h = 0; h < 16; ++h) bbv[h] = Bb[h];
    for (int s = 0; s < 16; ++s) { float br = 0.f, bi = 0.f;
        const v4u u0 = *(const v4u*)(UM + s * 1024 + g * 16), u1 = *(const v4u*)(UM + s * 1024 + g * 16 + 8); const unsigned uw[8] = {u0.x, u0.y, u0.z, u0.w, u1.x, u1.y, u1.z, u1.w};
#pragma unroll
        for (int h = 0; h < 16; ++h) { const float u = (h & 1) ? bfhi(uw[h >> 1]) : bflo(uw[h >> 1]); const f32x2 bb = bbv[h]; br += bb.x * u; bi += bb.y * u; }
        const float nr = a1.x * sr - a1.y * si + br, ni = a1.x * si + a1.y * sr + bi; sr = nr; si = ni; }
    float er = 0.f, ei = 0.f;
#pragma unroll
    for (int j = 0; j < 32; ++j) { const float nr = a16.x * er - a16.y * ei + se[j].x, ni = a16.x * ei + a16.y * er + se[j].y; er = nr; ei = ni; }
    f32x2* EL = (f32x2*)lds;
    EL[seg * 32 + (tid & 31)] = (f32x2){er, ei};
    float pr = a16.x, pi = a16.y;
#pragma unroll
    for (int k = 0; k < 5; ++k) { const float nr = pr * pr - pi * pi, ni = 2.f * pr * pi; pr = nr; pi = ni; }
    __syncthreads();
    for (int k = 0; k < seg; ++k) { const f32x2 ek = EL[k * 32 + (tid & 31)]; const float nr = pr * sr - pi * si + ek.x, ni = pr * si + pi * sr + ek.y; sr = nr; si = ni; }
    unsigned* UA = (unsigned*)((bf16*)(ws + WS_UA) + ((size_t)(g * 1024 + b * 512 + seg * 32) * 384 + 256 + 2 * p));
#pragma unroll
    for (int j = 0; j < 32; ++j) { UA[(size_t)j * 192] = pk2(sr, si);
        const float nr = a16.x * sr - a16.y * si + se[j].x, ni = a16.x * si + a16.y * sr + se[j].y; sr = nr; si = ni; }
    __syncthreads();
}

__device__ __forceinline__ void p5_ssd_out_unit(const Args& a, int q, int g, int half, unsigned char* lds, int tid) {
    unsigned char* ws = a.ws; const int lane = tid & 63, r = tid >> 6, h = g * 8 + r, fr = lane & 15, fq = lane >> 4;
    bf16* CBs = (bf16*)lds;
    float* ACSs = (float*)(lds + 256 * 264 * 2);
    float* DTs = ACSs + 8 * 256;
    const bf16* CT = (const bf16*)(ws + WS_CT) + (size_t)q * 65536 + g * 128;
    const bf16* BTK = (const bf16*)(ws + WS_BTK) + (size_t)q * 65536 + g * 128;
    for (int i = tid; i < 2048; i += NT) { ACSs[i] = ((const float*)(ws + WS_ACS))[((size_t)q * 16 + g * 8) * 256 + i]; DTs[i] = ((const float*)(ws + WS_DT))[((size_t)q * 16 + g * 8) * 256 + i]; }
    {
        int cnt = 0;
#pragma unroll 1
        for (int ti = 0; ti < 8; ++ti) {
            const int lt = half ? 4 + ti : (ti < 4 ? ti : 8 + ti);
#pragma unroll 1
            for (int stl = 0; stl <= lt; ++stl, ++cnt) {
                if ((cnt & 7) != r) continue;
                f32x4 c = (f32x4){0.f, 0.f, 0.f, 0.f};
#pragma unroll
                for (int k = 0; k < 4; ++k) { const bf16x8 Af = *(const bf16x8*)(CT + (size_t)(lt * 16 + fr) * 256 + k * 32 + fq * 8);
                    const bf16x8 Bf = *(const bf16x8*)(BTK + (size_t)(stl * 16 + fr) * 256 + k * 32 + fq * 8); c = MFMA16(Af, Bf, c); }
#pragma unroll
                for (int e = 0; e < 4; ++e) CBs[(lt * 16 + fq * 4 + e) * 264 + stl * 16 + fr] = (bf16)f2bf(c[e]);
            }
        }
    }
    __syncthreads();
    const bf16* XF = (const bf16*)(ws + WS_XF) + ((size_t)q * 1024 + h * 64) * 256;
    const bf16* PREV = (const bf16*)(ws + WS_PREV) + ((size_t)(q - 1) * 16 + h) * 8192;
    const float* acs = ACSs + r * 256; const float* dts = DTs + r * 256;
    const float dsk = a.in[I_DSSD][h];
    const int b = (q - 1) >> 5, c = (q - 1) & 31; const int m0 = b * 8192 + c * 256;
    bf16* MIX = (bf16*)(ws + WS_MIX); float* SSS = (float*)(ws + WS_SS);
#pragma unroll 1
    for (int lbi = 0; lbi < 2; ++lbi) {
        const int lb = half ? 1 + lbi : 3 * lbi;
        f32x4 acc[4][4];
#pragma unroll
        for (int i = 0; i < 4; ++i)
#pragma unroll
            for (int j = 0; j < 4; ++j) acc[i][j] = (f32x4){0.f, 0.f, 0.f, 0.f};
#pragma unroll 1
        for (int k = 0; k < 4; ++k) { bf16x8 Af[4], Bf[4];
#pragma unroll
            for (int i = 0; i < 4; ++i) Af[i] = *(const bf16x8*)(CT + (size_t)(lb * 64 + i * 16 + fr) * 256 + k * 32 + fq * 8);
#pragma unroll
            for (int j = 0; j < 4; ++j) Bf[j] = *(const bf16x8*)(PREV + (size_t)(j * 16 + fr) * 128 + k * 32 + fq * 8);
#pragma unroll
            for (int i = 0; i < 4; ++i)
#pragma unroll
                for (int j = 0; j < 4; ++j) acc[i][j] = MFMA16(Bf[j], Af[i], acc[i][j]); }
#pragma unroll
        for (int i = 0; i < 4; ++i) { const float sc = expf_(acs[lb * 64 + i * 16 + fr]);
#pragma unroll
            for (int j = 0; j < 4; ++j) acc[i][j] *= sc; }
        const int nsb = 2 * lb + 2;
#pragma unroll 1
        for (int sb = 0; sb < nsb; ++sb) {
            const int s0 = sb * 32 + fq * 8;
            bf16x8 Bf[4];
#pragma unroll
            for (int j = 0; j < 4; ++j) Bf[j] = *(const bf16x8*)(XF + (size_t)(j * 16 + fr) * 256 + s0);
            float as[8], ds[8];
#pragma unroll
            for (int j = 0; j < 8; ++j) { as[j] = acs[s0 + j]; ds[j] = dts[s0 + j]; }
#pragma unroll
            for (int i = 0; i < 4; ++i) {
                const int l = lb * 64 + i * 16 + fr;
                if (sb * 32 > lb * 64 + i * 16 + 15) continue;
                const float al = acs[l];
                const v4u v = *(const v4u*)(CBs + l * 264 + s0); const unsigned w4[4] = {v.x, v.y, v.z, v.w}; float pv[8];
#pragma unroll
                for (int j = 0; j < 4; ++j) {
                    const float p0 = bflo(w4[j]) * expf_(fminf(al - as[2 * j], 0.f)) * ds[2 * j], p1 = bfhi(w4[j]) * expf_(fminf(al - as[2 * j + 1], 0.f)) * ds[2 * j + 1];
                    const int sa = s0 + 2 * j, sbq = sa + 1;
                    pv[2 * j] = (sa < l) ? p0 : (sa == l ? p0 + dsk : 0.f); pv[2 * j + 1] = (sbq < l) ? p1 : (sbq == l ? p1 + dsk : 0.f); }
                v4u o; o.x = pk2(pv[0], pv[1]); o.y = pk2(pv[2], pv[3]); o.z = pk2(pv[4], pv[5]); o.w = pk2(pv[6], pv[7]);
                const bf16x8 Af = __builtin_bit_cast(bf16x8, o);
#pragma unroll
                for (int j = 0; j < 4; ++j) acc[i][j] = MFMA16(Bf[j], Af, acc[i][j]);
            }
        }
#pragma unroll
        for (int i = 0; i < 4; ++i) {
            const int l = lb * 64 + i * 16 + fr; float ssq = 0.f;
            bf16* zrow = MIX + (size_t)(m0 + l) * 2048 + h * 64 + fq * 4;
#pragma unroll
            for (int j = 0; j < 4; ++j) {
                const v2u zv = *(const v2u*)(zrow + j * 16);
                const float y0 = acc[i][j][0] * silu_(bflo(zv.x)), y1 = acc[i][j][1] * silu_(bfhi(zv.x)), y2 = acc[i][j][2] * silu_(bflo(zv.y)), y3 = acc[i][j][3] * silu_(bfhi(zv.y));
                v2u o; o.x = pk2(y0, y1); o.y = pk2(y2, y3); *(v2u*)(zrow + j * 16) = o;
                ssq += (y0 * y0 + y1 * y1) + (y2 * y2 + y3 * y3);
            }
            ssq += __shfl_xor(ssq, 16); ssq += __shfl_xor(ssq, 32);
            if (fq == 0) atomicAdd(SSS + m0 + l, ssq);
        }
    }
    __syncthreads();
}

__device__ __forceinline__ void p10_final(const Args& a, int tid, int G) {
    const int lane = tid & 63, wave = tid >> 6; const int gw = blockIdx.x * NWAVES + wave, NGW = G * NWAVES;
    const float* SSF = (const float*)(a.ws + WS_SS) + 3 * 16384; const f32x4* gf = (const f32x4*)a.in[I_GFIN] + lane;
    for (int m = gw; m < MR; m += NGW) { f32x4* row = (f32x4*)(a.out + (size_t)m * 1024) + lane; const float rs = 1.0f / sqrtf(SSF[m] * (1.0f / 1024.0f) + EPS);
#pragma unroll
        for (int j = 0; j < 4; ++j) row[64 * j] = row[64 * j] * rs * gf[64 * j]; }
}

__global__ void __launch_bounds__(NT, 2) fwd_kernel(Args args) {
    extern __shared__ __attribute__((aligned(16))) unsigned char lds[];
    cg::grid_group grid = cg::this_grid();
    const int tid = threadIdx.x, G = gridDim.x, bx = blockIdx.x;
    unsigned char* ws = args.ws;
    PG8_LAS unsigned char* ldsl = (PG8_LAS unsigned char*)lds;
    const int lo = args.ph_lo, hi = args.ph_hi;
#ifndef SKIPMASK
#define SKIPMASK 0
#endif
#define IN(k) (!((SKIPMASK >> (k)) & 1) && lo <= (k) && (k) < hi)
    volatile LAS unsigned* bst = (volatile LAS unsigned*)(ldsl + 155136);
    if (tid < 2) bst[tid] = 0u;
    __syncthreads();
    XcdBarrier xbar = xcd_barrier_post((unsigned*)(ws + WS_BAR), bst);
#define SEAM(k) do { if (IN(k) && IN((k) + 1)) { if ((k) == 0) grid.sync(); else xcd_barrier(xbar); } } while (0)
    float* SS = (float*)(ws + WS_SS);
    if (IN(0)) { const int tid = pg8::fresh_tid(); p0_prologue(args, lds, tid, G); }
    SEAM(0);
    if (IN(1)) {
        pg8::Gemm g{(const bf16*)(ws + WS_XN), (const bf16*)(ws + WS_WIN), MP, NIN, 1024, 1024, 1024, 0, 0}; pg8::StaticOrder S; S.init(MP, NIN, G, bx);
        pg8::EpiInProj E{(bf16*)(ws + WS_MIX), (bf16*)(ws + WS_XBCP), (bf16*)(ws + WS_UA), (bf16*)(ws + WS_UMETA), (float*)(ws + WS_DTRAW)};
        pg8::gemm_phase<pg8::EpiInProj, pg8::StaticOrder, true, true>(ldsl, g, S, E);
    }
    SEAM(1);
    if (IN(2)) {
        const int tid = pg8::fresh_tid(), wave = tid >> 6, lane = tid & 63;
        for (int u = bx; u < NQ * 24; u += G) p2_conv_unit(args, u / 24, u % 24, lds, tid);
        for (int it = bx * NWAVES + wave; it < NQ * 16; it += G * NWAVES) p2_dt_item(args, it >> 4, it & 15, lane);
    }
    SEAM(2);
    const int nS3 = (G / 2 < 126) ? G / 2 : 126;
    if (IN(3)) {
        const int tid = pg8::fresh_tid();
        if (bx < nS3) { for (int u = bx; u < 126; u += nS3) { const int qi = u >> 1; p3_states_unit(args, qi < 32 ? qi : qi + 1, u & 1, tid); } }
        pg8::Gemm g{(const bf16*)(ws + WS_UA), (const bf16*)(ws + WS_TE5), 1024, 256, 256, 384, 256, (size_t)1024 * 384 * 2, (size_t)256 * 256 * 2};
        pg8::BatchOrder S; S.init(256, 4, G, nS3, bx);
        pg8::EpiS5a E{(float*)(ws + WS_SEND)};
        pg8::gemm_phase<pg8::EpiS5a, pg8::BatchOrder, true, true>(ldsl, g, S, E);
    }
    SEAM(3);
    if (IN(4)) {
        const int tid = pg8::fresh_tid();
        for (int it = bx; it < 384; it += G) { if (it < 256) p4_s5_scan_item(args, it, lds, tid); else p4_ssd_scan_item(args, it - 256, tid); }
    }
    SEAM(4);
    if (IN(5)) {
        const int tid = pg8::fresh_tid();
#ifndef NO_SSDOUT
        for (int u = bx; u < 256; u += G) p5_ssd_out_unit(args, 1 + (u >> 2), (u >> 1) & 1, u & 1, lds, tid);
        __syncthreads();
#endif
        pg8::Gemm g{(const bf16*)(ws + WS_UA), (const bf16*)(ws + WS_TB5), 1024, 256, 384, 384, 384, (size_t)1024 * 384 * 2, (size_t)256 * 384 * 2};
        pg8::BatchOrder S; S.init(256, 4, G, 0, bx);
        pg8::EpiS5b E{(bf16*)(ws + WS_Y5)};
        pg8::gemm_phase<pg8::EpiS5b, pg8::BatchOrder, true, true>(ldsl, g, S, E);
    }
    SEAM(5);
    if (IN(6)) {
        const int tid = pg8::fresh_tid();
        p6_weights(args, lds, tid, G);
        pg8::Gemm g{(const bf16*)(ws + WS_Y5), (const bf16*)(ws + WS_WGLU), MR, 2048, 1024, 1024, 1024, 0, 0}; pg8::StaticOrder S; S.init(MR, 2048, G, bx);
        pg8::EpiGlu E{(bf16*)(ws + WS_MIX), args.in[I_BGLU], SS + 16384};
        pg8::gemm_phase<pg8::EpiGlu, pg8::StaticOrder, true, true>(ldsl, g, S, E);
    }
    SEAM(6);
    if (IN(7)) {
        pg8::Gemm g{(const bf16*)(ws + WS_MIX), (const bf16*)(ws + WS_WOUT), MR, 1024, 1024, 2048, 2048, 0, 0, (size_t)1024 * 2, (size_t)1024 * 2};
        pg8::SplitKOrder S; S.base.init(MR, 1024, G, bx);
        pg8::EpiOut E{args.in[I_X], args.out, (bf16*)(ws + WS_H1B), SS, SS + 16384, SS + 2 * 16384};
        pg8::gemm_phase<pg8::EpiOut, pg8::SplitKOrder, true, true>(ldsl, g, S, E);
    }
    SEAM(7);
    if (IN(8)) {
        pg8::Gemm g{(const bf16*)(ws + WS_H1B), (const bf16*)(ws + WS_WUP), MR, 4096, 1024, 1024, 1024, 0, 0}; pg8::StaticOrder S; S.init(MR, 4096, G, bx);
        pg8::EpiUp E{(bf16*)(ws + WS_HB), SS + 2 * 16384};
        pg8::gemm_phase<pg8::EpiUp, pg8::StaticOrder, true, true>(ldsl, g, S, E);
    }
    SEAM(8);
    const int fused_fin = (G == 256 && lo <= 9 && hi >= 11) ? 1 : 0;
    if (IN(9)) {
        pg8::Gemm g{(const bf16*)(ws + WS_HB), (const bf16*)(ws + WS_WDN), MR, 1024, 4096, 4096, 4096, 0, 0}; pg8::StaticOrder S; S.init(MR, 1024, G, bx);
        pg8::EpiDown E{args.out, SS + 3 * 16384, (unsigned*)(ws + WS_BAR) + 3584, args.in[I_GFIN], fused_fin};
        pg8::gemm_phase<pg8::EpiDown, pg8::StaticOrder, true, true>(ldsl, g, S, E);
    }
    if (!fused_fin) {
        SEAM(9);
        if (IN(10)) { const int tid = pg8::fresh_tid(); p10_final(args, tid, G); }
    }
#undef IN
#undef SEAM
}

#ifndef N_LAUNCHES
#define N_LAUNCHES 1
#endif
extern "C" void kernel_launch(void* const* d_in, const int* in_sizes, int n_in, void* d_out, int out_size, void* d_ws, size_t ws_size, hipStream_t stream) {
    static int grid = 0;
    if (grid == 0) {
        int dev = 0, cus = 0, per_cu = 0;
        hipGetDevice(&dev); hipDeviceGetAttribute(&cus, hipDeviceAttributeMultiprocessorCount, dev);
        hipFuncSetAttribute((const void*)fwd_kernel, hipFuncAttributeMaxDynamicSharedMemorySize, LDS_BYTES);
        hipOccupancyMaxActiveBlocksPerMultiprocessor(&per_cu, (const void*)fwd_kernel, NT, LDS_BYTES);
        if (per_cu < 1) { fprintf(stderr, "occupancy query says %d blocks per CU\n", per_cu); per_cu = 1; }
        grid = cus * 1;
        (void)hipGetLastError();
    }
    hipMemsetAsync((char*)d_ws + WS_BAR, 0, 16384, stream);
    Args a{};
    for (int i = 0; i < 26; ++i) a.in[i] = (const float*)d_in[i];
    a.out = (float*)d_out; a.ws = (unsigned char*)d_ws;
    if (N_LAUNCHES == 1) {
        a.ph_lo = 0; a.ph_hi = 11;
        void* args[] = {&a};
        hipError_t e = hipLaunchCooperativeKernel((const void*)fwd_kernel, dim3(grid), dim3(NT), args, LDS_BYTES, stream);
        if (e != hipSuccess) fprintf(stderr, "cooperative launch failed: %s (grid %d)\n", hipGetErrorString(e), grid);
    } else {
        for (int p = 0; p < 11; ++p) { a.ph_lo = p; a.ph_hi = p + 1; hipLaunchKernelGGL(fwd_kernel, dim3(grid), dim3(NT), LDS_BYTES, stream, a); }
    }
}
```

```cpp
#include <hip/hip_runtime.h>
#include <cstdio>
#include <cstdint>
namespace pg8 {
#define PG8_LAS __attribute__((address_space(3)))
typedef unsigned short bf16_t;
typedef short bf16x8 __attribute__((ext_vector_type(8)));
typedef float f32x4 __attribute__((ext_vector_type(4)));
typedef unsigned u32x4 __attribute__((ext_vector_type(4)));
constexpr int BM = 256, BK = 64, HALF = 128, HTB = HALF * BK * 2  , STAGE_BYTES = 8 * HTB, NXCD = 8, WGM = 8;

__host__ __device__ __forceinline__ int lds_byte(int r, int c) { const int st = (r >> 4) * 2 + (c >> 5), rr = r & 15, cc = c & 31, ob = rr * 64 + cc * 2; return st * 1024 + (ob ^ (((ob >> 9) & 1) << 5)); }
__host__ __device__ __forceinline__ void stage_rc(int b, int& R, int& C) { const int st = b / 1024, sb = b % 1024, swz = sb ^ (((sb >> 9) & 1) << 5); R = (st >> 1) * 16 + swz / 64; C = (st & 1) * 32 + (swz % 64) / 2; }
__host__ __device__ __forceinline__ int perm32(int rho) { const int n = rho >> 4, i = rho & 15; return 8 * (i >> 2) + 4 * n + (i & 3); }

struct Unit { int pm, pn, g, par, kh; };
struct Gemm { const bf16_t* A; const bf16_t* Bt; int M, N, K, lda, ldb; size_t gsA, gsB; size_t khA = 0, khB = 0; };

struct StaticOrder {
    int nM, nN, nwg, G, c;
    __host__ __device__ void init(int M, int N, int G_, int c_) { nM = M / BM; nN = N / BM; nwg = nM * nN; G = G_; c = c_; }
    __host__ __device__ bool next(int i, Unit& u) const {
        const long L = (long)i * G + c; if (L >= nwg) return false;
        int wgid = (int)L; { const int q = nwg / NXCD, r = nwg % NXCD, xcd = wgid % NXCD, off = wgid / NXCD; wgid = (xcd < r ? xcd * (q + 1) : r * (q + 1) + (xcd - r) * q) + off; }
        const int nig = WGM * nN, gid = wgid / nig, fm = gid * WGM, gsz = (nM - fm) < WGM ? (nM - fm) : WGM;
        u.pm = fm + ((wgid % nig) % gsz); u.pn = (wgid % nig) / gsz; u.g = 0; u.par = i & 1; u.kh = 0; return true;
    }
    __device__ __forceinline__ void a_ready(const Unit&) const {}
    __device__ __forceinline__ void done(const Unit&) const {}
};

__device__ __forceinline__ unsigned cvt_pk_bf16(float lo, float hi) { unsigned r; asm volatile("v_cvt_pk_bf16_f32 %0, %1, %2" : "=v"(r) : "v"(lo), "v"(hi)); return r; }
typedef float f32x2 __attribute__((ext_vector_type(2)));
__device__ __forceinline__ f32x2 gelu_pk(f32x2 v) {
    const f32x2 av = __builtin_elementwise_abs(v), d = av * 0.2316418882f + 1.0f;
    f32x2 t; t.x = __builtin_amdgcn_rcpf(d.x); t.y = __builtin_amdgcn_rcpf(d.y);
    f32x2 q = t * 0.5307027145f + (-0.7265760135f); q = q * t + 0.7107068705f; q = q * t + (-0.142248368f); q = q * t + 0.127414796f; q = q * t;
    const f32x2 s = (v * v) * (-0.72134752044f);
    f32x2 e; e.x = __builtin_amdgcn_exp2f(s.x); e.y = __builtin_amdgcn_exp2f(s.y);
    const f32x2 m = v * (q * e), r = v - m;
    f32x2 o; o.x = v.x < 0.f ? m.x : r.x; o.y = v.y < 0.f ? m.y : r.y; return o;
}

__device__ __forceinline__ int fresh_tid() { int t; asm volatile("v_mov_b32 %0, %1" : "=v"(t) : "v"((int)threadIdx.x)); return t; }
#define EPI_ROWS_COLS const int rowb = u.pm * BM + wr * 64 + fr; const int colb = wc * 32 + 8 * fq;
__device__ __forceinline__ u32x4 pack8(const f32x4 v0, const f32x4 v1) { u32x4 w; w.x = cvt_pk_bf16(v0[0], v0[1]); w.y = cvt_pk_bf16(v0[2], v0[3]); w.z = cvt_pk_bf16(v1[0], v1[1]); w.w = cvt_pk_bf16(v1[2], v1[3]); return w; }
__device__ __forceinline__ float sum8sq(const f32x4 a, const f32x4 b) { return (a[0] * a[0] + a[1] * a[1]) + (a[2] * a[2] + a[3] * a[3]) + (b[0] * b[0] + b[1] * b[1]) + (b[2] * b[2] + b[3] * b[3]); }

struct EpiInProj {
    static constexpr bool PERM = true, AFTER_DRAIN = false, HAS_MID = false;
    bf16_t* MIX; bf16_t* XBCP; bf16_t* UA; bf16_t* UMETA; float* DTRAW;
    __device__ __forceinline__ void operator()(const f32x4 (&acc)[2][2][4][2], const Unit& u, int wr, int wc, int fr, int fq) const {
        EPI_ROWS_COLS
        const int pn = u.pn;
#pragma unroll
        for (int ai = 0; ai < 2; ++ai)
#pragma unroll
            for (int m = 0; m < 4; ++m) {
                const int r = rowb + ai * HALF + m * 16;
#pragma unroll
                for (int bj = 0; bj < 2; ++bj) {
                    const int c = pn * BM + bj * HALF + colb;
                    const f32x4 v0 = acc[ai][bj][m][0], v1 = acc[ai][bj][m][1];
                    if (pn < 4) { if (r < 16384) *(u32x4*)(MIX + (size_t)r * 2048 + c) = pack8(v0, v1); }
                    else if (pn < 10) { *(u32x4*)(XBCP + (size_t)r * 1536 + (c - 1024)) = pack8(v0, v1); }
                    else if (pn < 14) {
                        const int j = c - 2560, g = j >> 4, h0 = j & 15;
                        if (r < 16384) { const int b = r >> 13, tok = r & 8191, ch = tok >> 4, t = tok & 15;
                            *(u32x4*)(UA + ((size_t)(g * 1024 + b * 512 + ch) * 384 + t * 16 + h0)) = pack8(v0, v1); }
                        else *(u32x4*)(UMETA + (size_t)(r - 16384) * 1024 + j) = pack8(v0, v1);
                    } else {
                        const int j = c - 3584;
                        if (j < 16) { float* d = DTRAW + (size_t)r * 16 + j; *(f32x4*)d = v0; *(f32x4*)(d + 4) = v1; }
                    }
                }
            }
    }
};
struct EpiS5a {
    static constexpr bool PERM = true, AFTER_DRAIN = false, HAS_MID = false;
    float* SEND;
    __device__ __forceinline__ void operator()(const f32x4 (&acc)[2][2][4][2], const Unit& u, int wr, int wc, int fr, int fq) const {
        EPI_ROWS_COLS
#pragma unroll
        for (int ai = 0; ai < 2; ++ai)
#pragma unroll
            for (int m = 0; m < 4; ++m) {
                const int r = rowb + ai * HALF + m * 16;
                float* d = SEND + ((size_t)(u.g * 1024 + r) * 128 + colb);
                *(f32x4*)d = acc[ai][0][m][0]; *(f32x4*)(d + 4) = acc[ai][0][m][1];
            }
    }
};
struct EpiS5b {
    static constexpr bool PERM = true, AFTER_DRAIN = false, HAS_MID = false;
    bf16_t* Y5;
    __device__ __forceinline__ void operator()(const f32x4 (&acc)[2][2][4][2], const Unit& u, int wr, int wc, int fr, int fq) const {
        { const int t2 = fresh_tid(); const int w2 = t2 >> 6, l2 = t2 & 63; wr = w2 >> 2; wc = w2 & 3; fr = l2 & 15; fq = l2 >> 4; }
        const unsigned lane_off = (unsigned)((((u.pm >> 1) * 8192 + (((u.pm & 1) * 256 + wr * 64 + fr) * 16) + (wc * 2 + (fq >> 1))) * 1024 + u.g * 16 + (fq & 1) * 8) * 2);
        char* base = (char*)Y5;
#pragma unroll
        for (int ai = 0; ai < 2; ++ai)
#pragma unroll
            for (int m = 0; m < 4; ++m)
#pragma unroll
                for (int bj = 0; bj < 2; ++bj) {
                    const f32x4 v0 = acc[ai][bj][m][0], v1 = acc[ai][bj][m][1]; u32x4 w;
                    { const f32x2 a = gelu_pk((f32x2){v0[0], v0[1]}); w.x = cvt_pk_bf16(a.x, a.y); } __builtin_amdgcn_sched_barrier(0);
                    { const f32x2 a = gelu_pk((f32x2){v0[2], v0[3]}); w.y = cvt_pk_bf16(a.x, a.y); } __builtin_amdgcn_sched_barrier(0);
                    { const f32x2 a = gelu_pk((f32x2){v1[0], v1[1]}); w.z = cvt_pk_bf16(a.x, a.y); } __builtin_amdgcn_sched_barrier(0);
                    { const f32x2 a = gelu_pk((f32x2){v1[2], v1[3]}); w.w = cvt_pk_bf16(a.x, a.y); } __builtin_amdgcn_sched_barrier(0);
                    const unsigned off = lane_off + (unsigned)(ai * 4194304 + m * 524288 + bj * 16384);
                    *(u32x4*)(base + off) = w;
                }
    }
};
__device__ __forceinline__ float sigm(float x) { return __builtin_amdgcn_rcpf(1.0f + __builtin_amdgcn_exp2f(-1.44269504f * x)); }
struct EpiGlu {
    static constexpr bool PERM = true, AFTER_DRAIN = false, HAS_MID = false;
    bf16_t* MIX; const float* bglu; float* SS5;
    __device__ __forceinline__ void operator()(const f32x4 (&acc)[2][2][4][2], const Unit& u, int wr, int wc, int fr, int fq) const {
        EPI_ROWS_COLS
        const int oc = u.pn * 128 + colb;
        const f32x4 ba0 = *(const f32x4*)(bglu + oc), ba1 = *(const f32x4*)(bglu + oc + 4), bg0 = *(const f32x4*)(bglu + 1024 + oc), bg1 = *(const f32x4*)(bglu + 1024 + oc + 4);
#pragma unroll
        for (int ai = 0; ai < 2; ++ai)
#pragma unroll
            for (int m = 0; m < 4; ++m) {
                const int r = rowb + ai * HALF + m * 16;
                f32x4 a0 = acc[ai][0][m][0] + ba0, a1 = acc[ai][0][m][1] + ba1; const f32x4 g0 = acc[ai][1][m][0] + bg0, g1 = acc[ai][1][m][1] + bg1;
#pragma unroll
                for (int e = 0; e < 4; ++e) { a0[e] *= sigm(g0[e]); a1[e] *= sigm(g1[e]); }
                *(u32x4*)(MIX + (size_t)r * 2048 + 1024 + oc) = pack8(a0, a1);
                float s = sum8sq(a0, a1); s += __shfl_xor(s, 16); s += __shfl_xor(s, 32);
                if (fq == 0) atomicAdd(SS5 + r, s);
            }
    }
};
struct EpiOut {
    static constexpr bool PERM = true, AFTER_DRAIN = false, HAS_MID = true;
    const float* X; float* H1; bf16_t* H1B; const float* SSS; const float* SS5; float* SSM;
    __device__ __forceinline__ void mid(f32x4 (&acc)[2][2][4][2], const Unit& u, int wr, int wc, int fr, int fq) const {
        const int rowb = u.pm * BM + wr * 64 + fr;
#pragma unroll
        for (int ai = 0; ai < 2; ++ai)
#pragma unroll
            for (int m = 0; m < 4; ++m) {
                const int r = rowb + ai * HALF + m * 16;
                const float ratio = sqrtf((SS5[r] * (1.0f / 1024.0f) + 1e-5f) / (SSS[r] * (1.0f / 1024.0f) + 1e-5f));
#pragma unroll
                for (int bj = 0; bj < 2; ++bj)
#pragma unroll
                    for (int n = 0; n < 2; ++n) acc[ai][bj][m][n] *= ratio;
                asm volatile("" ::: "memory");
            }
    }
    __device__ __forceinline__ void operator()(const f32x4 (&acc)[2][2][4][2], const Unit& u, int wr, int wc, int fr, int fq) const {
        EPI_ROWS_COLS
        const unsigned lane_off = (unsigned)(rowb * 1024 + u.pn * BM + colb);
        const char* xb = (const char*)X; char* hb = (char*)H1; char* bb = (char*)H1B;
#pragma unroll
        for (int ai = 0; ai < 2; ++ai)
#pragma unroll
            for (int m = 0; m < 4; ++m) {
                const int r = rowb + ai * HALF + m * 16;
                const float rs = 1.0f / sqrtf(SS5[r] * (1.0f / 1024.0f) + 1e-5f);
                float s = 0.f;
#pragma unroll
                for (int bj = 0; bj < 2; ++bj) {
                    const unsigned off = lane_off + (unsigned)(ai * 131072 + m * 16384 + bj * 128);
                    const f32x4 v0 = *(const f32x4*)(xb + off * 4u) + acc[ai][bj][m][0] * rs, v1 = *(const f32x4*)(xb + off * 4u + 16u) + acc[ai][bj][m][1] * rs;
                    *(f32x4*)(hb + off * 4u) = v0; *(f32x4*)(hb + off * 4u + 16u) = v1;
                    *(u32x4*)(bb + off * 2u) = pack8(v0, v1); s += sum8sq(v0, v1);
                }
                s += __shfl_xor(s, 16); s += __shfl_xor(s, 32);
                if (fq == 0) atomicAdd(SSM + r, s);
                asm volatile("" ::: "memory");
            }
    }
};
struct SplitKOrder {
    StaticOrder base;
    __device__ bool next(int i, Unit& u) const { if (!base.next(i >> 1, u)) return false; u.kh = i & 1; u.par = i & 1; return true; }
    __device__ __forceinline__ void a_ready(const Unit&) const {}
    __device__ __forceinline__ void done(const Unit&) const {}
};
struct EpiUp {
    static constexpr bool PERM = true, AFTER_DRAIN = false, HAS_MID = false;
    bf16_t* HB; const float* SSM;
    __device__ __forceinline__ void operator()(const f32x4 (&acc)[2][2][4][2], const Unit& u, int wr, int wc, int fr, int fq) const {
        EPI_ROWS_COLS
#pragma unroll
        for (int ai = 0; ai < 2; ++ai)
#pragma unroll
            for (int m = 0; m < 4; ++m) {
                const int r = rowb + ai * HALF + m * 16;
                const float rs = 1.0f / sqrtf(SSM[r] * (1.0f / 1024.0f) + 1e-5f);
#pragma unroll
                for (int bj = 0; bj < 2; ++bj) {
                    f32x4 v0 = acc[ai][bj][m][0] * rs, v1 = acc[ai][bj][m][1] * rs;
#pragma unroll
                    for (int e = 0; e < 4; ++e) { const float p = fmaxf(v0[e], 0.f), q = fmaxf(v1[e], 0.f); v0[e] = p * p; v1[e] = q * q; }
                    *(u32x4*)(HB + (size_t)r * 4096 + u.pn * BM + bj * HALF + colb) = pack8(v0, v1);
                }
            }
    }
};
struct EpiDown {
    static constexpr bool PERM = true, AFTER_DRAIN = false, HAS_MID = false;
    float* H; float* SSF; unsigned* pcnt; const float* gfin; int fused;
    __device__ __forceinline__ void operator()(const f32x4 (&acc_)[2][2][4][2], const Unit& u, int wr, int wc, int fr, int fq) const {
        f32x4 (&acc)[2][2][4][2] = const_cast<f32x4 (&)[2][2][4][2]>(acc_);
        EPI_ROWS_COLS
        const unsigned lane_off = (unsigned)(rowb * 1024 + u.pn * BM + colb);
        char* hb = (char*)H;
#pragma unroll
        for (int ai = 0; ai < 2; ++ai)
#pragma unroll
            for (int m = 0; m < 4; ++m) {
                const int r = rowb + ai * HALF + m * 16;
                float s = 0.f;
#pragma unroll
                for (int bj = 0; bj < 2; ++bj) {
                    const unsigned off = lane_off + (unsigned)(ai * 131072 + m * 16384 + bj * 128);
                    const f32x4 v0 = *(const f32x4*)(hb + off * 4u) + acc[ai][bj][m][0], v1 = *(const f32x4*)(hb + off * 4u + 16u) + acc[ai][bj][m][1];
                    if (fused) { acc[ai][bj][m][0] = v0; acc[ai][bj][m][1] = v1; } else { *(f32x4*)(hb + off * 4u) = v0; *(f32x4*)(hb + off * 4u + 16u) = v1; }
                    s += sum8sq(v0, v1);
                }
                s += __shfl_xor(s, 16); s += __shfl_xor(s, 32);
                if (fq == 0) atomicAdd(SSF + r, s);
                asm volatile("" ::: "memory");
            }
        if (!fused) return;
        asm volatile("s_waitcnt vmcnt(0)" ::: "memory");
        unsigned* cw = pcnt + 4 * u.pm;
        if (fr == 0 && fq == 0) __hip_atomic_fetch_add(cw, 1u, __ATOMIC_RELAXED, __HIP_MEMORY_SCOPE_AGENT);
        while (__hip_atomic_load(cw, __ATOMIC_RELAXED, __HIP_MEMORY_SCOPE_AGENT) < 32u) __builtin_amdgcn_s_sleep(4);
        asm volatile("" ::: "memory");
        f32x4 gv[2][2];
#pragma unroll
        for (int bj = 0; bj < 2; ++bj) { gv[bj][0] = *(const f32x4*)(gfin + u.pn * BM + bj * HALF + colb); gv[bj][1] = *(const f32x4*)(gfin + u.pn * BM + bj * HALF + colb + 4); }
#pragma unroll
        for (int ai = 0; ai < 2; ++ai)
#pragma unroll
            for (int m = 0; m < 4; ++m) {
                const int r = rowb + ai * HALF + m * 16;
                const float ssum = __builtin_bit_cast(float, __hip_atomic_load((const unsigned*)(SSF + r), __ATOMIC_RELAXED, __HIP_MEMORY_SCOPE_AGENT));
                const float rs = 1.0f / sqrtf(ssum * (1.0f / 1024.0f) + 1e-5f);
#pragma unroll
                for (int bj = 0; bj < 2; ++bj) {
                    const unsigned off = lane_off + (unsigned)(ai * 131072 + m * 16384 + bj * 128);
                    *(f32x4*)(hb + off * 4u) = acc[ai][bj][m][0] * rs * gv[bj][0]; *(f32x4*)(hb + off * 4u + 16u) = acc[ai][bj][m][1] * rs * gv[bj][1];
                }
            }
    }
};
struct BatchOrder {
    int nU, per_g, Ge, ce;
    __host__ __device__ void init(int nU_, int per_g_, int G, int w0, int c) { nU = nU_; per_g = per_g_; Ge = G - w0; ce = c - w0; }
    __device__ bool next(int i, Unit& u) const {
        if (ce < 0) return false;
        const long L = (long)i * Ge + ce; if (L >= nU) return false;
        u.g = __builtin_amdgcn_readfirstlane((int)L / per_g); u.pm = __builtin_amdgcn_readfirstlane((int)L % per_g); u.pn = 0; u.par = i & 1; u.kh = 0; return true;
    }
    __device__ __forceinline__ void a_ready(const Unit&) const {}
    __device__ __forceinline__ void done(const Unit&) const {}
};
template <class Epi, class Sched, bool ALIGN_EPI = false, bool SP2 = false>
__device__ __forceinline__ void gemm_phase(PG8_LAS unsigned char* lds, const Gemm g, const Sched& S, const Epi& E) {
    const int tid = threadIdx.x, wid = __builtin_amdgcn_readfirstlane(tid >> 6), lane = tid & 63, wr = wid >> 2, wc = wid & 3, fr = lane & 15, fq = lane >> 4;
    const int K = g.K, nt = K / BK;
    unsigned voffA[2], voffB[2];
#pragma unroll
    for (int i = 0; i < 2; ++i) { int R, C; stage_rc(tid * 16 + i * 8192, R, C); const int Rb = Epi::PERM ? ((R & ~31) + perm32(R & 31)) : R;
        voffA[i] = (unsigned)(R * g.lda + C) * 2u; voffB[i] = (unsigned)(Rb * g.ldb + C) * 2u; }
    const size_t kstep = (size_t)(BK * 2);
    const size_t hstepA = (size_t)HALF * g.lda * 2, hstepB = (size_t)HALF * g.ldb * 2;
    const size_t tstepA = 2 * hstepA, tstepB = 2 * hstepB;
    const unsigned ldsw = (unsigned)wid * 1024u;
    const int aoff = lds_byte(wr * 64 + fr, fq * 8), boff = lds_byte(wc * 32 + fr, fq * 8);
#define PG8_SA(b, h) (((b) * 2 + (h)) * HTB)
#define PG8_SB(b, h) ((4 + (b) * 2 + (h)) * HTB)
#define PG8_STAGE(bufoff, gbase, voff) do { _Pragma("unroll") for (int _i = 0; _i < 2; ++_i) \
        __builtin_amdgcn_global_load_lds((const unsigned*)((const char*)(gbase) + (voff)[_i]), (PG8_LAS unsigned*)(lds + (bufoff) + ldsw + _i * 8192), 16, 0, 0); } while (0)
#define PG8_LDA(dst, b, h) do { _Pragma("unroll") for (int m = 0; m < 4; ++m) _Pragma("unroll") for (int k = 0; k < 2; ++k) dst[m][k] = *(const PG8_LAS bf16x8*)(lds + PG8_SA(b, h) + aoff + m * 2048 + k * 1024); } while (0)
#define PG8_LDB(dst, b, h) do { _Pragma("unroll") for (int n = 0; n < 2; ++n) _Pragma("unroll") for (int k = 0; k < 2; ++k) dst[n][k] = *(const PG8_LAS bf16x8*)(lds + PG8_SB(b, h) + boff + n * 2048 + k * 1024); } while (0)
#define PG8_MMA(ai, bj, At, Bt) do { __builtin_amdgcn_s_setprio(1); _Pragma("unroll") for (int m = 0; m < 4; ++m) _Pragma("unroll") for (int n = 0; n < 2; ++n) _Pragma("unroll") for (int k = 0; k < 2; ++k) \
        acc[ai][bj][m][n] = __builtin_amdgcn_mfma_f32_16x16x32_bf16(Bt[n][k], At[m][k], acc[ai][bj][m][n], 0, 0, 0); __builtin_amdgcn_s_setprio(0); } while (0)
#define PG8_WAIT_V(n) asm volatile("s_waitcnt vmcnt(" #n ")" ::: "memory")
#define PG8_WAIT_L(n) asm volatile("s_waitcnt lgkmcnt(" #n ")" ::: "memory")
#define PG8_BAR __builtin_amdgcn_s_barrier()
#define PG8_SCHED __builtin_amdgcn_sched_barrier(0)
    Unit cur, nxt; int ui = 0;
    if (!S.next(0, cur)) return;
    f32x4 acc[2][2][4][2];
#pragma unroll
    for (int a = 0; a < 2; ++a)
#pragma unroll
        for (int b = 0; b < 2; ++b)
#pragma unroll
            for (int m = 0; m < 4; ++m)
#pragma unroll
                for (int n = 0; n < 2; ++n) acc[a][b][m][n] = (f32x4){0.f, 0.f, 0.f, 0.f};
    bf16x8 At[4][2], B0[2][2], B1[2][2];
    const char* cA = (const char*)g.A + (size_t)cur.g * g.gsA + (size_t)cur.pm * tstepA + (size_t)cur.kh * g.khA; const char* cB = (const char*)g.Bt + (size_t)cur.g * g.gsB + (size_t)cur.pn * tstepB + (size_t)cur.kh * g.khB;
    S.a_ready(cur);
    if constexpr (SP2) {
        PG8_STAGE(PG8_SB(0, 0), cB, voffB); PG8_STAGE(PG8_SB(0, 1), cB + hstepB, voffB); PG8_STAGE(PG8_SA(0, 0), cA, voffA); PG8_STAGE(PG8_SA(0, 1), cA + hstepA, voffA);
        if (wr == 1) PG8_BAR;
        PG8_WAIT_V(2); PG8_BAR;
        PG8_STAGE(PG8_SB(1, 0), cB + kstep, voffB); PG8_STAGE(PG8_SA(1, 0), cA + kstep, voffA); PG8_STAGE(PG8_SB(1, 1), cB + hstepB + kstep, voffB);
        PG8_WAIT_V(6); PG8_BAR;
    } else {
        PG8_STAGE(PG8_SB(0, 0), cB, voffB); PG8_STAGE(PG8_SA(0, 0), cA, voffA); PG8_STAGE(PG8_SB(0, 1), cB + hstepB, voffB); PG8_STAGE(PG8_SA(0, 1), cA + hstepA, voffA);
        if (wr == 1) PG8_BAR;
        PG8_WAIT_V(4); PG8_BAR;
        PG8_STAGE(PG8_SB(1, 0), cB + kstep, voffB); PG8_STAGE(PG8_SA(1, 0), cA + kstep, voffA); PG8_STAGE(PG8_SB(1, 1), cB + hstepB + kstep, voffB);
        PG8_WAIT_V(6); PG8_BAR;
    }
    for (;;) {
        const bool has_next = S.next(ui + 1, nxt);
        const char* nA = has_next ? (const char*)g.A + (size_t)nxt.g * g.gsA + (size_t)nxt.pm * tstepA + (size_t)nxt.kh * g.khA : cA; const char* nB = has_next ? (const char*)g.Bt + (size_t)nxt.g * g.gsB + (size_t)nxt.pn * tstepB + (size_t)nxt.kh * g.khB : cB;
        for (int t = 0; t < nt; t += 2) {
            const bool last = (t == nt - 2);
            const char* a1 = cA + (size_t)(t + 1) * kstep;
            const char* a2 = last ? nA : cA + (size_t)(t + 2) * kstep; const char* b2 = last ? nB : cB + (size_t)(t + 2) * kstep;
            const char* a3 = a2 + kstep; const char* b3 = b2 + kstep;
            if (last && has_next) S.a_ready(nxt);
            if constexpr (SP2) {
            PG8_LDB(B0, 0, 0); PG8_LDB(B1, 0, 1); PG8_SCHED; PG8_LDA(At, 0, 0); PG8_STAGE(PG8_SA(1, 1), a1 + hstepA, voffA);
            PG8_WAIT_V(8); PG8_WAIT_L(0); PG8_BAR; PG8_MMA(0, 0, At, B0); PG8_MMA(0, 1, At, B1); PG8_BAR; PG8_SCHED;
            PG8_LDA(At, 0, 1); PG8_STAGE(PG8_SB(0, 0), b2, voffB); PG8_STAGE(PG8_SB(0, 1), b2 + hstepB, voffB); PG8_STAGE(PG8_SA(0, 0), a2, voffA);
            PG8_WAIT_V(8); PG8_WAIT_L(0); PG8_BAR; PG8_MMA(1, 0, At, B0); PG8_MMA(1, 1, At, B1); PG8_BAR; PG8_SCHED;
            PG8_LDB(B0, 1, 0); PG8_LDB(B1, 1, 1); PG8_SCHED; PG8_LDA(At, 1, 0); PG8_STAGE(PG8_SA(0, 1), a2 + hstepA, voffA);
            PG8_WAIT_V(8); PG8_WAIT_L(0); PG8_BAR; PG8_MMA(0, 0, At, B0); PG8_MMA(0, 1, At, B1); PG8_BAR; PG8_SCHED;
            PG8_LDA(At, 1, 1); PG8_STAGE(PG8_SB(1, 0), b3, voffB); PG8_STAGE(PG8_SB(1, 1), b3 + hstepB, voffB); PG8_STAGE(PG8_SA(1, 0), a3, voffA);
            PG8_WAIT_V(8); PG8_WAIT_L(0); PG8_BAR; PG8_MMA(1, 0, At, B0); PG8_MMA(1, 1, At, B1); PG8_BAR; PG8_SCHED;
            } else {
            PG8_LDB(B0, 0, 0); PG8_SCHED; PG8_LDA(At, 0, 0); PG8_STAGE(PG8_SA(1, 1), a1 + hstepA, voffA);
            PG8_WAIT_L(8); PG8_BAR; PG8_WAIT_L(0); PG8_MMA(0, 0, At, B0); PG8_BAR; PG8_SCHED;
            PG8_LDB(B1, 0, 1); PG8_STAGE(PG8_SB(0, 0), b2, voffB);
            PG8_BAR; PG8_WAIT_L(0); PG8_MMA(0, 1, At, B1); PG8_BAR;
            PG8_LDA(At, 0, 1); PG8_STAGE(PG8_SA(0, 0), a2, voffA);
            PG8_BAR; PG8_WAIT_L(0); PG8_MMA(1, 0, At, B0); PG8_BAR; PG8_SCHED;
            PG8_STAGE(PG8_SB(0, 1), b2 + hstepB, voffB);
            PG8_WAIT_V(6); PG8_BAR; PG8_MMA(1, 1, At, B1); PG8_BAR;
            PG8_LDB(B0, 1, 0); PG8_SCHED; PG8_LDA(At, 1, 0); PG8_STAGE(PG8_SA(0, 1), a2 + hstepA, voffA);
            PG8_WAIT_L(8); PG8_BAR; PG8_WAIT_L(0); PG8_MMA(0, 0, At, B0); PG8_BAR; PG8_SCHED;
            PG8_LDB(B1, 1, 1); PG8_STAGE(PG8_SB(1, 0), b3, voffB);
            PG8_BAR; PG8_WAIT_L(0); PG8_MMA(0, 1, At, B1); PG8_BAR;
            PG8_LDA(At, 1, 1); PG8_STAGE(PG8_SA(1, 0), a3, voffA);
            PG8_BAR; PG8_WAIT_L(0); PG8_MMA(1, 0, At, B0); PG8_BAR; PG8_SCHED;
            PG8_STAGE(PG8_SB(1, 1), b3 + hstepB, voffB);
            PG8_WAIT_V(6); PG8_BAR; PG8_MMA(1, 1, At, B1); PG8_BAR;
            }
        }
        if constexpr (ALIGN_EPI) { if (wr == 0) PG8_BAR; }
        bool keep = false;
        if constexpr (Epi::HAS_MID) { if (cur.kh == 0) { E.mid(acc, cur, wr, wc, fr, fq); keep = true; } }
        if (!keep) { if constexpr (!Epi::AFTER_DRAIN) { E(acc, cur, wr, wc, fr, fq); S.done(cur); } }
        if (!has_next) break;
        if (!keep)
#pragma unroll
        for (int a = 0; a < 2; ++a)
#pragma unroll
            for (int b = 0; b < 2; ++b)
#pragma unroll
                for (int m = 0; m < 4; ++m)
#pragma unroll
                    for (int n = 0; n < 2; ++n) acc[a][b][m][n] = (f32x4){0.f, 0.f, 0.f, 0.f};
        cur = nxt; cA = nA; cB = nB; ++ui;
        if constexpr (ALIGN_EPI) { if (wr == 1) PG8_BAR; }
    }
    PG8_WAIT_V(0);
    if constexpr (!ALIGN_EPI) { if (wr == 0) PG8_BAR; }
    PG8_BAR;
    if constexpr (Epi::AFTER_DRAIN) { E.fused(acc, cur, wr, wc, fr, fq, lds, wid, lane); S.done(cur); }
#undef PG8_SA
#undef PG8_SB
#undef PG8_STAGE
#undef PG8_LDA
#undef PG8_LDB
#undef PG8_MMA
#undef PG8_WAIT_V
#undef PG8_WAIT_L
#undef PG8_BAR
#undef PG8_SCHED
}
}

#include <hip/hip_cooperative_groups.h>
namespace cg = cooperative_groups;
typedef unsigned short bf16;
typedef unsigned v4u __attribute__((ext_vector_type(4)));
typedef unsigned v2u __attribute__((ext_vector_type(2)));
typedef float f32x4 __attribute__((ext_vector_type(4)));
typedef float f32x2 __attribute__((ext_vector_type(2)));
typedef short bf16x8 __attribute__((ext_vector_type(8)));

constexpr int NT = 512, NWAVES = 8;
constexpr int MR = 16384, MP = 16640;
constexpr int NIN = 3840;
constexpr int NQ = 65;
constexpr float EPS = 1e-5f;
constexpr size_t MiB = 1u << 20;
constexpr size_t WS_SS    = 0;
constexpr size_t WS_DEC   = 256 * 1024;
constexpr size_t WS_A1    = 288 * 1024;
constexpr size_t WS_A16   = 320 * 1024;
constexpr size_t WS_BAR   = 384 * 1024;
constexpr size_t WS_BBAR  = 512 * 1024;
constexpr size_t WS_UMETA = 1 * MiB;
constexpr size_t WS_DTRAW = 1 * MiB + 512 * 1024;
constexpr size_t WS_DT    = 2 * MiB + 640 * 1024;
constexpr size_t WS_ACS   = 254 * MiB + 512 * 1024;
static_assert(WS_DTRAW + 16640 * 16 * 4 <= WS_DT && WS_DT + 65 * 16 * 256 * 4 <= 4 * MiB && WS_ACS + 65 * 16 * 256 * 4 <= 256 * MiB, "smalls");
constexpr size_t WS_WGLU  = 4 * MiB;
constexpr size_t WS_TB5   = 8 * MiB;
constexpr size_t WS_TE5   = 20 * MiB;
constexpr size_t WS_WIN   = 28 * MiB;
constexpr size_t WS_PREV  = 20 * MiB;
constexpr size_t WS_WOUT  = 8 * MiB, WS_WUP = 12 * MiB, WS_WDN = 20 * MiB;
constexpr size_t WS_MIX   = 36 * MiB;
constexpr size_t WS_UA    = 100 * MiB;
constexpr size_t WS_XBCP  = 148 * MiB;
constexpr size_t WS_SEND  = 148 * MiB;
constexpr size_t WS_ST    = 180 * MiB;
constexpr size_t WS_Y5    = 148 * MiB;
constexpr size_t WS_XN    = 197 * MiB;
constexpr size_t WS_XF    = 197 * MiB;
constexpr size_t WS_H1B   = 197 * MiB;
constexpr size_t WS_CT    = 230 * MiB;
constexpr size_t WS_BTK   = WS_CT + 65 * 65536 * 2;
constexpr size_t WS_BF    = WS_BTK + 65 * 65536 * 2;
constexpr size_t WS_HB    = 36 * MiB;
static_assert(WS_BF + 65 * 65536 * 2 <= WS_ACS, "ws");
constexpr int LDS_BYTES = 155648;

__device__ __forceinline__ unsigned f2bf(float f) { unsigned u = __builtin_bit_cast(unsigned, f); return (u + 0x7fffu + ((u >> 16) & 1u)) >> 16; }
__device__ __forceinline__ unsigned pk2(float lo, float hi) { unsigned r; asm("v_cvt_pk_bf16_f32 %0, %1, %2" : "=v"(r) : "v"(lo), "v"(hi)); return r; }
__device__ __forceinline__ float bf2f(unsigned short h) { return __builtin_bit_cast(float, (unsigned)h << 16); }
__device__ __forceinline__ float bflo(unsigned w) { return __builtin_bit_cast(float, w << 16); }
__device__ __forceinline__ float bfhi(unsigned w) { return __builtin_bit_cast(float, w & 0xffff0000u); }
__device__ __forceinline__ float ex2(float x) { return __builtin_amdgcn_exp2f(x); }
__device__ __forceinline__ float expf_(float x) { return __builtin_amdgcn_exp2f(1.44269504f * x); }
__device__ __forceinline__ float wave_sum(float v) {
#pragma unroll
    for (int o = 1; o < 64; o <<= 1) v += __shfl_xor(v, o);
    return v;
}

#define LAS __attribute__((address_space(3)))
#define XB_TMO      128
#define XB_XCNT(j)  (256  + 64 * (j))
#define XB_XSUB(j)  (1280 + 64 * (j))
#define XB_XGEN(j)  (2304 + 64 * (j))
#define XB_TOP      3328
#define XB_TOPGEN   3392
#define XCD_BAR_WORDS 3456
#define XB_SPIN_CAP (1u << 18)

__device__ __forceinline__ unsigned xb_ld(unsigned* p)              { return __hip_atomic_load(p, __ATOMIC_RELAXED, __HIP_MEMORY_SCOPE_AGENT); }
__device__ __forceinline__ unsigned xb_add(unsigned* p, unsigned v) { return __hip_atomic_fetch_add(p, v, __ATOMIC_RELAXED, __HIP_MEMORY_SCOPE_AGENT); }
__device__ __forceinline__ unsigned xb_xcc_id() { return (unsigned)__builtin_amdgcn_s_getreg((3 << 11) | 20) & 0xFu; }
#define XB_SPIN(cond, bar) do { unsigned _sp = 0; while (cond) { __builtin_amdgcn_s_sleep(1); \
    if ((++_sp & 255u) == 0u) { if (xb_ld(&(bar)[XB_TMO])) break; if (_sp > XB_SPIN_CAP) { atomicAdd(&(bar)[XB_TMO], 1u); break; } } } } while (0)

struct XcdBarrier {
    unsigned* bar; unsigned x;
    volatile LAS unsigned* st;
};

__device__ __forceinline__ XcdBarrier xcd_barrier_post(unsigned* bar, volatile LAS unsigned* st) {
    XcdBarrier b; b.bar = bar; b.x = xb_xcc_id(); b.st = st;
    if (threadIdx.x == 0) (void)xb_add(&bar[XB_XCNT(b.x)], 1u);
    return b;
}
__device__ __forceinline__ void xcd_barrier_complete(unsigned* bar, unsigned x, unsigned& nloc, unsigned& nx) {
    const unsigned G = gridDim.x * gridDim.y * gridDim.z;
    unsigned sum, cnt, mine, sp = 0u;
    for (;;) {
        sum = 0u; cnt = 0u; mine = 0u;
#pragma unroll
        for (unsigned j = 0; j < 16; ++j) { const unsigned c = xb_ld(&bar[XB_XCNT(j)]); sum += c; cnt += (c > 0u) ? 1u : 0u; mine = (j == x) ? c : mine; }
        if (sum == G) break;
        __builtin_amdgcn_s_sleep(1);
        if ((++sp & 255u) == 0u) { if (xb_ld(&bar[XB_TMO])) break; if (sp > XB_SPIN_CAP) { atomicAdd(&bar[XB_TMO], 1u); break; } }
    }
    nloc = mine > 0u ? mine : 1u; nx = cnt > 0u ? cnt : 1u;
}

__device__ __forceinline__ void xcd_barrier(const XcdBarrier& b) {
    asm volatile("s_waitcnt vmcnt(0)" ::: "memory");
    __syncthreads();
    if (threadIdx.x == 0) {
        unsigned* bar = b.bar;
        __builtin_amdgcn_s_waitcnt(0);
        unsigned nloc = b.st[0], nx = b.st[1];
        if (nloc == 0u) { xcd_barrier_complete(bar, b.x, nloc, nx); b.st[0] = nloc; b.st[1] = nx; }
        const unsigned old = xb_add(&bar[XB_XSUB(b.x)], 1u);
        const unsigned gen = old / nloc;
        if (old + 1u == (gen + 1u) * nloc) {
            __builtin_amdgcn_fence(__ATOMIC_RELEASE, "agent");
            asm volatile("s_waitcnt vmcnt(0)" ::: "memory");
            const unsigned og = xb_add(&bar[XB_TOP], 1u);
            const unsigned tg = og / nx;
            if (og + 1u == (tg + 1u) * nx) xb_add(&bar[XB_TOPGEN], 1u);
            else XB_SPIN(xb_ld(&bar[XB_TOPGEN]) == tg, bar);
            __builtin_amdgcn_fence(__ATOMIC_ACQUIRE, "agent");
            xb_add(&bar[XB_XGEN(b.x)], 1u);
            asm volatile("s_waitcnt vmcnt(0)" ::: "memory");
        } else {
            XB_SPIN(xb_ld(&bar[XB_XGEN(b.x)]) == gen, bar);
            __builtin_amdgcn_fence(__ATOMIC_ACQUIRE, "agent");
            asm volatile("s_waitcnt vmcnt(0)" ::: "memory");
        }
    }
    __syncthreads();
}

struct Args {
    const float* in[26]; float* out; unsigned char* ws; int ph_lo, ph_hi;
};
enum { I_X = 0, I_META, I_GMIX, I_WIN, I_CONVW, I_CONVB, I_DTB, I_ALOG, I_DSSD, I_GSSD, I_LRE, I_LIM, I_LSTEP, I_BRE, I_BIM, I_CRE, I_CIM, I_DS5, I_WGLU, I_BGLU, I_GS5, I_WOUT, I_GMLP, I_WUP, I_WDN, I_GFIN };

template <int MODE> __device__ __forceinline__ int colmap(int j) {
    if (MODE == 1) { if (j < 2560) return j; if (j < 3584) return j + 16; if (j < 3600) return j - 1024; return -1; }
    if (MODE == 2) { const int pn = j >> 8, r = j & 255; return r < 128 ? pn * 128 + r : 1024 + pn * 128 + (r - 128); }
    return j;
}
template <int MODE> __device__ __forceinline__ void transpose_item(const float* W, int K, int N, bf16* WT, const float* ks0, const float* ks1, float* scr, int item, int nblk, int lane) {
    const int kb = item / nblk, nb = item % nblk, k0 = 64 * kb, n0 = 32 * nb;
    const int src = colmap<MODE>(n0 + (lane & 31));
#pragma unroll
    for (int i = 0; i < 32; ++i) { const int kk = 2 * i + (lane >> 5); const int k = k0 + kk;
        float v = src >= 0 ? W[(size_t)k * N + src] : 0.f;
        if (ks0) v *= (k < 1024 ? ks0[k] : ks1[k - 1024]);
        scr[kk * 33 + (lane & 31)] = v; }
    asm volatile("s_waitcnt lgkmcnt(0)" ::: "memory");
    const int c = lane & 7;
#pragma unroll
    for (int j = 0; j < 4; ++j) { const int n = (lane >> 3) + 8 * j; const float* s = scr + (8 * c) * 33 + n;
        v4u o; o.x = pk2(s[0 * 33], s[1 * 33]); o.y = pk2(s[2 * 33], s[3 * 33]); o.z = pk2(s[4 * 33], s[5 * 33]); o.w = pk2(s[6 * 33], s[7 * 33]);
        *(v4u*)(WT + (size_t)(n0 + n) * K + k0 + 8 * c) = o; }
    asm volatile("s_waitcnt lgkmcnt(0)" ::: "memory");
}

__device__ __forceinline__ void sincos_d(double th, float& sn, float& cs) {
    const double k = rint(th * 0.15915494309189535); const double r = fma(-k, 6.283185307179586, th);
    const double t = r * 0.125, t2 = t * t;
    double s = t * (1.0 + t2 * (-1.0 / 6 + t2 * (1.0 / 120 + t2 * (-1.0 / 5040 + t2 * (1.0 / 362880 + t2 * (-1.0 / 39916800))))));
    double c = 1.0 + t2 * (-0.5 + t2 * (1.0 / 24 + t2 * (-1.0 / 720 + t2 * (1.0 / 40320 + t2 * (-1.0 / 3628800 + t2 * (1.0 / 479001600))))));
#pragma unroll
    for (int i = 0; i < 3; ++i) { const double s2 = 2.0 * s * c, c2 = 1.0 - 2.0 * s * s; s = s2; c = c2; }
    sn = (float)s; cs = (float)c;
}

__device__ __forceinline__ void s5_tables(const Args& a, int g, unsigned char* lds, int tid) {
    f32x2* pw = (f32x2*)lds;
    f32x2* Cc = pw + 17 * 64;
    f32x2* Bb = Cc + 16 * 64;
    float* Kt = (float*)(Bb + 64 * 16);
    unsigned char* ws = a.ws;
    if (tid < 64) {
        const int p = tid; const float lr = a.in[I_LRE][g * 64 + p], li = a.in[I_LIM][g * 64 + p]; const float st = expf(a.in[I_LSTEP][g]);
        float are = 1.f, aim = 0.f;
        for (int tau = 0; tau <= 16; ++tau) {
            const float mag = expf(lr * st * (float)tau); float sn, cs; sincos_d((double)li * (double)st * (double)tau, sn, cs);
            pw[tau * 64 + p] = (f32x2){mag * cs, mag * sn};
            if (tau == 1) { are = mag * cs; aim = mag * sn; ((f32x2*)(ws + WS_A1))[g * 64 + p] = (f32x2){are, aim}; }
            if (tau == 16) ((f32x2*)(ws + WS_A16))[g * 64 + p] = (f32x2){mag * cs, mag * sn};
        }
        const float den = lr * lr + li * li;
        const float cre = ((are - 1.0f) * lr + aim * li) / den, cim = (aim * lr - (are - 1.0f) * li) / den;
        f32x4 brv[4], biv[4];
#pragma unroll
        for (int h4 = 0; h4 < 4; ++h4) { brv[h4] = *(const f32x4*)(a.in[I_BRE] + (g * 64 + p) * 16 + 4 * h4); biv[h4] = *(const f32x4*)(a.in[I_BIM] + (g * 64 + p) * 16 + 4 * h4); }
#pragma unroll
        for (int h = 0; h < 16; ++h) { const float br = brv[h >> 2][h & 3], bi = biv[h >> 2][h & 3];
            const f32x2 v = (f32x2){cre * br - cim * bi, cre * bi + cim * br}; Bb[p * 16 + h] = v; ((f32x2*)(ws + WS_BBAR))[(g * 64 + p) * 16 + h] = v; }
    }
    for (int e = tid; e < 1024; e += NT) Cc[e] = (f32x2){a.in[I_CRE][g * 1024 + e], a.in[I_CIM][g * 1024 + e]};
    __syncthreads();
    {
        const int tau = tid >> 5, h = (tid >> 1) & 15, h0 = (tid & 1) * 8; float acc[8];
#pragma unroll
        for (int j = 0; j < 8; ++j) acc[j] = 0.f;
        for (int p = 0; p < 64; ++p) { const f32x2 c = Cc[h * 64 + p], w = pw[tau * 64 + p]; const float tr = c.x * w.x - c.y * w.y, ti = c.x * w.y + c.y * w.x;
#pragma unroll
            for (int j = 0; j < 8; ++j) { const f32x2 b = Bb[p * 16 + h0 + j]; acc[j] += tr * b.x - ti * b.y; } }
        if (tau == 0) {
#pragma unroll
            for (int j = 0; j < 8; ++j) if (h0 + j == h) acc[j] += a.in[I_DS5][g * 16 + h];
        }
#pragma unroll
        for (int j = 0; j < 8; ++j) Kt[(tau * 16 + h) * 16 + h0 + j] = acc[j];
    }
    __syncthreads();
    bf16* TB = (bf16*)(ws + WS_TB5) + (size_t)g * 256 * 384;
    for (int pc = tid; pc < 256 * 48; pc += NT) {
        const int row = pc / 48, c8 = (pc % 48) * 8, t = row >> 4, h = row & 15; float v[8];
        if (c8 < 256) { const int s = c8 >> 4, h0 = c8 & 15;
#pragma unroll
            for (int j = 0; j < 8; ++j) v[j] = s <= t ? Kt[((t - s) * 16 + h) * 16 + h0 + j] : 0.f;
        } else { const int p0 = (c8 - 256) >> 1;
#pragma unroll
            for (int j = 0; j < 4; ++j) { const f32x2 c = Cc[h * 64 + p0 + j], w = pw[(t + 1) * 64 + p0 + j]; v[2 * j] = c.x * w.x - c.y * w.y; v[2 * j + 1] = -(c.x * w.y + c.y * w.x); }
        }
        v4u o; o.x = pk2(v[0], v[1]); o.y = pk2(v[2], v[3]); o.z = pk2(v[4], v[5]); o.w = pk2(v[6], v[7]);
        *(v4u*)(TB + (size_t)row * 384 + c8) = o;
    }
    bf16* TE = (bf16*)(ws + WS_TE5) + (size_t)g * 256 * 256;
    for (int pc = tid; pc < 256 * 32; pc += NT) {
        const int row = pc >> 5, c8 = (pc & 31) * 8; float v[8];
        if (row < 128) { const int p = row >> 1, ri = row & 1, s = c8 >> 4, h0 = c8 & 15; const f32x2 w = pw[(15 - s) * 64 + p];
#pragma unroll
            for (int j = 0; j < 8; ++j) { const f32x2 b = Bb[p * 16 + h0 + j]; v[j] = ri ? (w.x * b.y + w.y * b.x) : (w.x * b.x - w.y * b.y); }
        } else {
#pragma unroll
            for (int j = 0; j < 8; ++j) v[j] = 0.f;
        }
        v4u o; o.x = pk2(v[0], v[1]); o.y = pk2(v[2], v[3]); o.z = pk2(v[4], v[5]); o.w = pk2(v[6], v[7]);
        *(v4u*)(TE + (size_t)row * 256 + c8) = o;
    }
    __syncthreads();
}

__device__ __forceinline__ void rms_row_to_bf16(const float* xrow, const float* gain, bf16* orow, int lane) {
    unsigned long long* o8 = (unsigned long long*)orow + lane;
    if (!xrow) {
#pragma unroll
        for (int j = 0; j < 4; ++j) o8[64 * j] = 0ull;
        return; }
    const f32x4* xr = (const f32x4*)xrow + lane; const f32x4* gr = (const f32x4*)gain + lane;
    f32x4 v[4]; float s = 0.f;
#pragma unroll
    for (int j = 0; j < 4; ++j) { v[j] = xr[64 * j]; s += (v[j].x * v[j].x + v[j].y * v[j].y) + (v[j].z * v[j].z + v[j].w * v[j].w); }
    const float rstd = 1.f / sqrtf(wave_sum(s) * (1.f / 1024.f) + EPS);
#pragma unroll
    for (int j = 0; j < 4; ++j) { const f32x4 gg = gr[64 * j]; const f32x4 w = v[j] * rstd * gg; o8[64 * j] = (unsigned long long)pk2(w.x, w.y) | ((unsigned long long)pk2(w.z, w.w) << 32); }
}

__device__ __forceinline__ void p0_prologue(const Args& a, unsigned char* lds, int tid, int G) {
    unsigned char* ws = a.ws; const int lane = tid & 63, wave = tid >> 6;
    const int gw = blockIdx.x * NWAVES + wave, NGW = G * NWAVES;
    for (int i = blockIdx.x * NT + tid; i < 4 * 16384; i += G * NT) ((float*)(ws + WS_SS))[i] = 0.f;
    for (int g = (G - 1 - (int)blockIdx.x); g < 64; g += G) s5_tables(a, g, lds, tid);
    __syncthreads();
    float* scr = (float*)(lds + wave * 16384);
    constexpr int NB_IN = NIN / 32, NB_GL = 2048 / 32;
    constexpr int I_IN = 16 * NB_IN, I_GL = 16 * NB_GL;
    const int nT = (G > 128) ? G - 64 : G;
    if ((int)blockIdx.x < nT) for (int it = gw; it < I_IN + I_GL; it += nT * NWAVES) {
        if (it < I_IN) transpose_item<1>(a.in[I_WIN], 1024, 3600, (bf16*)(ws + WS_WIN), nullptr, nullptr, scr, it, NB_IN, lane);
        else transpose_item<2>(a.in[I_WGLU], 1024, 2048, (bf16*)(ws + WS_WGLU), nullptr, nullptr, scr, it - I_IN, NB_GL, lane);
    }
    for (int m = gw; m < MP; m += NGW) {
        const float* src = m < MR ? a.in[I_X] + (size_t)m * 1024 : (m < MR + 16 ? a.in[I_META] + (size_t)(m - MR) * 1024 : nullptr);
        rms_row_to_bf16(src, a.in[I_GMIX], (bf16*)(ws + WS_XN) + (size_t)m * 1024, lane);
    }
}
__device__ __forceinline__ void p6_weights(const Args& a, unsigned char* lds, int tid, int G) {
    unsigned char* ws = a.ws; const int lane = tid & 63, wave = tid >> 6;
    const int gw = blockIdx.x * NWAVES + wave, NGW = G * NWAVES;
    float* scr = (float*)(lds + wave * 16384);
    constexpr int I_O = 32 * 32, I_U = 16 * 128, I_D = 64 * 32;
    for (int it = gw; it < I_O + I_U + I_D; it += NGW) {
        if (it < I_O) transpose_item<0>(a.in[I_WOUT], 2048, 1024, (bf16*)(ws + WS_WOUT), a.in[I_GSSD], a.in[I_GS5], scr, it, 32, lane);
        else if (it < I_O + I_U) transpose_item<0>(a.in[I_WUP], 1024, 4096, (bf16*)(ws + WS_WUP), a.in[I_GMLP], a.in[I_GMLP], scr, it - I_O, 128, lane);
        else transpose_item<0>(a.in[I_WDN], 4096, 1024, (bf16*)(ws + WS_WDN), nullptr, nullptr, scr, it - I_O - I_U, 32, lane);
    }
    __syncthreads();
}

__device__ __forceinline__ int chunk_row(int q, int tok) {
    if (q == 0) return tok < 240 ? -1 : MR + (tok - 240);
    const int b = (q - 1) >> 5, c = (q - 1) & 31;
    if (tok < 0 && c == 0) return MR + 16 + tok;
    return b * 8192 + c * 256 + tok;
}
__device__ __forceinline__ float silu_(float x) { return x * __builtin_amdgcn_rcpf(1.0f + ex2(-1.44269504f * x)); }
__device__ __forceinline__ void p2_conv_unit(const Args& a, int q, int blk, unsigned char* lds, int tid) {
    unsigned char* ws = a.ws;
    bf16* IN = (bf16*)lds;
    bf16* OT = (bf16*)(lds + 40960);
    const bf16* XBCP = (const bf16*)(ws + WS_XBCP);
    const int ch0 = blk * 64;
    for (int pc = tid; pc < 259 * 8; pc += NT) { const int rr = pc >> 3, c8 = (pc & 7) * 8; const int row = chunk_row(q, rr - 3);
        v4u v = (v4u){0u, 0u, 0u, 0u}; if (row >= 0) v = *(const v4u*)(XBCP + (size_t)row * 1536 + ch0 + c8);
        *(v4u*)(IN + rr * 64 + c8) = v; }
    __syncthreads();
    const float* cw = a.in[I_CONVW]; const float* cb = a.in[I_CONVB];
    const bool is_x = blk < 16, is_b = blk >= 16 && blk < 20;
    if (!is_x) {
        bf16* dst = (bf16*)(ws + (is_b ? WS_BTK : WS_CT)) + (size_t)q * 65536 + (is_b ? (blk - 16) : (blk - 20)) * 64;
        for (int pc = tid; pc < 256 * 8; pc += NT) { const int tok = pc >> 3, c8 = (pc & 7) * 8; float o[8];
            const bool zero = (q == 0 && tok < 240);
#pragma unroll
            for (int j = 0; j < 8; ++j) o[j] = cb[ch0 + c8 + j];
#pragma unroll
            for (int k = 0; k < 4; ++k) { const v4u v = *(const v4u*)(IN + (tok + k) * 64 + c8); const unsigned w[4] = {v.x, v.y, v.z, v.w};
#pragma unroll
                for (int j = 0; j < 4; ++j) { o[2 * j] += cw[k * 1536 + ch0 + c8 + 2 * j] * bflo(w[j]); o[2 * j + 1] += cw[k * 1536 + ch0 + c8 + 2 * j + 1] * bfhi(w[j]); } }
#pragma unroll
            for (int j = 0; j < 8; ++j) o[j] = zero ? 0.f : silu_(o[j]);
            v4u ov; ov.x = pk2(o[0], o[1]); ov.y = pk2(o[2], o[3]); ov.z = pk2(o[4], o[5]); ov.w = pk2(o[6], o[7]);
            *(v4u*)(dst + (size_t)tok * 256 + c8) = ov; }
    }
    if (is_x || is_b) {
        for (int it = tid; it < 64 * 32; it += NT) { const int ch = it & 63, t0 = (it >> 6) * 8; float wk[4], in[11], o[8]; const float bias = cb[ch0 + ch];
#pragma unroll
            for (int k = 0; k < 4; ++k) wk[k] = cw[k * 1536 + ch0 + ch];
#pragma unroll
            for (int j = 0; j < 11; ++j) in[j] = bf2f(IN[(t0 + j) * 64 + ch]);
#pragma unroll
            for (int j = 0; j < 8; ++j) { const float v = bias + wk[0] * in[j] + wk[1] * in[j + 1] + wk[2] * in[j + 2] + wk[3] * in[j + 3]; o[j] = (q == 0 && t0 + j < 240) ? 0.f : silu_(v); }
            v4u ov; ov.x = pk2(o[0], o[1]); ov.y = pk2(o[2], o[3]); ov.z = pk2(o[4], o[5]); ov.w = pk2(o[6], o[7]);
            *(v4u*)(OT + ch * 264 + t0) = ov; }
        __syncthreads();
        bf16* dst = is_x ? (bf16*)(ws + WS_XF) + ((size_t)q * 1024 + ch0) * 256 : (bf16*)(ws + WS_BF) + ((size_t)q * 256 + (blk - 16) * 64) * 256;
        for (int pc = tid; pc < 64 * 32; pc += NT) { const int ch = pc >> 5, t8 = (pc & 31) * 8; *(v4u*)(dst + (size_t)ch * 256 + t8) = *(const v4u*)(OT + ch * 264 + t8); }
    }
    __syncthreads();
}
__device__ __forceinline__ void p2_dt_item(const Args& a, int q, int h, int lane) {
    unsigned char* ws = a.ws; const float* DTRAW = (const float*)(ws + WS_DTRAW);
    const float bias = a.in[I_DTB][h], A = -expf(a.in[I_ALOG][h]);
    float dt[4], cs[4]; float run = 0.f;
#pragma unroll
    for (int j = 0; j < 4; ++j) { const int tok = 4 * lane + j; const int row = chunk_row(q, tok);
        float d = 0.f; if (row >= 0) { const float x = DTRAW[(size_t)row * 16 + h] + bias; d = fmaxf(x, 0.f) + __logf(1.0f + expf_(-fabsf(x))); }
        dt[j] = d; run += d * A; cs[j] = run; }
    float incl = run;
#pragma unroll
    for (int o = 1; o < 64; o <<= 1) { const float t = __shfl_up(incl, o); if (lane >= o) incl += t; }
    const float excl = incl - run;
    float* DT = (float*)(ws + WS_DT) + ((size_t)q * 16 + h) * 256 + 4 * lane; float* ACS = (float*)(ws + WS_ACS) + ((size_t)q * 16 + h) * 256 + 4 * lane;
    *(f32x4*)DT = (f32x4){dt[0], dt[1], dt[2], dt[3]}; *(f32x4*)ACS = (f32x4){cs[0] + excl, cs[1] + excl, cs[2] + excl, cs[3] + excl};
    if (lane == 63) ((float*)(ws + WS_DEC))[q * 16 + h] = expf_(cs[3] + excl);
}

#define MFMA16(A, B, C) __builtin_amdgcn_mfma_f32_16x16x32_bf16(A, B, C, 0, 0, 0)
__device__ __forceinline__ void p3_states_unit(const Args& a, int q, int g, int tid) {
    unsigned char* ws = a.ws; const int lane = tid & 63, r = tid >> 6, h = g * 8 + r, fr = lane & 15, fq = lane >> 4;
    const bf16* XF = (const bf16*)(ws + WS_XF) + ((size_t)q * 1024 + h * 64) * 256;
    const bf16* BF = (const bf16*)(ws + WS_BF) + ((size_t)q * 256 + g * 128) * 256;
    const float* DT = (const float*)(ws + WS_DT) + ((size_t)q * 16 + h) * 256; const float* ACS = (const float*)(ws + WS_ACS) + ((size_t)q * 16 + h) * 256;
    const float alast = ACS[255];
    bf16* ST = (bf16*)(ws + WS_ST) + ((size_t)q * 16 + h) * 8192;
#pragma unroll 1
    for (int nh = 0; nh < 2; ++nh) {
        f32x4 acc[4][4];
#pragma unroll
        for (int i = 0; i < 4; ++i)
#pragma unroll
            for (int j = 0; j < 4; ++j) acc[i][j] = (f32x4){0.f, 0.f, 0.f, 0.f};
#pragma unroll 2
        for (int kb = 0; kb < 8; ++kb) {
            const int s0 = kb * 32 + fq * 8;
            float w[8];
            { const f32x4 d0 = *(const f32x4*)(DT + s0), d1 = *(const f32x4*)(DT + s0 + 4), c0 = *(const f32x4*)(ACS + s0), c1 = *(const f32x4*)(ACS + s0 + 4);
#pragma unroll
              for (int j = 0; j < 4; ++j) { w[j] = expf_(alast - c0[j]) * d0[j]; w[4 + j] = expf_(alast - c1[j]) * d1[j]; } }
            bf16x8 Af[4], Bf[4];
#pragma unroll
            for (int i = 0; i < 4; ++i) { const v4u v = *(const v4u*)(XF + (size_t)(i * 16 + fr) * 256 + s0);
                v4u o; o.x = pk2(bflo(v.x) * w[0], bfhi(v.x) * w[1]); o.y = pk2(bflo(v.y) * w[2], bfhi(v.y) * w[3]); o.z = pk2(bflo(v.z) * w[4], bfhi(v.z) * w[5]); o.w = pk2(bflo(v.w) * w[6], bfhi(v.w) * w[7]);
                Af[i] = __builtin_bit_cast(bf16x8, o); }
#pragma unroll
            for (int j = 0; j < 4; ++j) Bf[j] = *(const bf16x8*)(BF + (size_t)((nh * 4 + j) * 16 + fr) * 256 + s0);
#pragma unroll
            for (int i = 0; i < 4; ++i)
#pragma unroll
                for (int j = 0; j < 4; ++j) acc[i][j] = MFMA16(Bf[j], Af[i], acc[i][j]);
        }
#pragma unroll
        for (int i = 0; i < 4; ++i)
#pragma unroll
            for (int j = 0; j < 4; ++j) { v2u o; o.x = pk2(acc[i][j][0], acc[i][j][1]); o.y = pk2(acc[i][j][2], acc[i][j][3]);
                *(v2u*)(ST + (i * 16 + fr) * 128 + (nh * 4 + j) * 16 + fq * 4) = o; }
    }
}

__device__ __forceinline__ void p4_ssd_scan_item(const Args& a, int item, int tid) {
    unsigned char* ws = a.ws; const int e = item * 2048 + tid * 4;
    const int b = e >> 17, hpn = e & 131071, h = hpn >> 13;
    const bf16* ST = (const bf16*)(ws + WS_ST); bf16* PREV = (bf16*)(ws + WS_PREV); const float* DEC = (const float*)(ws + WS_DEC);
    v2u st[32]; float dec[32];
    st[0] = *(const v2u*)(ST + hpn); dec[0] = 0.f;
#pragma unroll
    for (int k = 1; k < 32; ++k) { const int q = b * 32 + k; st[k] = *(const v2u*)(ST + (size_t)q * 131072 + hpn); dec[k] = DEC[q * 16 + h]; }
    float s0 = bflo(st[0].x), s1 = bfhi(st[0].x), s2 = bflo(st[0].y), s3 = bfhi(st[0].y);
#pragma unroll
    for (int c = 0; c < 32; ++c) {
        v2u o; o.x = pk2(s0, s1); o.y = pk2(s2, s3); *(v2u*)(PREV + (size_t)(b * 32 + c) * 131072 + hpn) = o;
        if (c < 31) { const float d = dec[c + 1]; const v2u v = st[c + 1];
            s0 = s0 * d + bflo(v.x); s1 = s1 * d + bfhi(v.x); s2 = s2 * d + bflo(v.y); s3 = s3 * d + bfhi(v.y); }
    }
}
__device__ __forceinline__ void p4_s5_scan_item(const Args& a, int item, unsigned char* lds, int tid) {
    unsigned char* ws = a.ws; const int b = item >> 7, g = (item >> 1) & 63, p = (item & 1) * 32 + (tid & 31), seg = tid >> 5;
    const f32x2 a1 = ((const f32x2*)(ws + WS_A1))[g * 64 + p], a16 = ((const f32x2*)(ws + WS_A16))[g * 64 + p];
    const f32x2* Bb = (const f32x2*)(ws + WS_BBAR) + (size_t)(g * 64 + p) * 16;
    const bf16* UM = (const bf16*)(ws + WS_UMETA);
    const f32x2* SE = (const f32x2*)(ws + WS_SEND) + ((size_t)(g * 1024 + b * 512 + seg * 32) * 64 + p);
    f32x2 se[32];
#pragma unroll
    for (int j = 0; j < 32; ++j) se[j] = SE[(size_t)j * 64];
    float sr = 0.f, si = 0.f;
    f32x2 bbv[16];
#pragma unroll
    for (int h = 0; h < 16; ++h) bbv[h] = Bb[h];
    for (int s = 0; s < 16; ++s) { float br = 0.f, bi = 0.f;
        const v4u u0 = *(const v4u*)(UM + s * 1024 + g * 16), u1 = *(const v4u*)(UM + s * 1024 + g * 16 + 8); const unsigned uw[8] = {u0.x, u0.y, u0.z, u0.w, u1.x, u1.y, u1.z, u1.w};
#pragma unroll
        for (int h = 0; h < 16; ++h) { const float u = (h & 1) ? bfhi(uw[h >> 1]) : bflo(uw[h >> 1]); const f32x2 bb = bbv[h]; br += bb.x * u; bi += bb.y * u; }
        const float nr = a1.x * sr - a1.y * si + br, ni = a1.x * si + a1.y * sr + bi; sr = nr; si = ni; }
    float er = 0.f, ei = 0.f;
#pragma unroll
    for (int j = 0; j < 32; ++j) { const float nr = a16.x * er - a16.y * ei + se[j].x, ni = a16.x * ei + a16.y * er + se[j].y; er = nr; ei = ni; }
    f32x2* EL = (f32x2*)lds;
    EL[seg * 32 + (tid & 31)] = (f32x2){er, ei};
    float pr = a16.x, pi = a16.y;
#pragma unroll
    for (int k = 0; k < 5; ++k) { const float nr = pr * pr - pi * pi, ni = 2.f * pr * pi; pr = nr; pi = ni; }
    __syncthreads();
    for (int k = 0; k < seg; ++k) { const f32x2 ek = EL[k * 32 + (tid & 31)]; const float nr = pr * sr - pi * si + ek.x, ni = pr * si + pi * sr + ek.y; sr = nr; si = ni; }
    unsigned* UA = (unsigned*)((bf16*)(ws + WS_UA) + ((size_t)(g * 1024 + b * 512 + seg * 32) * 384 + 256 + 2 * p));
#pragma unroll
    for (int j = 0; j < 32; ++j) { UA[(size_t)j * 192] = pk2(sr, si);
        const float nr = a16.x * sr - a16.y * si + se[j].x, ni = a16.x * si + a16.y * sr + se[j].y; sr = nr; si = ni; }
    __syncthreads();
}

__device__ __forceinline__ void p5_ssd_out_unit(const Args& a, int q, int g, int half, unsigned char* lds, int tid) {
    unsigned char* ws = a.ws; const int lane = tid & 63, r = tid >> 6, h = g * 8 + r, fr = lane & 15, fq = lane >> 4;
    bf16* CBs = (bf16*)lds;
    float* ACSs = (float*)(lds + 256 * 264 * 2);
    float* DTs = ACSs + 8 * 256;
    const bf16* CT = (const bf16*)(ws + WS_CT) + (size_t)q * 65536 + g * 128;
    const bf16* BTK = (const bf16*)(ws + WS_BTK) + (size_t)q * 65536 + g * 128;
    for (int i = tid; i < 2048; i += NT) { ACSs[i] = ((const float*)(ws + WS_ACS))[((size_t)q * 16 + g * 8) * 256 + i]; DTs[i] = ((const float*)(ws + WS_DT))[((size_t)q * 16 + g * 8) * 256 + i]; }
    {
        int cnt = 0;
#pragma unroll 1
        for (int ti = 0; ti < 8; ++ti) {
            const int lt = half ? 4 + ti : (ti < 4 ? ti : 8 + ti);
#pragma unroll 1
            for (int stl = 0; stl <= lt; ++stl, ++cnt) {
                if ((cnt & 7) != r) continue;
                f32x4 c = (f32x4){0.f, 0.f, 0.f, 0.f};
#pragma unroll
                for (int k = 0; k < 4; ++k) { const bf16x8 Af = *(const bf16x8*)(CT + (size_t)(lt * 16 + fr) * 256 + k * 32 + fq * 8);
                    const bf16x8 Bf = *(const bf16x8*)(BTK + (size_t)(stl * 16 + fr) * 256 + k * 32 + fq * 8); c = MFMA16(Af, Bf, c); }
#pragma unroll
                for (int e = 0; e < 4; ++e) CBs[(lt * 16 + fq * 4 + e) * 264 + stl * 16 + fr] = (bf16)f2bf(c[e]);
            }
        }
    }
    __syncthreads();
    const bf16* XF = (const bf16*)(ws + WS_XF) + ((size_t)q * 1024 + h * 64) * 256;
    const bf16* PREV = (const bf16*)(ws + WS_PREV) + ((size_t)(q - 1) * 16 + h) * 8192;
    const float* acs = ACSs + r * 256; const float* dts = DTs + r * 256;
    const float dsk = a.in[I_DSSD][h];
    const int b = (q - 1) >> 5, c = (q - 1) & 31; const int m0 = b * 8192 + c * 256;
    bf16* MIX = (bf16*)(ws + WS_MIX); float* SSS = (float*)(ws + WS_SS);
#pragma unroll 1
    for (int lbi = 0; lbi < 2; ++lbi) {
        const int lb = half ? 1 + lbi : 3 * lbi;
        f32x4 acc[4][4];
#pragma unroll
        for (int i = 0; i < 4; ++i)
#pragma unroll
            for (int j = 0; j < 4; ++j) acc[i][j] = (f32x4){0.f, 0.f, 0.f, 0.f};
#pragma unroll 1
        for (int k = 0; k < 4; ++k) { bf16x8 Af[4], Bf[4];
#pragma unroll
            for (int i = 0; i < 4; ++i) Af[i] = *(const bf16x8*)(CT + (size_t)(lb * 64 + i * 16 + fr) * 256 + k * 32 + fq * 8);
#pragma unroll
            for (int j = 0; j < 4; ++j) Bf[j] = *(const bf16x8*)(PREV + (size_t)(j * 16 + fr) * 128 + k * 32 + fq * 8);
#pragma unroll
            for (int i = 0; i < 4; ++i)
#pragma unroll
                for (int j = 0; j < 4; ++j) acc[i][j] = MFMA16(Bf[j], Af[i], acc[i][j]); }
#pragma unroll
        for (int i = 0; i < 4; ++i) { const float sc = expf_(acs[lb * 64 + i * 16 + fr]);
#pragma unroll
            for (int j = 0; j < 4; ++j) acc[i][j] *= sc; }
        const int nsb = 2 * lb + 2;
#pragma unroll 1
        for (int sb = 0; sb < nsb; ++sb) {
            const int s0 = sb * 32 + fq * 8;
            bf16x8 Bf[4];
#pragma unroll
            for (int j = 0; j < 4; ++j) Bf[j] = *(const bf16x8*)(XF + (size_t)(j * 16 + fr) * 256 + s0);
            float as[8], ds[8];
#pragma unroll
            for (int j = 0; j < 8; ++j) { as[j] = acs[s0 + j]; ds[j] = dts[s0 + j]; }
#pragma unroll
            for (int i = 0; i < 4; ++i) {
                const int l = lb * 64 + i * 16 + fr;
                if (sb * 32 > lb * 64 + i * 16 + 15) continue;
                const float al = acs[l];
                const v4u v = *(const v4u*)(CBs + l * 264 + s0); const unsigned w4[4] = {v.x, v.y, v.z, v.w}; float pv[8];
#pragma unroll
                for (int j = 0; j < 4; ++j) {
                    const float p0 = bflo(w4[j]) * expf_(fminf(al - as[2 * j], 0.f)) * ds[2 * j], p1 = bfhi(w4[j]) * expf_(fminf(al - as[2 * j + 1], 0.f)) * ds[2 * j + 1];
                    const int sa = s0 + 2 * j, sbq = sa + 1;
                    pv[2 * j] = (sa < l) ? p0 : (sa == l ? p0 + dsk : 0.f); pv[2 * j + 1] = (sbq < l) ? p1 : (sbq == l ? p1 + dsk : 0.f); }
                v4u o; o.x = pk2(pv[0], pv[1]); o.y = pk2(pv[2], pv[3]); o.z = pk2(pv[4], pv[5]); o.w = pk2(pv[6], pv[7]);
                const bf16x8 Af = __builtin_bit_cast(bf16x8, o);
#pragma unroll
                for (int j = 0; j < 4; ++j) acc[i][j] = MFMA16(Bf[j], Af, acc[i][j]);
            }
        }
#pragma unroll
        for (int i = 0; i < 4; ++i) {
            const int l = lb * 64 + i * 16 + fr; float ssq = 0.f;
            bf16* zrow = MIX + (size_t)(m0 + l) * 2048 + h * 64 + fq * 4;
#pragma unroll
            for (int j = 0; j < 4; ++j) {
                const v2u zv = *(const v2u*)(zrow + j * 16);
                const float y0 = acc[i][j][0] * silu_(bflo(zv.x)), y1 = acc[i][j][1] * silu_(bfhi(zv.x)), y2 = acc[i][j][2] * silu_(bflo(zv.y)), y3 = acc[i][j][3] * silu_(bfhi(zv.y));
                v2u o; o.x = pk2(y0, y1); o.y = pk2(y2, y3); *(v2u*)(zrow + j * 16) = o;
                ssq += (y0 * y0 + y1 * y1) + (y2 * y2 + y3 * y3);
            }
            ssq += __shfl_xor(ssq, 16); ssq += __shfl_xor(ssq, 32);
            if (fq == 0) atomicAdd(SSS + m0 + l, ssq);
        }
    }
    __syncthreads();
}

__device__ __forceinline__ void p10_final(const Args& a, int tid, int G) {
    const int lane = tid & 63, wave = tid >> 6; const int gw = blockIdx.x * NWAVES + wave, NGW = G * NWAVES;
    const float* SSF = (const float*)(a.ws + WS_SS) + 3 * 16384; const f32x4* gf = (const f32x4*)a.in[I_GFIN] + lane;
    for (int m = gw; m < MR; m += NGW) { f32x4* row = (f32x4*)(a.out + (size_t)m * 1024) + lane; const float rs = 1.0f / sqrtf(SSF[m] * (1.0f / 1024.0f) + EPS);
#pragma unroll
        for (int j = 0; j < 4; ++j) row[64 * j] = row[64 * j] * rs * gf[64 * j]; }
}

__global__ void __launch_bounds__(NT, 2) fwd_kernel(Args args) {
    extern __shared__ __attribute__((aligned(16))) unsigned char lds[];
    cg::grid_group grid = cg::this_grid();
    const int tid = threadIdx.x, G = gridDim.x, bx = blockIdx.x;
    unsigned char* ws = args.ws;
    PG8_LAS unsigned char* ldsl = (PG8_LAS unsigned char*)lds;
    const int lo = args.ph_lo, hi = args.ph_hi;
#ifndef SKIPMASK
#define SKIPMASK 0
#endif
#define IN(k) (!((SKIPMASK >> (k)) & 1) && lo <= (k) && (k) < hi)
    volatile LAS unsigned* bst = (volatile LAS unsigned*)(ldsl + 155136);
    if (tid < 2) bst[tid] = 0u;
    __syncthreads();
    XcdBarrier xbar = xcd_barrier_post((unsigned*)(ws + WS_BAR), bst);
#define SEAM(k) do { if (IN(k) && IN((k) + 1)) { if ((k) == 0) grid.sync(); else xcd_barrier(xbar); } } while (0)
    float* SS = (float*)(ws + WS_SS);
    if (IN(0)) { const int tid = pg8::fresh_tid(); p0_prologue(args, lds, tid, G); }
    SEAM(0);
    if (IN(1)) {
        pg8::Gemm g{(const bf16*)(ws + WS_XN), (const bf16*)(ws + WS_WIN), MP, NIN, 1024, 1024, 1024, 0, 0}; pg8::StaticOrder S; S.init(MP, NIN, G, bx);
        pg8::EpiInProj E{(bf16*)(ws + WS_MIX), (bf16*)(ws + WS_XBCP), (bf16*)(ws + WS_UA), (bf16*)(ws + WS_UMETA), (float*)(ws + WS_DTRAW)};
        pg8::gemm_phase<pg8::EpiInProj, pg8::StaticOrder, true, true>(ldsl, g, S, E);
    }
    SEAM(1);
    if (IN(2)) {
        const int tid = pg8::fresh_tid(), wave = tid >> 6, lane = tid & 63;
        for (int u = bx; u < NQ * 24; u += G) p2_conv_unit(args, u / 24, u % 24, lds, tid);
        for (int it = bx * NWAVES + wave; it < NQ * 16; it += G * NWAVES) p2_dt_item(args, it >> 4, it & 15, lane);
    }
    SEAM(2);
    const int nS3 = (G / 2 < 126) ? G / 2 : 126;
    if (IN(3)) {
        const int tid = pg8::fresh_tid();
        if (bx < nS3) { for (int u = bx; u < 126; u += nS3) { const int qi = u >> 1; p3_states_unit(args, qi < 32 ? qi : qi + 1, u & 1, tid); } }
        pg8::Gemm g{(const bf16*)(ws + WS_UA), (const bf16*)(ws + WS_TE5), 1024, 256, 256, 384, 256, (size_t)1024 * 384 * 2, (size_t)256 * 256 * 2};
        pg8::BatchOrder S; S.init(256, 4, G, nS3, bx);
        pg8::EpiS5a E{(float*)(ws + WS_SEND)};
        pg8::gemm_phase<pg8::EpiS5a, pg8::BatchOrder, true, true>(ldsl, g, S, E);
    }
    SEAM(3);
    if (IN(4)) {
        const int tid = pg8::fresh_tid();
        for (int it = bx; it < 384; it += G) { if (it < 256) p4_s5_scan_item(args, it, lds, tid); else p4_ssd_scan_item(args, it - 256, tid); }
    }
    SEAM(4);
    if (IN(5)) {
        const int tid = pg8::fresh_tid();
#ifndef NO_SSDOUT
        for (int u = bx; u < 256; u += G) p5_ssd_out_unit(args, 1 + (u >> 2), (u >> 1) & 1, u & 1, lds, tid);
        __syncthreads();
#endif
        pg8::Gemm g{(const bf16*)(ws + WS_UA), (const bf16*)(ws + WS_TB5), 1024, 256, 384, 384, 384, (size_t)1024 * 384 * 2, (size_t)256 * 384 * 2};
        pg8::BatchOrder S; S.init(256, 4, G, 0, bx);
        pg8::EpiS5b E{(bf16*)(ws + WS_Y5)};
        pg8::gemm_phase<pg8::EpiS5b, pg8::BatchOrder, true, true>(ldsl, g, S, E);
    }
    SEAM(5);
    if (IN(6)) {
        const int tid = pg8::fresh_tid();
        p6_weights(args, lds, tid, G);
        pg8::Gemm g{(const bf16*)(ws + WS_Y5), (const bf16*)(ws + WS_WGLU), MR, 2048, 1024, 1024, 1024, 0, 0}; pg8::StaticOrder S; S.init(MR, 2048, G, bx);
        pg8::EpiGlu E{(bf16*)(ws + WS_MIX), args.in[I_BGLU], SS + 16384};
        pg8::gemm_phase<pg8::EpiGlu, pg8::StaticOrder, true, true>(ldsl, g, S, E);
    }
    SEAM(6);
    if (IN(7)) {
        pg8::Gemm g{(const bf16*)(ws + WS_MIX), (const bf16*)(ws + WS_WOUT), MR, 1024, 1024, 2048, 2048, 0, 0, (size_t)1024 * 2, (size_t)1024 * 2};
        pg8::SplitKOrder S; S.base.init(MR, 1024, G, bx);
        pg8::EpiOut E{args.in[I_X], args.out, (bf16*)(ws + WS_H1B), SS, SS + 16384, SS + 2 * 16384};
        pg8::gemm_phase<pg8::EpiOut, pg8::SplitKOrder, true, true>(ldsl, g, S, E);
    }
    SEAM(7);
    if (IN(8)) {
        pg8::Gemm g{(const bf16*)(ws + WS_H1B), (const bf16*)(ws + WS_WUP), MR, 4096, 1024, 1024, 1024, 0, 0}; pg8::StaticOrder S; S.init(MR, 4096, G, bx);
        pg8::EpiUp E{(bf16*)(ws + WS_HB), SS + 2 * 16384};
        pg8::gemm_phase<pg8::EpiUp, pg8::StaticOrder, true, true>(ldsl, g, S, E);
    }
    SEAM(8);
    const int fused_fin = (G == 256 && lo <= 9 && hi >= 11) ? 1 : 0;
    if (IN(9)) {
        pg8::Gemm g{(const bf16*)(ws + WS_HB), (const bf16*)(ws + WS_WDN), MR, 1024, 4096, 4096, 4096, 0, 0}; pg8::StaticOrder S; S.init(MR, 1024, G, bx);
        pg8::EpiDown E{args.out, SS + 3 * 16384, (unsigned*)(ws + WS_BAR) + 3584, args.in[I_GFIN], fused_fin};
        pg8::gemm_phase<pg8::EpiDown, pg8::StaticOrder, true, true>(ldsl, g, S, E);
    }
    if (!fused_fin) {
        SEAM(9);
        if (IN(10)) { const int tid = pg8::fresh_tid(); p10_final(args, tid, G); }
    }
#undef IN
#undef SEAM
}

#ifndef N_LAUNCHES
#define N_LAUNCHES 1
#endif
extern "C" void kernel_launch(void* const* d_in, const int* in_sizes, int n_in, void* d_out, int out_size, void* d_ws, size_t ws_size, hipStream_t stream) {
    static int grid = 0;
    if (grid == 0) {
        int dev = 0, cus = 0, per_cu = 0;
        hipGetDevice(&dev); hipDeviceGetAttribute(&cus, hipDeviceAttributeMultiprocessorCount, dev);
        hipFuncSetAttribute((const void*)fwd_kernel, hipFuncAttributeMaxDynamicSharedMemorySize, LDS_BYTES);
        hipOccupancyMaxActiveBlocksPerMultiprocessor(&per_cu, (const void*)fwd_kernel, NT, LDS_BYTES);
        if (per_cu < 1) { fprintf(stderr, "occupancy query says %d blocks per CU\n", per_cu); per_cu = 1; }
        grid = cus * 1;
        (void)hipGetLastError();
    }
    hipMemsetAsync((char*)d_ws + WS_BAR, 0, 16384, stream);
    Args a{};
    for (int i = 0; i < 26; ++i) a.in[i] = (const float*)d_in[i];
    a.out = (float*)d_out; a.ws = (unsigned char*)d_ws;
    if (N_LAUNCHES == 1) {
        a.ph_lo = 0; a.ph_hi = 11;
        void* args[] = {&a};
        hipError_t e = hipLaunchCooperativeKernel((const void*)fwd_kernel, dim3(grid), dim3(NT), args, LDS_BYTES, stream);
        if (e != hipSuccess) fprintf(stderr, "cooperative launch failed: %s (grid %d)\n", hipGetErrorString(e), grid);
    } else {
        for (int p = 0; p < 11; ++p) { a.ph_lo = p; a.ph_hi = p + 1; hipLaunchKernelGGL(fwd_kernel, dim3(grid), dim3(NT), LDS_BYTES, stream, a); }
    }
}
```

```cpp
#include <hip/hip_runtime.h>
#include <cstdio>
#include <cstdint>
namespace pg8 {
#define PG8_LAS __attribute__((address_space(3)))
typedef unsigned short bf16_t;
typedef short bf16x8 __attribute__((ext_vector_type(8)));
typedef float f32x4 __attribute__((ext_vector_type(4)));
typedef unsigned u32x4 __attribute__((ext_vector_type(4)));
constexpr int BM = 256, BK = 64, HALF = 128, HTB = HALF * BK * 2  , STAGE_BYTES = 8 * HTB, NXCD = 8, WGM = 8;

__host__ __device__ __forceinline__ int lds_byte(int r, int c) { const int st = (r >> 4) * 2 + (c >> 5), rr = r & 15, cc = c & 31, ob = rr * 64 + cc * 2; return st * 1024 + (ob ^ (((ob >> 9) & 1) << 5)); }
__host__ __device__ __forceinline__ void stage_rc(int b, int& R, int& C) { const int st = b / 1024, sb = b % 1024, swz = sb ^ (((sb >> 9) & 1) << 5); R = (st >> 1) * 16 + swz / 64; C = (st & 1) * 32 + (swz % 64) / 2; }
__host__ __device__ __forceinline__ int perm32(int rho) { const int n = rho >> 4, i = rho & 15; return 8 * (i >> 2) + 4 * n + (i & 3); }

struct Unit { int pm, pn, g, par, kh; };
struct Gemm { const bf16_t* A; const bf16_t* Bt; int M, N, K, lda, ldb; size_t gsA, gsB; size_t khA = 0, khB = 0; };

struct StaticOrder {
    int nM, nN, nwg, G, c;
    __host__ __device__ void init(int M, int N, int G_, int c_) { nM = M / BM; nN = N / BM; nwg = nM * nN; G = G_; c = c_; }
    __host__ __device__ bool next(int i, Unit& u) const {
        const long L = (long)i * G + c; if (L >= nwg) return false;
        int wgid = (int)L; { const int q = nwg / NXCD, r = nwg % NXCD, xcd = wgid % NXCD, off = wgid / NXCD; wgid = (xcd < r ? xcd * (q + 1) : r * (q + 1) + (xcd - r) * q) + off; }
        const int nig = WGM * nN, gid = wgid / nig, fm = gid * WGM, gsz = (nM - fm) < WGM ? (nM - fm) : WGM;
        u.pm = fm + ((wgid % nig) % gsz); u.pn = (wgid % nig) / gsz; u.g = 0; u.par = i & 1; u.kh = 0; return true;
    }
    __device__ __forceinline__ void a_ready(const Unit&) const {}
    __device__ __forceinline__ void done(const Unit&) const {}
};

__device__ __forceinline__ unsigned cvt_pk_bf16(float lo, float hi) { unsigned r; asm volatile("v_cvt_pk_bf16_f32 %0, %1, %2" : "=v"(r) : "v"(lo), "v"(hi)); return r; }
typedef float f32x2 __attribute__((ext_vector_type(2)));
__device__ __forceinline__ f32x2 gelu_pk(f32x2 v) {
    const f32x2 av = __builtin_elementwise_abs(v), d = av * 0.2316418882f + 1.0f;
    f32x2 t; t.x = __builtin_amdgcn_rcpf(d.x); t.y = __builtin_amdgcn_rcpf(d.y);
    f32x2 q = t * 0.5307027145f + (-0.7265760135f); q = q * t + 0.7107068705f; q = q * t + (-0.142248368f); q = q * t + 0.127414796f; q = q * t;
    const f32x2 s = (v * v) * (-0.72134752044f);
    f32x2 e; e.x = __builtin_amdgcn_exp2f(s.x); e.y = __builtin_amdgcn_exp2f(s.y);
    const f32x2 m = v * (q * e), r = v - m;
    f32x2 o; o.x = v.x < 0.f ? m.x : r.x; o.y = v.y < 0.f ? m.y : r.y; return o;
}

__device__ __forceinline__ int fresh_tid() { int t; asm volatile("v_mov_b32 %0, %1" : "=v"(t) : "v"((int)threadIdx.x)); return t; }
#define EPI_ROWS_COLS const int rowb = u.pm * BM + wr * 64 + fr; const int colb = wc * 32 + 8 * fq;
__device__ __forceinline__ u32x4 pack8(const f32x4 v0, const f32x4 v1) { u32x4 w; w.x = cvt_pk_bf16(v0[0], v0[1]); w.y = cvt_pk_bf16(v0[2], v0[3]); w.z = cvt_pk_bf16(v1[0], v1[1]); w.w = cvt_pk_bf16(v1[2], v1[3]); return w; }
__device__ __forceinline__ float sum8sq(const f32x4 a, const f32x4 b) { return (a[0] * a[0] + a[1] * a[1]) + (a[2] * a[2] + a[3] * a[3]) + (b[0] * b[0] + b[1] * b[1]) + (b[2] * b[2] + b[3] * b[3]); }

struct EpiInProj {
    static constexpr bool PERM = true, AFTER_DRAIN = false, HAS_MID = false;
    bf16_t* MIX; bf16_t* XBCP; bf16_t* UA; bf16_t* UMETA; float* DTRAW;
    __device__ __forceinline__ void operator()(const f32x4 (&acc)[2][2][4][2], const Unit& u, int wr, int wc, int fr, int fq) const {
        EPI_ROWS_COLS
        const int pn = u.pn;
#pragma unroll
        for (int ai = 0; ai < 2; ++ai)
#pragma unroll
            for (int m = 0; m < 4; ++m) {
                const int r = rowb + ai * HALF + m * 16;
#pragma unroll
                for (int bj = 0; bj < 2; ++bj) {
                    const int c = pn * BM + bj * HALF + colb;
                    const f32x4 v0 = acc[ai][bj][m][0], v1 = acc[ai][bj][m][1];
                    if (pn < 4) { if (r < 16384) *(u32x4*)(MIX + (size_t)r * 2048 + c) = pack8(v0, v1); }
                    else if (pn < 10) { *(u32x4*)(XBCP + (size_t)r * 1536 + (c - 1024)) = pack8(v0, v1); }
                    else if (pn < 14) {
                        const int j = c - 2560, g = j >> 4, h0 = j & 15;
                        if (r < 16384) { const int b = r >> 13, tok = r & 8191, ch = tok >> 4, t = tok & 15;
                            *(u32x4*)(UA + ((size_t)(g * 1024 + b * 512 + ch) * 384 + t * 16 + h0)) = pack8(v0, v1); }
                        else *(u32x4*)(UMETA + (size_t)(r - 16384) * 1024 + j) = pack8(v0, v1);
                    } else {
                        const int j = c - 3584;
                        if (j < 16) { float* d = DTRAW + (size_t)r * 16 + j; *(f32x4*)d = v0; *(f32x4*)(d + 4) = v1; }
                    }
                }
            }
    }
};
struct EpiS5a {
    static constexpr bool PERM = true, AFTER_DRAIN = false, HAS_MID = false;
    float* SEND;
    __device__ __forceinline__ void operator()(const f32x4 (&acc)[2][2][4][2], const Unit& u, int wr, int wc, int fr, int fq) const {
        EPI_ROWS_COLS
#pragma unroll
        for (int ai = 0; ai < 2; ++ai)
#pragma unroll
            for (int m = 0; m < 4; ++m) {
                const int r = rowb + ai * HALF + m * 16;
                float* d = SEND + ((size_t)(u.g * 1024 + r) * 128 + colb);
                *(f32x4*)d = acc[ai][0][m][0]; *(f32x4*)(d + 4) = acc[ai][0][m][1];
            }
    }
};
struct EpiS5b {
    static constexpr bool PERM = true, AFTER_DRAIN = false, HAS_MID = false;
    bf16_t* Y5;
    __device__ __forceinline__ void operator()(const f32x4 (&acc)[2][2][4][2], const Unit& u, int wr, int wc, int fr, int fq) const {
        { const int t2 = fresh_tid(); const int w2 = t2 >> 6, l2 = t2 & 63; wr = w2 >> 2; wc = w2 & 3; fr = l2 & 15; fq = l2 >> 4; }
        const unsigned lane_off = (unsigned)((((u.pm >> 1) * 8192 + (((u.pm & 1) * 256 + wr * 64 + fr) * 16) + (wc * 2 + (fq >> 1))) * 1024 + u.g * 16 + (fq & 1) * 8) * 2);
        char* base = (char*)Y5;
#pragma unroll
        for (int ai = 0; ai < 2; ++ai)
#pragma unroll
            for (int m = 0; m < 4; ++m)
#pragma unroll
                for (int bj = 0; bj < 2; ++bj) {
                    const f32x4 v0 = acc[ai][bj][m][0], v1 = acc[ai][bj][m][1]; u32x4 w;
                    { const f32x2 a = gelu_pk((f32x2){v0[0], v0[1]}); w.x = cvt_pk_bf16(a.x, a.y); } __builtin_amdgcn_sched_barrier(0);
                    { const f32x2 a = gelu_pk((f32x2){v0[2], v0[3]}); w.y = cvt_pk_bf16(a.x, a.y); } __builtin_amdgcn_sched_barrier(0);
                    { const f32x2 a = gelu_pk((f32x2){v1[0], v1[1]}); w.z = cvt_pk_bf16(a.x, a.y); } __builtin_amdgcn_sched_barrier(0);
                    { const f32x2 a = gelu_pk((f32x2){v1[2], v1[3]}); w.w = cvt_pk_bf16(a.x, a.y); } __builtin_amdgcn_sched_barrier(0);
                    const unsigned off = lane_off + (unsigned)(ai * 4194304 + m * 524288 + bj * 16384);
                    *(u32x4*)(base + off) = w;
                }
    }
};
__device__ __forceinline__ float sigm(float x) { return __builtin_amdgcn_rcpf(1.0f + __builtin_amdgcn_exp2f(-1.44269504f * x)); }
struct EpiGlu {
    static constexpr bool PERM = true, AFTER_DRAIN = false, HAS_MID = false;
    bf16_t* MIX; const float* bglu; float* SS5;
    __device__ __forceinline__ void operator()(const f32x4 (&acc)[2][2][4][2], const Unit& u, int wr, int wc, int fr, int fq) const {
        EPI_ROWS_COLS
        const int oc = u.pn * 128 + colb;
        const f32x4 ba0 = *(const f32x4*)(bglu + oc), ba1 = *(const f32x4*)(bglu + oc + 4), bg0 = *(const f32x4*)(bglu + 1024 + oc), bg1 = *(const f32x4*)(bglu + 1024 + oc + 4);
#pragma unroll
        for (int ai = 0; ai < 2; ++ai)
#pragma unroll
            for (int m = 0; m < 4; ++m) {
                const int r = rowb + ai * HALF + m * 16;
                f32x4 a0 = acc[ai][0][m][0] + ba0, a1 = acc[ai][0][m][1] + ba1; const f32x4 g0 = acc[ai][1][m][0] + bg0, g1 = acc[ai][1][m][1] + bg1;
#pragma unroll
                for (int e = 0; e < 4; ++e) { a0[e] *= sigm(g0[e]); a1[e] *= sigm(g1[e]); }
                *(u32x4*)(MIX + (size_t)r * 2048 + 1024 + oc) = pack8(a0, a1);
                float s = sum8sq(a0, a1); s += __shfl_xor(s, 16); s += __shfl_xor(s, 32);
                if (fq == 0) atomicAdd(SS5 + r, s);
            }
    }
};
struct EpiOut {
    static constexpr bool PERM = true, AFTER_DRAIN = false, HAS_MID = true;
    const float* X; float* H1; bf16_t* H1B; const float* SSS; const float* SS5; float* SSM;
    __device__ __forceinline__ void mid(f32x4 (&acc)[2][2][4][2], const Unit& u, int wr, int wc, int fr, int fq) const {
        const int rowb = u.pm * BM + wr * 64 + fr;
#pragma unroll
        for (int ai = 0; ai < 2; ++ai)
#pragma unroll
            for (int m = 0; m < 4; ++m) {
                const int r = rowb + ai * HALF + m * 16;
                const float ratio = sqrtf((SS5[r] * (1.0f / 1024.0f) + 1e-5f) / (SSS[r] * (1.0f / 1024.0f) + 1e-5f));
#pragma unroll
                for (int bj = 0; bj < 2; ++bj)
#pragma unroll
                    for (int n = 0; n < 2; ++n) acc[ai][bj][m][n] *= ratio;
                asm volatile("" ::: "memory");
            }
    }
    __device__ __forceinline__ void operator()(const f32x4 (&acc)[2][2][4][2], const Unit& u, int wr, int wc, int fr, int fq) const {
        EPI_ROWS_COLS
        const unsigned lane_off = (unsigned)(rowb * 1024 + u.pn * BM + colb);
        const char* xb = (const char*)X; char* hb = (char*)H1; char* bb = (char*)H1B;
#pragma unroll
        for (int ai = 0; ai < 2; ++ai)
#pragma unroll
            for (int m = 0; m < 4; ++m) {
                const int r = rowb + ai * HALF + m * 16;
                const float rs = 1.0f / sqrtf(SS5[r] * (1.0f / 1024.0f) + 1e-5f);
                float s = 0.f;
#pragma unroll
                for (int bj = 0; bj < 2; ++bj) {
                    const unsigned off = lane_off + (unsigned)(ai * 131072 + m * 16384 + bj * 128);
                    const f32x4 v0 = *(const f32x4*)(xb + off * 4u) + acc[ai][bj][m][0] * rs, v1 = *(const f32x4*)(xb + off * 4u + 16u) + acc[ai][bj][m][1] * rs;
                    *(f32x4*)(hb + off * 4u) = v0; *(f32x4*)(hb + off * 4u + 16u) = v1;
                    *(u32x4*)(bb + off * 2u) = pack8(v0, v1); s += sum8sq(v0, v1);
                }
                s += __shfl_xor(s, 16); s += __shfl_xor(s, 32);
                if (fq == 0) atomicAdd(SSM + r, s);
                asm volatile("" ::: "memory");
            }
    }
};
struct SplitKOrder {
    StaticOrder base;
    __device__ bool next(int i, Unit& u) const { if (!base.next(i >> 1, u)) return false; u.kh = i & 1; u.par = i & 1; return true; }
    __device__ __forceinline__ void a_ready(const Unit&) const {}
    __device__ __forceinline__ void done(const Unit&) const {}
};
struct EpiUp {
    static constexpr bool PERM = true, AFTER_DRAIN = false, HAS_MID = false;
    bf16_t* HB; const float* SSM;
    __device__ __forceinline__ void operator()(const f32x4 (&acc)[2][2][4][2], const Unit& u, int wr, int wc, int fr, int fq) const {
        EPI_ROWS_COLS
#pragma unroll
        for (int ai = 0; ai < 2; ++ai)
#pragma unroll
            for (int m = 0; m < 4; ++m) {
                const int r = rowb + ai * HALF + m * 16;
                const float rs = 1.0f / sqrtf(SSM[r] * (1.0f / 1024.0f) + 1e-5f);
#pragma unroll
                for (int bj = 0; bj < 2; ++bj) {
                    f32x4 v0 = acc[ai][bj][m][0] * rs, v1 = acc[ai][bj][m][1] * rs;
#pragma unroll
                    for (int e = 0; e < 4; ++e) { const float p = fmaxf(v0[e], 0.f), q = fmaxf(v1[e], 0.f); v0[e] = p * p; v1[e] = q * q; }
                    *(u32x4*)(HB + (size_t)r * 4096 + u.pn * BM + bj * HALF + colb) = pack8(v0, v1);
                }
            }
    }
};
struct EpiDown {
    static constexpr bool PERM = true, AFTER_DRAIN = false, HAS_MID = false;
    float* H; float* SSF; unsigned* pcnt; const float* gfin; int fused;
    __device__ __forceinline__ void operator()(const f32x4 (&acc_)[2][2][4][2], const Unit& u, int wr, int wc, int fr, int fq) const {
        f32x4 (&acc)[2][2][4][2] = const_cast<f32x4 (&)[2][2][4][2]>(acc_);
        EPI_ROWS_COLS
        const unsigned lane_off = (unsigned)(rowb * 1024 + u.pn * BM + colb);
        char* hb = (char*)H;
#pragma unroll
        for (int ai = 0; ai < 2; ++ai)
#pragma unroll
            for (int m = 0; m < 4; ++m) {
                const int r = rowb + ai * HALF + m * 16;
                float s = 0.f;
#pragma unroll
                for (int bj = 0; bj < 2; ++bj) {
                    const unsigned off = lane_off + (unsigned)(ai * 131072 + m * 16384 + bj * 128);
                    const f32x4 v0 = *(const f32x4*)(hb + off * 4u) + acc[ai][bj][m][0], v1 = *(const f32x4*)(hb + off * 4u + 16u) + acc[ai][bj][m][1];
                    if (fused) { acc[ai][bj][m][0] = v0; acc[ai][bj][m][1] = v1; } else { *(f32x4*)(hb + off * 4u) = v0; *(f32x4*)(hb + off * 4u + 16u) = v1; }
                    s += sum8sq(v0, v1);
                }
                s += __shfl_xor(s, 16); s += __shfl_xor(s, 32);
                if (fq == 0) atomicAdd(SSF + r, s);
                asm volatile("" ::: "memory");
            }
        if (!fused) return;
        asm volatile("s_waitcnt vmcnt(0)" ::: "memory");
        unsigned* cw = pcnt + 4 * u.pm;
        if (fr == 0 && fq == 0) __hip_atomic_fetch_add(cw, 1u, __ATOMIC_RELAXED, __HIP_MEMORY_SCOPE_AGENT);
        while (__hip_atomic_load(cw, __ATOMIC_RELAXED, __HIP_MEMORY_SCOPE_AGENT) < 32u) __builtin_amdgcn_s_sleep(4);
        asm volatile("" ::: "memory");
        f32x4 gv[2][2];
#pragma unroll
        for (int bj = 0; bj < 2; ++bj) { gv[bj][0] = *(const f32x4*)(gfin + u.pn * BM + bj * HALF + colb); gv[bj][1] = *(const f32x4*)(gfin + u.pn * BM + bj * HALF + colb + 4); }
#pragma unroll
        for (int ai = 0; ai < 2; ++ai)
#pragma unroll
            for (int m = 0; m < 4; ++m) {
                const int r = rowb + ai * HALF + m * 16;
                const float ssum = __builtin_bit_cast(float, __hip_atomic_load((const unsigned*)(SSF + r), __ATOMIC_RELAXED, __HIP_MEMORY_SCOPE_AGENT));
                const float rs = 1.0f / sqrtf(ssum * (1.0f / 1024.0f) + 1e-5f);
#pragma unroll
                for (int bj = 0; bj < 2; ++bj) {
                    const unsigned off = lane_off + (unsigned)(ai * 131072 + m * 16384 + bj * 128);
                    *(f32x4*)(hb + off * 4u) = acc[ai][bj][m][0] * rs * gv[bj][0]; *(f32x4*)(hb + off * 4u + 16u) = acc[ai][bj][m][1] * rs * gv[bj][1];
                }
            }
    }
};
struct BatchOrder {
    int nU, per_g, Ge, ce;
    __host__ __device__ void init(int nU_, int per_g_, int G, int w0, int c) { nU = nU_; per_g = per_g_; Ge = G - w0; ce = c - w0; }
    __device__ bool next(int i, Unit& u) const {
        if (ce < 0) return false;
        const long L = (long)i * Ge + ce; if (L >= nU) return false;
        u.g = __builtin_amdgcn_readfirstlane((int)L / per_g); u.pm = __builtin_amdgcn_readfirstlane((int)L % per_g); u.pn = 0; u.par = i & 1; u.kh = 0; return true;
    }
    __device__ __forceinline__ void a_ready(const Unit&) const {}
    __device__ __forceinline__ void done(const Unit&) const {}
};
template <class Epi, class Sched, bool ALIGN_EPI = false, bool SP2 = false>
__device__ __forceinline__ void gemm_phase(PG8_LAS unsigned char* lds, const Gemm g, const Sched& S, const Epi& E) {
    const int tid = threadIdx.x, wid = __builtin_amdgcn_readfirstlane(tid >> 6), lane = tid & 63, wr = wid >> 2, wc = wid & 3, fr = lane & 15, fq = lane >> 4;
    const int K = g.K, nt = K / BK;
    unsigned voffA[2], voffB[2];
#pragma unroll
    for (int i = 0; i < 2; ++i) { int R, C; stage_rc(tid * 16 + i * 8192, R, C); const int Rb = Epi::PERM ? ((R & ~31) + perm32(R & 31)) : R;
        voffA[i] = (unsigned)(R * g.lda + C) * 2u; voffB[i] = (unsigned)(Rb * g.ldb + C) * 2u; }
    const size_t kstep = (size_t)(BK * 2);
    const size_t hstepA = (size_t)HALF * g.lda * 2, hstepB = (size_t)HALF * g.ldb * 2;
    const size_t tstepA = 2 * hstepA, tstepB = 2 * hstepB;
    const unsigned ldsw = (unsigned)wid * 1024u;
    const int aoff = lds_byte(wr * 64 + fr, fq * 8), boff = lds_byte(wc * 32 + fr, fq * 8);
#define PG8_SA(b, h) (((b) * 2 + (h)) * HTB)
#define PG8_SB(b, h) ((4 + (b) * 2 + (h)) * HTB)
#define PG8_STAGE(bufoff, gbase, voff) do { _Pragma("unroll") for (int _i = 0; _i < 2; ++_i) \
        __builtin_amdgcn_global_load_lds((const unsigned*)((const char*)(gbase) + (voff)[_i]), (PG8_LAS unsigned*)(lds + (bufoff) + ldsw + _i * 8192), 16, 0, 0); } while (0)
#define PG8_LDA(dst, b, h) do { _Pragma("unroll") for (int m = 0; m < 4; ++m) _Pragma("unroll") for (int k = 0; k < 2; ++k) dst[m][k] = *(const PG8_LAS bf16x8*)(lds + PG8_SA(b, h) + aoff + m * 2048 + k * 1024); } while (0)
#define PG8_LDB(dst, b, h) do { _Pragma("unroll") for (int n = 0; n < 2; ++n) _Pragma("unroll") for (int k = 0; k < 2; ++k) dst[n][k] = *(const PG8_LAS bf16x8*)(lds + PG8_SB(b, h) + boff + n * 2048 + k * 1024); } while (0)
#define PG8_MMA(ai, bj, At, Bt) do { __builtin_amdgcn_s_setprio(1); _Pragma("unroll") for (int m = 0; m < 4; ++m) _Pragma("unroll") for (int n = 0; n < 2; ++n) _Pragma("unroll") for (int k = 0; k < 2; ++k) \
        acc[ai][bj][m][n] = __builtin_amdgcn_mfma_f32_16x16x32_bf16(Bt[n][k], At[m][k], acc[ai][bj][m][n], 0, 0, 0); __builtin_amdgcn_s_setprio(0); } while (0)
#define PG8_WAIT_V(n) asm volatile("s_waitcnt vmcnt(" #n ")" ::: "memory")
#define PG8_WAIT_L(n) asm volatile("s_waitcnt lgkmcnt(" #n ")" ::: "memory")
#define PG8_BAR __builtin_amdgcn_s_barrier()
#define PG8_SCHED __builtin_amdgcn_sched_barrier(0)
    Unit cur, nxt; int ui = 0;
    if (!S.next(0, cur)) return;
    f32x4 acc[2][2][4][2];
#pragma unroll
    for (int a = 0; a < 2; ++a)
#pragma unroll
        for (int b = 0; b < 2; ++b)
#pragma unroll
            for (int m = 0; m < 4; ++m)
#pragma unroll
                for (int n = 0; n < 2; ++n) acc[a][b][m][n] = (f32x4){0.f, 0.f, 0.f, 0.f};
    bf16x8 At[4][2], B0[2][2], B1[2][2];
    const char* cA = (const char*)g.A + (size_t)cur.g * g.gsA + (size_t)cur.pm * tstepA + (size_t)cur.kh * g.khA; const char* cB = (const char*)g.Bt + (size_t)cur.g * g.gsB + (size_t)cur.pn * tstepB + (size_t)cur.kh * g.khB;
    S.a_ready(cur);
    if constexpr (SP2) {
        PG8_STAGE(PG8_SB(0, 0), cB, voffB); PG8_STAGE(PG8_SB(0, 1), cB + hstepB, voffB); PG8_STAGE(PG8_SA(0, 0), cA, voffA); PG8_STAGE(PG8_SA(0, 1), cA + hstepA, voffA);
        if (wr == 1) PG8_BAR;
        PG8_WAIT_V(2); PG8_BAR;
        PG8_STAGE(PG8_SB(1, 0), cB + kstep, voffB); PG8_STAGE(PG8_SA(1, 0), cA + kstep, voffA); PG8_STAGE(PG8_SB(1, 1), cB + hstepB + kstep, voffB);
        PG8_WAIT_V(6); PG8_BAR;
    } else {
        PG8_STAGE(PG8_SB(0, 0), cB, voffB); PG8_STAGE(PG8_SA(0, 0), cA, voffA); PG8_STAGE(PG8_SB(0, 1), cB + hstepB, voffB); PG8_STAGE(PG8_SA(0, 1), cA + hstepA, voffA);
        if (wr == 1) PG8_BAR;
        PG8_WAIT_V(4); PG8_BAR;
        PG8_STAGE(PG8_SB(1, 0), cB + kstep, voffB); PG8_STAGE(PG8_SA(1, 0), cA + kstep, voffA); PG8_STAGE(PG8_SB(1, 1), cB + hstepB + kstep, voffB);
        PG8_WAIT_V(6); PG8_BAR;
    }
    for (;;) {
        const bool has_next = S.next(ui + 1, nxt);
        const char* nA = has_next ? (const char*)g.A + (size_t)nxt.g * g.gsA + (size_t)nxt.pm * tstepA + (size_t)nxt.kh * g.khA : cA; const char* nB = has_next ? (const char*)g.Bt + (size_t)nxt.g * g.gsB + (size_t)nxt.pn * tstepB + (size_t)nxt.kh * g.khB : cB;
        for (int t = 0; t < nt; t += 2) {
            const bool last = (t == nt - 2);
            const char* a1 = cA + (size_t)(t + 1) * kstep;
            const char* a2 = last ? nA : cA + (size_t)(t + 2) * kstep; const char* b2 = last ? nB : cB + (size_t)(t + 2) * kstep;
            const char* a3 = a2 + kstep; const char* b3 = b2 + kstep;
            if (last && has_next) S.a_ready(nxt);
            if constexpr (SP2) {
            PG8_LDB(B0, 0, 0); PG8_LDB(B1, 0, 1); PG8_SCHED; PG8_LDA(At, 0, 0); PG8_STAGE(PG8_SA(1, 1), a1 + hstepA, voffA);
            PG8_WAIT_V(8); PG8_WAIT_L(0); PG8_BAR; PG8_MMA(0, 0, At, B0); PG8_MMA(0, 1, At, B1); PG8_BAR; PG8_SCHED;
            PG8_LDA(At, 0, 1); PG8_STAGE(PG8_SB(0, 0), b2, voffB); PG8_STAGE(PG8_SB(0, 1), b2 + hstepB, voffB); PG8_STAGE(PG8_SA(0, 0), a2, voffA);
            PG8_WAIT_V(8); PG8_WAIT_L(0); PG8_BAR; PG8_MMA(1, 0, At, B0); PG8_MMA(1, 1, At, B1); PG8_BAR; PG8_SCHED;
            PG8_LDB(B0, 1, 0); PG8_LDB(B1, 1, 1); PG8_SCHED; PG8_LDA(At, 1, 0); PG8_STAGE(PG8_SA(0, 1), a2 + hstepA, voffA);
            PG8_WAIT_V(8); PG8_WAIT_L(0); PG8_BAR; PG8_MMA(0, 0, At, B0); PG8_MMA(0, 1, At, B1); PG8_BAR; PG8_SCHED;
            PG8_LDA(At, 1, 1); PG8_STAGE(PG8_SB(1, 0), b3, voffB); PG8_STAGE(PG8_SB(1, 1), b3 + hstepB, voffB); PG8_STAGE(PG8_SA(1, 0), a3, voffA);
            PG8_WAIT_V(8); PG8_WAIT_L(0); PG8_BAR; PG8_MMA(1, 0, At, B0); PG8_MMA(1, 1, At, B1); PG8_BAR; PG8_SCHED;
            } else {
            PG8_LDB(B0, 0, 0); PG8_SCHED; PG8_LDA(At, 0, 0); PG8_STAGE(PG8_SA(1, 1), a1 + hstepA, voffA);
            PG8_WAIT_L(8); PG8_BAR; PG8_WAIT_L(0); PG8_MMA(0, 0, At, B0); PG8_BAR; PG8_SCHED;
            PG8_LDB(B1, 0, 1); PG8_STAGE(PG8_SB(0, 0), b2, voffB);
            PG8_BAR; PG8_WAIT_L(0); PG8_MMA(0, 1, At, B1); PG8_BAR;
            PG8_LDA(At, 0, 1); PG8_STAGE(PG8_SA(0, 0), a2, voffA);
            PG8_BAR; PG8_WAIT_L(0); PG8_MMA(1, 0, At, B0); PG8_BAR; PG8_SCHED;
            PG8_STAGE(PG8_SB(0, 1), b2 + hstepB, voffB);
            PG8_WAIT_V(6); PG8_BAR; PG8_MMA(1, 1, At, B1); PG8_BAR;
            PG8_LDB(B0, 1, 0); PG8_SCHED; PG8_LDA(At, 1, 0); PG8_STAGE(PG8_SA(0, 1), a2 + hstepA, voffA);
            PG8_WAIT_L(8); PG8_BAR; PG8_WAIT_L(0); PG8_MMA(0, 0, At, B0); PG8_BAR; PG8_SCHED;
            PG8_LDB(B1, 1, 1); PG8_STAGE(PG8_SB(1, 0), b3, voffB);
            PG8_BAR; PG8_WAIT_L(0); PG8_MMA(0, 1, At, B1); PG8_BAR;
            PG8_LDA(At, 1, 1); PG8_STAGE(PG8_SA(1, 0), a3, voffA);
            PG8_BAR; PG8_WAIT_L(0); PG8_MMA(1, 0, At, B0); PG8_BAR; PG8_SCHED;
            PG8_STAGE(PG8_SB(1, 1), b3 + hstepB, voffB);
            PG8_WAIT_V(6); PG8_BAR; PG8_MMA(1, 1, At, B1); PG8_BAR;
            }
        }
        if constexpr (ALIGN_EPI) { if (wr == 0) PG8_BAR; }
        bool keep = false;
        if constexpr (Epi::HAS_MID) { if (cur.kh == 0) { E.mid(acc, cur, wr, wc, fr, fq); keep = true; } }
        if (!keep) { if constexpr (!Epi::AFTER_DRAIN) { E(acc, cur, wr, wc, fr, fq); S.done(cur); } }
        if (!has_next) break;
        if (!keep)
#pragma unroll
        for (int a = 0; a < 2; ++a)
#pragma unroll
            for (int b = 0; b < 2; ++b)
#pragma unroll
                for (int m = 0; m < 4; ++m)
#pragma unroll
                    for (int n = 0; n < 2; ++n) acc[a][b][m][n] = (f32x4){0.f, 0.f, 0.f, 0.f};
        cur = nxt; cA = nA; cB = nB; ++ui;
        if constexpr (ALIGN_EPI) { if (wr == 1) PG8_BAR; }
    }
    PG8_WAIT_V(0);
    if constexpr (!ALIGN_EPI) { if (wr == 0) PG8_BAR; }
    PG8_BAR;
    if constexpr (Epi::AFTER_DRAIN) { E.fused(acc, cur, wr, wc, fr, fq, lds, wid, lane); S.done(cur); }
#undef PG8_SA
#undef PG8_SB
#undef PG8_STAGE
#undef PG8_LDA
#undef PG8_LDB
#undef PG8_MMA
#undef PG8_WAIT_V
#undef PG8_WAIT_L
#undef PG8_BAR
#undef PG8_SCHED
}
}

#include <hip/hip_cooperative_groups.h>
namespace cg = cooperative_groups;
typedef unsigned short bf16;
typedef unsigned v4u __attribute__((ext_vector_type(4)));
typedef unsigned v2u __attribute__((ext_vector_type(2)));
typedef float f32x4 __attribute__((ext_vector_type(4)));
typedef float f32x2 __attribute__((ext_vector_type(2)));
typedef short bf16x8 __attribute__((ext_vector_type(8)));

constexpr int NT = 512, NWAVES = 8;
constexpr int MR = 16384, MP = 16640;
constexpr int NIN = 3840;
constexpr int NQ = 65;
constexpr float EPS = 1e-5f;
constexpr size_t MiB = 1u << 20;
constexpr size_t WS_SS    = 0;
constexpr size_t WS_DEC   = 256 * 1024;
constexpr size_t WS_A1    = 288 * 1024;
constexpr size_t WS_A16   = 320 * 1024;
constexpr size_t WS_BAR   = 384 * 1024;
constexpr size_t WS_BBAR  = 512 * 1024;
constexpr size_t WS_UMETA = 1 * MiB;
constexpr size_t WS_DTRAW = 1 * MiB + 512 * 1024;
constexpr size_t WS_DT    = 2 * MiB + 640 * 1024;
constexpr size_t WS_ACS   = 254 * MiB + 512 * 1024;
static_assert(WS_DTRAW + 16640 * 16 * 4 <= WS_DT && WS_DT + 65 * 16 * 256 * 4 <= 4 * MiB && WS_ACS + 65 * 16 * 256 * 4 <= 256 * MiB, "smalls");
constexpr size_t WS_WGLU  = 4 * MiB;
constexpr size_t WS_TB5   = 8 * MiB;
constexpr size_t WS_TE5   = 20 * MiB;
constexpr size_t WS_WIN   = 28 * MiB;
constexpr size_t WS_PREV  = 20 * MiB;
constexpr size_t WS_WOUT  = 8 * MiB, WS_WUP = 12 * MiB, WS_WDN = 20 * MiB;
constexpr size_t WS_MIX   = 36 * MiB;
constexpr size_t WS_UA    = 100 * MiB;
constexpr size_t WS_XBCP  = 148 * MiB;
constexpr size_t WS_SEND  = 148 * MiB;
constexpr size_t WS_ST    = 180 * MiB;
constexpr size_t WS_Y5    = 148 * MiB;
constexpr size_t WS_XN    = 197 * MiB;
constexpr size_t WS_XF    = 197 * MiB;
constexpr size_t WS_H1B   = 197 * MiB;
constexpr size_t WS_CT    = 230 * MiB;
constexpr size_t WS_BTK   = WS_CT + 65 * 65536 * 2;
constexpr size_t WS_BF    = WS_BTK + 65 * 65536 * 2;
constexpr size_t WS_HB    = 36 * MiB;
static_assert(WS_BF + 65 * 65536 * 2 <= WS_ACS, "ws");
constexpr int LDS_BYTES = 155648;

__device__ __forceinline__ unsigned f2bf(float f) { unsigned u = __builtin_bit_cast(unsigned, f); return (u + 0x7fffu + ((u >> 16) & 1u)) >> 16; }
__device__ __forceinline__ unsigned pk2(float lo, float hi) { unsigned r; asm("v_cvt_pk_bf16_f32 %0, %1, %2" : "=v"(r) : "v"(lo), "v"(hi)); return r; }
__device__ __forceinline__ float bf2f(unsigned short h) { return __builtin_bit_cast(float, (unsigned)h << 16); }
__device__ __forceinline__ float bflo(unsigned w) { return __builtin_bit_cast(float, w << 16); }
__device__ __forceinline__ float bfhi(unsigned w) { return __builtin_bit_cast(float, w & 0xffff0000u); }
__device__ __forceinline__ float ex2(float x) { return __builtin_amdgcn_exp2f(x); }
__device__ __forceinline__ float expf_(float x) { return __builtin_amdgcn_exp2f(1.44269504f * x); }
__device__ __forceinline__ float wave_sum(float v) {
#pragma unroll
    for (int o = 1; o < 64; o <<= 1) v += __shfl_xor(v, o);
    return v;
}

#define LAS __attribute__((address_space(3)))
#define XB_TMO      128
#define XB_XCNT(j)  (256  + 64 * (j))
#define XB_XSUB(j)  (1280 + 64 * (j))
#define XB_XGEN(j)  (2304 + 64 * (j))
#define XB_TOP      3328
#define XB_TOPGEN   3392
#define XCD_BAR_WORDS 3456
#define XB_SPIN_CAP (1u << 18)

__device__ __forceinline__ unsigned xb_ld(unsigned* p)              { return __hip_atomic_load(p, __ATOMIC_RELAXED, __HIP_MEMORY_SCOPE_AGENT); }
__device__ __forceinline__ unsigned xb_add(unsigned* p, unsigned v) { return __hip_atomic_fetch_add(p, v, __ATOMIC_RELAXED, __HIP_MEMORY_SCOPE_AGENT); }
__device__ __forceinline__ unsigned xb_xcc_id() { return (unsigned)__builtin_amdgcn_s_getreg((3 << 11) | 20) & 0xFu; }
#define XB_SPIN(cond, bar) do { unsigned _sp = 0; while (cond) { __builtin_amdgcn_s_sleep(1); \
    if ((++_sp & 255u) == 0u) { if (xb_ld(&(bar)[XB_TMO])) break; if (_sp > XB_SPIN_CAP) { atomicAdd(&(bar)[XB_TMO], 1u); break; } } } } while (0)

struct XcdBarrier {
    unsigned* bar; unsigned x;
    volatile LAS unsigned* st;
};

__device__ __forceinline__ XcdBarrier xcd_barrier_post(unsigned* bar, volatile LAS unsigned* st) {
    XcdBarrier b; b.bar = bar; b.x = xb_xcc_id(); b.st = st;
    if (threadIdx.x == 0) (void)xb_add(&bar[XB_XCNT(b.x)], 1u);
    return b;
}
__device__ __forceinline__ void xcd_barrier_complete(unsigned* bar, unsigned x, unsigned& nloc, unsigned& nx) {
    const unsigned G = gridDim.x * gridDim.y * gridDim.z;
    unsigned sum, cnt, mine, sp = 0u;
    for (;;) {
        sum = 0u; cnt = 0u; mine = 0u;
#pragma unroll
        for (unsigned j = 0; j < 16; ++j) { const unsigned c = xb_ld(&bar[XB_XCNT(j)]); sum += c; cnt += (c > 0u) ? 1u : 0u; mine = (j == x) ? c : mine; }
        if (sum == G) break;
        __builtin_amdgcn_s_sleep(1);
        if ((++sp & 255u) == 0u) { if (xb_ld(&bar[XB_TMO])) break; if (sp > XB_SPIN_CAP) { atomicAdd(&bar[XB_TMO], 1u); break; } }
    }
    nloc = mine > 0u ? mine : 1u; nx = cnt > 0u ? cnt : 1u;
}

__device__ __forceinline__ void xcd_barrier(const XcdBarrier& b) {
    asm volatile("s_waitcnt vmcnt(0)" ::: "memory");
    __syncthreads();
    if (threadIdx.x == 0) {
        unsigned* bar = b.bar;
        __builtin_amdgcn_s_waitcnt(0);
        unsigned nloc = b.st[0], nx = b.st[1];
        if (nloc == 0u) { xcd_barrier_complete(bar, b.x, nloc, nx); b.st[0] = nloc; b.st[1] = nx; }
        const unsigned old = xb_add(&bar[XB_XSUB(b.x)], 1u);
        const unsigned gen = old / nloc;
        if (old + 1u == (gen + 1u) * nloc) {
            __builtin_amdgcn_fence(__ATOMIC_RELEASE, "agent");
            asm volatile("s_waitcnt vmcnt(0)" ::: "memory");
            const unsigned og = xb_add(&bar[XB_TOP], 1u);
            const unsigned tg = og / nx;
            if (og + 1u == (tg + 1u) * nx) xb_add(&bar[XB_TOPGEN], 1u);
            else XB_SPIN(xb_ld(&bar[XB_TOPGEN]) == tg, bar);
            __builtin_amdgcn_fence(__ATOMIC_ACQUIRE, "agent");
            xb_add(&bar[XB_XGEN(b.x)], 1u);
            asm volatile("s_waitcnt vmcnt(0)" ::: "memory");
        } else {
            XB_SPIN(xb_ld(&bar[XB_XGEN(b.x)]) == gen, bar);
            __builtin_amdgcn_fence(__ATOMIC_ACQUIRE, "agent");
            asm volatile("s_waitcnt vmcnt(0)" ::: "memory");
        }
    }
    __syncthreads();
}

struct Args {
    const float* in[26]; float* out; unsigned char* ws; int ph_lo, ph_hi;
};
enum { I_X = 0, I_META, I_GMIX, I_WIN, I_CONVW, I_CONVB, I_DTB, I_ALOG, I_DSSD, I_GSSD, I_LRE, I_LIM, I_LSTEP, I_BRE, I_BIM, I_CRE, I_CIM, I_DS5, I_WGLU, I_BGLU, I_GS5, I_WOUT, I_GMLP, I_WUP, I_WDN, I_GFIN };

template <int MODE> __device__ __forceinline__ int colmap(int j) {
    if (MODE == 1) { if (j < 2560) return j; if (j < 3584) return j + 16; if (j < 3600) return j - 1024; return -1; }
    if (MODE == 2) { const int pn = j >> 8, r = j & 255; return r < 128 ? pn * 128 + r : 1024 + pn * 128 + (r - 128); }
    return j;
}
template <int MODE> __device__ __forceinline__ void transpose_item(const float* W, int K, int N, bf16* WT, const float* ks0, const float* ks1, float* scr, int item, int nblk, int lane) {
    const int kb = item / nblk, nb = item % nblk, k0 = 64 * kb, n0 = 32 * nb;
    const int src = colmap<MODE>(n0 + (lane & 31));
#pragma unroll
    for (int i = 0; i < 32; ++i) { const int kk = 2 * i + (lane >> 5); const int k = k0 + kk;
        float v = src >= 0 ? W[(size_t)k * N + src] : 0.f;
        if (ks0) v *= (k < 1024 ? ks0[k] : ks1[k - 1024]);
        scr[kk * 33 + (lane & 31)] = v; }
    asm volatile("s_waitcnt lgkmcnt(0)" ::: "memory");
    const int c = lane & 7;
#pragma unroll
    for (int j = 0; j < 4; ++j) { const int n = (lane >> 3) + 8 * j; const float* s = scr + (8 * c) * 33 + n;
        v4u o; o.x = pk2(s[0 * 33], s[1 * 33]); o.y = pk2(s[2 * 33], s[3 * 33]); o.z = pk2(s[4 * 33], s[5 * 33]); o.w = pk2(s[6 * 33], s[7 * 33]);
        *(v4u*)(WT + (size_t)(n0 + n) * K + k0 + 8 * c) = o; }
    asm volatile("s_waitcnt lgkmcnt(0)" ::: "memory");
}

__device__ __forceinline__ void sincos_d(double th, float& sn, float& cs) {
    const double k = rint(th * 0.15915494309189535); const double r = fma(-k, 6.283185307179586, th);
    const double t = r * 0.125, t2 = t * t;
    double s = t * (1.0 + t2 * (-1.0 / 6 + t2 * (1.0 / 120 + t2 * (-1.0 / 5040 + t2 * (1.0 / 362880 + t2 * (-1.0 / 39916800))))));
    double c = 1.0 + t2 * (-0.5 + t2 * (1.0 / 24 + t2 * (-1.0 / 720 + t2 * (1.0 / 40320 + t2 * (-1.0 / 3628800 + t2 * (1.0 / 479001600))))));
#pragma unroll
    for (int i = 0; i < 3; ++i) { const double s2 = 2.0 * s * c, c2 = 1.0 - 2.0 * s * s; s = s2; c = c2; }
    sn = (float)s; cs = (float)c;
}

__device__ __forceinline__ void s5_tables(const Args& a, int g, unsigned char* lds, int tid) {
    f32x2* pw = (f32x2*)lds;
    f32x2* Cc = pw + 17 * 64;
    f32x2* Bb = Cc + 16 * 64;
    float* Kt = (float*)(Bb + 64 * 16);
    unsigned char* ws = a.ws;
    if (tid < 64) {
        const int p = tid; const float lr = a.in[I_LRE][g * 64 + p], li = a.in[I_LIM][g * 64 + p]; const float st = expf(a.in[I_LSTEP][g]);
        float are = 1.f, aim = 0.f;
        for (int tau = 0; tau <= 16; ++tau) {
            const float mag = expf(lr * st * (float)tau); float sn, cs; sincos_d((double)li * (double)st * (double)tau, sn, cs);
            pw[tau * 64 + p] = (f32x2){mag * cs, mag * sn};
            if (tau == 1) { are = mag * cs; aim = mag * sn; ((f32x2*)(ws + WS_A1))[g * 64 + p] = (f32x2){are, aim}; }
            if (tau == 16) ((f32x2*)(ws + WS_A16))[g * 64 + p] = (f32x2){mag * cs, mag * sn};
        }
        const float den = lr * lr + li * li;
        const float cre = ((are - 1.0f) * lr + aim * li) / den, cim = (aim * lr - (are - 1.0f) * li) / den;
        f32x4 brv[4], biv[4];
#pragma unroll
        for (int h4 = 0; h4 < 4; ++h4) { brv[h4] = *(const f32x4*)(a.in[I_BRE] + (g * 64 + p) * 16 + 4 * h4); biv[h4] = *(const f32x4*)(a.in[I_BIM] + (g * 64 + p) * 16 + 4 * h4); }
#pragma unroll
        for (int h = 0; h < 16; ++h) { const float br = brv[h >> 2][h & 3], bi = biv[h >> 2][h & 3];
            const f32x2 v = (f32x2){cre * br - cim * bi, cre * bi + cim * br}; Bb[p * 16 + h] = v; ((f32x2*)(ws + WS_BBAR))[(g * 64 + p) * 16 + h] = v; }
    }
    for (int e = tid; e < 1024; e += NT) Cc[e] = (f32x2){a.in[I_CRE][g * 1024 + e], a.in[I_CIM][g * 1024 + e]};
    __syncthreads();
    {
        const int tau = tid >> 5, h = (tid >> 1) & 15, h0 = (tid & 1) * 8; float acc[8];
#pragma unroll
        for (int j = 0; j < 8; ++j) acc[j] = 0.f;
        for (int p = 0; p < 64; ++p) { const f32x2 c = Cc[h * 64 + p], w = pw[tau * 64 + p]; const float tr = c.x * w.x - c.y * w.y, ti = c.x * w.y + c.y * w.x;
#pragma unroll
            for (int j = 0; j < 8; ++j) { const f32x2 b = Bb[p * 16 + h0 + j]; acc[j] += tr * b.x - ti * b.y; } }
        if (tau == 0) {
#pragma unroll
            for (int j = 0; j < 8; ++j) if (h0 + j == h) acc[j] += a.in[I_DS5][g * 16 + h];
        }
#pragma unroll
        for (int j = 0; j < 8; ++j) Kt[(tau * 16 + h) * 16 + h0 + j] = acc[j];
    }
    __syncthreads();
    bf16* TB = (bf16*)(ws + WS_TB5) + (size_t)g * 256 * 384;
    for (int pc = tid; pc < 256 * 48; pc += NT) {
        const int row = pc / 48, c8 = (pc % 48) * 8, t = row >> 4, h = row & 15; float v[8];
        if (c8 < 256) { const int s = c8 >> 4, h0 = c8 & 15;
#pragma unroll
            for (int j = 0; j < 8; ++j) v[j] = s <= t ? Kt[((t - s) * 16 + h) * 16 + h0 + j] : 0.f;
        } else { const int p0 = (c8 - 256) >> 1;
#pragma unroll
            for (int j = 0; j < 4; ++j) { const f32x2 c = Cc[h * 64 + p0 + j], w = pw[(t + 1) * 64 + p0 + j]; v[2 * j] = c.x * w.x - c.y * w.y; v[2 * j + 1] = -(c.x * w.y + c.y * w.x); }
        }
        v4u o; o.x = pk2(v[0], v[1]); o.y = pk2(v[2], v[3]); o.z = pk2(v[4], v[5]); o.w = pk2(v[6], v[7]);
        *(v4u*)(TB + (size_t)row * 384 + c8) = o;
    }
    bf16* TE = (bf16*)(ws + WS_TE5) + (size_t)g * 256 * 256;
    for (int pc = tid; pc < 256 * 32; pc += NT) {
        const int row = pc >> 5, c8 = (pc & 31) * 8; float v[8];
        if (row < 128) { const int p = row >> 1, ri = row & 1, s = c8 >> 4, h0 = c8 & 15; const f32x2 w = pw[(15 - s) * 64 + p];
#pragma unroll
            for (int j = 0; j < 8; ++j) { const f32x2 b = Bb[p * 16 + h0 + j]; v[j] = ri ? (w.x * b.y + w.y * b.x) : (w.x * b.x - w.y * b.y); }
        } else {
#pragma unroll
            for (int j = 0; j < 8; ++j) v[j] = 0.f;
        }
        v4u o; o.x = pk2(v[0], v[1]); o.y = pk2(v[2], v[3]); o.z = pk2(v[4], v[5]); o.w = pk2(v[6], v[7]);
        *(v4u*)(TE + (size_t)row * 256 + c8) = o;
    }
    __syncthreads();
}

__device__ __forceinline__ void rms_row_to_bf16(const float* xrow, const float* gain, bf16* orow, int lane) {
    unsigned long long* o8 = (unsigned long long*)orow + lane;
    if (!xrow) {
#pragma unroll
        for (int j = 0; j < 4; ++j) o8[64 * j] = 0ull;
        return; }
    const f32x4* xr = (const f32x4*)xrow + lane; const f32x4* gr = (const f32x4*)gain + lane;
    f32x4 v[4]; float s = 0.f;
#pragma unroll
    for (int j = 0; j < 4; ++j) { v[j] = xr[64 * j]; s += (v[j].x * v[j].x + v[j].y * v[j].y) + (v[j].z * v[j].z + v[j].w * v[j].w); }
    const float rstd = 1.f / sqrtf(wave_sum(s) * (1.f / 1024.f) + EPS);
#pragma unroll
    for (int j = 0; j < 4; ++j) { const f32x4 gg = gr[64 * j]; const f32x4 w = v[j] * rstd * gg; o8[64 * j] = (unsigned long long)pk2(w.x, w.y) | ((unsigned long long)pk2(w.z, w.w) << 32); }
}

__device__ __forceinline__ void p0_prologue(const Args& a, unsigned char* lds, int tid, int G) {
    unsigned char* ws = a.ws; const int lane = tid & 63, wave = tid >> 6;
    const int gw = blockIdx.x * NWAVES + wave, NGW = G * NWAVES;
    for (int i = blockIdx.x * NT + tid; i < 4 * 16384; i += G * NT) ((float*)(ws + WS_SS))[i] = 0.f;
    for (int g = (G - 1 - (int)blockIdx.x); g < 64; g += G) s5_tables(a, g, lds, tid);
    __syncthreads();
    float* scr = (float*)(lds + wave * 16384);
    constexpr int NB_IN = NIN / 32, NB_GL = 2048 / 32;
    constexpr int I_IN = 16 * NB_IN, I_GL = 16 * NB_GL;
    const int nT = (G > 128) ? G - 64 : G;
    if ((int)blockIdx.x < nT) for (int it = gw; it < I_IN + I_GL; it += nT * NWAVES) {
        if (it < I_IN) transpose_item<1>(a.in[I_WIN], 1024, 3600, (bf16*)(ws + WS_WIN), nullptr, nullptr, scr, it, NB_IN, lane);
        else transpose_item<2>(a.in[I_WGLU], 1024, 2048, (bf16*)(ws + WS_WGLU), nullptr, nullptr, scr, it - I_IN, NB_GL, lane);
    }
    for (int m = gw; m < MP; m += NGW) {
        const float* src = m < MR ? a.in[I_X] + (size_t)m * 1024 : (m < MR + 16 ? a.in[I_META] + (size_t)(m - MR) * 1024 : nullptr);
        rms_row_to_bf16(src, a.in[I_GMIX], (bf16*)(ws + WS_XN) + (size_t)m * 1024, lane);
    }
}
__device__ __forceinline__ void p6_weights(const Args& a, unsigned char* lds, int tid, int G) {
    unsigned char* ws = a.ws; const int lane = tid & 63, wave = tid >> 6;
    const int gw = blockIdx.x * NWAVES + wave, NGW = G * NWAVES;
    float* scr = (float*)(lds + wave * 16384);
    constexpr int I_O = 32 * 32, I_U = 16 * 128, I_D = 64 * 32;
    for (int it = gw; it < I_O + I_U + I_D; it += NGW) {
        if (it < I_O) transpose_item<0>(a.in[I_WOUT], 2048, 1024, (bf16*)(ws + WS_WOUT), a.in[I_GSSD], a.in[I_GS5], scr, it, 32, lane);
        else if (it < I_O + I_U) transpose_item<0>(a.in[I_WUP], 1024, 4096, (bf16*)(ws + WS_WUP), a.in[I_GMLP], a.in[I_GMLP], scr, it - I_O, 128, lane);
        else transpose_item<0>(a.in[I_WDN], 4096, 1024, (bf16*)(ws + WS_WDN), nullptr, nullptr, scr, it - I_O - I_U, 32, lane);
    }
    __syncthreads();
}

__device__ __forceinline__ int chunk_row(int q, int tok) {
    if (q == 0) return tok < 240 ? -1 : MR + (tok - 240);
    const int b = (q - 1) >> 5, c = (q - 1) & 31;
    if (tok < 0 && c == 0) return MR + 16 + tok;
    return b * 8192 + c * 256 + tok;
}
__device__ __forceinline__ float silu_(float x) { return x * __builtin_amdgcn_rcpf(1.0f + ex2(-1.44269504f * x)); }
__device__ __forceinline__ void p2_conv_unit(const Args& a, int q, int blk, unsigned char* lds, int tid) {
    unsigned char* ws = a.ws;
    bf16* IN = (bf16*)lds;
    bf16* OT = (bf16*)(lds + 40960);
    const bf16* XBCP = (const bf16*)(ws + WS_XBCP);
    const int ch0 = blk * 64;
    for (int pc = tid; pc < 259 * 8; pc += NT) { const int rr = pc >> 3, c8 = (pc & 7) * 8; const int row = chunk_row(q, rr - 3);
        v4u v = (v4u){0u, 0u, 0u, 0u}; if (row >= 0) v = *(const v4u*)(XBCP + (size_t)row * 1536 + ch0 + c8);
        *(v4u*)(IN + rr * 64 + c8) = v; }
    __syncthreads();
    const float* cw = a.in[I_CONVW]; const float* cb = a.in[I_CONVB];
    const bool is_x = blk < 16, is_b = blk >= 16 && blk < 20;
    if (!is_x) {
        bf16* dst = (bf16*)(ws + (is_b ? WS_BTK : WS_CT)) + (size_t)q * 65536 + (is_b ? (blk - 16) : (blk - 20)) * 64;
        const int c8 = (tid & 7) * 8; float wreg[4][8], breg[8];
#pragma unroll
        for (int j = 0; j < 8; ++j) { breg[j] = cb[ch0 + c8 + j];
#pragma unroll
            for (int k = 0; k < 4; ++k) wreg[k][j] = cw[k * 1536 + ch0 + c8 + j]; }
        for (int pc = tid; pc < 256 * 8; pc += NT) { const int tok = pc >> 3; float o[8];
            const bool zero = (q == 0 && tok < 240);
#pragma unroll
            for (int j = 0; j < 8; ++j) o[j] = breg[j];
#pragma unroll
            for (int k = 0; k < 4; ++k) { const v4u v = *(const v4u*)(IN + (tok + k) * 64 + c8); const unsigned w[4] = {v.x, v.y, v.z, v.w};
#pragma unroll
                for (int j = 0; j < 4; ++j) { o[2 * j] += wreg[k][2 * j] * bflo(w[j]); o[2 * j + 1] += wreg[k][2 * j + 1] * bfhi(w[j]); } }
#pragma unroll
            for (int j = 0; j < 8; ++j) o[j] = zero ? 0.f : silu_(o[j]);
            v4u ov; ov.x = pk2(o[0], o[1]); ov.y = pk2(o[2], o[3]); ov.z = pk2(o[4], o[5]); ov.w = pk2(o[6], o[7]);
            *(v4u*)(dst + (size_t)tok * 256 + c8) = ov; }
    }
    if (is_x || is_b) {
        const int ch = tid & 63; float wk[4]; const float bias = cb[ch0 + ch];
#pragma unroll
        for (int k = 0; k < 4; ++k) wk[k] = cw[k * 1536 + ch0 + ch];
        for (int it = tid; it < 64 * 32; it += NT) { const int t0 = (it >> 6) * 8; float in[11], o[8];
#pragma unroll
            for (int j = 0; j < 11; ++j) in[j] = bf2f(IN[(t0 + j) * 64 + ch]);
#pragma unroll
            for (int j = 0; j < 8; ++j) { const float v = bias + wk[0] * in[j] + wk[1] * in[j + 1] + wk[2] * in[j + 2] + wk[3] * in[j + 3]; o[j] = (q == 0 && t0 + j < 240) ? 0.f : silu_(v); }
            v4u ov; ov.x = pk2(o[0], o[1]); ov.y = pk2(o[2], o[3]); ov.z = pk2(o[4], o[5]); ov.w = pk2(o[6], o[7]);
            *(v4u*)(OT + ch * 264 + t0) = ov; }
        __syncthreads();
        bf16* dst = is_x ? (bf16*)(ws + WS_XF) + ((size_t)q * 1024 + ch0) * 256 : (bf16*)(ws + WS_BF) + ((size_t)q * 256 + (blk - 16) * 64) * 256;
        for (int pc = tid; pc < 64 * 32; pc += NT) { const int ch = pc >> 5, t8 = (pc & 31) * 8; *(v4u*)(dst + (size_t)ch * 256 + t8) = *(const v4u*)(OT + ch * 264 + t8); }
    }
    __syncthreads();
}
__device__ __forceinline__ void p2_dt_item(const Args& a, int q, int h, int lane) {
    unsigned char* ws = a.ws; const float* DTRAW = (const float*)(ws + WS_DTRAW);
    const float bias = a.in[I_DTB][h], A = -expf(a.in[I_ALOG][h]);
    float dt[4], cs[4]; float run = 0.f;
#pragma unroll
    for (int j = 0; j < 4; ++j) { const int tok = 4 * lane + j; const int row = chunk_row(q, tok);
        float d = 0.f; if (row >= 0) { const float x = DTRAW[(size_t)row * 16 + h] + bias; d = fmaxf(x, 0.f) + __logf(1.0f + expf_(-fabsf(x))); }
        dt[j] = d; run += d * A; cs[j] = run; }
    float incl = run;
#pragma unroll
    for (int o = 1; o < 64; o <<= 1) { const float t = __shfl_up(incl, o); if (lane >= o) incl += t; }
    const float excl = incl - run;
    float* DT = (float*)(ws + WS_DT) + ((size_t)q * 16 + h) * 256 + 4 * lane; float* ACS = (float*)(ws + WS_ACS) + ((size_t)q * 16 + h) * 256 + 4 * lane;
    *(f32x4*)DT = (f32x4){dt[0], dt[1], dt[2], dt[3]}; *(f32x4*)ACS = (f32x4){cs[0] + excl, cs[1] + excl, cs[2] + excl, cs[3] + excl};
    if (lane == 63) ((float*)(ws + WS_DEC))[q * 16 + h] = expf_(cs[3] + excl);
}

#define MFMA16(A, B, C) __builtin_amdgcn_mfma_f32_16x16x32_bf16(A, B, C, 0, 0, 0)
__device__ __forceinline__ void p3_states_unit(const Args& a, int q, int g, int nh, int tid) {
    unsigned char* ws = a.ws; const int lane = tid & 63, r = tid >> 6, h = g * 8 + r, fr = lane & 15, fq = lane >> 4;
    const bf16* XF = (const bf16*)(ws + WS_XF) + ((size_t)q * 1024 + h * 64) * 256;
    const bf16* BF = (const bf16*)(ws + WS_BF) + ((size_t)q * 256 + g * 128) * 256;
    const float* DT = (const float*)(ws + WS_DT) + ((size_t)q * 16 + h) * 256; const float* ACS = (const float*)(ws + WS_ACS) + ((size_t)q * 16 + h) * 256;
    const float alast = ACS[255];
    bf16* ST = (bf16*)(ws + WS_ST) + ((size_t)q * 16 + h) * 8192;
    {
        f32x4 acc[4][4];
#pragma unroll
        for (int i = 0; i < 4; ++i)
#pragma unroll
            for (int j = 0; j < 4; ++j) acc[i][j] = (f32x4){0.f, 0.f, 0.f, 0.f};
#pragma unroll 2
        for (int kb = 0; kb < 8; ++kb) {
            const int s0 = kb * 32 + fq * 8;
            float w[8];
            { const f32x4 d0 = *(const f32x4*)(DT + s0), d1 = *(const f32x4*)(DT + s0 + 4), c0 = *(const f32x4*)(ACS + s0), c1 = *(const f32x4*)(ACS + s0 + 4);
#pragma unroll
              for (int j = 0; j < 4; ++j) { w[j] = expf_(alast - c0[j]) * d0[j]; w[4 + j] = expf_(alast - c1[j]) * d1[j]; } }
            bf16x8 Af[4], Bf[4];
#pragma unroll
            for (int i = 0; i < 4; ++i) { const v4u v = *(const v4u*)(XF + (size_t)(i * 16 + fr) * 256 + s0);
                v4u o; o.x = pk2(bflo(v.x) * w[0], bfhi(v.x) * w[1]); o.y = pk2(bflo(v.y) * w[2], bfhi(v.y) * w[3]); o.z = pk2(bflo(v.z) * w[4], bfhi(v.z) * w[5]); o.w = pk2(bflo(v.w) * w[6], bfhi(v.w) * w[7]);
                Af[i] = __builtin_bit_cast(bf16x8, o); }
#pragma unroll
            for (int j = 0; j < 4; ++j) Bf[j] = *(const bf16x8*)(BF + (size_t)((nh * 4 + j) * 16 + fr) * 256 + s0);
#pragma unroll
            for (int i = 0; i < 4; ++i)
#pragma unroll
                for (int j = 0; j < 4; ++j) acc[i][j] = MFMA16(Bf[j], Af[i], acc[i][j]);
        }
#pragma unroll
        for (int i = 0; i < 4; ++i)
#pragma unroll
            for (int j = 0; j < 4; ++j) { v2u o; o.x = pk2(acc[i][j][0], acc[i][j][1]); o.y = pk2(acc[i][j][2], acc[i][j][3]);
                *(v2u*)(ST + (i * 16 + fr) * 128 + (nh * 4 + j) * 16 + fq * 4) = o; }
    }
}

__device__ __forceinline__ void p4_ssd_scan_item(const Args& a, int item, int tid) {
    unsigned char* ws = a.ws; const int e = item * 2048 + tid * 4;
    const int b = e >> 17, hpn = e & 131071, h = hpn >> 13;
    const bf16* ST = (const bf16*)(ws + WS_ST); bf16* PREV = (bf16*)(ws + WS_PREV); const float* DEC = (const float*)(ws + WS_DEC);
    v2u st[32]; float dec[32];
    st[0] = *(const v2u*)(ST + hpn); dec[0] = 0.f;
#pragma unroll
    for (int k = 1; k < 32; ++k) { const int q = b * 32 + k; st[k] = *(const v2u*)(ST + (size_t)q * 131072 + hpn); dec[k] = DEC[q * 16 + h]; }
    float s0 = bflo(st[0].x), s1 = bfhi(st[0].x), s2 = bflo(st[0].y), s3 = bfhi(st[0].y);
#pragma unroll
    for (int c = 0; c < 32; ++c) {
        v2u o; o.x = pk2(s0, s1); o.y = pk2(s2, s3); *(v2u*)(PREV + (size_t)(b * 32 + c) * 131072 + hpn) = o;
        if (c < 31) { const float d = dec[c + 1]; const v2u v = st[c + 1];
            s0 = s0 * d + bflo(v.x); s1 = s1 * d + bfhi(v.x); s2 = s2 * d + bflo(v.y); s3 = s3 * d + bfhi(v.y); }
    }
}
__device__ __forceinline__ void p4_s5_scan_item(const Args& a, int item, unsigned char* lds, int tid) {
    unsigned char* ws = a.ws; const int b = item >> 7, g = (item >> 1) & 63, p = (item & 1) * 32 + (tid & 31), seg = tid >> 5;
    const f32x2 a1 = ((const f32x2*)(ws + WS_A1))[g * 64 + p], a16 = ((const f32x2*)(ws + WS_A16))[g * 64 + p];
    const f32x2* Bb = (const f32x2*)(ws + WS_BBAR) + (size_t)(g * 64 + p) * 16;
    const bf16* UM = (const bf16*)(ws + WS_UMETA);
    const f32x2* SE = (const f32x2*)(ws + WS_SEND) + ((size_t)(g * 1024 + b * 512 + seg * 32) * 64 + p);
    f32x2 se[32];
#pragma unroll
    for (int j = 0; j < 32; ++j) se[j] = SE[(size_t)j * 64];
    float sr = 0.f, si = 0.f;
    f32x2 bbv[16];
#pragma unroll
    for (int h = 0; h < 16; ++h) bbv[h] = Bb[h];
    for (int s = 0; s < 16; ++s) { float br = 0.f, bi = 0.f;
        const v4u u0 = *(const v4u*)(UM + s * 1024 + g * 16), u1 = *(const v4u*)(UM + s * 1024 + g * 16 + 8); const unsigned uw[8] = {u0.x, u0.y, u0.z, u0.w, u1.x, u1.y, u1.z, u1.w};
#pragma unroll
        for (int h = 0; h < 16; ++h) { const float u = (h & 1) ? bfhi(uw[h >> 1]) : bflo(uw[h >> 1]); const f32x2 bb = bbv[h]; br += bb.x * u; bi += bb.y * u; }
        const float nr = a1.x * sr - a1.y * si + br, ni = a1.x * si + a1.y * sr + bi; sr = nr; si = ni; }
    float er = 0.f, ei = 0.f;
#pragma unroll
    for (int j = 0; j < 32; ++j) { const float nr = a16.x * er - a16.y * ei + se[j].x, ni = a16.x * ei + a16.y * er + se[j].y; er = nr; ei = ni; }
    f32x2* EL = (f32x2*)lds;
    EL[seg * 32 + (tid & 31)] = (f32x2){er, ei};
    float pr = a16.x, pi = a16.y;
#pragma unroll
    for (int k = 0; k < 5; ++k) { const float nr = pr * pr - pi * pi, ni = 2.f * pr * pi; pr = nr; pi = ni; }
    __syncthreads();
    for (int k = 0; k < seg; ++k) { const f32x2 ek = EL[k * 32 + (tid & 31)]; const float nr = pr * sr - pi * si + ek.x, ni = pr * si + pi * sr + ek.y; sr = nr; si = ni; }
    unsigned* UA = (unsigned*)((bf16*)(ws + WS_UA) + ((size_t)(g * 1024 + b * 512 + seg * 32) * 384 + 256 + 2 * p));
#pragma unroll
    for (int j = 0; j < 32; ++j) { UA[(size_t)j * 192] = pk2(sr, si);
        const float nr = a16.x * sr - a16.y * si + se[j].x, ni = a16.x * si + a16.y * sr + se[j].y; sr = nr; si = ni; }
    __syncthreads();
}

__device__ __forceinline__ void p5_ssd_out_unit(const Args& a, int q, int g, int half, unsigned char* lds, int tid) {
    unsigned char* ws = a.ws; const int lane = tid & 63, r = tid >> 6, h = g * 8 + r, fr = lane & 15, fq = lane >> 4;
    bf16* CBs = (bf16*)lds;
    float* ACSs = (float*)(lds + 256 * 264 * 2);
    float* DTs = ACSs + 8 * 256;
    const bf16* CT = (const bf16*)(ws + WS_CT) + (size_t)q * 65536 + g * 128;
    const bf16* BTK = (const bf16*)(ws + WS_BTK) + (size_t)q * 65536 + g * 128;
    for (int i = tid; i < 2048; i += NT) { ACSs[i] = ((const float*)(ws + WS_ACS))[((size_t)q * 16 + g * 8) * 256 + i]; DTs[i] = ((const float*)(ws + WS_DT))[((size_t)q * 16 + g * 8) * 256 + i]; }
    {
        int cnt = 0;
#pragma unroll 1
        for (int ti = 0; ti < 8; ++ti) {
            const int lt = half ? 4 + ti : (ti < 4 ? ti : 8 + ti);
#pragma unroll 1
            for (int stl = 0; stl <= lt; ++stl, ++cnt) {
                if ((cnt & 7) != r) continue;
                f32x4 c = (f32x4){0.f, 0.f, 0.f, 0.f};
#pragma unroll
                for (int k = 0; k < 4; ++k) { const bf16x8 Af = *(const bf16x8*)(CT + (size_t)(lt * 16 + fr) * 256 + k * 32 + fq * 8);
                    const bf16x8 Bf = *(const bf16x8*)(BTK + (size_t)(stl * 16 + fr) * 256 + k * 32 + fq * 8); c = MFMA16(Af, Bf, c); }
#pragma unroll
                for (int e = 0; e < 4; ++e) CBs[(lt * 16 + fq * 4 + e) * 264 + stl * 16 + fr] = (bf16)f2bf(c[e]);
            }
        }
    }
    __syncthreads();
    const bf16* XF = (const bf16*)(ws + WS_XF) + ((size_t)q * 1024 + h * 64) * 256;
    const bf16* PREV = (const bf16*)(ws + WS_PREV) + ((size_t)(q - 1) * 16 + h) * 8192;
    const float* acs = ACSs + r * 256; const float* dts = DTs + r * 256;
    const float dsk = a.in[I_DSSD][h];
    const int b = (q - 1) >> 5, c = (q - 1) & 31; const int m0 = b * 8192 + c * 256;
    bf16* MIX = (bf16*)(ws + WS_MIX); float* SSS = (float*)(ws + WS_SS);
#pragma unroll 1
    for (int lbi = 0; lbi < 2; ++lbi) {
        const int lb = half ? 1 + lbi : 3 * lbi;
        f32x4 acc[4][4];
#pragma unroll
        for (int i = 0; i < 4; ++i)
#pragma unroll
            for (int j = 0; j < 4; ++j) acc[i][j] = (f32x4){0.f, 0.f, 0.f, 0.f};
#pragma unroll 2
        for (int k = 0; k < 4; ++k) { bf16x8 Af[4], Bf[4];
#pragma unroll
            for (int i = 0; i < 4; ++i) Af[i] = *(const bf16x8*)(CT + (size_t)(lb * 64 + i * 16 + fr) * 256 + k * 32 + fq * 8);
#pragma unroll
            for (int j = 0; j < 4; ++j) Bf[j] = *(const bf16x8*)(PREV + (size_t)(j * 16 + fr) * 128 + k * 32 + fq * 8);
#pragma unroll
            for (int i = 0; i < 4; ++i)
#pragma unroll
                for (int j = 0; j < 4; ++j) acc[i][j] = MFMA16(Bf[j], Af[i], acc[i][j]); }
#pragma unroll
        for (int i = 0; i < 4; ++i) { const float sc = expf_(acs[lb * 64 + i * 16 + fr]);
#pragma unroll
            for (int j = 0; j < 4; ++j) acc[i][j] *= sc; }
        const int nsb = 2 * lb + 2;
#pragma unroll 1
        for (int sb = 0; sb < nsb; ++sb) {
            const int s0 = sb * 32 + fq * 8;
            bf16x8 Bf[4];
#pragma unroll
            for (int j = 0; j < 4; ++j) Bf[j] = *(const bf16x8*)(XF + (size_t)(j * 16 + fr) * 256 + s0);
            float as[8], ds[8];
#pragma unroll
            for (int j = 0; j < 8; ++j) { as[j] = acs[s0 + j]; ds[j] = dts[s0 + j]; }
            float fs[8];
#pragma unroll
            for (int j = 0; j < 8; ++j) fs[j] = expf_(as[7] - as[j]) * ds[j];
#pragma unroll
            for (int i = 0; i < 4; ++i) {
                const int l = lb * 64 + i * 16 + fr;
                if (sb * 32 > lb * 64 + i * 16 + 15) continue;
                const float al = acs[l];
                const v4u v = *(const v4u*)(CBs + l * 264 + s0); const unsigned w4[4] = {v.x, v.y, v.z, v.w}; float pv[8];
                if (sb * 32 + 31 < lb * 64 + i * 16) {
                    const float gl = expf_(al - as[7]);
#pragma unroll
                    for (int j = 0; j < 4; ++j) { pv[2 * j] = bflo(w4[j]) * (gl * fs[2 * j]); pv[2 * j + 1] = bfhi(w4[j]) * (gl * fs[2 * j + 1]); }
                } else
#pragma unroll
                for (int j = 0; j < 4; ++j) {
                    const float p0 = bflo(w4[j]) * expf_(fminf(al - as[2 * j], 0.f)) * ds[2 * j], p1 = bfhi(w4[j]) * expf_(fminf(al - as[2 * j + 1], 0.f)) * ds[2 * j + 1];
                    const int sa = s0 + 2 * j, sbq = sa + 1;
                    pv[2 * j] = (sa < l) ? p0 : (sa == l ? p0 + dsk : 0.f); pv[2 * j + 1] = (sbq < l) ? p1 : (sbq == l ? p1 + dsk : 0.f); }
                v4u o; o.x = pk2(pv[0], pv[1]); o.y = pk2(pv[2], pv[3]); o.z = pk2(pv[4], pv[5]); o.w = pk2(pv[6], pv[7]);
                const bf16x8 Af = __builtin_bit_cast(bf16x8, o);
#pragma unroll
                for (int j = 0; j < 4; ++j) acc[i][j] = MFMA16(Bf[j], Af, acc[i][j]);
            }
        }
#pragma unroll
        for (int i = 0; i < 4; ++i) {
            const int l = lb * 64 + i * 16 + fr; float ssq = 0.f;
            bf16* zrow = MIX + (size_t)(m0 + l) * 2048 + h * 64 + fq * 4;
#pragma unroll
            for (int j = 0; j < 4; ++j) {
                const v2u zv = *(const v2u*)(zrow + j * 16);
                const float y0 = acc[i][j][0] * silu_(bflo(zv.x)), y1 = acc[i][j][1] * silu_(bfhi(zv.x)), y2 = acc[i][j][2] * silu_(bflo(zv.y)), y3 = acc[i][j][3] * silu_(bfhi(zv.y));
                v2u o; o.x = pk2(y0, y1); o.y = pk2(y2, y3); *(v2u*)(zrow + j * 16) = o;
                ssq += (y0 * y0 + y1 * y1) + (y2 * y2 + y3 * y3);
            }
            ssq += __shfl_xor(ssq, 16); ssq += __shfl_xor(ssq, 32);
            if (fq == 0) atomicAdd(SSS + m0 + l, ssq);
        }
    }
    __syncthreads();
}

__device__ __forceinline__ void p10_final(const Args& a, int tid, int G) {
    const int lane = tid & 63, wave = tid >> 6; const int gw = blockIdx.x * NWAVES + wave, NGW = G * NWAVES;
    const float* SSF = (const float*)(a.ws + WS_SS) + 3 * 16384; const f32x4* gf = (const f32x4*)a.in[I_GFIN] + lane;
    for (int m = gw; m < MR; m += NGW) { f32x4* row = (f32x4*)(a.out + (size_t)m * 1024) + lane; const float rs = 1.0f / sqrtf(SSF[m] * (1.0f / 1024.0f) + EPS);
#pragma unroll
        for (int j = 0; j < 4; ++j) row[64 * j] = row[64 * j] * rs * gf[64 * j]; }
}

__global__ void __launch_bounds__(NT, 2) fwd_kernel(Args args) {
    extern __shared__ __attribute__((aligned(16))) unsigned char lds[];
    cg::grid_group grid = cg::this_grid();
    const int tid = threadIdx.x, G = gridDim.x, bx = blockIdx.x;
    unsigned char* ws = args.ws;
    PG8_LAS unsigned char* ldsl = (PG8_LAS unsigned char*)lds;
    const int lo = args.ph_lo, hi = args.ph_hi;
#ifndef SKIPMASK
#define SKIPMASK 0
#endif
#define IN(k) (!((SKIPMASK >> (k)) & 1) && lo <= (k) && (k) < hi)
    volatile LAS unsigned* bst = (volatile LAS unsigned*)(ldsl + 155136);
    if (tid < 2) bst[tid] = 0u;
    __syncthreads();
    XcdBarrier xbar = xcd_barrier_post((unsigned*)(ws + WS_BAR), bst);
#define SEAM(k) do { if (IN(k) && IN((k) + 1)) { if ((k) == 0) grid.sync(); else xcd_barrier(xbar); } } while (0)
    float* SS = (float*)(ws + WS_SS);
    if (IN(0)) { const int tid = pg8::fresh_tid(); p0_prologue(args, lds, tid, G); }
    SEAM(0);
    if (IN(1)) {
        pg8::Gemm g{(const bf16*)(ws + WS_XN), (const bf16*)(ws + WS_WIN), MP, NIN, 1024, 1024, 1024, 0, 0}; pg8::StaticOrder S; S.init(MP, NIN, G, bx);
        pg8::EpiInProj E{(bf16*)(ws + WS_MIX), (bf16*)(ws + WS_XBCP), (bf16*)(ws + WS_UA), (bf16*)(ws + WS_UMETA), (float*)(ws + WS_DTRAW)};
        pg8::gemm_phase<pg8::EpiInProj, pg8::StaticOrder, true, true>(ldsl, g, S, E);
    }
    SEAM(1);
    if (IN(2)) {
        const int tid = pg8::fresh_tid(), wave = tid >> 6, lane = tid & 63;
        for (int u = bx; u < NQ * 24; u += G) p2_conv_unit(args, u / 24, u % 24, lds, tid);
        for (int it = bx * NWAVES + wave; it < NQ * 16; it += G * NWAVES) p2_dt_item(args, it >> 4, it & 15, lane);
    }
    SEAM(2);
    const int nS3 = (G / 2 < 126) ? G / 2 : 126;
    if (IN(3)) {
        const int tid = pg8::fresh_tid();
        for (int u = bx; u < 252; u += G) { const int qi = u >> 2; p3_states_unit(args, qi < 32 ? qi : qi + 1, (u >> 1) & 1, u & 1, tid); }
        pg8::Gemm g{(const bf16*)(ws + WS_UA), (const bf16*)(ws + WS_TE5), 1024, 256, 256, 384, 256, (size_t)1024 * 384 * 2, (size_t)256 * 256 * 2};
        pg8::BatchOrder S; S.init(256, 4, G, 0, bx);
        pg8::EpiS5a E{(float*)(ws + WS_SEND)};
        pg8::gemm_phase<pg8::EpiS5a, pg8::BatchOrder, true, true>(ldsl, g, S, E);
    }
    SEAM(3);
    if (IN(4)) {
        const int tid = pg8::fresh_tid();
        for (int it = bx; it < 384; it += G) { if (it < 256) p4_s5_scan_item(args, it, lds, tid); else p4_ssd_scan_item(args, it - 256, tid); }
    }
    SEAM(4);
    if (IN(5)) {
        const int tid = pg8::fresh_tid();
#ifndef NO_SSDOUT
        for (int u = bx; u < 256; u += G) p5_ssd_out_unit(args, 1 + (u >> 2), (u >> 1) & 1, u & 1, lds, tid);
        __syncthreads();
#endif
        pg8::Gemm g{(const bf16*)(ws + WS_UA), (const bf16*)(ws + WS_TB5), 1024, 256, 384, 384, 384, (size_t)1024 * 384 * 2, (size_t)256 * 384 * 2};
        pg8::BatchOrder S; S.init(256, 4, G, 0, bx);
        pg8::EpiS5b E{(bf16*)(ws + WS_Y5)};
        pg8::gemm_phase<pg8::EpiS5b, pg8::BatchOrder, true, true>(ldsl, g, S, E);
    }
    SEAM(5);
    if (IN(6)) {
        const int tid = pg8::fresh_tid();
        p6_weights(args, lds, tid, G);
        pg8::Gemm g{(const bf16*)(ws + WS_Y5), (const bf16*)(ws + WS_WGLU), MR, 2048, 1024, 1024, 1024, 0, 0}; pg8::StaticOrder S; S.init(MR, 2048, G, bx);
        pg8::EpiGlu E{(bf16*)(ws + WS_MIX), args.in[I_BGLU], SS + 16384};
        pg8::gemm_phase<pg8::EpiGlu, pg8::StaticOrder, true, true>(ldsl, g, S, E);
    }
    SEAM(6);
    if (IN(7)) {
        pg8::Gemm g{(const bf16*)(ws + WS_MIX), (const bf16*)(ws + WS_WOUT), MR, 1024, 1024, 2048, 2048, 0, 0, (size_t)1024 * 2, (size_t)1024 * 2};
        pg8::SplitKOrder S; S.base.init(MR, 1024, G, bx);
        pg8::EpiOut E{args.in[I_X], args.out, (bf16*)(ws + WS_H1B), SS, SS + 16384, SS + 2 * 16384};
        pg8::gemm_phase<pg8::EpiOut, pg8::SplitKOrder, true, true>(ldsl, g, S, E);
    }
    SEAM(7);
    if (IN(8)) {
        pg8::Gemm g{(const bf16*)(ws + WS_H1B), (const bf16*)(ws + WS_WUP), MR, 4096, 1024, 1024, 1024, 0, 0}; pg8::StaticOrder S; S.init(MR, 4096, G, bx);
        pg8::EpiUp E{(bf16*)(ws + WS_HB), SS + 2 * 16384};
        pg8::gemm_phase<pg8::EpiUp, pg8::StaticOrder, true, true>(ldsl, g, S, E);
    }
    SEAM(8);
    const int fused_fin = (G == 256 && lo <= 9 && hi >= 11) ? 1 : 0;
    if (IN(9)) {
        pg8::Gemm g{(const bf16*)(ws + WS_HB), (const bf16*)(ws + WS_WDN), MR, 1024, 4096, 4096, 4096, 0, 0}; pg8::StaticOrder S; S.init(MR, 1024, G, bx);
        pg8::EpiDown E{args.out, SS + 3 * 16384, (unsigned*)(ws + WS_BAR) + 3584, args.in[I_GFIN], fused_fin};
        pg8::gemm_phase<pg8::EpiDown, pg8::StaticOrder, true, true>(ldsl, g, S, E);
    }
    if (!fused_fin) {
        SEAM(9);
        if (IN(10)) { const int tid = pg8::fresh_tid(); p10_final(args, tid, G); }
    }
#undef IN
#undef SEAM
}

#ifndef N_LAUNCHES
#define N_LAUNCHES 1
#endif
extern "C" void kernel_launch(void* const* d_in, const int* in_sizes, int n_in, void* d_out, int out_size, void* d_ws, size_t ws_size, hipStream_t stream) {
    static int grid = 0;
    if (grid == 0) {
        int dev = 0, cus = 0, per_cu = 0;
        hipGetDevice(&dev); hipDeviceGetAttribute(&cus, hipDeviceAttributeMultiprocessorCount, dev);
        hipFuncSetAttribute((const void*)fwd_kernel, hipFuncAttributeMaxDynamicSharedMemorySize, LDS_BYTES);
        hipOccupancyMaxActiveBlocksPerMultiprocessor(&per_cu, (const void*)fwd_kernel, NT, LDS_BYTES);
        if (per_cu < 1) { fprintf(stderr, "occupancy query says %d blocks per CU\n", per_cu); per_cu = 1; }
        grid = cus * 1;
        (void)hipGetLastError();
    }
    hipMemsetAsync((char*)d_ws + WS_BAR, 0, 16384, stream);
    Args a{};
    for (int i = 0; i < 26; ++i) a.in[i] = (const float*)d_in[i];
    a.out = (float*)d_out; a.ws = (unsigned char*)d_ws;
    if (N_LAUNCHES == 1) {
        a.ph_lo = 0; a.ph_hi = 11;
        void* args[] = {&a};
        hipError_t e = hipLaunchCooperativeKernel((const void*)fwd_kernel, dim3(grid), dim3(NT), args, LDS_BYTES, stream);
        if (e != hipSuccess) fprintf(stderr, "cooperative launch failed: %s (grid %d)\n", hipGetErrorString(e), grid);
    } else {
        for (int p = 0; p < 11; ++p) { a.ph_lo = p; a.ph_hi = p + 1; hipLaunchKernelGGL(fwd_kernel, dim3(grid), dim3(NT), LDS_BYTES, stream, a); }
    }
}
```

```cpp
#include <hip/hip_runtime.h>
#include <cstdio>
#include <cstdint>
namespace pg8 {
#define PG8_LAS __attribute__((address_space(3)))
typedef unsigned short bf16_t;
typedef short bf16x8 __attribute__((ext_vector_type(8)));
typedef float f32x4 __attribute__((ext_vector_type(4)));
typedef unsigned u32x4 __attribute__((ext_vector_type(4)));
constexpr int BM = 256, BK = 64, HALF = 128, HTB = HALF * BK * 2  , STAGE_BYTES = 8 * HTB, NXCD = 8, WGM = 8;

__host__ __device__ __forceinline__ int lds_byte(int r, int c) { const int st = (r >> 4) * 2 + (c >> 5), rr = r & 15, cc = c & 31, ob = rr * 64 + cc * 2; return st * 1024 + (ob ^ (((ob >> 9) & 1) << 5)); }
__host__ __device__ __forceinline__ void stage_rc(int b, int& R, int& C) { const int st = b / 1024, sb = b % 1024, swz = sb ^ (((sb >> 9) & 1) << 5); R = (st >> 1) * 16 + swz / 64; C = (st & 1) * 32 + (swz % 64) / 2; }
__host__ __device__ __forceinline__ int perm32(int rho) { const int n = rho >> 4, i = rho & 15; return 8 * (i >> 2) + 4 * n + (i & 3); }

struct Unit { int pm, pn, g, par, kh; };
struct Gemm { const bf16_t* A; const bf16_t* Bt; int M, N, K, lda, ldb; size_t gsA, gsB; size_t khA = 0, khB = 0; };

struct StaticOrder {
    int nM, nN, nwg, G, c;
    __host__ __device__ void init(int M, int N, int G_, int c_) { nM = M / BM; nN = N / BM; nwg = nM * nN; G = G_; c = c_; }
    __host__ __device__ bool next(int i, Unit& u) const {
        const long L = (long)i * G + c; if (L >= nwg) return false;
        int wgid = (int)L; { const int q = nwg / NXCD, r = nwg % NXCD, xcd = wgid % NXCD, off = wgid / NXCD; wgid = (xcd < r ? xcd * (q + 1) : r * (q + 1) + (xcd - r) * q) + off; }
        const int nig = WGM * nN, gid = wgid / nig, fm = gid * WGM, gsz = (nM - fm) < WGM ? (nM - fm) : WGM;
        u.pm = fm + ((wgid % nig) % gsz); u.pn = (wgid % nig) / gsz; u.g = 0; u.par = i & 1; u.kh = 0; return true;
    }
    __device__ __forceinline__ void a_ready(const Unit&) const {}
    __device__ __forceinline__ void done(const Unit&) const {}
};

__device__ __forceinline__ unsigned cvt_pk_bf16(float lo, float hi) { unsigned r; asm volatile("v_cvt_pk_bf16_f32 %0, %1, %2" : "=v"(r) : "v"(lo), "v"(hi)); return r; }
typedef float f32x2 __attribute__((ext_vector_type(2)));
__device__ __forceinline__ f32x2 gelu_pk(f32x2 v) {
    const f32x2 av = __builtin_elementwise_abs(v), d = av * 0.2316418882f + 1.0f;
    f32x2 t; t.x = __builtin_amdgcn_rcpf(d.x); t.y = __builtin_amdgcn_rcpf(d.y);
    f32x2 q = t * 0.5307027145f + (-0.7265760135f); q = q * t + 0.7107068705f; q = q * t + (-0.142248368f); q = q * t + 0.127414796f; q = q * t;
    const f32x2 s = (v * v) * (-0.72134752044f);
    f32x2 e; e.x = __builtin_amdgcn_exp2f(s.x); e.y = __builtin_amdgcn_exp2f(s.y);
    const f32x2 m = v * (q * e), r = v - m;
    f32x2 o; o.x = v.x < 0.f ? m.x : r.x; o.y = v.y < 0.f ? m.y : r.y; return o;
}

__device__ __forceinline__ int fresh_tid() { int t; asm volatile("v_mov_b32 %0, %1" : "=v"(t) : "v"((int)threadIdx.x)); return t; }
#define EPI_ROWS_COLS const int rowb = u.pm * BM + wr * 64 + fr; const int colb = wc * 32 + 8 * fq;
__device__ __forceinline__ u32x4 pack8(const f32x4 v0, const f32x4 v1) { u32x4 w; w.x = cvt_pk_bf16(v0[0], v0[1]); w.y = cvt_pk_bf16(v0[2], v0[3]); w.z = cvt_pk_bf16(v1[0], v1[1]); w.w = cvt_pk_bf16(v1[2], v1[3]); return w; }
__device__ __forceinline__ float sum8sq(const f32x4 a, const f32x4 b) { return (a[0] * a[0] + a[1] * a[1]) + (a[2] * a[2] + a[3] * a[3]) + (b[0] * b[0] + b[1] * b[1]) + (b[2] * b[2] + b[3] * b[3]); }

struct EpiInProj {
    static constexpr bool PERM = true, AFTER_DRAIN = false, HAS_MID = false;
    bf16_t* MIX; bf16_t* XBCP; bf16_t* UA; bf16_t* UMETA; float* DTRAW;
    __device__ __forceinline__ void operator()(const f32x4 (&acc)[2][2][4][2], const Unit& u, int wr, int wc, int fr, int fq) const {
        EPI_ROWS_COLS
        const int pn = u.pn;
#pragma unroll
        for (int ai = 0; ai < 2; ++ai)
#pragma unroll
            for (int m = 0; m < 4; ++m) {
                const int r = rowb + ai * HALF + m * 16;
#pragma unroll
                for (int bj = 0; bj < 2; ++bj) {
                    const int c = pn * BM + bj * HALF + colb;
                    const f32x4 v0 = acc[ai][bj][m][0], v1 = acc[ai][bj][m][1];
                    if (pn < 4) { if (r < 16384) *(u32x4*)(MIX + (size_t)r * 2048 + c) = pack8(v0, v1); }
                    else if (pn < 10) { *(u32x4*)(XBCP + (size_t)r * 1536 + (c - 1024)) = pack8(v0, v1); }
                    else if (pn < 14) {
                        const int j = c - 2560, g = j >> 4, h0 = j & 15;
                        if (r < 16384) { const int b = r >> 13, tok = r & 8191, ch = tok >> 4, t = tok & 15;
                            *(u32x4*)(UA + ((size_t)(g * 1024 + b * 512 + ch) * 384 + t * 16 + h0)) = pack8(v0, v1); }
                        else *(u32x4*)(UMETA + (size_t)(r - 16384) * 1024 + j) = pack8(v0, v1);
                    } else {
                        const int j = c - 3584;
                        if (j < 16) { float* d = DTRAW + (size_t)r * 16 + j; *(f32x4*)d = v0; *(f32x4*)(d + 4) = v1; }
                    }
                }
            }
    }
};
struct EpiS5a {
    static constexpr bool PERM = true, AFTER_DRAIN = false, HAS_MID = false;
    float* SEND;
    __device__ __forceinline__ void operator()(const f32x4 (&acc)[2][2][4][2], const Unit& u, int wr, int wc, int fr, int fq) const {
        EPI_ROWS_COLS
#pragma unroll
        for (int ai = 0; ai < 2; ++ai)
#pragma unroll
            for (int m = 0; m < 4; ++m) {
                const int r = rowb + ai * HALF + m * 16;
                float* d = SEND + ((size_t)(u.g * 1024 + r) * 128 + colb);
                *(f32x4*)d = acc[ai][0][m][0]; *(f32x4*)(d + 4) = acc[ai][0][m][1];
            }
    }
};
struct EpiS5b {
    static constexpr bool PERM = true, AFTER_DRAIN = false, HAS_MID = false;
    bf16_t* Y5;
    __device__ __forceinline__ void operator()(const f32x4 (&acc)[2][2][4][2], const Unit& u, int wr, int wc, int fr, int fq) const {
        { const int t2 = fresh_tid(); const int w2 = t2 >> 6, l2 = t2 & 63; wr = w2 >> 2; wc = w2 & 3; fr = l2 & 15; fq = l2 >> 4; }
        const unsigned lane_off = (unsigned)((((u.pm >> 1) * 8192 + (((u.pm & 1) * 256 + wr * 64 + fr) * 16) + (wc * 2 + (fq >> 1))) * 1024 + u.g * 16 + (fq & 1) * 8) * 2);
        char* base = (char*)Y5;
#pragma unroll
        for (int ai = 0; ai < 2; ++ai)
#pragma unroll
            for (int m = 0; m < 4; ++m)
#pragma unroll
                for (int bj = 0; bj < 2; ++bj) {
                    const f32x4 v0 = acc[ai][bj][m][0], v1 = acc[ai][bj][m][1]; u32x4 w;
                    { const f32x2 a = gelu_pk((f32x2){v0[0], v0[1]}); w.x = cvt_pk_bf16(a.x, a.y); } __builtin_amdgcn_sched_barrier(0);
                    { const f32x2 a = gelu_pk((f32x2){v0[2], v0[3]}); w.y = cvt_pk_bf16(a.x, a.y); } __builtin_amdgcn_sched_barrier(0);
                    { const f32x2 a = gelu_pk((f32x2){v1[0], v1[1]}); w.z = cvt_pk_bf16(a.x, a.y); } __builtin_amdgcn_sched_barrier(0);
                    { const f32x2 a = gelu_pk((f32x2){v1[2], v1[3]}); w.w = cvt_pk_bf16(a.x, a.y); } __builtin_amdgcn_sched_barrier(0);
                    const unsigned off = lane_off + (unsigned)(ai * 4194304 + m * 524288 + bj * 16384);
                    *(u32x4*)(base + off) = w;
                }
    }
};
__device__ __forceinline__ float sigm(float x) { return __builtin_amdgcn_rcpf(1.0f + __builtin_amdgcn_exp2f(-1.44269504f * x)); }
struct EpiGlu {
    static constexpr bool PERM = true, AFTER_DRAIN = false, HAS_MID = false;
    bf16_t* MIX; const float* bglu; float* SS5;
    __device__ __forceinline__ void operator()(const f32x4 (&acc)[2][2][4][2], const Unit& u, int wr, int wc, int fr, int fq) const {
        EPI_ROWS_COLS
        const int oc = u.pn * 128 + colb;
        const f32x4 ba0 = *(const f32x4*)(bglu + oc), ba1 = *(const f32x4*)(bglu + oc + 4), bg0 = *(const f32x4*)(bglu + 1024 + oc), bg1 = *(const f32x4*)(bglu + 1024 + oc + 4);
#pragma unroll
        for (int ai = 0; ai < 2; ++ai)
#pragma unroll
            for (int m = 0; m < 4; ++m) {
                const int r = rowb + ai * HALF + m * 16;
                f32x4 a0 = acc[ai][0][m][0] + ba0, a1 = acc[ai][0][m][1] + ba1; const f32x4 g0 = acc[ai][1][m][0] + bg0, g1 = acc[ai][1][m][1] + bg1;
#pragma unroll
                for (int e = 0; e < 4; ++e) { a0[e] *= sigm(g0[e]); a1[e] *= sigm(g1[e]); }
                *(u32x4*)(MIX + (size_t)r * 2048 + 1024 + oc) = pack8(a0, a1);
                float s = sum8sq(a0, a1); s += __shfl_xor(s, 16); s += __shfl_xor(s, 32);
                if (fq == 0) atomicAdd(SS5 + r, s);
            }
    }
};
struct EpiOut {
    static constexpr bool PERM = true, AFTER_DRAIN = false, HAS_MID = true;
    const float* X; float* H1; bf16_t* H1B; const float* SSS; const float* SS5; float* SSM;
    __device__ __forceinline__ void mid(f32x4 (&acc)[2][2][4][2], const Unit& u, int wr, int wc, int fr, int fq) const {
        const int rowb = u.pm * BM + wr * 64 + fr;
#pragma unroll
        for (int ai = 0; ai < 2; ++ai)
#pragma unroll
            for (int m = 0; m < 4; ++m) {
                const int r = rowb + ai * HALF + m * 16;
                const float ratio = sqrtf((SS5[r] * (1.0f / 1024.0f) + 1e-5f) / (SSS[r] * (1.0f / 1024.0f) + 1e-5f));
#pragma unroll
                for (int bj = 0; bj < 2; ++bj)
#pragma unroll
                    for (int n = 0; n < 2; ++n) acc[ai][bj][m][n] *= ratio;
                asm volatile("" ::: "memory");
            }
    }
    __device__ __forceinline__ void operator()(const f32x4 (&acc)[2][2][4][2], const Unit& u, int wr, int wc, int fr, int fq) const {
        EPI_ROWS_COLS
        const unsigned lane_off = (unsigned)(rowb * 1024 + u.pn * BM + colb);
        const char* xb = (const char*)X; char* hb = (char*)H1; char* bb = (char*)H1B;
#pragma unroll
        for (int ai = 0; ai < 2; ++ai)
#pragma unroll
            for (int m = 0; m < 4; ++m) {
                const int r = rowb + ai * HALF + m * 16;
                const float rs = 1.0f / sqrtf(SS5[r] * (1.0f / 1024.0f) + 1e-5f);
                float s = 0.f;
#pragma unroll
                for (int bj = 0; bj < 2; ++bj) {
                    const unsigned off = lane_off + (unsigned)(ai * 131072 + m * 16384 + bj * 128);
                    const f32x4 v0 = *(const f32x4*)(xb + off * 4u) + acc[ai][bj][m][0] * rs, v1 = *(const f32x4*)(xb + off * 4u + 16u) + acc[ai][bj][m][1] * rs;
                    *(f32x4*)(hb + off * 4u) = v0; *(f32x4*)(hb + off * 4u + 16u) = v1;
                    *(u32x4*)(bb + off * 2u) = pack8(v0, v1); s += sum8sq(v0, v1);
                }
                s += __shfl_xor(s, 16); s += __shfl_xor(s, 32);
                if (fq == 0) atomicAdd(SSM + r, s);
                asm volatile("" ::: "memory");
            }
    }
};
struct SplitKOrder {
    StaticOrder base;
    __device__ bool next(int i, Unit& u) const { if (!base.next(i >> 1, u)) return false; u.kh = i & 1; u.par = i & 1; return true; }
    __device__ __forceinline__ void a_ready(const Unit&) const {}
    __device__ __forceinline__ void done(const Unit&) const {}
};
struct EpiUp {
    static constexpr bool PERM = true, AFTER_DRAIN = false, HAS_MID = false;
    bf16_t* HB; const float* SSM;
    __device__ __forceinline__ void operator()(const f32x4 (&acc)[2][2][4][2], const Unit& u, int wr, int wc, int fr, int fq) const {
        EPI_ROWS_COLS
#pragma unroll
        for (int ai = 0; ai < 2; ++ai)
#pragma unroll
            for (int m = 0; m < 4; ++m) {
                const int r = rowb + ai * HALF + m * 16;
                const float rs = 1.0f / sqrtf(SSM[r] * (1.0f / 1024.0f) + 1e-5f);
#pragma unroll
                for (int bj = 0; bj < 2; ++bj) {
                    f32x4 v0 = acc[ai][bj][m][0] * rs, v1 = acc[ai][bj][m][1] * rs;
#pragma unroll
                    for (int e = 0; e < 4; ++e) { const float p = fmaxf(v0[e], 0.f), q = fmaxf(v1[e], 0.f); v0[e] = p * p; v1[e] = q * q; }
                    *(u32x4*)(HB + (size_t)r * 4096 + u.pn * BM + bj * HALF + colb) = pack8(v0, v1);
                }
            }
    }
};
struct EpiDown {
    static constexpr bool PERM = true, AFTER_DRAIN = false, HAS_MID = false;
    float* H; float* SSF; unsigned* pcnt; const float* gfin; int fused;
    __device__ __forceinline__ void operator()(const f32x4 (&acc_)[2][2][4][2], const Unit& u, int wr, int wc, int fr, int fq) const {
        f32x4 (&acc)[2][2][4][2] = const_cast<f32x4 (&)[2][2][4][2]>(acc_);
        EPI_ROWS_COLS
        const unsigned lane_off = (unsigned)(rowb * 1024 + u.pn * BM + colb);
        char* hb = (char*)H;
#pragma unroll
        for (int ai = 0; ai < 2; ++ai)
#pragma unroll
            for (int m = 0; m < 4; ++m) {
                const int r = rowb + ai * HALF + m * 16;
                float s = 0.f;
#pragma unroll
                for (int bj = 0; bj < 2; ++bj) {
                    const unsigned off = lane_off + (unsigned)(ai * 131072 + m * 16384 + bj * 128);
                    const f32x4 v0 = *(const f32x4*)(hb + off * 4u) + acc[ai][bj][m][0], v1 = *(const f32x4*)(hb + off * 4u + 16u) + acc[ai][bj][m][1];
                    if (fused) { acc[ai][bj][m][0] = v0; acc[ai][bj][m][1] = v1; } else { *(f32x4*)(hb + off * 4u) = v0; *(f32x4*)(hb + off * 4u + 16u) = v1; }
                    s += sum8sq(v0, v1);
                }
                s += __shfl_xor(s, 16); s += __shfl_xor(s, 32);
                if (fq == 0) atomicAdd(SSF + r, s);
                asm volatile("" ::: "memory");
            }
        if (!fused) return;
        asm volatile("s_waitcnt vmcnt(0)" ::: "memory");
        unsigned* cw = pcnt + 4 * u.pm;
        if (fr == 0 && fq == 0) __hip_atomic_fetch_add(cw, 1u, __ATOMIC_RELAXED, __HIP_MEMORY_SCOPE_AGENT);
        while (__hip_atomic_load(cw, __ATOMIC_RELAXED, __HIP_MEMORY_SCOPE_AGENT) < 32u) __builtin_amdgcn_s_sleep(4);
        asm volatile("" ::: "memory");
        f32x4 gv[2][2];
#pragma unroll
        for (int bj = 0; bj < 2; ++bj) { gv[bj][0] = *(const f32x4*)(gfin + u.pn * BM + bj * HALF + colb); gv[bj][1] = *(const f32x4*)(gfin + u.pn * BM + bj * HALF + colb + 4); }
#pragma unroll
        for (int ai = 0; ai < 2; ++ai)
#pragma unroll
            for (int m = 0; m < 4; ++m) {
                const int r = rowb + ai * HALF + m * 16;
                const float ssum = __builtin_bit_cast(float, __hip_atomic_load((const unsigned*)(SSF + r), __ATOMIC_RELAXED, __HIP_MEMORY_SCOPE_AGENT));
                const float rs = 1.0f / sqrtf(ssum * (1.0f / 1024.0f) + 1e-5f);
#pragma unroll
                for (int bj = 0; bj < 2; ++bj) {
                    const unsigned off = lane_off + (unsigned)(ai * 131072 + m * 16384 + bj * 128);
                    *(f32x4*)(hb + off * 4u) = acc[ai][bj][m][0] * rs * gv[bj][0]; *(f32x4*)(hb + off * 4u + 16u) = acc[ai][bj][m][1] * rs * gv[bj][1];
                }
            }
    }
};
struct BatchOrder {
    int nU, per_g, Ge, ce;
    __host__ __device__ void init(int nU_, int per_g_, int G, int w0, int c) { nU = nU_; per_g = per_g_; Ge = G - w0; ce = c - w0; }
    __device__ bool next(int i, Unit& u) const {
        if (ce < 0) return false;
        const long L = (long)i * Ge + ce; if (L >= nU) return false;
        u.g = __builtin_amdgcn_readfirstlane((int)L / per_g); u.pm = __builtin_amdgcn_readfirstlane((int)L % per_g); u.pn = 0; u.par = i & 1; u.kh = 0; return true;
    }
    __device__ __forceinline__ void a_ready(const Unit&) const {}
    __device__ __forceinline__ void done(const Unit&) const {}
};
template <class Epi, class Sched, bool ALIGN_EPI = false, bool SP2 = false>
__device__ __forceinline__ void gemm_phase(PG8_LAS unsigned char* lds, const Gemm g, const Sched& S, const Epi& E) {
    const int tid = threadIdx.x, wid = __builtin_amdgcn_readfirstlane(tid >> 6), lane = tid & 63, wr = wid >> 2, wc = wid & 3, fr = lane & 15, fq = lane >> 4;
    const int K = g.K, nt = K / BK;
    unsigned voffA[2], voffB[2];
#pragma unroll
    for (int i = 0; i < 2; ++i) { int R, C; stage_rc(tid * 16 + i * 8192, R, C); const int Rb = Epi::PERM ? ((R & ~31) + perm32(R & 31)) : R;
        voffA[i] = (unsigned)(R * g.lda + C) * 2u; voffB[i] = (unsigned)(Rb * g.ldb + C) * 2u; }
    const size_t kstep = (size_t)(BK * 2);
    const size_t hstepA = (size_t)HALF * g.lda * 2, hstepB = (size_t)HALF * g.ldb * 2;
    const size_t tstepA = 2 * hstepA, tstepB = 2 * hstepB;
    const unsigned ldsw = (unsigned)wid * 1024u;
    const int aoff = lds_byte(wr * 64 + fr, fq * 8), boff = lds_byte(wc * 32 + fr, fq * 8);
#define PG8_SA(b, h) (((b) * 2 + (h)) * HTB)
#define PG8_SB(b, h) ((4 + (b) * 2 + (h)) * HTB)
#define PG8_STAGE(bufoff, gbase, voff) do { _Pragma("unroll") for (int _i = 0; _i < 2; ++_i) \
        __builtin_amdgcn_global_load_lds((const unsigned*)((const char*)(gbase) + (voff)[_i]), (PG8_LAS unsigned*)(lds + (bufoff) + ldsw + _i * 8192), 16, 0, 0); } while (0)
#define PG8_LDA(dst, b, h) do { _Pragma("unroll") for (int m = 0; m < 4; ++m) _Pragma("unroll") for (int k = 0; k < 2; ++k) dst[m][k] = *(const PG8_LAS bf16x8*)(lds + PG8_SA(b, h) + aoff + m * 2048 + k * 1024); } while (0)
#define PG8_LDB(dst, b, h) do { _Pragma("unroll") for (int n = 0; n < 2; ++n) _Pragma("unroll") for (int k = 0; k < 2; ++k) dst[n][k] = *(const PG8_LAS bf16x8*)(lds + PG8_SB(b, h) + boff + n * 2048 + k * 1024); } while (0)
#define PG8_MMA(ai, bj, At, Bt) do { __builtin_amdgcn_s_setprio(1); _Pragma("unroll") for (int m = 0; m < 4; ++m) _Pragma("unroll") for (int n = 0; n < 2; ++n) _Pragma("unroll") for (int k = 0; k < 2; ++k) \
        acc[ai][bj][m][n] = __builtin_amdgcn_mfma_f32_16x16x32_bf16(Bt[n][k], At[m][k], acc[ai][bj][m][n], 0, 0, 0); __builtin_amdgcn_s_setprio(0); } while (0)
#define PG8_WAIT_V(n) asm volatile("s_waitcnt vmcnt(" #n ")" ::: "memory")
#define PG8_WAIT_L(n) asm volatile("s_waitcnt lgkmcnt(" #n ")" ::: "memory")
#define PG8_BAR __builtin_amdgcn_s_barrier()
#define PG8_SCHED __builtin_amdgcn_sched_barrier(0)
    Unit cur, nxt; int ui = 0;
    if (!S.next(0, cur)) return;
    f32x4 acc[2][2][4][2];
#pragma unroll
    for (int a = 0; a < 2; ++a)
#pragma unroll
        for (int b = 0; b < 2; ++b)
#pragma unroll
            for (int m = 0; m < 4; ++m)
#pragma unroll
                for (int n = 0; n < 2; ++n) acc[a][b][m][n] = (f32x4){0.f, 0.f, 0.f, 0.f};
    bf16x8 At[4][2], B0[2][2], B1[2][2];
    const char* cA = (const char*)g.A + (size_t)cur.g * g.gsA + (size_t)cur.pm * tstepA + (size_t)cur.kh * g.khA; const char* cB = (const char*)g.Bt + (size_t)cur.g * g.gsB + (size_t)cur.pn * tstepB + (size_t)cur.kh * g.khB;
    S.a_ready(cur);
    if constexpr (SP2) {
        PG8_STAGE(PG8_SB(0, 0), cB, voffB); PG8_STAGE(PG8_SB(0, 1), cB + hstepB, voffB); PG8_STAGE(PG8_SA(0, 0), cA, voffA); PG8_STAGE(PG8_SA(0, 1), cA + hstepA, voffA);
        if (wr == 1) PG8_BAR;
        PG8_WAIT_V(2); PG8_BAR;
        PG8_STAGE(PG8_SB(1, 0), cB + kstep, voffB); PG8_STAGE(PG8_SA(1, 0), cA + kstep, voffA); PG8_STAGE(PG8_SB(1, 1), cB + hstepB + kstep, voffB);
        PG8_WAIT_V(6); PG8_BAR;
    } else {
        PG8_STAGE(PG8_SB(0, 0), cB, voffB); PG8_STAGE(PG8_SA(0, 0), cA, voffA); PG8_STAGE(PG8_SB(0, 1), cB + hstepB, voffB); PG8_STAGE(PG8_SA(0, 1), cA + hstepA, voffA);
        if (wr == 1) PG8_BAR;
        PG8_WAIT_V(4); PG8_BAR;
        PG8_STAGE(PG8_SB(1, 0), cB + kstep, voffB); PG8_STAGE(PG8_SA(1, 0), cA + kstep, voffA); PG8_STAGE(PG8_SB(1, 1), cB + hstepB + kstep, voffB);
        PG8_WAIT_V(6); PG8_BAR;
    }
    for (;;) {
        const bool has_next = S.next(ui + 1, nxt);
        const char* nA = has_next ? (const char*)g.A + (size_t)nxt.g * g.gsA + (size_t)nxt.pm * tstepA + (size_t)nxt.kh * g.khA : cA; const char* nB = has_next ? (const char*)g.Bt + (size_t)nxt.g * g.gsB + (size_t)nxt.pn * tstepB + (size_t)nxt.kh * g.khB : cB;
        for (int t = 0; t < nt; t += 2) {
            const bool last = (t == nt - 2);
            const char* a1 = cA + (size_t)(t + 1) * kstep;
            const char* a2 = last ? nA : cA + (size_t)(t + 2) * kstep; const char* b2 = last ? nB : cB + (size_t)(t + 2) * kstep;
            const char* a3 = a2 + kstep; const char* b3 = b2 + kstep;
            if (last && has_next) S.a_ready(nxt);
            if constexpr (SP2) {
            PG8_LDB(B0, 0, 0); PG8_LDB(B1, 0, 1); PG8_SCHED; PG8_LDA(At, 0, 0); PG8_STAGE(PG8_SA(1, 1), a1 + hstepA, voffA);
            PG8_WAIT_V(8); PG8_WAIT_L(0); PG8_BAR; PG8_MMA(0, 0, At, B0); PG8_MMA(0, 1, At, B1); PG8_BAR; PG8_SCHED;
            PG8_LDA(At, 0, 1); PG8_STAGE(PG8_SB(0, 0), b2, voffB); PG8_STAGE(PG8_SB(0, 1), b2 + hstepB, voffB); PG8_STAGE(PG8_SA(0, 0), a2, voffA);
            PG8_WAIT_V(8); PG8_WAIT_L(0); PG8_BAR; PG8_MMA(1, 0, At, B0); PG8_MMA(1, 1, At, B1); PG8_BAR; PG8_SCHED;
            PG8_LDB(B0, 1, 0); PG8_LDB(B1, 1, 1); PG8_SCHED; PG8_LDA(At, 1, 0); PG8_STAGE(PG8_SA(0, 1), a2 + hstepA, voffA);
            PG8_WAIT_V(8); PG8_WAIT_L(0); PG8_BAR; PG8_MMA(0, 0, At, B0); PG8_MMA(0, 1, At, B1); PG8_BAR; PG8_SCHED;
            PG8_LDA(At, 1, 1); PG8_STAGE(PG8_SB(1, 0), b3, voffB); PG8_STAGE(PG8_SB(1, 1), b3 + hstepB, voffB); PG8_STAGE(PG8_SA(1, 0), a3, voffA);
            PG8_WAIT_V(8); PG8_WAIT_L(0); PG8_BAR; PG8_MMA(1, 0, At, B0); PG8_MMA(1, 1, At, B1); PG8_BAR; PG8_SCHED;
            } else {
            PG8_LDB(B0, 0, 0); PG8_SCHED; PG8_LDA(At, 0, 0); PG8_STAGE(PG8_SA(1, 1), a1 + hstepA, voffA);
            PG8_WAIT_L(8); PG8_BAR; PG8_WAIT_L(0); PG8_MMA(0, 0, At, B0); PG8_BAR; PG8_SCHED;
            PG8_LDB(B1, 0, 1); PG8_STAGE(PG8_SB(0, 0), b2, voffB);
            PG8_BAR; PG8_WAIT_L(0); PG8_MMA(0, 1, At, B1); PG8_BAR;
            PG8_LDA(At, 0, 1); PG8_STAGE(PG8_SA(0, 0), a2, voffA);
            PG8_BAR; PG8_WAIT_L(0); PG8_MMA(1, 0, At, B0); PG8_BAR; PG8_SCHED;
            PG8_STAGE(PG8_SB(0, 1), b2 + hstepB, voffB);
            PG8_WAIT_V(6); PG8_BAR; PG8_MMA(1, 1, At, B1); PG8_BAR;
            PG8_LDB(B0, 1, 0); PG8_SCHED; PG8_LDA(At, 1, 0); PG8_STAGE(PG8_SA(0, 1), a2 + hstepA, voffA);
            PG8_WAIT_L(8); PG8_BAR; PG8_WAIT_L(0); PG8_MMA(0, 0, At, B0); PG8_BAR; PG8_SCHED;
            PG8_LDB(B1, 1, 1); PG8_STAGE(PG8_SB(1, 0), b3, voffB);
            PG8_BAR; PG8_WAIT_L(0); PG8_MMA(0, 1, At, B1); PG8_BAR;
            PG8_LDA(At, 1, 1); PG8_STAGE(PG8_SA(1, 0), a3, voffA);
            PG8_BAR; PG8_WAIT_L(0); PG8_MMA(1, 0, At, B0); PG8_BAR; PG8_SCHED;
            PG8_STAGE(PG8_SB(1, 1), b3 + hstepB, voffB);
            PG8_WAIT_V(6); PG8_BAR; PG8_MMA(1, 1, At, B1); PG8_BAR;
            }
        }
        if constexpr (ALIGN_EPI) { if (wr == 0) PG8_BAR; }
        bool keep = false;
        if constexpr (Epi::HAS_MID) { if (cur.kh == 0) { E.mid(acc, cur, wr, wc, fr, fq); keep = true; } }
        if (!keep) { if constexpr (!Epi::AFTER_DRAIN) { E(acc, cur, wr, wc, fr, fq); S.done(cur); } }
        if (!has_next) break;
        if (!keep)
#pragma unroll
        for (int a = 0; a < 2; ++a)
#pragma unroll
            for (int b = 0; b < 2; ++b)
#pragma unroll
                for (int m = 0; m < 4; ++m)
#pragma unroll
                    for (int n = 0; n < 2; ++n) acc[a][b][m][n] = (f32x4){0.f, 0.f, 0.f, 0.f};
        cur = nxt; cA = nA; cB = nB; ++ui;
        if constexpr (ALIGN_EPI) { if (wr == 1) PG8_BAR; }
    }
    PG8_WAIT_V(0);
    if constexpr (!ALIGN_EPI) { if (wr == 0) PG8_BAR; }
    PG8_BAR;
    if constexpr (Epi::AFTER_DRAIN) { E.fused(acc, cur, wr, wc, fr, fq, lds, wid, lane); S.done(cur); }
#undef PG8_SA
#undef PG8_SB
#undef PG8_STAGE
#undef PG8_LDA
#undef PG8_LDB
#undef PG8_MMA
#undef PG8_WAIT_V
#undef PG8_WAIT_L
#undef PG8_BAR
#undef PG8_SCHED
}
}

#include <hip/hip_cooperative_groups.h>
namespace cg = cooperative_groups;
typedef unsigned short bf16;
typedef unsigned v4u __attribute__((ext_vector_type(4)));
typedef unsigned v2u __attribute__((ext_vector_type(2)));
typedef float f32x4 __attribute__((ext_vector_type(4)));
typedef float f32x2 __attribute__((ext_vector_type(2)));
typedef short bf16x8 __attribute__((ext_vector_type(8)));

constexpr int NT = 512, NWAVES = 8;
constexpr int MR = 16384, MP = 16640;
constexpr int NIN = 3840;
constexpr int NQ = 65;
constexpr float EPS = 1e-5f;
constexpr size_t MiB = 1u << 20;
constexpr size_t WS_SS    = 0;
constexpr size_t WS_DEC   = 256 * 1024;
constexpr size_t WS_A1    = 288 * 1024;
constexpr size_t WS_A16   = 320 * 1024;
constexpr size_t WS_BAR   = 384 * 1024;
constexpr size_t WS_BBAR  = 512 * 1024;
constexpr size_t WS_UMETA = 1 * MiB;
constexpr size_t WS_DTRAW = 1 * MiB + 512 * 1024;
constexpr size_t WS_DT    = 2 * MiB + 640 * 1024;
constexpr size_t WS_ACS   = 254 * MiB + 512 * 1024;
static_assert(WS_DTRAW + 16640 * 16 * 4 <= WS_DT && WS_DT + 65 * 16 * 256 * 4 <= 4 * MiB && WS_ACS + 65 * 16 * 256 * 4 <= 256 * MiB, "smalls");
constexpr size_t WS_WGLU  = 4 * MiB;
constexpr size_t WS_TB5   = 8 * MiB;
constexpr size_t WS_TE5   = 20 * MiB;
constexpr size_t WS_WIN   = 28 * MiB;
constexpr size_t WS_PREV  = 20 * MiB;
constexpr size_t WS_WOUT  = 8 * MiB, WS_WUP = 12 * MiB, WS_WDN = 20 * MiB;
constexpr size_t WS_MIX   = 36 * MiB;
constexpr size_t WS_UA    = 100 * MiB;
constexpr size_t WS_XBCP  = 148 * MiB;
constexpr size_t WS_SEND  = 148 * MiB;
constexpr size_t WS_ST    = 180 * MiB;
constexpr size_t WS_Y5    = 148 * MiB;
constexpr size_t WS_XN    = 197 * MiB;
constexpr size_t WS_XF    = 197 * MiB;
constexpr size_t WS_H1B   = 197 * MiB;
constexpr size_t WS_CT    = 230 * MiB;
constexpr size_t WS_BTK   = WS_CT + 65 * 65536 * 2;
constexpr size_t WS_BF    = WS_BTK + 65 * 65536 * 2;
constexpr size_t WS_HB    = 36 * MiB;
static_assert(WS_BF + 65 * 65536 * 2 <= WS_ACS, "ws");
constexpr int LDS_BYTES = 155648;

__device__ __forceinline__ unsigned f2bf(float f) { unsigned u = __builtin_bit_cast(unsigned, f); return (u + 0x7fffu + ((u >> 16) & 1u)) >> 16; }
__device__ __forceinline__ unsigned pk2(float lo, float hi) { unsigned r; asm("v_cvt_pk_bf16_f32 %0, %1, %2" : "=v"(r) : "v"(lo), "v"(hi)); return r; }
__device__ __forceinline__ float bf2f(unsigned short h) { return __builtin_bit_cast(float, (unsigned)h << 16); }
__device__ __forceinline__ float bflo(unsigned w) { return __builtin_bit_cast(float, w << 16); }
__device__ __forceinline__ float bfhi(unsigned w) { return __builtin_bit_cast(float, w & 0xffff0000u); }
__device__ __forceinline__ float ex2(float x) { return __builtin_amdgcn_exp2f(x); }
__device__ __forceinline__ float expf_(float x) { return __builtin_amdgcn_exp2f(1.44269504f * x); }
__device__ __forceinline__ float wave_sum(float v) {
#pragma unroll
    for (int o = 1; o < 64; o <<= 1) v += __shfl_xor(v, o);
    return v;
}

#define LAS __attribute__((address_space(3)))
#define XB_TMO      128
#define XB_XCNT(j)  (256  + 64 * (j))
#define XB_XSUB(j)  (1280 + 64 * (j))
#define XB_XGEN(j)  (2304 + 64 * (j))
#define XB_TOP      3328
#define XB_TOPGEN   3392
#define XCD_BAR_WORDS 3456
#define XB_SPIN_CAP (1u << 18)

__device__ __forceinline__ unsigned xb_ld(unsigned* p)              { return __hip_atomic_load(p, __ATOMIC_RELAXED, __HIP_MEMORY_SCOPE_AGENT); }
__device__ __forceinline__ unsigned xb_add(unsigned* p, unsigned v) { return __hip_atomic_fetch_add(p, v, __ATOMIC_RELAXED, __HIP_MEMORY_SCOPE_AGENT); }
__device__ __forceinline__ unsigned xb_xcc_id() { return (unsigned)__builtin_amdgcn_s_getreg((3 << 11) | 20) & 0xFu; }
#define XB_SPIN(cond, bar) do { unsigned _sp = 0; while (cond) { __builtin_amdgcn_s_sleep(1); \
    if ((++_sp & 255u) == 0u) { if (xb_ld(&(bar)[XB_TMO])) break; if (_sp > XB_SPIN_CAP) { atomicAdd(&(bar)[XB_TMO], 1u); break; } } } } while (0)

struct XcdBarrier {
    unsigned* bar; unsigned x;
    volatile LAS unsigned* st;
};

__device__ __forceinline__ XcdBarrier xcd_barrier_post(unsigned* bar, volatile LAS unsigned* st) {
    XcdBarrier b; b.bar = bar; b.x = xb_xcc_id(); b.st = st;
    if (threadIdx.x == 0) (void)xb_add(&bar[XB_XCNT(b.x)], 1u);
    return b;
}
__device__ __forceinline__ void xcd_barrier_complete(unsigned* bar, unsigned x, unsigned& nloc, unsigned& nx) {
    const unsigned G = gridDim.x * gridDim.y * gridDim.z;
    unsigned sum, cnt, mine, sp = 0u;
    for (;;) {
        sum = 0u; cnt = 0u; mine = 0u;
#pragma unroll
        for (unsigned j = 0; j < 16; ++j) { const unsigned c = xb_ld(&bar[XB_XCNT(j)]); sum += c; cnt += (c > 0u) ? 1u : 0u; mine = (j == x) ? c : mine; }
        if (sum == G) break;
        __builtin_amdgcn_s_sleep(1);
        if ((++sp & 255u) == 0u) { if (xb_ld(&bar[XB_TMO])) break; if (sp > XB_SPIN_CAP) { atomicAdd(&bar[XB_TMO], 1u); break; } }
    }
    nloc = mine > 0u ? mine : 1u; nx = cnt > 0u ? cnt : 1u;
}

__device__ __forceinline__ void xcd_barrier(const XcdBarrier& b) {
    asm volatile("s_waitcnt vmcnt(0)" ::: "memory");
    __syncthreads();
    if (threadIdx.x == 0) {
        unsigned* bar = b.bar;
        __builtin_amdgcn_s_waitcnt(0);
        unsigned nloc = b.st[0], nx = b.st[1];
        if (nloc == 0u) { xcd_barrier_complete(bar, b.x, nloc, nx); b.st[0] = nloc; b.st[1] = nx; }
        const unsigned old = xb_add(&bar[XB_XSUB(b.x)], 1u);
        const unsigned gen = old / nloc;
        if (old + 1u == (gen + 1u) * nloc) {
            __builtin_amdgcn_fence(__ATOMIC_RELEASE, "agent");
            asm volatile("s_waitcnt vmcnt(0)" ::: "memory");
            const unsigned og = xb_add(&bar[XB_TOP], 1u);
            const unsigned tg = og / nx;
            if (og + 1u == (tg + 1u) * nx) xb_add(&bar[XB_TOPGEN], 1u);
            else XB_SPIN(xb_ld(&bar[XB_TOPGEN]) == tg, bar);
            __builtin_amdgcn_fence(__ATOMIC_ACQUIRE, "agent");
            xb_add(&bar[XB_XGEN(b.x)], 1u);
            asm volatile("s_waitcnt vmcnt(0)" ::: "memory");
        } else {
            XB_SPIN(xb_ld(&bar[XB_XGEN(b.x)]) == gen, bar);
            __builtin_amdgcn_fence(__ATOMIC_ACQUIRE, "agent");
            asm volatile("s_waitcnt vmcnt(0)" ::: "memory");
        }
    }
    __syncthreads();
}

struct Args {
    const float* in[26]; float* out; unsigned char* ws; int ph_lo, ph_hi;
};
enum { I_X = 0, I_META, I_GMIX, I_WIN, I_CONVW, I_CONVB, I_DTB, I_ALOG, I_DSSD, I_GSSD, I_LRE, I_LIM, I_LSTEP, I_BRE, I_BIM, I_CRE, I_CIM, I_DS5, I_WGLU, I_BGLU, I_GS5, I_WOUT, I_GMLP, I_WUP, I_WDN, I_GFIN };

template <int MODE> __device__ __forceinline__ int colmap(int j) {
    if (MODE == 1) { if (j < 2560) return j; if (j < 3584) return j + 16; if (j < 3600) return j - 1024; return -1; }
    if (MODE == 2) { const int pn = j >> 8, r = j & 255; return r < 128 ? pn * 128 + r : 1024 + pn * 128 + (r - 128); }
    return j;
}
template <int MODE> __device__ __forceinline__ void transpose_item(const float* W, int K, int N, bf16* WT, const float* ks0, const float* ks1, float* scr, int item, int nblk, int lane) {
    const int kb = item / nblk, nb = item % nblk, k0 = 64 * kb, n0 = 32 * nb;
    const int src = colmap<MODE>(n0 + (lane & 31));
#pragma unroll
    for (int i = 0; i < 32; ++i) { const int kk = 2 * i + (lane >> 5); const int k = k0 + kk;
        float v = src >= 0 ? W[(size_t)k * N + src] : 0.f;
        if (ks0) v *= (k < 1024 ? ks0[k] : ks1[k - 1024]);
        scr[kk * 33 + (lane & 31)] = v; }
    asm volatile("s_waitcnt lgkmcnt(0)" ::: "memory");
    const int c = lane & 7;
#pragma unroll
    for (int j = 0; j < 4; ++j) { const int n = (lane >> 3) + 8 * j; const float* s = scr + (8 * c) * 33 + n;
        v4u o; o.x = pk2(s[0 * 33], s[1 * 33]); o.y = pk2(s[2 * 33], s[3 * 33]); o.z = pk2(s[4 * 33], s[5 * 33]); o.w = pk2(s[6 * 33], s[7 * 33]);
        *(v4u*)(WT + (size_t)(n0 + n) * K + k0 + 8 * c) = o; }
    asm volatile("s_waitcnt lgkmcnt(0)" ::: "memory");
}

__device__ __forceinline__ void sincos_d(double th, float& sn, float& cs) {
    const double k = rint(th * 0.15915494309189535); const double r = fma(-k, 6.283185307179586, th);
    const double t = r * 0.125, t2 = t * t;
    double s = t * (1.0 + t2 * (-1.0 / 6 + t2 * (1.0 / 120 + t2 * (-1.0 / 5040 + t2 * (1.0 / 362880 + t2 * (-1.0 / 39916800))))));
    double c = 1.0 + t2 * (-0.5 + t2 * (1.0 / 24 + t2 * (-1.0 / 720 + t2 * (1.0 / 40320 + t2 * (-1.0 / 3628800 + t2 * (1.0 / 479001600))))));
#pragma unroll
    for (int i = 0; i < 3; ++i) { const double s2 = 2.0 * s * c, c2 = 1.0 - 2.0 * s * s; s = s2; c = c2; }
    sn = (float)s; cs = (float)c;
}

__device__ __forceinline__ void s5_tables(const Args& a, int g, unsigned char* lds, int tid) {
    f32x2* pw = (f32x2*)lds;
    f32x2* Cc = pw + 17 * 64;
    f32x2* Bb = Cc + 16 * 64;
    float* Kt = (float*)(Bb + 64 * 16);
    unsigned char* ws = a.ws;
    if (tid < 64) {
        const int p = tid; const float lr = a.in[I_LRE][g * 64 + p], li = a.in[I_LIM][g * 64 + p]; const float st = expf(a.in[I_LSTEP][g]);
        float are = 1.f, aim = 0.f;
        for (int tau = 0; tau <= 16; ++tau) {
            const float mag = expf(lr * st * (float)tau); float sn, cs; sincos_d((double)li * (double)st * (double)tau, sn, cs);
            pw[tau * 64 + p] = (f32x2){mag * cs, mag * sn};
            if (tau == 1) { are = mag * cs; aim = mag * sn; ((f32x2*)(ws + WS_A1))[g * 64 + p] = (f32x2){are, aim}; }
            if (tau == 16) ((f32x2*)(ws + WS_A16))[g * 64 + p] = (f32x2){mag * cs, mag * sn};
        }
        const float den = lr * lr + li * li;
        const float cre = ((are - 1.0f) * lr + aim * li) / den, cim = (aim * lr - (are - 1.0f) * li) / den;
        f32x4 brv[4], biv[4];
#pragma unroll
        for (int h4 = 0; h4 < 4; ++h4) { brv[h4] = *(const f32x4*)(a.in[I_BRE] + (g * 64 + p) * 16 + 4 * h4); biv[h4] = *(const f32x4*)(a.in[I_BIM] + (g * 64 + p) * 16 + 4 * h4); }
#pragma unroll
        for (int h = 0; h < 16; ++h) { const float br = brv[h >> 2][h & 3], bi = biv[h >> 2][h & 3];
            const f32x2 v = (f32x2){cre * br - cim * bi, cre * bi + cim * br}; Bb[p * 16 + h] = v; ((f32x2*)(ws + WS_BBAR))[(g * 64 + p) * 16 + h] = v; }
    }
    for (int e = tid; e < 1024; e += NT) Cc[e] = (f32x2){a.in[I_CRE][g * 1024 + e], a.in[I_CIM][g * 1024 + e]};
    __syncthreads();
    {
        const int tau = tid >> 5, h = (tid >> 1) & 15, h0 = (tid & 1) * 8; float acc[8];
#pragma unroll
        for (int j = 0; j < 8; ++j) acc[j] = 0.f;
        for (int p = 0; p < 64; ++p) { const f32x2 c = Cc[h * 64 + p], w = pw[tau * 64 + p]; const float tr = c.x * w.x - c.y * w.y, ti = c.x * w.y + c.y * w.x;
#pragma unroll
            for (int j = 0; j < 8; ++j) { const f32x2 b = Bb[p * 16 + h0 + j]; acc[j] += tr * b.x - ti * b.y; } }
        if (tau == 0) {
#pragma unroll
            for (int j = 0; j < 8; ++j) if (h0 + j == h) acc[j] += a.in[I_DS5][g * 16 + h];
        }
#pragma unroll
        for (int j = 0; j < 8; ++j) Kt[(tau * 16 + h) * 16 + h0 + j] = acc[j];
    }
    __syncthreads();
    bf16* TB = (bf16*)(ws + WS_TB5) + (size_t)g * 256 * 384;
    for (int pc = tid; pc < 256 * 48; pc += NT) {
        const int row = pc / 48, c8 = (pc % 48) * 8, t = row >> 4, h = row & 15; float v[8];
        if (c8 < 256) { const int s = c8 >> 4, h0 = c8 & 15;
#pragma unroll
            for (int j = 0; j < 8; ++j) v[j] = s <= t ? Kt[((t - s) * 16 + h) * 16 + h0 + j] : 0.f;
        } else { const int p0 = (c8 - 256) >> 1;
#pragma unroll
            for (int j = 0; j < 4; ++j) { const f32x2 c = Cc[h * 64 + p0 + j], w = pw[(t + 1) * 64 + p0 + j]; v[2 * j] = c.x * w.x - c.y * w.y; v[2 * j + 1] = -(c.x * w.y + c.y * w.x); }
        }
        v4u o; o.x = pk2(v[0], v[1]); o.y = pk2(v[2], v[3]); o.z = pk2(v[4], v[5]); o.w = pk2(v[6], v[7]);
        *(v4u*)(TB + (size_t)row * 384 + c8) = o;
    }
    bf16* TE = (bf16*)(ws + WS_TE5) + (size_t)g * 256 * 256;
    for (int pc = tid; pc < 256 * 32; pc += NT) {
        const int row = pc >> 5, c8 = (pc & 31) * 8; float v[8];
        if (row < 128) { const int p = row >> 1, ri = row & 1, s = c8 >> 4, h0 = c8 & 15; const f32x2 w = pw[(15 - s) * 64 + p];
#pragma unroll
            for (int j = 0; j < 8; ++j) { const f32x2 b = Bb[p * 16 + h0 + j]; v[j] = ri ? (w.x * b.y + w.y * b.x) : (w.x * b.x - w.y * b.y); }
        } else {
#pragma unroll
            for (int j = 0; j < 8; ++j) v[j] = 0.f;
        }
        v4u o; o.x = pk2(v[0], v[1]); o.y = pk2(v[2], v[3]); o.z = pk2(v[4], v[5]); o.w = pk2(v[6], v[7]);
        *(v4u*)(TE + (size_t)row * 256 + c8) = o;
    }
    __syncthreads();
}

__device__ __forceinline__ void rms_row_to_bf16(const float* xrow, const float* gain, bf16* orow, int lane) {
    unsigned long long* o8 = (unsigned long long*)orow + lane;
    if (!xrow) {
#pragma unroll
        for (int j = 0; j < 4; ++j) o8[64 * j] = 0ull;
        return; }
    const f32x4* xr = (const f32x4*)xrow + lane; const f32x4* gr = (const f32x4*)gain + lane;
    f32x4 v[4]; float s = 0.f;
#pragma unroll
    for (int j = 0; j < 4; ++j) { v[j] = xr[64 * j]; s += (v[j].x * v[j].x + v[j].y * v[j].y) + (v[j].z * v[j].z + v[j].w * v[j].w); }
    const float rstd = 1.f / sqrtf(wave_sum(s) * (1.f / 1024.f) + EPS);
#pragma unroll
    for (int j = 0; j < 4; ++j) { const f32x4 gg = gr[64 * j]; const f32x4 w = v[j] * rstd * gg; o8[64 * j] = (unsigned long long)pk2(w.x, w.y) | ((unsigned long long)pk2(w.z, w.w) << 32); }
}

__device__ __forceinline__ void p0_prologue(const Args& a, unsigned char* lds, int tid, int G) {
    unsigned char* ws = a.ws; const int lane = tid & 63, wave = tid >> 6;
    const int gw = blockIdx.x * NWAVES + wave, NGW = G * NWAVES;
    for (int i = blockIdx.x * NT + tid; i < 4 * 16384; i += G * NT) ((float*)(ws + WS_SS))[i] = 0.f;
    for (int g = (G - 1 - (int)blockIdx.x); g < 64; g += G) s5_tables(a, g, lds, tid);
    __syncthreads();
    float* scr = (float*)(lds + wave * 16384);
    constexpr int NB_IN = NIN / 32, NB_GL = 2048 / 32;
    constexpr int I_IN = 16 * NB_IN, I_GL = 16 * NB_GL;
    const int nT = (G > 128) ? G - 64 : G;
    if ((int)blockIdx.x < nT) for (int it = gw; it < I_IN + I_GL; it += nT * NWAVES) {
        if (it < I_IN) transpose_item<1>(a.in[I_WIN], 1024, 3600, (bf16*)(ws + WS_WIN), nullptr, nullptr, scr, it, NB_IN, lane);
        else transpose_item<2>(a.in[I_WGLU], 1024, 2048, (bf16*)(ws + WS_WGLU), nullptr, nullptr, scr, it - I_IN, NB_GL, lane);
    }
    for (int m = gw; m < MP; m += 2 * NGW) {
        const int m2 = m + NGW;
        if (m2 < MR) {
            const f32x4* xa = (const f32x4*)(a.in[I_X] + (size_t)m * 1024) + lane; const f32x4* xb = (const f32x4*)(a.in[I_X] + (size_t)m2 * 1024) + lane; const f32x4* gr = (const f32x4*)a.in[I_GMIX] + lane;
            f32x4 va[4], vb[4]; float sa = 0.f, sb = 0.f;
#pragma unroll
            for (int j = 0; j < 4; ++j) { va[j] = xa[64 * j]; vb[j] = xb[64 * j]; }
#pragma unroll
            for (int j = 0; j < 4; ++j) { sa += (va[j].x * va[j].x + va[j].y * va[j].y) + (va[j].z * va[j].z + va[j].w * va[j].w); sb += (vb[j].x * vb[j].x + vb[j].y * vb[j].y) + (vb[j].z * vb[j].z + vb[j].w * vb[j].w); }
            const float ra = 1.f / sqrtf(wave_sum(sa) * (1.f / 1024.f) + EPS), rb = 1.f / sqrtf(wave_sum(sb) * (1.f / 1024.f) + EPS);
            unsigned long long* oa = (unsigned long long*)((bf16*)(ws + WS_XN) + (size_t)m * 1024) + lane; unsigned long long* ob = (unsigned long long*)((bf16*)(ws + WS_XN) + (size_t)m2 * 1024) + lane;
#pragma unroll
            for (int j = 0; j < 4; ++j) { const f32x4 gg = gr[64 * j]; const f32x4 wa = va[j] * ra * gg, wb = vb[j] * rb * gg;
                oa[64 * j] = (unsigned long long)pk2(wa.x, wa.y) | ((unsigned long long)pk2(wa.z, wa.w) << 32); ob[64 * j] = (unsigned long long)pk2(wb.x, wb.y) | ((unsigned long long)pk2(wb.z, wb.w) << 32); }
        } else {
            for (int mm = m; mm < MP && mm <= m2; mm += NGW) {
                const float* src = mm < MR ? a.in[I_X] + (size_t)mm * 1024 : (mm < MR + 16 ? a.in[I_META] + (size_t)(mm - MR) * 1024 : nullptr);
                rms_row_to_bf16(src, a.in[I_GMIX], (bf16*)(ws + WS_XN) + (size_t)mm * 1024, lane);
            }
        }
    }
}
__device__ __forceinline__ void p6_weights(const Args& a, unsigned char* lds, int tid, int G) {
    unsigned char* ws = a.ws; const int lane = tid & 63, wave = tid >> 6;
    const int gw = blockIdx.x * NWAVES + wave, NGW = G * NWAVES;
    float* scr = (float*)(lds + wave * 16384);
    constexpr int I_O = 32 * 32, I_U = 16 * 128, I_D = 64 * 32;
    for (int it = gw; it < I_O + I_U + I_D; it += NGW) {
        if (it < I_O) transpose_item<0>(a.in[I_WOUT], 2048, 1024, (bf16*)(ws + WS_WOUT), a.in[I_GSSD], a.in[I_GS5], scr, it, 32, lane);
        else if (it < I_O + I_U) transpose_item<0>(a.in[I_WUP], 1024, 4096, (bf16*)(ws + WS_WUP), a.in[I_GMLP], a.in[I_GMLP], scr, it - I_O, 128, lane);
        else transpose_item<0>(a.in[I_WDN], 4096, 1024, (bf16*)(ws + WS_WDN), nullptr, nullptr, scr, it - I_O - I_U, 32, lane);
    }
    __syncthreads();
}

__device__ __forceinline__ int chunk_row(int q, int tok) {
    if (q == 0) return tok < 240 ? -1 : MR + (tok - 240);
    const int b = (q - 1) >> 5, c = (q - 1) & 31;
    if (tok < 0 && c == 0) return MR + 16 + tok;
    return b * 8192 + c * 256 + tok;
}
__device__ __forceinline__ float silu_(float x) { return x * __builtin_amdgcn_rcpf(1.0f + ex2(-1.44269504f * x)); }
__device__ __forceinline__ void p2_conv_unit(const Args& a, int q, int blk, unsigned char* lds, int tid) {
    unsigned char* ws = a.ws;
    bf16* IN = (bf16*)lds;
    bf16* OT = (bf16*)(lds + 40960);
    const bf16* XBCP = (const bf16*)(ws + WS_XBCP);
    const int ch0 = blk * 64;
    for (int pc = tid; pc < 259 * 8; pc += NT) { const int rr = pc >> 3, c8 = (pc & 7) * 8; const int row = chunk_row(q, rr - 3);
        v4u v = (v4u){0u, 0u, 0u, 0u}; if (row >= 0) v = *(const v4u*)(XBCP + (size_t)row * 1536 + ch0 + c8);
        *(v4u*)(IN + rr * 64 + c8) = v; }
    __syncthreads();
    const float* cw = a.in[I_CONVW]; const float* cb = a.in[I_CONVB];
    const bool is_x = blk < 16, is_b = blk >= 16 && blk < 20;
    if (!is_x) {
        bf16* dst = (bf16*)(ws + (is_b ? WS_BTK : WS_CT)) + (size_t)q * 65536 + (is_b ? (blk - 16) : (blk - 20)) * 64;
        const int c8 = (tid & 7) * 8; float wreg[4][8], breg[8];
#pragma unroll
        for (int j = 0; j < 8; ++j) { breg[j] = cb[ch0 + c8 + j];
#pragma unroll
            for (int k = 0; k < 4; ++k) wreg[k][j] = cw[k * 1536 + ch0 + c8 + j]; }
        for (int pc = tid; pc < 256 * 8; pc += NT) { const int tok = pc >> 3; float o[8];
            const bool zero = (q == 0 && tok < 240);
#pragma unroll
            for (int j = 0; j < 8; ++j) o[j] = breg[j];
#pragma unroll
            for (int k = 0; k < 4; ++k) { const v4u v = *(const v4u*)(IN + (tok + k) * 64 + c8); const unsigned w[4] = {v.x, v.y, v.z, v.w};
#pragma unroll
                for (int j = 0; j < 4; ++j) { o[2 * j] += wreg[k][2 * j] * bflo(w[j]); o[2 * j + 1] += wreg[k][2 * j + 1] * bfhi(w[j]); } }
#pragma unroll
            for (int j = 0; j < 8; ++j) o[j] = zero ? 0.f : silu_(o[j]);
            v4u ov; ov.x = pk2(o[0], o[1]); ov.y = pk2(o[2], o[3]); ov.z = pk2(o[4], o[5]); ov.w = pk2(o[6], o[7]);
            *(v4u*)(dst + (size_t)tok * 256 + c8) = ov; }
    }
    if (is_x || is_b) {
        const int ch = tid & 63; float wk[4]; const float bias = cb[ch0 + ch];
#pragma unroll
        for (int k = 0; k < 4; ++k) wk[k] = cw[k * 1536 + ch0 + ch];
        for (int it = tid; it < 64 * 32; it += NT) { const int t0 = (it >> 6) * 8; float in[11], o[8];
#pragma unroll
            for (int j = 0; j < 11; ++j) in[j] = bf2f(IN[(t0 + j) * 64 + ch]);
#pragma unroll
            for (int j = 0; j < 8; ++j) { const float v = bias + wk[0] * in[j] + wk[1] * in[j + 1] + wk[2] * in[j + 2] + wk[3] * in[j + 3]; o[j] = (q == 0 && t0 + j < 240) ? 0.f : silu_(v); }
            v4u ov; ov.x = pk2(o[0], o[1]); ov.y = pk2(o[2], o[3]); ov.z = pk2(o[4], o[5]); ov.w = pk2(o[6], o[7]);
            *(v4u*)(OT + ch * 264 + t0) = ov; }
        __syncthreads();
        bf16* dst = is_x ? (bf16*)(ws + WS_XF) + ((size_t)q * 1024 + ch0) * 256 : (bf16*)(ws + WS_BF) + ((size_t)q * 256 + (blk - 16) * 64) * 256;
        for (int pc = tid; pc < 64 * 32; pc += NT) { const int ch = pc >> 5, t8 = (pc & 31) * 8; *(v4u*)(dst + (size_t)ch * 256 + t8) = *(const v4u*)(OT + ch * 264 + t8); }
    }
    __syncthreads();
}
__device__ __forceinline__ void p2_dt_item(const Args& a, int q, int h, int lane) {
    unsigned char* ws = a.ws; const float* DTRAW = (const float*)(ws + WS_DTRAW);
    const float bias = a.in[I_DTB][h], A = -expf(a.in[I_ALOG][h]);
    float dt[4], cs[4]; float run = 0.f;
#pragma unroll
    for (int j = 0; j < 4; ++j) { const int tok = 4 * lane + j; const int row = chunk_row(q, tok);
        float d = 0.f; if (row >= 0) { const float x = DTRAW[(size_t)row * 16 + h] + bias; d = fmaxf(x, 0.f) + __logf(1.0f + expf_(-fabsf(x))); }
        dt[j] = d; run += d * A; cs[j] = run; }
    float incl = run;
#pragma unroll
    for (int o = 1; o < 64; o <<= 1) { const float t = __shfl_up(incl, o); if (lane >= o) incl += t; }
    const float excl = incl - run;
    float* DT = (float*)(ws + WS_DT) + ((size_t)q * 16 + h) * 256 + 4 * lane; float* ACS = (float*)(ws + WS_ACS) + ((size_t)q * 16 + h) * 256 + 4 * lane;
    *(f32x4*)DT = (f32x4){dt[0], dt[1], dt[2], dt[3]}; *(f32x4*)ACS = (f32x4){cs[0] + excl, cs[1] + excl, cs[2] + excl, cs[3] + excl};
    if (lane == 63) ((float*)(ws + WS_DEC))[q * 16 + h] = expf_(cs[3] + excl);
}

#define MFMA16(A, B, C) __builtin_amdgcn_mfma_f32_16x16x32_bf16(A, B, C, 0, 0, 0)
__device__ __forceinline__ void p3_states_unit(const Args& a, int q, int g, int nh, int tid) {
    unsigned char* ws = a.ws; const int lane = tid & 63, r = tid >> 6, h = g * 8 + r, fr = lane & 15, fq = lane >> 4;
    const bf16* XF = (const bf16*)(ws + WS_XF) + ((size_t)q * 1024 + h * 64) * 256;
    const bf16* BF = (const bf16*)(ws + WS_BF) + ((size_t)q * 256 + g * 128) * 256;
    const float* DT = (const float*)(ws + WS_DT) + ((size_t)q * 16 + h) * 256; const float* ACS = (const float*)(ws + WS_ACS) + ((size_t)q * 16 + h) * 256;
    const float alast = ACS[255];
    bf16* ST = (bf16*)(ws + WS_ST) + ((size_t)q * 16 + h) * 8192;
    {
        f32x4 acc[4][4];
#pragma unroll
        for (int i = 0; i < 4; ++i)
#pragma unroll
            for (int j = 0; j < 4; ++j) acc[i][j] = (f32x4){0.f, 0.f, 0.f, 0.f};
#pragma unroll 2
        for (int kb = 0; kb < 8; ++kb) {
            const int s0 = kb * 32 + fq * 8;
            float w[8];
            { const f32x4 d0 = *(const f32x4*)(DT + s0), d1 = *(const f32x4*)(DT + s0 + 4), c0 = *(const f32x4*)(ACS + s0), c1 = *(const f32x4*)(ACS + s0 + 4);
#pragma unroll
              for (int j = 0; j < 4; ++j) { w[j] = expf_(alast - c0[j]) * d0[j]; w[4 + j] = expf_(alast - c1[j]) * d1[j]; } }
            bf16x8 Af[4], Bf[4];
#pragma unroll
            for (int i = 0; i < 4; ++i) { const v4u v = *(const v4u*)(XF + (size_t)(i * 16 + fr) * 256 + s0);
                v4u o; o.x = pk2(bflo(v.x) * w[0], bfhi(v.x) * w[1]); o.y = pk2(bflo(v.y) * w[2], bfhi(v.y) * w[3]); o.z = pk2(bflo(v.z) * w[4], bfhi(v.z) * w[5]); o.w = pk2(bflo(v.w) * w[6], bfhi(v.w) * w[7]);
                Af[i] = __builtin_bit_cast(bf16x8, o); }
#pragma unroll
            for (int j = 0; j < 4; ++j) Bf[j] = *(const bf16x8*)(BF + (size_t)((nh * 4 + j) * 16 + fr) * 256 + s0);
#pragma unroll
            for (int i = 0; i < 4; ++i)
#pragma unroll
                for (int j = 0; j < 4; ++j) acc[i][j] = MFMA16(Bf[j], Af[i], acc[i][j]);
        }
#pragma unroll
        for (int i = 0; i < 4; ++i)
#pragma unroll
            for (int j = 0; j < 4; ++j) { v2u o; o.x = pk2(acc[i][j][0], acc[i][j][1]); o.y = pk2(acc[i][j][2], acc[i][j][3]);
                *(v2u*)(ST + (i * 16 + fr) * 128 + (nh * 4 + j) * 16 + fq * 4) = o; }
    }
}

__device__ __forceinline__ void p4_ssd_scan_item(const Args& a, int item, int tid) {
    unsigned char* ws = a.ws; const int e = item * 1024 + tid * 2;
    const int b = e >> 17, hpn = e & 131071, h = hpn >> 13;
    const bf16* ST = (const bf16*)(ws + WS_ST); bf16* PREV = (bf16*)(ws + WS_PREV); const float* DEC = (const float*)(ws + WS_DEC);
    unsigned st[32]; float dec[32];
    st[0] = *(const unsigned*)(ST + hpn); dec[0] = 0.f;
#pragma unroll
    for (int k = 1; k < 32; ++k) { const int q = b * 32 + k; st[k] = *(const unsigned*)(ST + (size_t)q * 131072 + hpn); dec[k] = DEC[q * 16 + h]; }
    float s0 = bflo(st[0]), s1 = bfhi(st[0]);
#pragma unroll
    for (int c = 0; c < 32; ++c) {
        *(unsigned*)(PREV + (size_t)(b * 32 + c) * 131072 + hpn) = pk2(s0, s1);
        if (c < 31) { const float d = dec[c + 1]; const unsigned v = st[c + 1]; s0 = s0 * d + bflo(v); s1 = s1 * d + bfhi(v); }
    }
}
__device__ __forceinline__ void p4_s5_scan_item(const Args& a, int item, unsigned char* lds, int tid) {
    unsigned char* ws = a.ws; const int b = item >> 7, g = (item >> 1) & 63, p = (item & 1) * 32 + (tid & 31), seg = tid >> 5;
    const f32x2 a1 = ((const f32x2*)(ws + WS_A1))[g * 64 + p], a16 = ((const f32x2*)(ws + WS_A16))[g * 64 + p];
    const f32x2* Bb = (const f32x2*)(ws + WS_BBAR) + (size_t)(g * 64 + p) * 16;
    const bf16* UM = (const bf16*)(ws + WS_UMETA);
    const f32x2* SE = (const f32x2*)(ws + WS_SEND) + ((size_t)(g * 1024 + b * 512 + seg * 32) * 64 + p);
    f32x2 se[32];
#pragma unroll
    for (int j = 0; j < 32; ++j) se[j] = SE[(size_t)j * 64];
    float sr = 0.f, si = 0.f;
    f32x2 bbv[16];
#pragma unroll
    for (int h = 0; h < 16; ++h) bbv[h] = Bb[h];
    for (int s = 0; s < 16; ++s) { float br = 0.f, bi = 0.f;
        const v4u u0 = *(const v4u*)(UM + s * 1024 + g * 16), u1 = *(const v4u*)(UM + s * 1024 + g * 16 + 8); const unsigned uw[8] = {u0.x, u0.y, u0.z, u0.w, u1.x, u1.y, u1.z, u1.w};
#pragma unroll
        for (int h = 0; h < 16; ++h) { const float u = (h & 1) ? bfhi(uw[h >> 1]) : bflo(uw[h >> 1]); const f32x2 bb = bbv[h]; br += bb.x * u; bi += bb.y * u; }
        const float nr = a1.x * sr - a1.y * si + br, ni = a1.x * si + a1.y * sr + bi; sr = nr; si = ni; }
    float er = 0.f, ei = 0.f;
#pragma unroll
    for (int j = 0; j < 32; ++j) { const float nr = a16.x * er - a16.y * ei + se[j].x, ni = a16.x * ei + a16.y * er + se[j].y; er = nr; ei = ni; }
    f32x2* EL = (f32x2*)lds;
    EL[seg * 32 + (tid & 31)] = (f32x2){er, ei};
    float pr = a16.x, pi = a16.y;
#pragma unroll
    for (int k = 0; k < 5; ++k) { const float nr = pr * pr - pi * pi, ni = 2.f * pr * pi; pr = nr; pi = ni; }
    __syncthreads();
    for (int k = 0; k < seg; ++k) { const f32x2 ek = EL[k * 32 + (tid & 31)]; const float nr = pr * sr - pi * si + ek.x, ni = pr * si + pi * sr + ek.y; sr = nr; si = ni; }
    unsigned* UA = (unsigned*)((bf16*)(ws + WS_UA) + ((size_t)(g * 1024 + b * 512 + seg * 32) * 384 + 256 + 2 * p));
#pragma unroll
    for (int j = 0; j < 32; ++j) { UA[(size_t)j * 192] = pk2(sr, si);
        const float nr = a16.x * sr - a16.y * si + se[j].x, ni = a16.x * si + a16.y * sr + se[j].y; sr = nr; si = ni; }
    __syncthreads();
}

__device__ __forceinline__ void p5_ssd_out_unit(const Args& a, int q, int g, int half, unsigned char* lds, int tid) {
    unsigned char* ws = a.ws; const int lane = tid & 63, r = tid >> 6, h = g * 8 + r, fr = lane & 15, fq = lane >> 4;
    bf16* CBs = (bf16*)lds;
    float* ACSs = (float*)(lds + 256 * 264 * 2);
    float* DTs = ACSs + 8 * 256;
    const bf16* CT = (const bf16*)(ws + WS_CT) + (size_t)q * 65536 + g * 128;
    const bf16* BTK = (const bf16*)(ws + WS_BTK) + (size_t)q * 65536 + g * 128;
    for (int i = tid; i < 2048; i += NT) { ACSs[i] = ((const float*)(ws + WS_ACS))[((size_t)q * 16 + g * 8) * 256 + i]; DTs[i] = ((const float*)(ws + WS_DT))[((size_t)q * 16 + g * 8) * 256 + i]; }
    {
        int cnt = 0;
#pragma unroll 1
        for (int ti = 0; ti < 8; ++ti) {
            const int lt = half ? 4 + ti : (ti < 4 ? ti : 8 + ti);
#pragma unroll 1
            for (int stl = 0; stl <= lt; ++stl, ++cnt) {
                if ((cnt & 7) != r) continue;
                f32x4 c = (f32x4){0.f, 0.f, 0.f, 0.f};
#pragma unroll
                for (int k = 0; k < 4; ++k) { const bf16x8 Af = *(const bf16x8*)(CT + (size_t)(lt * 16 + fr) * 256 + k * 32 + fq * 8);
                    const bf16x8 Bf = *(const bf16x8*)(BTK + (size_t)(stl * 16 + fr) * 256 + k * 32 + fq * 8); c = MFMA16(Af, Bf, c); }
#pragma unroll
                for (int e = 0; e < 4; ++e) CBs[(lt * 16 + fq * 4 + e) * 264 + stl * 16 + fr] = (bf16)f2bf(c[e]);
            }
        }
    }
    __syncthreads();
    const bf16* XF = (const bf16*)(ws + WS_XF) + ((size_t)q * 1024 + h * 64) * 256;
    const bf16* PREV = (const bf16*)(ws + WS_PREV) + ((size_t)(q - 1) * 16 + h) * 8192;
    const float* acs = ACSs + r * 256; const float* dts = DTs + r * 256;
    const float dsk = a.in[I_DSSD][h];
    const int b = (q - 1) >> 5, c = (q - 1) & 31; const int m0 = b * 8192 + c * 256;
    bf16* MIX = (bf16*)(ws + WS_MIX); float* SSS = (float*)(ws + WS_SS);
#pragma unroll 1
    for (int lbi = 0; lbi < 2; ++lbi) {
        const int lb = half ? 1 + lbi : 3 * lbi;
        f32x4 acc[4][4];
#pragma unroll
        for (int i = 0; i < 4; ++i)
#pragma unroll
            for (int j = 0; j < 4; ++j) acc[i][j] = (f32x4){0.f, 0.f, 0.f, 0.f};
#pragma unroll 2
        for (int k = 0; k < 4; ++k) { bf16x8 Af[4], Bf[4];
#pragma unroll
            for (int i = 0; i < 4; ++i) Af[i] = *(const bf16x8*)(CT + (size_t)(lb * 64 + i * 16 + fr) * 256 + k * 32 + fq * 8);
#pragma unroll
            for (int j = 0; j < 4; ++j) Bf[j] = *(const bf16x8*)(PREV + (size_t)(j * 16 + fr) * 128 + k * 32 + fq * 8);
#pragma unroll
            for (int i = 0; i < 4; ++i)
#pragma unroll
                for (int j = 0; j < 4; ++j) acc[i][j] = MFMA16(Bf[j], Af[i], acc[i][j]); }
#pragma unroll
        for (int i = 0; i < 4; ++i) { const float sc = expf_(acs[lb * 64 + i * 16 + fr]);
#pragma unroll
            for (int j = 0; j < 4; ++j) acc[i][j] *= sc; }
        const int nsb = 2 * lb + 2;
#pragma unroll 1
        for (int sb = 0; sb < nsb; ++sb) {
            const int s0 = sb * 32 + fq * 8;
            bf16x8 Bf[4];
#pragma unroll
            for (int j = 0; j < 4; ++j) Bf[j] = *(const bf16x8*)(XF + (size_t)(j * 16 + fr) * 256 + s0);
            float as[8], ds[8];
#pragma unroll
            for (int j = 0; j < 8; ++j) { as[j] = acs[s0 + j]; ds[j] = dts[s0 + j]; }
            float fs[8];
#pragma unroll
            for (int j = 0; j < 8; ++j) fs[j] = expf_(as[7] - as[j]) * ds[j];
#pragma unroll
            for (int i = 0; i < 4; ++i) {
                const int l = lb * 64 + i * 16 + fr;
                if (sb * 32 > lb * 64 + i * 16 + 15) continue;
                const float al = acs[l];
                const v4u v = *(const v4u*)(CBs + l * 264 + s0); const unsigned w4[4] = {v.x, v.y, v.z, v.w}; float pv[8];
                if (sb * 32 + 31 < lb * 64 + i * 16) {
                    const float gl = expf_(al - as[7]);
#pragma unroll
                    for (int j = 0; j < 4; ++j) { pv[2 * j] = bflo(w4[j]) * (gl * fs[2 * j]); pv[2 * j + 1] = bfhi(w4[j]) * (gl * fs[2 * j + 1]); }
                } else
#pragma unroll
                for (int j = 0; j < 4; ++j) {
                    const float p0 = bflo(w4[j]) * expf_(fminf(al - as[2 * j], 0.f)) * ds[2 * j], p1 = bfhi(w4[j]) * expf_(fminf(al - as[2 * j + 1], 0.f)) * ds[2 * j + 1];
                    const int sa = s0 + 2 * j, sbq = sa + 1;
                    pv[2 * j] = (sa < l) ? p0 : (sa == l ? p0 + dsk : 0.f); pv[2 * j + 1] = (sbq < l) ? p1 : (sbq == l ? p1 + dsk : 0.f); }
                v4u o; o.x = pk2(pv[0], pv[1]); o.y = pk2(pv[2], pv[3]); o.z = pk2(pv[4], pv[5]); o.w = pk2(pv[6], pv[7]);
                const bf16x8 Af = __builtin_bit_cast(bf16x8, o);
#pragma unroll
                for (int j = 0; j < 4; ++j) acc[i][j] = MFMA16(Bf[j], Af, acc[i][j]);
            }
        }
#pragma unroll
        for (int i = 0; i < 4; ++i) {
            const int l = lb * 64 + i * 16 + fr; float ssq = 0.f;
            bf16* zrow = MIX + (size_t)(m0 + l) * 2048 + h * 64 + fq * 4;
#pragma unroll
            for (int j = 0; j < 4; ++j) {
                const v2u zv = *(const v2u*)(zrow + j * 16);
                const float y0 = acc[i][j][0] * silu_(bflo(zv.x)), y1 = acc[i][j][1] * silu_(bfhi(zv.x)), y2 = acc[i][j][2] * silu_(bflo(zv.y)), y3 = acc[i][j][3] * silu_(bfhi(zv.y));
                v2u o; o.x = pk2(y0, y1); o.y = pk2(y2, y3); *(v2u*)(zrow + j * 16) = o;
                ssq += (y0 * y0 + y1 * y1) + (y2 * y2 + y3 * y3);
            }
            ssq += __shfl_xor(ssq, 16); ssq += __shfl_xor(ssq, 32);
            if (fq == 0) atomicAdd(SSS + m0 + l, ssq);
        }
    }
    __syncthreads();
}

__device__ __forceinline__ void p10_final(const Args& a, int tid, int G) {
    const int lane = tid & 63, wave = tid >> 6; const int gw = blockIdx.x * NWAVES + wave, NGW = G * NWAVES;
    const float* SSF = (const float*)(a.ws + WS_SS) + 3 * 16384; const f32x4* gf = (const f32x4*)a.in[I_GFIN] + lane;
    for (int m = gw; m < MR; m += NGW) { f32x4* row = (f32x4*)(a.out + (size_t)m * 1024) + lane; const float rs = 1.0f / sqrtf(SSF[m] * (1.0f / 1024.0f) + EPS);
#pragma unroll
        for (int j = 0; j < 4; ++j) row[64 * j] = row[64 * j] * rs * gf[64 * j]; }
}

__global__ void __launch_bounds__(NT, 2) fwd_kernel(Args args) {
    extern __shared__ __attribute__((aligned(16))) unsigned char lds[];
    cg::grid_group grid = cg::this_grid();
    const int tid = threadIdx.x, G = gridDim.x, bx = blockIdx.x;
    unsigned char* ws = args.ws;
    PG8_LAS unsigned char* ldsl = (PG8_LAS unsigned char*)lds;
    const int lo = args.ph_lo, hi = args.ph_hi;
#ifndef SKIPMASK
#define SKIPMASK 0
#endif
#define IN(k) (!((SKIPMASK >> (k)) & 1) && lo <= (k) && (k) < hi)
    volatile LAS unsigned* bst = (volatile LAS unsigned*)(ldsl + 155136);
    if (tid < 2) bst[tid] = 0u;
    __syncthreads();
    XcdBarrier xbar = xcd_barrier_post((unsigned*)(ws + WS_BAR), bst);
#define SEAM(k) do { if (IN(k) && IN((k) + 1)) { if ((k) == 0) grid.sync(); else xcd_barrier(xbar); } } while (0)
    float* SS = (float*)(ws + WS_SS);
    if (IN(0)) { const int tid = pg8::fresh_tid(); p0_prologue(args, lds, tid, G); }
    SEAM(0);
    if (IN(1)) {
        pg8::Gemm g{(const bf16*)(ws + WS_XN), (const bf16*)(ws + WS_WIN), MP, NIN, 1024, 1024, 1024, 0, 0}; pg8::StaticOrder S; S.init(MP, NIN, G, bx);
        pg8::EpiInProj E{(bf16*)(ws + WS_MIX), (bf16*)(ws + WS_XBCP), (bf16*)(ws + WS_UA), (bf16*)(ws + WS_UMETA), (float*)(ws + WS_DTRAW)};
        pg8::gemm_phase<pg8::EpiInProj, pg8::StaticOrder, true, true>(ldsl, g, S, E);
    }
    SEAM(1);
    if (IN(2)) {
        const int tid = pg8::fresh_tid(), wave = tid >> 6, lane = tid & 63;
        for (int u = bx; u < NQ * 24; u += G) p2_conv_unit(args, u / 24, u % 24, lds, tid);
        for (int it = bx * NWAVES + wave; it < NQ * 16; it += G * NWAVES) p2_dt_item(args, it >> 4, it & 15, lane);
    }
    SEAM(2);
    const int nS3 = (G / 2 < 126) ? G / 2 : 126;
    if (IN(3)) {
        const int tid = pg8::fresh_tid();
        for (int u = bx; u < 252; u += G) { const int qi = u >> 2; p3_states_unit(args, qi < 32 ? qi : qi + 1, (u >> 1) & 1, u & 1, tid); }
        pg8::Gemm g{(const bf16*)(ws + WS_UA), (const bf16*)(ws + WS_TE5), 1024, 256, 256, 384, 256, (size_t)1024 * 384 * 2, (size_t)256 * 256 * 2};
        pg8::BatchOrder S; S.init(256, 4, G, 0, bx);
        pg8::EpiS5a E{(float*)(ws + WS_SEND)};
        pg8::gemm_phase<pg8::EpiS5a, pg8::BatchOrder, true, true>(ldsl, g, S, E);
    }
    SEAM(3);
    if (IN(4)) {
        const int tid = pg8::fresh_tid();
        for (int it = bx; it < 512; it += G) { if (it < 256) p4_s5_scan_item(args, it, lds, tid); else p4_ssd_scan_item(args, it - 256, tid); }
    }
    SEAM(4);
    if (IN(5)) {
        const int tid = pg8::fresh_tid();
#ifndef NO_SSDOUT
        for (int u = bx; u < 256; u += G) p5_ssd_out_unit(args, 1 + (u >> 2), (u >> 1) & 1, u & 1, lds, tid);
        __syncthreads();
#endif
        pg8::Gemm g{(const bf16*)(ws + WS_UA), (const bf16*)(ws + WS_TB5), 1024, 256, 384, 384, 384, (size_t)1024 * 384 * 2, (size_t)256 * 384 * 2};
        pg8::BatchOrder S; S.init(256, 4, G, 0, bx);
        pg8::EpiS5b E{(bf16*)(ws + WS_Y5)};
        pg8::gemm_phase<pg8::EpiS5b, pg8::BatchOrder, true, true>(ldsl, g, S, E);
    }
    SEAM(5);
    if (IN(6)) {
        const int tid = pg8::fresh_tid();
        p6_weights(args, lds, tid, G);
        pg8::Gemm g{(const bf16*)(ws + WS_Y5), (const bf16*)(ws + WS_WGLU), MR, 2048, 1024, 1024, 1024, 0, 0}; pg8::StaticOrder S; S.init(MR, 2048, G, bx);
        pg8::EpiGlu E{(bf16*)(ws + WS_MIX), args.in[I_BGLU], SS + 16384};
        pg8::gemm_phase<pg8::EpiGlu, pg8::StaticOrder, true, true>(ldsl, g, S, E);
    }
    SEAM(6);
    if (IN(7)) {
        pg8::Gemm g{(const bf16*)(ws + WS_MIX), (const bf16*)(ws + WS_WOUT), MR, 1024, 1024, 2048, 2048, 0, 0, (size_t)1024 * 2, (size_t)1024 * 2};
        pg8::SplitKOrder S; S.base.init(MR, 1024, G, bx);
        pg8::EpiOut E{args.in[I_X], args.out, (bf16*)(ws + WS_H1B), SS, SS + 16384, SS + 2 * 16384};
        pg8::gemm_phase<pg8::EpiOut, pg8::SplitKOrder, true, true>(ldsl, g, S, E);
    }
    SEAM(7);
    if (IN(8)) {
        pg8::Gemm g{(const bf16*)(ws + WS_H1B), (const bf16*)(ws + WS_WUP), MR, 4096, 1024, 1024, 1024, 0, 0}; pg8::StaticOrder S; S.init(MR, 4096, G, bx);
        pg8::EpiUp E{(bf16*)(ws + WS_HB), SS + 2 * 16384};
        pg8::gemm_phase<pg8::EpiUp, pg8::StaticOrder, true, true>(ldsl, g, S, E);
    }
    SEAM(8);
    const int fused_fin = (G == 256 && lo <= 9 && hi >= 11) ? 1 : 0;
    if (IN(9)) {
        pg8::Gemm g{(const bf16*)(ws + WS_HB), (const bf16*)(ws + WS_WDN), MR, 1024, 4096, 4096, 4096, 0, 0}; pg8::StaticOrder S; S.init(MR, 1024, G, bx);
        pg8::EpiDown E{args.out, SS + 3 * 16384, (unsigned*)(ws + WS_BAR) + 3584, args.in[I_GFIN], fused_fin};
        pg8::gemm_phase<pg8::EpiDown, pg8::StaticOrder, true, true>(ldsl, g, S, E);
    }
    if (!fused_fin) {
        SEAM(9);
        if (IN(10)) { const int tid = pg8::fresh_tid(); p10_final(args, tid, G); }
    }
#undef IN
#undef SEAM
}

#ifndef N_LAUNCHES
#define N_LAUNCHES 1
#endif
extern "C" void kernel_launch(void* const* d_in, const int* in_sizes, int n_in, void* d_out, int out_size, void* d_ws, size_t ws_size, hipStream_t stream) {
    static int grid = 0;
    if (grid == 0) {
        int dev = 0, cus = 0, per_cu = 0;
        hipGetDevice(&dev); hipDeviceGetAttribute(&cus, hipDeviceAttributeMultiprocessorCount, dev);
        hipFuncSetAttribute((const void*)fwd_kernel, hipFuncAttributeMaxDynamicSharedMemorySize, LDS_BYTES);
        hipOccupancyMaxActiveBlocksPerMultiprocessor(&per_cu, (const void*)fwd_kernel, NT, LDS_BYTES);
        if (per_cu < 1) { fprintf(stderr, "occupancy query says %d blocks per CU\n", per_cu); per_cu = 1; }
        grid = cus * 1;
        (void)hipGetLastError();
    }
    hipMemsetAsync((char*)d_ws + WS_BAR, 0, 16384, stream);
    Args a{};
    for (int i = 0; i < 26; ++i) a.in[i] = (const float*)d_in[i];
    a.out = (float*)d_out; a.ws = (unsigned char*)d_ws;
    if (N_LAUNCHES == 1) {
        a.ph_lo = 0; a.ph_hi = 11;
        void* args[] = {&a};
        hipError_t e = hipLaunchCooperativeKernel((const void*)fwd_kernel, dim3(grid), dim3(NT), args, LDS_BYTES, stream);
        if (e != hipSuccess) fprintf(stderr, "cooperative launch failed: %s (grid %d)\n", hipGetErrorString(e), grid);
    } else {
        for (int p = 0; p < 11; ++p) { a.ph_lo = p; a.ph_hi = p + 1; hipLaunchKernelGGL(fwd_kernel, dim3(grid), dim3(NT), LDS_BYTES, stream, a); }
    }
}
```

```cpp
#include <hip/hip_runtime.h>
#include <cstdio>
#include <cstdint>
namespace pg8 {
#define PG8_LAS __attribute__((address_space(3)))
typedef unsigned short bf16_t;
typedef short bf16x8 __attribute__((ext_vector_type(8)));
typedef float f32x4 __attribute__((ext_vector_type(4)));
typedef unsigned u32x4 __attribute__((ext_vector_type(4)));
constexpr int BM = 256, BK = 64, HALF = 128, HTB = HALF * BK * 2  , STAGE_BYTES = 8 * HTB, NXCD = 8, WGM = 8;

__host__ __device__ __forceinline__ int lds_byte(int r, int c) { const int st = (r >> 4) * 2 + (c >> 5), rr = r & 15, cc = c & 31, ob = rr * 64 + cc * 2; return st * 1024 + (ob ^ (((ob >> 9) & 1) << 5)); }
__host__ __device__ __forceinline__ void stage_rc(int b, int& R, int& C) { const int st = b / 1024, sb = b % 1024, swz = sb ^ (((sb >> 9) & 1) << 5); R = (st >> 1) * 16 + swz / 64; C = (st & 1) * 32 + (swz % 64) / 2; }
__host__ __device__ __forceinline__ int perm32(int rho) { const int n = rho >> 4, i = rho & 15; return 8 * (i >> 2) + 4 * n + (i & 3); }

struct Unit { int pm, pn, g, par, kh; };
struct Gemm { const bf16_t* A; const bf16_t* Bt; int M, N, K, lda, ldb; size_t gsA, gsB; size_t khA = 0, khB = 0; };

struct StaticOrder {
    int nM, nN, nwg, G, c;
    __host__ __device__ void init(int M, int N, int G_, int c_) { nM = M / BM; nN = N / BM; nwg = nM * nN; G = G_; c = c_; }
    __host__ __device__ bool next(int i, Unit& u) const {
        const long L = (long)i * G + c; if (L >= nwg) return false;
        int wgid = (int)L; { const int q = nwg / NXCD, r = nwg % NXCD, xcd = wgid % NXCD, off = wgid / NXCD; wgid = (xcd < r ? xcd * (q + 1) : r * (q + 1) + (xcd - r) * q) + off; }
        const int nig = WGM * nN, gid = wgid / nig, fm = gid * WGM, gsz = (nM - fm) < WGM ? (nM - fm) : WGM;
        u.pm = fm + ((wgid % nig) % gsz); u.pn = (wgid % nig) / gsz; u.g = 0; u.par = i & 1; u.kh = 0; return true;
    }
    __device__ __forceinline__ void a_ready(const Unit&) const {}
    __device__ __forceinline__ void done(const Unit&) const {}
};

__device__ __forceinline__ unsigned cvt_pk_bf16(float lo, float hi) { unsigned r; asm volatile("v_cvt_pk_bf16_f32 %0, %1, %2" : "=v"(r) : "v"(lo), "v"(hi)); return r; }
typedef float f32x2 __attribute__((ext_vector_type(2)));
__device__ __forceinline__ f32x2 gelu_pk(f32x2 v) {
    const f32x2 av = __builtin_elementwise_abs(v), d = av * 0.2316418882f + 1.0f;
    f32x2 t; t.x = __builtin_amdgcn_rcpf(d.x); t.y = __builtin_amdgcn_rcpf(d.y);
    f32x2 q = t * 0.5307027145f + (-0.7265760135f); q = q * t + 0.7107068705f; q = q * t + (-0.142248368f); q = q * t + 0.127414796f; q = q * t;
    const f32x2 s = (v * v) * (-0.72134752044f);
    f32x2 e; e.x = __builtin_amdgcn_exp2f(s.x); e.y = __builtin_amdgcn_exp2f(s.y);
    const f32x2 m = v * (q * e), r = v - m;
    f32x2 o; o.x = v.x < 0.f ? m.x : r.x; o.y = v.y < 0.f ? m.y : r.y; return o;
}

__device__ __forceinline__ int fresh_tid() { int t; asm volatile("v_mov_b32 %0, %1" : "=v"(t) : "v"((int)threadIdx.x)); return t; }
#define EPI_ROWS_COLS const int rowb = u.pm * BM + wr * 64 + fr; const int colb = wc * 32 + 8 * fq;
__device__ __forceinline__ u32x4 pack8(const f32x4 v0, const f32x4 v1) { u32x4 w; w.x = cvt_pk_bf16(v0[0], v0[1]); w.y = cvt_pk_bf16(v0[2], v0[3]); w.z = cvt_pk_bf16(v1[0], v1[1]); w.w = cvt_pk_bf16(v1[2], v1[3]); return w; }
__device__ __forceinline__ float sum8sq(const f32x4 a, const f32x4 b) { return (a[0] * a[0] + a[1] * a[1]) + (a[2] * a[2] + a[3] * a[3]) + (b[0] * b[0] + b[1] * b[1]) + (b[2] * b[2] + b[3] * b[3]); }

struct EpiInProj {
    static constexpr bool PERM = true, AFTER_DRAIN = false, HAS_MID = false;
    bf16_t* MIX; bf16_t* XBCP; bf16_t* UA; bf16_t* UMETA; float* DTRAW;
    __device__ __forceinline__ void operator()(const f32x4 (&acc)[2][2][4][2], const Unit& u, int wr, int wc, int fr, int fq) const {
        EPI_ROWS_COLS
        const int pn = u.pn;
#pragma unroll
        for (int ai = 0; ai < 2; ++ai)
#pragma unroll
            for (int m = 0; m < 4; ++m) {
                const int r = rowb + ai * HALF + m * 16;
#pragma unroll
                for (int bj = 0; bj < 2; ++bj) {
                    const int c = pn * BM + bj * HALF + colb;
                    const f32x4 v0 = acc[ai][bj][m][0], v1 = acc[ai][bj][m][1];
                    if (pn < 4) { if (r < 16384) *(u32x4*)(MIX + (size_t)r * 2048 + c) = pack8(v0, v1); }
                    else if (pn < 10) { *(u32x4*)(XBCP + (size_t)r * 1536 + (c - 1024)) = pack8(v0, v1); }
                    else if (pn < 14) {
                        const int j = c - 2560, g = j >> 4, h0 = j & 15;
                        if (r < 16384) { const int b = r >> 13, tok = r & 8191, ch = tok >> 4, t = tok & 15;
                            *(u32x4*)(UA + ((size_t)(g * 1024 + b * 512 + ch) * 384 + t * 16 + h0)) = pack8(v0, v1); }
                        else *(u32x4*)(UMETA + (size_t)(r - 16384) * 1024 + j) = pack8(v0, v1);
                    } else {
                        const int j = c - 3584;
                        if (j < 16) { float* d = DTRAW + (size_t)r * 16 + j; *(f32x4*)d = v0; *(f32x4*)(d + 4) = v1; }
                    }
                }
            }
    }
};
struct EpiS5a {
    static constexpr bool PERM = true, AFTER_DRAIN = false, HAS_MID = false;
    float* SEND;
    __device__ __forceinline__ void operator()(const f32x4 (&acc)[2][2][4][2], const Unit& u, int wr, int wc, int fr, int fq) const {
        EPI_ROWS_COLS
#pragma unroll
        for (int ai = 0; ai < 2; ++ai)
#pragma unroll
            for (int m = 0; m < 4; ++m) {
                const int r = rowb + ai * HALF + m * 16;
                float* d = SEND + ((size_t)(u.g * 1024 + r) * 128 + colb);
                *(f32x4*)d = acc[ai][0][m][0]; *(f32x4*)(d + 4) = acc[ai][0][m][1];
            }
    }
};
struct EpiS5b {
    static constexpr bool PERM = true, AFTER_DRAIN = false, HAS_MID = false;
    bf16_t* Y5;
    __device__ __forceinline__ void operator()(const f32x4 (&acc)[2][2][4][2], const Unit& u, int wr, int wc, int fr, int fq) const {
        { const int t2 = fresh_tid(); const int w2 = t2 >> 6, l2 = t2 & 63; wr = w2 >> 2; wc = w2 & 3; fr = l2 & 15; fq = l2 >> 4; }
        const unsigned lane_off = (unsigned)((((u.pm >> 1) * 8192 + (((u.pm & 1) * 256 + wr * 64 + fr) * 16) + (wc * 2 + (fq >> 1))) * 1024 + u.g * 16 + (fq & 1) * 8) * 2);
        char* base = (char*)Y5;
#pragma unroll
        for (int ai = 0; ai < 2; ++ai)
#pragma unroll
            for (int m = 0; m < 4; ++m)
#pragma unroll
                for (int bj = 0; bj < 2; ++bj) {
                    const f32x4 v0 = acc[ai][bj][m][0], v1 = acc[ai][bj][m][1]; u32x4 w;
                    { const f32x2 a = gelu_pk((f32x2){v0[0], v0[1]}); w.x = cvt_pk_bf16(a.x, a.y); } __builtin_amdgcn_sched_barrier(0);
                    { const f32x2 a = gelu_pk((f32x2){v0[2], v0[3]}); w.y = cvt_pk_bf16(a.x, a.y); } __builtin_amdgcn_sched_barrier(0);
                    { const f32x2 a = gelu_pk((f32x2){v1[0], v1[1]}); w.z = cvt_pk_bf16(a.x, a.y); } __builtin_amdgcn_sched_barrier(0);
                    { const f32x2 a = gelu_pk((f32x2){v1[2], v1[3]}); w.w = cvt_pk_bf16(a.x, a.y); } __builtin_amdgcn_sched_barrier(0);
                    const unsigned off = lane_off + (unsigned)(ai * 4194304 + m * 524288 + bj * 16384);
                    *(u32x4*)(base + off) = w;
                }
    }
};
__device__ __forceinline__ float sigm(float x) { return __builtin_amdgcn_rcpf(1.0f + __builtin_amdgcn_exp2f(-1.44269504f * x)); }
struct EpiGlu {
    static constexpr bool PERM = true, AFTER_DRAIN = false, HAS_MID = false;
    bf16_t* MIX; const float* bglu; float* SS5;
    __device__ __forceinline__ void operator()(const f32x4 (&acc)[2][2][4][2], const Unit& u, int wr, int wc, int fr, int fq) const {
        EPI_ROWS_COLS
        const int oc = u.pn * 128 + colb;
        const f32x4 ba0 = *(const f32x4*)(bglu + oc), ba1 = *(const f32x4*)(bglu + oc + 4), bg0 = *(const f32x4*)(bglu + 1024 + oc), bg1 = *(const f32x4*)(bglu + 1024 + oc + 4);
#pragma unroll
        for (int ai = 0; ai < 2; ++ai)
#pragma unroll
            for (int m = 0; m < 4; ++m) {
                const int r = rowb + ai * HALF + m * 16;
                f32x4 a0 = acc[ai][0][m][0] + ba0, a1 = acc[ai][0][m][1] + ba1; const f32x4 g0 = acc[ai][1][m][0] + bg0, g1 = acc[ai][1][m][1] + bg1;
#pragma unroll
                for (int e = 0; e < 4; ++e) { a0[e] *= sigm(g0[e]); a1[e] *= sigm(g1[e]); }
                *(u32x4*)(MIX + (size_t)r * 2048 + 1024 + oc) = pack8(a0, a1);
                float s = sum8sq(a0, a1); s += __shfl_xor(s, 16); s += __shfl_xor(s, 32);
                if (fq == 0) atomicAdd(SS5 + r, s);
            }
    }
};
struct EpiOut {
    static constexpr bool PERM = true, AFTER_DRAIN = false, HAS_MID = true;
    const float* X; float* H1; bf16_t* H1B; const float* SSS; const float* SS5; float* SSM;
    __device__ __forceinline__ void mid(f32x4 (&acc)[2][2][4][2], const Unit& u, int wr, int wc, int fr, int fq) const {
        const int rowb = u.pm * BM + wr * 64 + fr;
#pragma unroll
        for (int ai = 0; ai < 2; ++ai)
#pragma unroll
            for (int m = 0; m < 4; ++m) {
                const int r = rowb + ai * HALF + m * 16;
                const float ratio = sqrtf((SS5[r] * (1.0f / 1024.0f) + 1e-5f) / (SSS[r] * (1.0f / 1024.0f) + 1e-5f));
#pragma unroll
                for (int bj = 0; bj < 2; ++bj)
#pragma unroll
                    for (int n = 0; n < 2; ++n) acc[ai][bj][m][n] *= ratio;
                asm volatile("" ::: "memory");
            }
    }
    __device__ __forceinline__ void operator()(const f32x4 (&acc)[2][2][4][2], const Unit& u, int wr, int wc, int fr, int fq) const {
        EPI_ROWS_COLS
        const unsigned lane_off = (unsigned)(rowb * 1024 + u.pn * BM + colb);
        const char* xb = (const char*)X; char* hb = (char*)H1; char* bb = (char*)H1B;
#pragma unroll
        for (int ai = 0; ai < 2; ++ai)
#pragma unroll
            for (int m = 0; m < 4; ++m) {
                const int r = rowb + ai * HALF + m * 16;
                const float rs = 1.0f / sqrtf(SS5[r] * (1.0f / 1024.0f) + 1e-5f);
                float s = 0.f;
#pragma unroll
                for (int bj = 0; bj < 2; ++bj) {
                    const unsigned off = lane_off + (unsigned)(ai * 131072 + m * 16384 + bj * 128);
                    const f32x4 v0 = *(const f32x4*)(xb + off * 4u) + acc[ai][bj][m][0] * rs, v1 = *(const f32x4*)(xb + off * 4u + 16u) + acc[ai][bj][m][1] * rs;
                    *(f32x4*)(hb + off * 4u) = v0; *(f32x4*)(hb + off * 4u + 16u) = v1;
                    *(u32x4*)(bb + off * 2u) = pack8(v0, v1); s += sum8sq(v0, v1);
                }
                s += __shfl_xor(s, 16); s += __shfl_xor(s, 32);
                if (fq == 0) atomicAdd(SSM + r, s);
                asm volatile("" ::: "memory");
            }
    }
};
struct SplitKOrder {
    StaticOrder base;
    __device__ bool next(int i, Unit& u) const { if (!base.next(i >> 1, u)) return false; u.kh = i & 1; u.par = i & 1; return true; }
    __device__ __forceinline__ void a_ready(const Unit&) const {}
    __device__ __forceinline__ void done(const Unit&) const {}
};
struct EpiUp {
    static constexpr bool PERM = true, AFTER_DRAIN = false, HAS_MID = false;
    bf16_t* HB; const float* SSM;
    __device__ __forceinline__ void operator()(const f32x4 (&acc)[2][2][4][2], const Unit& u, int wr, int wc, int fr, int fq) const {
        EPI_ROWS_COLS
#pragma unroll
        for (int ai = 0; ai < 2; ++ai)
#pragma unroll
            for (int m = 0; m < 4; ++m) {
                const int r = rowb + ai * HALF + m * 16;
                const float rs = 1.0f / sqrtf(SSM[r] * (1.0f / 1024.0f) + 1e-5f);
#pragma unroll
                for (int bj = 0; bj < 2; ++bj) {
                    f32x4 v0 = acc[ai][bj][m][0] * rs, v1 = acc[ai][bj][m][1] * rs;
#pragma unroll
                    for (int e = 0; e < 4; ++e) { const float p = fmaxf(v0[e], 0.f), q = fmaxf(v1[e], 0.f); v0[e] = p * p; v1[e] = q * q; }
                    *(u32x4*)(HB + (size_t)r * 4096 + u.pn * BM + bj * HALF + colb) = pack8(v0, v1);
                }
            }
    }
};
struct EpiDown {
    static constexpr bool PERM = true, AFTER_DRAIN = false, HAS_MID = false;
    float* H; float* SSF; unsigned* pcnt; const float* gfin; int fused;
    __device__ __forceinline__ void operator()(const f32x4 (&acc_)[2][2][4][2], const Unit& u, int wr, int wc, int fr, int fq) const {
        f32x4 (&acc)[2][2][4][2] = const_cast<f32x4 (&)[2][2][4][2]>(acc_);
        EPI_ROWS_COLS
        const unsigned lane_off = (unsigned)(rowb * 1024 + u.pn * BM + colb);
        char* hb = (char*)H;
#pragma unroll
        for (int ai = 0; ai < 2; ++ai)
#pragma unroll
            for (int m = 0; m < 4; ++m) {
                const int r = rowb + ai * HALF + m * 16;
                float s = 0.f;
#pragma unroll
                for (int bj = 0; bj < 2; ++bj) {
                    const unsigned off = lane_off + (unsigned)(ai * 131072 + m * 16384 + bj * 128);
                    const f32x4 v0 = *(const f32x4*)(hb + off * 4u) + acc[ai][bj][m][0], v1 = *(const f32x4*)(hb + off * 4u + 16u) + acc[ai][bj][m][1];
                    if (fused) { acc[ai][bj][m][0] = v0; acc[ai][bj][m][1] = v1; } else { *(f32x4*)(hb + off * 4u) = v0; *(f32x4*)(hb + off * 4u + 16u) = v1; }
                    s += sum8sq(v0, v1);
                }
                s += __shfl_xor(s, 16); s += __shfl_xor(s, 32);
                if (fq == 0) atomicAdd(SSF + r, s);
                asm volatile("" ::: "memory");
            }
        if (!fused) return;
        asm volatile("s_waitcnt vmcnt(0)" ::: "memory");
        unsigned* cw = pcnt + 4 * u.pm;
        if (fr == 0 && fq == 0) __hip_atomic_fetch_add(cw, 1u, __ATOMIC_RELAXED, __HIP_MEMORY_SCOPE_AGENT);
        while (__hip_atomic_load(cw, __ATOMIC_RELAXED, __HIP_MEMORY_SCOPE_AGENT) < 32u) __builtin_amdgcn_s_sleep(4);
        asm volatile("" ::: "memory");
        f32x4 gv[2][2];
#pragma unroll
        for (int bj = 0; bj < 2; ++bj) { gv[bj][0] = *(const f32x4*)(gfin + u.pn * BM + bj * HALF + colb); gv[bj][1] = *(const f32x4*)(gfin + u.pn * BM + bj * HALF + colb + 4); }
#pragma unroll
        for (int ai = 0; ai < 2; ++ai)
#pragma unroll
            for (int m = 0; m < 4; ++m) {
                const int r = rowb + ai * HALF + m * 16;
                const float ssum = __builtin_bit_cast(float, __hip_atomic_load((const unsigned*)(SSF + r), __ATOMIC_RELAXED, __HIP_MEMORY_SCOPE_AGENT));
                const float rs = 1.0f / sqrtf(ssum * (1.0f / 1024.0f) + 1e-5f);
#pragma unroll
                for (int bj = 0; bj < 2; ++bj) {
                    const unsigned off = lane_off + (unsigned)(ai * 131072 + m * 16384 + bj * 128);
                    *(f32x4*)(hb + off * 4u) = acc[ai][bj][m][0] * rs * gv[bj][0]; *(f32x4*)(hb + off * 4u + 16u) = acc[ai][bj][m][1] * rs * gv[bj][1];
                }
            }
    }
};
struct BatchOrder {
    int nU, per_g, Ge, ce;
    __host__ __device__ void init(int nU_, int per_g_, int G, int w0, int c) { nU = nU_; per_g = per_g_; Ge = G - w0; ce = c - w0; }
    __device__ bool next(int i, Unit& u) const {
        if (ce < 0) return false;
        const long L = (long)i * Ge + ce; if (L >= nU) return false;
        u.g = __builtin_amdgcn_readfirstlane((int)L / per_g); u.pm = __builtin_amdgcn_readfirstlane((int)L % per_g); u.pn = 0; u.par = i & 1; u.kh = 0; return true;
    }
    __device__ __forceinline__ void a_ready(const Unit&) const {}
    __device__ __forceinline__ void done(const Unit&) const {}
};
template <class Epi, class Sched, bool ALIGN_EPI = false, bool SP2 = false>
__device__ __forceinline__ void gemm_phase(PG8_LAS unsigned char* lds, const Gemm g, const Sched& S, const Epi& E) {
    const int tid = threadIdx.x, wid = __builtin_amdgcn_readfirstlane(tid >> 6), lane = tid & 63, wr = wid >> 2, wc = wid & 3, fr = lane & 15, fq = lane >> 4;
    const int K = g.K, nt = K / BK;
    unsigned voffA[2], voffB[2];
#pragma unroll
    for (int i = 0; i < 2; ++i) { int R, C; stage_rc(tid * 16 + i * 8192, R, C); const int Rb = Epi::PERM ? ((R & ~31) + perm32(R & 31)) : R;
        voffA[i] = (unsigned)(R * g.lda + C) * 2u; voffB[i] = (unsigned)(Rb * g.ldb + C) * 2u; }
    const size_t kstep = (size_t)(BK * 2);
    const size_t hstepA = (size_t)HALF * g.lda * 2, hstepB = (size_t)HALF * g.ldb * 2;
    const size_t tstepA = 2 * hstepA, tstepB = 2 * hstepB;
    const unsigned ldsw = (unsigned)wid * 1024u;
    const int aoff = lds_byte(wr * 64 + fr, fq * 8), boff = lds_byte(wc * 32 + fr, fq * 8);
#define PG8_SA(b, h) (((b) * 2 + (h)) * HTB)
#define PG8_SB(b, h) ((4 + (b) * 2 + (h)) * HTB)
#define PG8_STAGE(bufoff, gbase, voff) do { _Pragma("unroll") for (int _i = 0; _i < 2; ++_i) \
        __builtin_amdgcn_global_load_lds((const unsigned*)((const char*)(gbase) + (voff)[_i]), (PG8_LAS unsigned*)(lds + (bufoff) + ldsw + _i * 8192), 16, 0, 0); } while (0)
#define PG8_LDA(dst, b, h) do { _Pragma("unroll") for (int m = 0; m < 4; ++m) _Pragma("unroll") for (int k = 0; k < 2; ++k) dst[m][k] = *(const PG8_LAS bf16x8*)(lds + PG8_SA(b, h) + aoff + m * 2048 + k * 1024); } while (0)
#define PG8_LDB(dst, b, h) do { _Pragma("unroll") for (int n = 0; n < 2; ++n) _Pragma("unroll") for (int k = 0; k < 2; ++k) dst[n][k] = *(const PG8_LAS bf16x8*)(lds + PG8_SB(b, h) + boff + n * 2048 + k * 1024); } while (0)
#define PG8_MMA(ai, bj, At, Bt) do { __builtin_amdgcn_s_setprio(1); _Pragma("unroll") for (int m = 0; m < 4; ++m) _Pragma("unroll") for (int n = 0; n < 2; ++n) _Pragma("unroll") for (int k = 0; k < 2; ++k) \
        acc[ai][bj][m][n] = __builtin_amdgcn_mfma_f32_16x16x32_bf16(Bt[n][k], At[m][k], acc[ai][bj][m][n], 0, 0, 0); __builtin_amdgcn_s_setprio(0); } while (0)
#define PG8_WAIT_V(n) asm volatile("s_waitcnt vmcnt(" #n ")" ::: "memory")
#define PG8_WAIT_L(n) asm volatile("s_waitcnt lgkmcnt(" #n ")" ::: "memory")
#define PG8_BAR __builtin_amdgcn_s_barrier()
#define PG8_SCHED __builtin_amdgcn_sched_barrier(0)
    Unit cur, nxt; int ui = 0;
    if (!S.next(0, cur)) return;
    f32x4 acc[2][2][4][2];
#pragma unroll
    for (int a = 0; a < 2; ++a)
#pragma unroll
        for (int b = 0; b < 2; ++b)
#pragma unroll
            for (int m = 0; m < 4; ++m)
#pragma unroll
                for (int n = 0; n < 2; ++n) acc[a][b][m][n] = (f32x4){0.f, 0.f, 0.f, 0.f};
    bf16x8 At[4][2], B0[2][2], B1[2][2];
    const char* cA = (const char*)g.A + (size_t)cur.g * g.gsA + (size_t)cur.pm * tstepA + (size_t)cur.kh * g.khA; const char* cB = (const char*)g.Bt + (size_t)cur.g * g.gsB + (size_t)cur.pn * tstepB + (size_t)cur.kh * g.khB;
    S.a_ready(cur);
    if constexpr (SP2) {
        PG8_STAGE(PG8_SB(0, 0), cB, voffB); PG8_STAGE(PG8_SB(0, 1), cB + hstepB, voffB); PG8_STAGE(PG8_SA(0, 0), cA, voffA); PG8_STAGE(PG8_SA(0, 1), cA + hstepA, voffA);
        if (wr == 1) PG8_BAR;
        PG8_WAIT_V(2); PG8_BAR;
        PG8_STAGE(PG8_SB(1, 0), cB + kstep, voffB); PG8_STAGE(PG8_SA(1, 0), cA + kstep, voffA); PG8_STAGE(PG8_SB(1, 1), cB + hstepB + kstep, voffB);
        PG8_WAIT_V(6); PG8_BAR;
    } else {
        PG8_STAGE(PG8_SB(0, 0), cB, voffB); PG8_STAGE(PG8_SA(0, 0), cA, voffA); PG8_STAGE(PG8_SB(0, 1), cB + hstepB, voffB); PG8_STAGE(PG8_SA(0, 1), cA + hstepA, voffA);
        if (wr == 1) PG8_BAR;
        PG8_WAIT_V(4); PG8_BAR;
        PG8_STAGE(PG8_SB(1, 0), cB + kstep, voffB); PG8_STAGE(PG8_SA(1, 0), cA + kstep, voffA); PG8_STAGE(PG8_SB(1, 1), cB + hstepB + kstep, voffB);
        PG8_WAIT_V(6); PG8_BAR;
    }
    for (;;) {
        const bool has_next = S.next(ui + 1, nxt);
        const char* nA = has_next ? (const char*)g.A + (size_t)nxt.g * g.gsA + (size_t)nxt.pm * tstepA + (size_t)nxt.kh * g.khA : cA; const char* nB = has_next ? (const char*)g.Bt + (size_t)nxt.g * g.gsB + (size_t)nxt.pn * tstepB + (size_t)nxt.kh * g.khB : cB;
        for (int t = 0; t < nt; t += 2) {
            const bool last = (t == nt - 2);
            const char* a1 = cA + (size_t)(t + 1) * kstep;
            const char* a2 = last ? nA : cA + (size_t)(t + 2) * kstep; const char* b2 = last ? nB : cB + (size_t)(t + 2) * kstep;
            const char* a3 = a2 + kstep; const char* b3 = b2 + kstep;
            if (last && has_next) S.a_ready(nxt);
            if constexpr (SP2) {
            PG8_LDB(B0, 0, 0); PG8_LDB(B1, 0, 1); PG8_SCHED; PG8_LDA(At, 0, 0); PG8_STAGE(PG8_SA(1, 1), a1 + hstepA, voffA);
            PG8_WAIT_V(8); PG8_WAIT_L(0); PG8_BAR; PG8_MMA(0, 0, At, B0); PG8_MMA(0, 1, At, B1); PG8_BAR; PG8_SCHED;
            PG8_LDA(At, 0, 1); PG8_STAGE(PG8_SB(0, 0), b2, voffB); PG8_STAGE(PG8_SB(0, 1), b2 + hstepB, voffB); PG8_STAGE(PG8_SA(0, 0), a2, voffA);
            PG8_WAIT_V(8); PG8_WAIT_L(0); PG8_BAR; PG8_MMA(1, 0, At, B0); PG8_MMA(1, 1, At, B1); PG8_BAR; PG8_SCHED;
            PG8_LDB(B0, 1, 0); PG8_LDB(B1, 1, 1); PG8_SCHED; PG8_LDA(At, 1, 0); PG8_STAGE(PG8_SA(0, 1), a2 + hstepA, voffA);
            PG8_WAIT_V(8); PG8_WAIT_L(0); PG8_BAR; PG8_MMA(0, 0, At, B0); PG8_MMA(0, 1, At, B1); PG8_BAR; PG8_SCHED;
            PG8_LDA(At, 1, 1); PG8_STAGE(PG8_SB(1, 0), b3, voffB); PG8_STAGE(PG8_SB(1, 1), b3 + hstepB, voffB); PG8_STAGE(PG8_SA(1, 0), a3, voffA);
            PG8_WAIT_V(8); PG8_WAIT_L(0); PG8_BAR; PG8_MMA(1, 0, At, B0); PG8_MMA(1, 1, At, B1); PG8_BAR; PG8_SCHED;
            } else {
            PG8_LDB(B0, 0, 0); PG8_SCHED; PG8_LDA(At, 0, 0); PG8_STAGE(PG8_SA(1, 1), a1 + hstepA, voffA);
            PG8_WAIT_L(8); PG8_BAR; PG8_WAIT_L(0); PG8_MMA(0, 0, At, B0); PG8_BAR; PG8_SCHED;
            PG8_LDB(B1, 0, 1); PG8_STAGE(PG8_SB(0, 0), b2, voffB);
            PG8_BAR; PG8_WAIT_L(0); PG8_MMA(0, 1, At, B1); PG8_BAR;
            PG8_LDA(At, 0, 1); PG8_STAGE(PG8_SA(0, 0), a2, voffA);
            PG8_BAR; PG8_WAIT_L(0); PG8_MMA(1, 0, At, B0); PG8_BAR; PG8_SCHED;
            PG8_STAGE(PG8_SB(0, 1), b2 + hstepB, voffB);
            PG8_WAIT_V(6); PG8_BAR; PG8_MMA(1, 1, At, B1); PG8_BAR;
            PG8_LDB(B0, 1, 0); PG8_SCHED; PG8_LDA(At, 1, 0); PG8_STAGE(PG8_SA(0, 1), a2 + hstepA, voffA);
            PG8_WAIT_L(8); PG8_BAR; PG8_WAIT_L(0); PG8_MMA(0, 0, At, B0); PG8_BAR; PG8_SCHED;
            PG8_LDB(B1, 1, 1); PG8_STAGE(PG8_SB(1, 0), b3, voffB);
            PG8_BAR; PG8_WAIT_L(0); PG8_MMA(0, 1, At, B1); PG8_BAR;
            PG8_LDA(At, 1, 1); PG8_STAGE(PG8_SA(1, 0), a3, voffA);
            PG8_BAR; PG8_WAIT_L(0); PG8_MMA(1, 0, At, B0); PG8_BAR; PG8_SCHED;
            PG8_STAGE(PG8_SB(1, 1), b3 + hstepB, voffB);
            PG8_WAIT_V(6); PG8_BAR; PG8_MMA(1, 1, At, B1); PG8_BAR;
            }
        }
        if constexpr (ALIGN_EPI) { if (wr == 0) PG8_BAR; }
        bool keep = false;
        if constexpr (Epi::HAS_MID) { if (cur.kh == 0) { E.mid(acc, cur, wr, wc, fr, fq); keep = true; } }
        if (!keep) { if constexpr (!Epi::AFTER_DRAIN) { E(acc, cur, wr, wc, fr, fq); S.done(cur); } }
        if (!has_next) break;
        if (!keep)
#pragma unroll
        for (int a = 0; a < 2; ++a)
#pragma unroll
            for (int b = 0; b < 2; ++b)
#pragma unroll
                for (int m = 0; m < 4; ++m)
#pragma unroll
                    for (int n = 0; n < 2; ++n) acc[a][b][m][n] = (f32x4){0.f, 0.f, 0.f, 0.f};
        cur = nxt; cA = nA; cB = nB; ++ui;
        if constexpr (ALIGN_EPI) { if (wr == 1) PG8_BAR; }
    }
    PG8_WAIT_V(0);
    if constexpr (!ALIGN_EPI) { if (wr == 0) PG8_BAR; }
    PG8_BAR;
    if constexpr (Epi::AFTER_DRAIN) { E.fused(acc, cur, wr, wc, fr, fq, lds, wid, lane); S.done(cur); }
#undef PG8_SA
#undef PG8_SB
#undef PG8_STAGE
#undef PG8_LDA
#undef PG8_LDB
#undef PG8_MMA
#undef PG8_WAIT_V
#undef PG8_WAIT_L
#undef PG8_BAR
#undef PG8_SCHED
}
}

#include <hip/hip_cooperative_groups.h>
namespace cg = cooperative_groups;
typedef unsigned short bf16;
typedef unsigned v4u __attribute__((ext_vector_type(4)));
typedef unsigned v2u __attribute__((ext_vector_type(2)));
typedef float f32x4 __attribute__((ext_vector_type(4)));
typedef float f32x2 __attribute__((ext_vector_type(2)));
typedef short bf16x8 __attribute__((ext_vector_type(8)));

constexpr int NT = 512, NWAVES = 8;
constexpr int MR = 16384, MP = 16640;
constexpr int NIN = 3840;
constexpr int NQ = 65;
constexpr float EPS = 1e-5f;
constexpr size_t MiB = 1u << 20;
constexpr size_t WS_SS    = 0;
constexpr size_t WS_DEC   = 256 * 1024;
constexpr size_t WS_A1    = 288 * 1024;
constexpr size_t WS_A16   = 320 * 1024;
constexpr size_t WS_BAR   = 384 * 1024;
constexpr size_t WS_BBAR  = 512 * 1024;
constexpr size_t WS_UMETA = 1 * MiB;
constexpr size_t WS_DTRAW = 1 * MiB + 512 * 1024;
constexpr size_t WS_DT    = 2 * MiB + 640 * 1024;
constexpr size_t WS_ACS   = 254 * MiB + 512 * 1024;
static_assert(WS_DTRAW + 16640 * 16 * 4 <= WS_DT && WS_DT + 65 * 16 * 256 * 4 <= 4 * MiB && WS_ACS + 65 * 16 * 256 * 4 <= 256 * MiB, "smalls");
constexpr size_t WS_WGLU  = 4 * MiB;
constexpr size_t WS_TB5   = 8 * MiB;
constexpr size_t WS_TE5   = 20 * MiB;
constexpr size_t WS_WIN   = 28 * MiB;
constexpr size_t WS_PREV  = 20 * MiB;
constexpr size_t WS_WOUT  = 8 * MiB, WS_WUP = 12 * MiB, WS_WDN = 20 * MiB;
constexpr size_t WS_MIX   = 36 * MiB;
constexpr size_t WS_UA    = 100 * MiB;
constexpr size_t WS_XBCP  = 148 * MiB;
constexpr size_t WS_SEND  = 148 * MiB;
constexpr size_t WS_ST    = 180 * MiB;
constexpr size_t WS_Y5    = 148 * MiB;
constexpr size_t WS_XN    = 197 * MiB;
constexpr size_t WS_XF    = 197 * MiB;
constexpr size_t WS_H1B   = 197 * MiB;
constexpr size_t WS_CT    = 230 * MiB;
constexpr size_t WS_BTK   = WS_CT + 65 * 65536 * 2;
constexpr size_t WS_BF    = WS_BTK + 65 * 65536 * 2;
constexpr size_t WS_HB    = 36 * MiB;
static_assert(WS_BF + 65 * 65536 * 2 <= WS_ACS, "ws");
constexpr int LDS_BYTES = 155648;

__device__ __forceinline__ unsigned f2bf(float f) { unsigned u = __builtin_bit_cast(unsigned, f); return (u + 0x7fffu + ((u >> 16) & 1u)) >> 16; }
__device__ __forceinline__ unsigned pk2(float lo, float hi) { unsigned r; asm("v_cvt_pk_bf16_f32 %0, %1, %2" : "=v"(r) : "v"(lo), "v"(hi)); return r; }
__device__ __forceinline__ float bf2f(unsigned short h) { return __builtin_bit_cast(float, (unsigned)h << 16); }
__device__ __forceinline__ float bflo(unsigned w) { return __builtin_bit_cast(float, w << 16); }
__device__ __forceinline__ float bfhi(unsigned w) { return __builtin_bit_cast(float, w & 0xffff0000u); }
__device__ __forceinline__ float ex2(float x) { return __builtin_amdgcn_exp2f(x); }
__device__ __forceinline__ float expf_(float x) { return __builtin_amdgcn_exp2f(1.44269504f * x); }
__device__ __forceinline__ float wave_sum(float v) {
#pragma unroll
    for (int o = 1; o < 64; o <<= 1) v += __shfl_xor(v, o);
    return v;
}

#define LAS __attribute__((address_space(3)))
#define XB_TMO      128
#define XB_XCNT(j)  (256  + 64 * (j))
#define XB_XSUB(j)  (1280 + 64 * (j))
#define XB_XGEN(j)  (2304 + 64 * (j))
#define XB_TOP      3328
#define XB_TOPGEN   3392
#define XCD_BAR_WORDS 3456
#define XB_SPIN_CAP (1u << 18)

__device__ __forceinline__ unsigned xb_ld(unsigned* p)              { return __hip_atomic_load(p, __ATOMIC_RELAXED, __HIP_MEMORY_SCOPE_AGENT); }
__device__ __forceinline__ unsigned xb_add(unsigned* p, unsigned v) { return __hip_atomic_fetch_add(p, v, __ATOMIC_RELAXED, __HIP_MEMORY_SCOPE_AGENT); }
__device__ __forceinline__ unsigned xb_xcc_id() { return (unsigned)__builtin_amdgcn_s_getreg((3 << 11) | 20) & 0xFu; }
#define XB_SPIN(cond, bar) do { unsigned _sp = 0; while (cond) { __builtin_amdgcn_s_sleep(1); \
    if ((++_sp & 255u) == 0u) { if (xb_ld(&(bar)[XB_TMO])) break; if (_sp > XB_SPIN_CAP) { atomicAdd(&(bar)[XB_TMO], 1u); break; } } } } while (0)

struct XcdBarrier {
    unsigned* bar; unsigned x;
    volatile LAS unsigned* st;
};

__device__ __forceinline__ XcdBarrier xcd_barrier_post(unsigned* bar, volatile LAS unsigned* st) {
    XcdBarrier b; b.bar = bar; b.x = xb_xcc_id(); b.st = st;
    if (threadIdx.x == 0) (void)xb_add(&bar[XB_XCNT(b.x)], 1u);
    return b;
}
__device__ __forceinline__ void xcd_barrier_complete(unsigned* bar, unsigned x, unsigned& nloc, unsigned& nx) {
    const unsigned G = gridDim.x * gridDim.y * gridDim.z;
    unsigned sum, cnt, mine, sp = 0u;
    for (;;) {
        sum = 0u; cnt = 0u; mine = 0u;
#pragma unroll
        for (unsigned j = 0; j < 16; ++j) { const unsigned c = xb_ld(&bar[XB_XCNT(j)]); sum += c; cnt += (c > 0u) ? 1u : 0u; mine = (j == x) ? c : mine; }
        if (sum == G) break;
        __builtin_amdgcn_s_sleep(1);
        if ((++sp & 255u) == 0u) { if (xb_ld(&bar[XB_TMO])) break; if (sp > XB_SPIN_CAP) { atomicAdd(&bar[XB_TMO], 1u); break; } }
    }
    nloc = mine > 0u ? mine : 1u; nx = cnt > 0u ? cnt : 1u;
}

__device__ __forceinline__ void xcd_barrier(const XcdBarrier& b) {
    asm volatile("s_waitcnt vmcnt(0)" ::: "memory");
    __syncthreads();
    if (threadIdx.x == 0) {
        unsigned* bar = b.bar;
        __builtin_amdgcn_s_waitcnt(0);
        unsigned nloc = b.st[0], nx = b.st[1];
        if (nloc == 0u) { xcd_barrier_complete(bar, b.x, nloc, nx); b.st[0] = nloc; b.st[1] = nx; }
        const unsigned old = xb_add(&bar[XB_XSUB(b.x)], 1u);
        const unsigned gen = old / nloc;
        if (old + 1u == (gen + 1u) * nloc) {
            __builtin_amdgcn_fence(__ATOMIC_RELEASE, "agent");
            asm volatile("s_waitcnt vmcnt(0)" ::: "memory");
            const unsigned og = xb_add(&bar[XB_TOP], 1u);
            const unsigned tg = og / nx;
            if (og + 1u == (tg + 1u) * nx) xb_add(&bar[XB_TOPGEN], 1u);
            else XB_SPIN(xb_ld(&bar[XB_TOPGEN]) == tg, bar);
            __builtin_amdgcn_fence(__ATOMIC_ACQUIRE, "agent");
            xb_add(&bar[XB_XGEN(b.x)], 1u);
            asm volatile("s_waitcnt vmcnt(0)" ::: "memory");
        } else {
            XB_SPIN(xb_ld(&bar[XB_XGEN(b.x)]) == gen, bar);
            __builtin_amdgcn_fence(__ATOMIC_ACQUIRE, "agent");
            asm volatile("s_waitcnt vmcnt(0)" ::: "memory");
        }
    }
    __syncthreads();
}

struct Args {
    const float* in[26]; float* out; unsigned char* ws; int ph_lo, ph_hi;
};
enum { I_X = 0, I_META, I_GMIX, I_WIN, I_CONVW, I_CONVB, I_DTB, I_ALOG, I_DSSD, I_GSSD, I_LRE, I_LIM, I_LSTEP, I_BRE, I_BIM, I_CRE, I_CIM, I_DS5, I_WGLU, I_BGLU, I_GS5, I_WOUT, I_GMLP, I_WUP, I_WDN, I_GFIN };

template <int MODE> __device__ __forceinline__ int colmap(int j) {
    if (MODE == 1) { if (j < 2560) return j; if (j < 3584) return j + 16; if (j < 3600) return j - 1024; return -1; }
    if (MODE == 2) { const int pn = j >> 8, r = j & 255; return r < 128 ? pn * 128 + r : 1024 + pn * 128 + (r - 128); }
    return j;
}
template <int MODE> __device__ __forceinline__ void transpose_item(const float* W, int K, int N, bf16* WT, const float* ks0, const float* ks1, float* scr, int item, int nblk, int lane) {
    const int kb = item / nblk, nb = item % nblk, k0 = 64 * kb, n0 = 32 * nb;
    const int src = colmap<MODE>(n0 + (lane & 31));
#pragma unroll
    for (int i = 0; i < 32; ++i) { const int kk = 2 * i + (lane >> 5); const int k = k0 + kk;
        float v = src >= 0 ? W[(size_t)k * N + src] : 0.f;
        if (ks0) v *= (k < 1024 ? ks0[k] : ks1[k - 1024]);
        scr[kk * 33 + (lane & 31)] = v; }
    asm volatile("s_waitcnt lgkmcnt(0)" ::: "memory");
    const int c = lane & 7;
#pragma unroll
    for (int j = 0; j < 4; ++j) { const int n = (lane >> 3) + 8 * j; const float* s = scr + (8 * c) * 33 + n;
        v4u o; o.x = pk2(s[0 * 33], s[1 * 33]); o.y = pk2(s[2 * 33], s[3 * 33]); o.z = pk2(s[4 * 33], s[5 * 33]); o.w = pk2(s[6 * 33], s[7 * 33]);
        *(v4u*)(WT + (size_t)(n0 + n) * K + k0 + 8 * c) = o; }
    asm volatile("s_waitcnt lgkmcnt(0)" ::: "memory");
}

__device__ __forceinline__ void sincos_d(double th, float& sn, float& cs) {
    const double k = rint(th * 0.15915494309189535); const double r = fma(-k, 6.283185307179586, th);
    const double t = r * 0.125, t2 = t * t;
    double s = t * (1.0 + t2 * (-1.0 / 6 + t2 * (1.0 / 120 + t2 * (-1.0 / 5040 + t2 * (1.0 / 362880 + t2 * (-1.0 / 39916800))))));
    double c = 1.0 + t2 * (-0.5 + t2 * (1.0 / 24 + t2 * (-1.0 / 720 + t2 * (1.0 / 40320 + t2 * (-1.0 / 3628800 + t2 * (1.0 / 479001600))))));
#pragma unroll
    for (int i = 0; i < 3; ++i) { const double s2 = 2.0 * s * c, c2 = 1.0 - 2.0 * s * s; s = s2; c = c2; }
    sn = (float)s; cs = (float)c;
}

__device__ __forceinline__ void s5_tables(const Args& a, int g, unsigned char* lds, int tid) {
    f32x2* pw = (f32x2*)lds;
    f32x2* Cc = pw + 17 * 64;
    f32x2* Bb = Cc + 16 * 64;
    float* Kt = (float*)(Bb + 64 * 16);
    unsigned char* ws = a.ws;
    if (tid < 64) {
        const int p = tid; const float lr = a.in[I_LRE][g * 64 + p], li = a.in[I_LIM][g * 64 + p]; const float st = expf(a.in[I_LSTEP][g]);
        float are = 1.f, aim = 0.f;
        for (int tau = 0; tau <= 16; ++tau) {
            const float mag = expf(lr * st * (float)tau); float sn, cs; sincos_d((double)li * (double)st * (double)tau, sn, cs);
            pw[tau * 64 + p] = (f32x2){mag * cs, mag * sn};
            if (tau == 1) { are = mag * cs; aim = mag * sn; ((f32x2*)(ws + WS_A1))[g * 64 + p] = (f32x2){are, aim}; }
            if (tau == 16) ((f32x2*)(ws + WS_A16))[g * 64 + p] = (f32x2){mag * cs, mag * sn};
        }
        const float den = lr * lr + li * li;
        const float cre = ((are - 1.0f) * lr + aim * li) / den, cim = (aim * lr - (are - 1.0f) * li) / den;
        f32x4 brv[4], biv[4];
#pragma unroll
        for (int h4 = 0; h4 < 4; ++h4) { brv[h4] = *(const f32x4*)(a.in[I_BRE] + (g * 64 + p) * 16 + 4 * h4); biv[h4] = *(const f32x4*)(a.in[I_BIM] + (g * 64 + p) * 16 + 4 * h4); }
#pragma unroll
        for (int h = 0; h < 16; ++h) { const float br = brv[h >> 2][h & 3], bi = biv[h >> 2][h & 3];
            const f32x2 v = (f32x2){cre * br - cim * bi, cre * bi + cim * br}; Bb[p * 16 + h] = v; ((f32x2*)(ws + WS_BBAR))[(g * 64 + p) * 16 + h] = v; }
    }
    for (int e = tid; e < 1024; e += NT) Cc[e] = (f32x2){a.in[I_CRE][g * 1024 + e], a.in[I_CIM][g * 1024 + e]};
    __syncthreads();
    {
        const int tau = tid >> 5, h = (tid >> 1) & 15, h0 = (tid & 1) * 8; float acc[8];
#pragma unroll
        for (int j = 0; j < 8; ++j) acc[j] = 0.f;
        for (int p = 0; p < 64; ++p) { const f32x2 c = Cc[h * 64 + p], w = pw[tau * 64 + p]; const float tr = c.x * w.x - c.y * w.y, ti = c.x * w.y + c.y * w.x;
#pragma unroll
            for (int j = 0; j < 8; ++j) { const f32x2 b = Bb[p * 16 + h0 + j]; acc[j] += tr * b.x - ti * b.y; } }
        if (tau == 0) {
#pragma unroll
            for (int j = 0; j < 8; ++j) if (h0 + j == h) acc[j] += a.in[I_DS5][g * 16 + h];
        }
#pragma unroll
        for (int j = 0; j < 8; ++j) Kt[(tau * 16 + h) * 16 + h0 + j] = acc[j];
    }
    __syncthreads();
    bf16* TB = (bf16*)(ws + WS_TB5) + (size_t)g * 256 * 384;
    for (int pc = tid; pc < 256 * 48; pc += NT) {
        const int row = pc / 48, c8 = (pc % 48) * 8, t = row >> 4, h = row & 15; float v[8];
        if (c8 < 256) { const int s = c8 >> 4, h0 = c8 & 15;
#pragma unroll
            for (int j = 0; j < 8; ++j) v[j] = s <= t ? Kt[((t - s) * 16 + h) * 16 + h0 + j] : 0.f;
        } else { const int p0 = (c8 - 256) >> 1;
#pragma unroll
            for (int j = 0; j < 4; ++j) { const f32x2 c = Cc[h * 64 + p0 + j], w = pw[(t + 1) * 64 + p0 + j]; v[2 * j] = c.x * w.x - c.y * w.y; v[2 * j + 1] = -(c.x * w.y + c.y * w.x); }
        }
        v4u o; o.x = pk2(v[0], v[1]); o.y = pk2(v[2], v[3]); o.z = pk2(v[4], v[5]); o.w = pk2(v[6], v[7]);
        *(v4u*)(TB + (size_t)row * 384 + c8) = o;
    }
    bf16* TE = (bf16*)(ws + WS_TE5) + (size_t)g * 256 * 256;
    for (int pc = tid; pc < 256 * 32; pc += NT) {
        const int row = pc >> 5, c8 = (pc & 31) * 8; float v[8];
        if (row < 128) { const int p = row >> 1, ri = row & 1, s = c8 >> 4, h0 = c8 & 15; const f32x2 w = pw[(15 - s) * 64 + p];
#pragma unroll
            for (int j = 0; j < 8; ++j) { const f32x2 b = Bb[p * 16 + h0 + j]; v[j] = ri ? (w.x * b.y + w.y * b.x) : (w.x * b.x - w.y * b.y); }
        } else {
#pragma unroll
            for (int j = 0; j < 8; ++j) v[j] = 0.f;
        }
        v4u o; o.x = pk2(v[0], v[1]); o.y = pk2(v[2], v[3]); o.z = pk2(v[4], v[5]); o.w = pk2(v[6], v[7]);
        *(v4u*)(TE + (size_t)row * 256 + c8) = o;
    }
    __syncthreads();
}

__device__ __forceinline__ void rms_row_to_bf16(const float* xrow, const float* gain, bf16* orow, int lane) {
    unsigned long long* o8 = (unsigned long long*)orow + lane;
    if (!xrow) {
#pragma unroll
        for (int j = 0; j < 4; ++j) o8[64 * j] = 0ull;
        return; }
    const f32x4* xr = (const f32x4*)xrow + lane; const f32x4* gr = (const f32x4*)gain + lane;
    f32x4 v[4]; float s = 0.f;
#pragma unroll
    for (int j = 0; j < 4; ++j) { v[j] = xr[64 * j]; s += (v[j].x * v[j].x + v[j].y * v[j].y) + (v[j].z * v[j].z + v[j].w * v[j].w); }
    const float rstd = 1.f / sqrtf(wave_sum(s) * (1.f / 1024.f) + EPS);
#pragma unroll
    for (int j = 0; j < 4; ++j) { const f32x4 gg = gr[64 * j]; const f32x4 w = v[j] * rstd * gg; o8[64 * j] = (unsigned long long)pk2(w.x, w.y) | ((unsigned long long)pk2(w.z, w.w) << 32); }
}

__device__ __forceinline__ void p0_prologue(const Args& a, unsigned char* lds, int tid, int G) {
    unsigned char* ws = a.ws; const int lane = tid & 63, wave = tid >> 6;
    const int gw = blockIdx.x * NWAVES + wave, NGW = G * NWAVES;
    for (int i = blockIdx.x * NT + tid; i < 4 * 16384; i += G * NT) ((float*)(ws + WS_SS))[i] = 0.f;
    for (int g = (G - 1 - (int)blockIdx.x); g < 64; g += G) s5_tables(a, g, lds, tid);
    __syncthreads();
    float* scr = (float*)(lds + wave * 16384);
    constexpr int NB_IN = NIN / 32, NB_GL = 2048 / 32;
    constexpr int I_IN = 16 * NB_IN, I_GL = 16 * NB_GL;
    const int nT = (G > 128) ? G - 64 : G;
    if ((int)blockIdx.x < nT) for (int it = gw; it < I_IN + I_GL; it += nT * NWAVES) {
        if (it < I_IN) transpose_item<1>(a.in[I_WIN], 1024, 3600, (bf16*)(ws + WS_WIN), nullptr, nullptr, scr, it, NB_IN, lane);
        else transpose_item<2>(a.in[I_WGLU], 1024, 2048, (bf16*)(ws + WS_WGLU), nullptr, nullptr, scr, it - I_IN, NB_GL, lane);
    }
    for (int m0 = gw; m0 < MR; m0 += 8 * NGW) {
        const f32x4* gr = (const f32x4*)a.in[I_GMIX] + lane; f32x4 v[8][4];
#pragma unroll
        for (int k = 0; k < 8; ++k) { const int m = m0 + k * NGW; const f32x4* xr = (const f32x4*)(a.in[I_X] + (size_t)(m < MR ? m : m0) * 1024) + lane;
#pragma unroll
            for (int j = 0; j < 4; ++j) v[k][j] = xr[64 * j]; }
        f32x4 gg[4];
#pragma unroll
        for (int j = 0; j < 4; ++j) gg[j] = gr[64 * j];
#pragma unroll
        for (int k = 0; k < 8; ++k) { const int m = m0 + k * NGW; float sq = 0.f;
#pragma unroll
            for (int j = 0; j < 4; ++j) sq += (v[k][j].x * v[k][j].x + v[k][j].y * v[k][j].y) + (v[k][j].z * v[k][j].z + v[k][j].w * v[k][j].w);
            const float rstd = 1.f / sqrtf(wave_sum(sq) * (1.f / 1024.f) + EPS);
            if (m < MR) { unsigned long long* o8 = (unsigned long long*)((bf16*)(ws + WS_XN) + (size_t)m * 1024) + lane;
#pragma unroll
                for (int j = 0; j < 4; ++j) { const f32x4 w = v[k][j] * rstd * gg[j]; o8[64 * j] = (unsigned long long)pk2(w.x, w.y) | ((unsigned long long)pk2(w.z, w.w) << 32); } }
        }
    }
    for (int m = MR + gw; m < MP; m += NGW)
        rms_row_to_bf16(m < MR + 16 ? a.in[I_META] + (size_t)(m - MR) * 1024 : nullptr, a.in[I_GMIX], (bf16*)(ws + WS_XN) + (size_t)m * 1024, lane);
}
__device__ __forceinline__ void p6_weights(const Args& a, unsigned char* lds, int tid, int G) {
    unsigned char* ws = a.ws; const int lane = tid & 63, wave = tid >> 6;
    const int gw = blockIdx.x * NWAVES + wave, NGW = G * NWAVES;
    float* scr = (float*)(lds + wave * 16384);
    constexpr int I_O = 32 * 32, I_U = 16 * 128, I_D = 64 * 32;
    for (int it = gw; it < I_O + I_U + I_D; it += NGW) {
        if (it < I_O) transpose_item<0>(a.in[I_WOUT], 2048, 1024, (bf16*)(ws + WS_WOUT), a.in[I_GSSD], a.in[I_GS5], scr, it, 32, lane);
        else if (it < I_O + I_U) transpose_item<0>(a.in[I_WUP], 1024, 4096, (bf16*)(ws + WS_WUP), a.in[I_GMLP], a.in[I_GMLP], scr, it - I_O, 128, lane);
        else transpose_item<0>(a.in[I_WDN], 4096, 1024, (bf16*)(ws + WS_WDN), nullptr, nullptr, scr, it - I_O - I_U, 32, lane);
    }
    __syncthreads();
}

__device__ __forceinline__ int chunk_row(int q, int tok) {
    if (q == 0) return tok < 240 ? -1 : MR + (tok - 240);
    const int b = (q - 1) >> 5, c = (q - 1) & 31;
    if (tok < 0 && c == 0) return MR + 16 + tok;
    return b * 8192 + c * 256 + tok;
}
__device__ __forceinline__ float silu_(float x) { return x * __builtin_amdgcn_rcpf(1.0f + ex2(-1.44269504f * x)); }
__device__ __forceinline__ void p2_conv_unit(const Args& a, int q, int blk, unsigned char* lds, int tid) {
    unsigned char* ws = a.ws;
    bf16* IN = (bf16*)lds;
    bf16* OT = (bf16*)(lds + 40960);
    const bf16* XBCP = (const bf16*)(ws + WS_XBCP);
    const int ch0 = blk * 64;
    for (int pc = tid; pc < 259 * 8; pc += NT) { const int rr = pc >> 3, c8 = (pc & 7) * 8; const int row = chunk_row(q, rr - 3);
        v4u v = (v4u){0u, 0u, 0u, 0u}; if (row >= 0) v = *(const v4u*)(XBCP + (size_t)row * 1536 + ch0 + c8);
        *(v4u*)(IN + rr * 64 + c8) = v; }
    __syncthreads();
    const float* cw = a.in[I_CONVW]; const float* cb = a.in[I_CONVB];
    const bool is_x = blk < 16, is_b = blk >= 16 && blk < 20;
    if (!is_x) {
        bf16* dst = (bf16*)(ws + (is_b ? WS_BTK : WS_CT)) + (size_t)q * 65536 + (is_b ? (blk - 16) : (blk - 20)) * 64;
        const int c8 = (tid & 7) * 8; float wreg[4][8], breg[8];
#pragma unroll
        for (int j = 0; j < 8; ++j) { breg[j] = cb[ch0 + c8 + j];
#pragma unroll
            for (int k = 0; k < 4; ++k) wreg[k][j] = cw[k * 1536 + ch0 + c8 + j]; }
        for (int pc = tid; pc < 256 * 8; pc += NT) { const int tok = pc >> 3; float o[8];
            const bool zero = (q == 0 && tok < 240);
#pragma unroll
            for (int j = 0; j < 8; ++j) o[j] = breg[j];
#pragma unroll
            for (int k = 0; k < 4; ++k) { const v4u v = *(const v4u*)(IN + (tok + k) * 64 + c8); const unsigned w[4] = {v.x, v.y, v.z, v.w};
#pragma unroll
                for (int j = 0; j < 4; ++j) { o[2 * j] += wreg[k][2 * j] * bflo(w[j]); o[2 * j + 1] += wreg[k][2 * j + 1] * bfhi(w[j]); } }
#pragma unroll
            for (int j = 0; j < 8; ++j) o[j] = zero ? 0.f : silu_(o[j]);
            v4u ov; ov.x = pk2(o[0], o[1]); ov.y = pk2(o[2], o[3]); ov.z = pk2(o[4], o[5]); ov.w = pk2(o[6], o[7]);
            *(v4u*)(dst + (size_t)tok * 256 + c8) = ov; }
    }
    if (is_x || is_b) {
        const int ch = tid & 63; float wk[4]; const float bias = cb[ch0 + ch];
#pragma unroll
        for (int k = 0; k < 4; ++k) wk[k] = cw[k * 1536 + ch0 + ch];
        for (int it = tid; it < 64 * 32; it += NT) { const int t0 = (it >> 6) * 8; float in[11], o[8];
#pragma unroll
            for (int j = 0; j < 11; ++j) in[j] = bf2f(IN[(t0 + j) * 64 + ch]);
#pragma unroll
            for (int j = 0; j < 8; ++j) { const float v = bias + wk[0] * in[j] + wk[1] * in[j + 1] + wk[2] * in[j + 2] + wk[3] * in[j + 3]; o[j] = (q == 0 && t0 + j < 240) ? 0.f : silu_(v); }
            v4u ov; ov.x = pk2(o[0], o[1]); ov.y = pk2(o[2], o[3]); ov.z = pk2(o[4], o[5]); ov.w = pk2(o[6], o[7]);
            *(v4u*)(OT + ch * 264 + t0) = ov; }
        __syncthreads();
        bf16* dst = is_x ? (bf16*)(ws + WS_XF) + ((size_t)q * 1024 + ch0) * 256 : (bf16*)(ws + WS_BF) + ((size_t)q * 256 + (blk - 16) * 64) * 256;
        for (int pc = tid; pc < 64 * 32; pc += NT) { const int ch = pc >> 5, t8 = (pc & 31) * 8; *(v4u*)(dst + (size_t)ch * 256 + t8) = *(const v4u*)(OT + ch * 264 + t8); }
    }
    __syncthreads();
}
__device__ __forceinline__ void p2_dt_item(const Args& a, int q, int h, int lane) {
    unsigned char* ws = a.ws; const float* DTRAW = (const float*)(ws + WS_DTRAW);
    const float bias = a.in[I_DTB][h], A = -expf(a.in[I_ALOG][h]);
    float dt[4], cs[4]; float run = 0.f;
    int rows[4]; float raw[4];
#pragma unroll
    for (int j = 0; j < 4; ++j) { rows[j] = chunk_row(q, 4 * lane + j); raw[j] = DTRAW[(size_t)(rows[j] < 0 ? 0 : rows[j]) * 16 + h]; }
#pragma unroll
    for (int j = 0; j < 4; ++j) { const float x = raw[j] + bias; float d = fmaxf(x, 0.f) + __logf(1.0f + expf_(-fabsf(x))); if (rows[j] < 0) d = 0.f;
        dt[j] = d; run += d * A; cs[j] = run; }
    float incl = run;
#pragma unroll
    for (int o = 1; o < 64; o <<= 1) { const float t = __shfl_up(incl, o); if (lane >= o) incl += t; }
    const float excl = incl - run;
    float* DT = (float*)(ws + WS_DT) + ((size_t)q * 16 + h) * 256 + 4 * lane; float* ACS = (float*)(ws + WS_ACS) + ((size_t)q * 16 + h) * 256 + 4 * lane;
    *(f32x4*)DT = (f32x4){dt[0], dt[1], dt[2], dt[3]}; *(f32x4*)ACS = (f32x4){cs[0] + excl, cs[1] + excl, cs[2] + excl, cs[3] + excl};
    if (lane == 63) ((float*)(ws + WS_DEC))[q * 16 + h] = expf_(cs[3] + excl);
}

#define MFMA16(A, B, C) __builtin_amdgcn_mfma_f32_16x16x32_bf16(A, B, C, 0, 0, 0)
__device__ __forceinline__ void p3_states_unit(const Args& a, int q, int g, int nh, int tid) {
    unsigned char* ws = a.ws; const int lane = tid & 63, r = tid >> 6, h = g * 8 + r, fr = lane & 15, fq = lane >> 4;
    const bf16* XF = (const bf16*)(ws + WS_XF) + ((size_t)q * 1024 + h * 64) * 256;
    const bf16* BF = (const bf16*)(ws + WS_BF) + ((size_t)q * 256 + g * 128) * 256;
    const float* DT = (const float*)(ws + WS_DT) + ((size_t)q * 16 + h) * 256; const float* ACS = (const float*)(ws + WS_ACS) + ((size_t)q * 16 + h) * 256;
    const float alast = ACS[255];
    bf16* ST = (bf16*)(ws + WS_ST) + ((size_t)q * 16 + h) * 8192;
    {
        f32x4 acc[4][4];
#pragma unroll
        for (int i = 0; i < 4; ++i)
#pragma unroll
            for (int j = 0; j < 4; ++j) acc[i][j] = (f32x4){0.f, 0.f, 0.f, 0.f};
#pragma unroll 2
        for (int kb = 0; kb < 8; ++kb) {
            const int s0 = kb * 32 + fq * 8;
            float w[8];
            { const f32x4 d0 = *(const f32x4*)(DT + s0), d1 = *(const f32x4*)(DT + s0 + 4), c0 = *(const f32x4*)(ACS + s0), c1 = *(const f32x4*)(ACS + s0 + 4);
#pragma unroll
              for (int j = 0; j < 4; ++j) { w[j] = expf_(alast - c0[j]) * d0[j]; w[4 + j] = expf_(alast - c1[j]) * d1[j]; } }
            bf16x8 Af[4], Bf[4];
#pragma unroll
            for (int i = 0; i < 4; ++i) { const v4u v = *(const v4u*)(XF + (size_t)(i * 16 + fr) * 256 + s0);
                v4u o; o.x = pk2(bflo(v.x) * w[0], bfhi(v.x) * w[1]); o.y = pk2(bflo(v.y) * w[2], bfhi(v.y) * w[3]); o.z = pk2(bflo(v.z) * w[4], bfhi(v.z) * w[5]); o.w = pk2(bflo(v.w) * w[6], bfhi(v.w) * w[7]);
                Af[i] = __builtin_bit_cast(bf16x8, o); }
#pragma unroll
            for (int j = 0; j < 4; ++j) Bf[j] = *(const bf16x8*)(BF + (size_t)((nh * 4 + j) * 16 + fr) * 256 + s0);
#pragma unroll
            for (int i = 0; i < 4; ++i)
#pragma unroll
                for (int j = 0; j < 4; ++j) acc[i][j] = MFMA16(Bf[j], Af[i], acc[i][j]);
        }
#pragma unroll
        for (int i = 0; i < 4; ++i)
#pragma unroll
            for (int j = 0; j < 4; ++j) { v2u o; o.x = pk2(acc[i][j][0], acc[i][j][1]); o.y = pk2(acc[i][j][2], acc[i][j][3]);
                *(v2u*)(ST + (i * 16 + fr) * 128 + (nh * 4 + j) * 16 + fq * 4) = o; }
    }
}

__device__ __forceinline__ void p4_ssd_scan_item(const Args& a, int item, int tid) {
    unsigned char* ws = a.ws; const int e = item * 1024 + tid * 2;
    const int b = e >> 17, hpn = e & 131071, h = hpn >> 13;
    const bf16* ST = (const bf16*)(ws + WS_ST); bf16* PREV = (bf16*)(ws + WS_PREV); const float* DEC = (const float*)(ws + WS_DEC);
    unsigned st[32]; float dec[32];
    st[0] = *(const unsigned*)(ST + hpn); dec[0] = 0.f;
#pragma unroll
    for (int k = 1; k < 32; ++k) { const int q = b * 32 + k; st[k] = *(const unsigned*)(ST + (size_t)q * 131072 + hpn); dec[k] = DEC[q * 16 + h]; }
    float s0 = bflo(st[0]), s1 = bfhi(st[0]);
#pragma unroll
    for (int c = 0; c < 32; ++c) {
        *(unsigned*)(PREV + (size_t)(b * 32 + c) * 131072 + hpn) = pk2(s0, s1);
        if (c < 31) { const float d = dec[c + 1]; const unsigned v = st[c + 1]; s0 = s0 * d + bflo(v); s1 = s1 * d + bfhi(v); }
    }
}
__device__ __forceinline__ void p4_s5_scan_item(const Args& a, int item, unsigned char* lds, int tid) {
    unsigned char* ws = a.ws; const int b = item >> 7, g = (item >> 1) & 63, p = (item & 1) * 32 + (tid & 31), seg = tid >> 5;
    const f32x2 a1 = ((const f32x2*)(ws + WS_A1))[g * 64 + p], a16 = ((const f32x2*)(ws + WS_A16))[g * 64 + p];
    const f32x2* Bb = (const f32x2*)(ws + WS_BBAR) + (size_t)(g * 64 + p) * 16;
    const bf16* UM = (const bf16*)(ws + WS_UMETA);
    const f32x2* SE = (const f32x2*)(ws + WS_SEND) + ((size_t)(g * 1024 + b * 512 + seg * 32) * 64 + p);
    f32x2 se[32];
#pragma unroll
    for (int j = 0; j < 32; ++j) se[j] = SE[(size_t)j * 64];
    float sr = 0.f, si = 0.f;
    f32x2 bbv[16];
#pragma unroll
    for (int h = 0; h < 16; ++h) bbv[h] = Bb[h];
    for (int s = 0; s < 16; ++s) { float br = 0.f, bi = 0.f;
        const v4u u0 = *(const v4u*)(UM + s * 1024 + g * 16), u1 = *(const v4u*)(UM + s * 1024 + g * 16 + 8); const unsigned uw[8] = {u0.x, u0.y, u0.z, u0.w, u1.x, u1.y, u1.z, u1.w};
#pragma unroll
        for (int h = 0; h < 16; ++h) { const float u = (h & 1) ? bfhi(uw[h >> 1]) : bflo(uw[h >> 1]); const f32x2 bb = bbv[h]; br += bb.x * u; bi += bb.y * u; }
        const float nr = a1.x * sr - a1.y * si + br, ni = a1.x * si + a1.y * sr + bi; sr = nr; si = ni; }
    float er = 0.f, ei = 0.f;
#pragma unroll
    for (int j = 0; j < 32; ++j) { const float nr = a16.x * er - a16.y * ei + se[j].x, ni = a16.x * ei + a16.y * er + se[j].y; er = nr; ei = ni; }
    f32x2* EL = (f32x2*)lds;
    EL[seg * 32 + (tid & 31)] = (f32x2){er, ei};
    float pr = a16.x, pi = a16.y;
#pragma unroll
    for (int k = 0; k < 5; ++k) { const float nr = pr * pr - pi * pi, ni = 2.f * pr * pi; pr = nr; pi = ni; }
    __syncthreads();
    for (int k = 0; k < seg; ++k) { const f32x2 ek = EL[k * 32 + (tid & 31)]; const float nr = pr * sr - pi * si + ek.x, ni = pr * si + pi * sr + ek.y; sr = nr; si = ni; }
    unsigned* UA = (unsigned*)((bf16*)(ws + WS_UA) + ((size_t)(g * 1024 + b * 512 + seg * 32) * 384 + 256 + 2 * p));
#pragma unroll
    for (int j = 0; j < 32; ++j) { UA[(size_t)j * 192] = pk2(sr, si);
        const float nr = a16.x * sr - a16.y * si + se[j].x, ni = a16.x * si + a16.y * sr + se[j].y; sr = nr; si = ni; }
    __syncthreads();
}

__device__ __forceinline__ void p5_ssd_out_unit(const Args& a, int q, int g, int half, unsigned char* lds, int tid) {
    unsigned char* ws = a.ws; const int lane = tid & 63, r = tid >> 6, h = g * 8 + r, fr = lane & 15, fq = lane >> 4;
    bf16* CBs = (bf16*)lds;
    float* ACSs = (float*)(lds + 256 * 264 * 2);
    float* DTs = ACSs + 8 * 256;
    const bf16* CT = (const bf16*)(ws + WS_CT) + (size_t)q * 65536 + g * 128;
    const bf16* BTK = (const bf16*)(ws + WS_BTK) + (size_t)q * 65536 + g * 128;
    for (int i = tid; i < 2048; i += NT) { ACSs[i] = ((const float*)(ws + WS_ACS))[((size_t)q * 16 + g * 8) * 256 + i]; DTs[i] = ((const float*)(ws + WS_DT))[((size_t)q * 16 + g * 8) * 256 + i]; }
    {
        int cnt = 0;
#pragma unroll 1
        for (int ti = 0; ti < 8; ++ti) {
            const int lt = half ? 4 + ti : (ti < 4 ? ti : 8 + ti);
#pragma unroll 1
            for (int stl = 0; stl <= lt; ++stl, ++cnt) {
                if ((cnt & 7) != r) continue;
                f32x4 c = (f32x4){0.f, 0.f, 0.f, 0.f};
#pragma unroll
                for (int k = 0; k < 4; ++k) { const bf16x8 Af = *(const bf16x8*)(CT + (size_t)(lt * 16 + fr) * 256 + k * 32 + fq * 8);
                    const bf16x8 Bf = *(const bf16x8*)(BTK + (size_t)(stl * 16 + fr) * 256 + k * 32 + fq * 8); c = MFMA16(Af, Bf, c); }
#pragma unroll
                for (int e = 0; e < 4; ++e) CBs[(lt * 16 + fq * 4 + e) * 264 + stl * 16 + fr] = (bf16)f2bf(c[e]);
            }
        }
    }
    __syncthreads();
    const bf16* XF = (const bf16*)(ws + WS_XF) + ((size_t)q * 1024 + h * 64) * 256;
    const bf16* PREV = (const bf16*)(ws + WS_PREV) + ((size_t)(q - 1) * 16 + h) * 8192;
    const float* acs = ACSs + r * 256; const float* dts = DTs + r * 256;
    const float dsk = a.in[I_DSSD][h];
    const int b = (q - 1) >> 5, c = (q - 1) & 31; const int m0 = b * 8192 + c * 256;
    bf16* MIX = (bf16*)(ws + WS_MIX); float* SSS = (float*)(ws + WS_SS);
#pragma unroll 1
    for (int lbi = 0; lbi < 2; ++lbi) {
        const int lb = half ? 1 + lbi : 3 * lbi;
        f32x4 acc[4][4];
#pragma unroll
        for (int i = 0; i < 4; ++i)
#pragma unroll
            for (int j = 0; j < 4; ++j) acc[i][j] = (f32x4){0.f, 0.f, 0.f, 0.f};
#pragma unroll 2
        for (int k = 0; k < 4; ++k) { bf16x8 Af[4], Bf[4];
#pragma unroll
            for (int i = 0; i < 4; ++i) Af[i] = *(const bf16x8*)(CT + (size_t)(lb * 64 + i * 16 + fr) * 256 + k * 32 + fq * 8);
#pragma unroll
            for (int j = 0; j < 4; ++j) Bf[j] = *(const bf16x8*)(PREV + (size_t)(j * 16 + fr) * 128 + k * 32 + fq * 8);
#pragma unroll
            for (int i = 0; i < 4; ++i)
#pragma unroll
                for (int j = 0; j < 4; ++j) acc[i][j] = MFMA16(Bf[j], Af[i], acc[i][j]); }
#pragma unroll
        for (int i = 0; i < 4; ++i) { const float sc = expf_(acs[lb * 64 + i * 16 + fr]);
#pragma unroll
            for (int j = 0; j < 4; ++j) acc[i][j] *= sc; }
        const int nsb = 2 * lb + 2;
#pragma unroll 1
        for (int sb = 0; sb < nsb; ++sb) {
            const int s0 = sb * 32 + fq * 8;
            bf16x8 Bf[4];
#pragma unroll
            for (int j = 0; j < 4; ++j) Bf[j] = *(const bf16x8*)(XF + (size_t)(j * 16 + fr) * 256 + s0);
            float as[8], ds[8];
#pragma unroll
            for (int j = 0; j < 8; ++j) { as[j] = acs[s0 + j]; ds[j] = dts[s0 + j]; }
            float fs[8];
#pragma unroll
            for (int j = 0; j < 8; ++j) fs[j] = expf_(as[7] - as[j]) * ds[j];
#pragma unroll
            for (int i = 0; i < 4; ++i) {
                const int l = lb * 64 + i * 16 + fr;
                if (sb * 32 > lb * 64 + i * 16 + 15) continue;
                const float al = acs[l];
                const v4u v = *(const v4u*)(CBs + l * 264 + s0); const unsigned w4[4] = {v.x, v.y, v.z, v.w}; float pv[8];
                if (sb * 32 + 31 < lb * 64 + i * 16) {
                    const float gl = expf_(al - as[7]);
#pragma unroll
                    for (int j = 0; j < 4; ++j) { pv[2 * j] = bflo(w4[j]) * (gl * fs[2 * j]); pv[2 * j + 1] = bfhi(w4[j]) * (gl * fs[2 * j + 1]); }
                } else
#pragma unroll
                for (int j = 0; j < 4; ++j) {
                    const float p0 = bflo(w4[j]) * expf_(fminf(al - as[2 * j], 0.f)) * ds[2 * j], p1 = bfhi(w4[j]) * expf_(fminf(al - as[2 * j + 1], 0.f)) * ds[2 * j + 1];
                    const int sa = s0 + 2 * j, sbq = sa + 1;
                    pv[2 * j] = (sa < l) ? p0 : (sa == l ? p0 + dsk : 0.f); pv[2 * j + 1] = (sbq < l) ? p1 : (sbq == l ? p1 + dsk : 0.f); }
                v4u o; o.x = pk2(pv[0], pv[1]); o.y = pk2(pv[2], pv[3]); o.z = pk2(pv[4], pv[5]); o.w = pk2(pv[6], pv[7]);
                const bf16x8 Af = __builtin_bit_cast(bf16x8, o);
#pragma unroll
                for (int j = 0; j < 4; ++j) acc[i][j] = MFMA16(Bf[j], Af, acc[i][j]);
            }
        }
#pragma unroll
        for (int i = 0; i < 4; ++i) {
            const int l = lb * 64 + i * 16 + fr; float ssq = 0.f;
            bf16* zrow = MIX + (size_t)(m0 + l) * 2048 + h * 64 + fq * 4;
#pragma unroll
            for (int j = 0; j < 4; ++j) {
                const v2u zv = *(const v2u*)(zrow + j * 16);
                const float y0 = acc[i][j][0] * silu_(bflo(zv.x)), y1 = acc[i][j][1] * silu_(bfhi(zv.x)), y2 = acc[i][j][2] * silu_(bflo(zv.y)), y3 = acc[i][j][3] * silu_(bfhi(zv.y));
                v2u o; o.x = pk2(y0, y1); o.y = pk2(y2, y3); *(v2u*)(zrow + j * 16) = o;
                ssq += (y0 * y0 + y1 * y1) + (y2 * y2 + y3 * y3);
            }
            ssq += __shfl_xor(ssq, 16); ssq += __shfl_xor(ssq, 32);
            if (fq == 0) atomicAdd(SSS + m0 + l, ssq);
        }
    }
    __syncthreads();
}

__device__ __forceinline__ void p10_final(const Args& a, int tid, int G) {
    const int lane = tid & 63, wave = tid >> 6; const int gw = blockIdx.x * NWAVES + wave, NGW = G * NWAVES;
    const float* SSF = (const float*)(a.ws + WS_SS) + 3 * 16384; const f32x4* gf = (const f32x4*)a.in[I_GFIN] + lane;
    for (int m = gw; m < MR; m += NGW) { f32x4* row = (f32x4*)(a.out + (size_t)m * 1024) + lane; const float rs = 1.0f / sqrtf(SSF[m] * (1.0f / 1024.0f) + EPS);
#pragma unroll
        for (int j = 0; j < 4; ++j) row[64 * j] = row[64 * j] * rs * gf[64 * j]; }
}

__global__ void __launch_bounds__(NT, 2) fwd_kernel(Args args) {
    extern __shared__ __attribute__((aligned(16))) unsigned char lds[];
    cg::grid_group grid = cg::this_grid();
    const int tid = threadIdx.x, G = gridDim.x, bx = blockIdx.x;
    unsigned char* ws = args.ws;
    PG8_LAS unsigned char* ldsl = (PG8_LAS unsigned char*)lds;
    const int lo = args.ph_lo, hi = args.ph_hi;
#ifndef SKIPMASK
#define SKIPMASK 0
#endif
#define IN(k) (!((SKIPMASK >> (k)) & 1) && lo <= (k) && (k) < hi)
    volatile LAS unsigned* bst = (volatile LAS unsigned*)(ldsl + 155136);
    if (tid < 2) bst[tid] = 0u;
    __syncthreads();
    XcdBarrier xbar = xcd_barrier_post((unsigned*)(ws + WS_BAR), bst);
#define SEAM(k) do { if (IN(k) && IN((k) + 1)) { if ((k) == 0) grid.sync(); else xcd_barrier(xbar); } } while (0)
    float* SS = (float*)(ws + WS_SS);
    if (IN(0)) { const int tid = pg8::fresh_tid(); p0_prologue(args, lds, tid, G); }
    SEAM(0);
    if (IN(1)) {
        pg8::Gemm g{(const bf16*)(ws + WS_XN), (const bf16*)(ws + WS_WIN), MP, NIN, 1024, 1024, 1024, 0, 0}; pg8::StaticOrder S; S.init(MP, NIN, G, bx);
        pg8::EpiInProj E{(bf16*)(ws + WS_MIX), (bf16*)(ws + WS_XBCP), (bf16*)(ws + WS_UA), (bf16*)(ws + WS_UMETA), (float*)(ws + WS_DTRAW)};
        pg8::gemm_phase<pg8::EpiInProj, pg8::StaticOrder, true, true>(ldsl, g, S, E);
    }
    SEAM(1);
    if (IN(2)) {
        const int tid = pg8::fresh_tid(), wave = tid >> 6, lane = tid & 63;
        for (int u = bx; u < NQ * 24; u += G) p2_conv_unit(args, u / 24, u % 24, lds, tid);
        for (int it = (G - 1 - bx) * NWAVES + wave; it < NQ * 16; it += G * NWAVES) p2_dt_item(args, it >> 4, it & 15, lane);
    }
    SEAM(2);
    const int nS3 = (G / 2 < 126) ? G / 2 : 126;
    if (IN(3)) {
        const int tid = pg8::fresh_tid();
        for (int u = bx; u < 252; u += G) { const int qi = u >> 2; p3_states_unit(args, qi < 32 ? qi : qi + 1, (u >> 1) & 1, u & 1, tid); }
        pg8::Gemm g{(const bf16*)(ws + WS_UA), (const bf16*)(ws + WS_TE5), 1024, 256, 256, 384, 256, (size_t)1024 * 384 * 2, (size_t)256 * 256 * 2};
        pg8::BatchOrder S; S.init(256, 4, G, 0, bx);
        pg8::EpiS5a E{(float*)(ws + WS_SEND)};
        pg8::gemm_phase<pg8::EpiS5a, pg8::BatchOrder, true, true>(ldsl, g, S, E);
    }
    SEAM(3);
    if (IN(4)) {
        const int tid = pg8::fresh_tid();
        for (int it = bx; it < 512; it += G) { if (it < 256) p4_s5_scan_item(args, it, lds, tid); else p4_ssd_scan_item(args, it - 256, tid); }
    }
    SEAM(4);
    if (IN(5)) {
        const int tid = pg8::fresh_tid();
#ifndef NO_SSDOUT
        for (int u = bx; u < 256; u += G) p5_ssd_out_unit(args, 1 + (u >> 2), (u >> 1) & 1, u & 1, lds, tid);
        __syncthreads();
#endif
        pg8::Gemm g{(const bf16*)(ws + WS_UA), (const bf16*)(ws + WS_TB5), 1024, 256, 384, 384, 384, (size_t)1024 * 384 * 2, (size_t)256 * 384 * 2};
        pg8::BatchOrder S; S.init(256, 4, G, 0, bx);
        pg8::EpiS5b E{(bf16*)(ws + WS_Y5)};
        pg8::gemm_phase<pg8::EpiS5b, pg8::BatchOrder, true, true>(ldsl, g, S, E);
    }
    SEAM(5);
    if (IN(6)) {
        const int tid = pg8::fresh_tid();
        p6_weights(args, lds, tid, G);
        pg8::Gemm g{(const bf16*)(ws + WS_Y5), (const bf16*)(ws + WS_WGLU), MR, 2048, 1024, 1024, 1024, 0, 0}; pg8::StaticOrder S; S.init(MR, 2048, G, bx);
        pg8::EpiGlu E{(bf16*)(ws + WS_MIX), args.in[I_BGLU], SS + 16384};
        pg8::gemm_phase<pg8::EpiGlu, pg8::StaticOrder, true, true>(ldsl, g, S, E);
    }
    SEAM(6);
    if (IN(7)) {
        pg8::Gemm g{(const bf16*)(ws + WS_MIX), (const bf16*)(ws + WS_WOUT), MR, 1024, 1024, 2048, 2048, 0, 0, (size_t)1024 * 2, (size_t)1024 * 2};
        pg8::SplitKOrder S; S.base.init(MR, 1024, G, bx);
        pg8::EpiOut E{args.in[I_X], args.out, (bf16*)(ws + WS_H1B), SS, SS + 16384, SS + 2 * 16384};
        pg8::gemm_phase<pg8::EpiOut, pg8::SplitKOrder, true, true>(ldsl, g, S, E);
    }
    SEAM(7);
    if (IN(8)) {
        pg8::Gemm g{(const bf16*)(ws + WS_H1B), (const bf16*)(ws + WS_WUP), MR, 4096, 1024, 1024, 1024, 0, 0}; pg8::StaticOrder S; S.init(MR, 4096, G, bx);
        pg8::EpiUp E{(bf16*)(ws + WS_HB), SS + 2 * 16384};
        pg8::gemm_phase<pg8::EpiUp, pg8::StaticOrder, true, true>(ldsl, g, S, E);
    }
    SEAM(8);
    const int fused_fin = (G == 256 && lo <= 9 && hi >= 11) ? 1 : 0;
    if (IN(9)) {
        pg8::Gemm g{(const bf16*)(ws + WS_HB), (const bf16*)(ws + WS_WDN), MR, 1024, 4096, 4096, 4096, 0, 0}; pg8::StaticOrder S; S.init(MR, 1024, G, bx);
        pg8::EpiDown E{args.out, SS + 3 * 16384, (unsigned*)(ws + WS_BAR) + 3584, args.in[I_GFIN], fused_fin};
        pg8::gemm_phase<pg8::EpiDown, pg8::StaticOrder, true, true>(ldsl, g, S, E);
    }
    if (!fused_fin) {
        SEAM(9);
        if (IN(10)) { const int tid = pg8::fresh_tid(); p10_final(args, tid, G); }
    }
#undef IN
#undef SEAM
}

#ifndef N_LAUNCHES
#define N_LAUNCHES 1
#endif
extern "C" void kernel_launch(void* const* d_in, const int* in_sizes, int n_in, void* d_out, int out_size, void* d_ws, size_t ws_size, hipStream_t stream) {
    static int grid = 0;
    if (grid == 0) {
        int dev = 0, cus = 0, per_cu = 0;
        hipGetDevice(&dev); hipDeviceGetAttribute(&cus, hipDeviceAttributeMultiprocessorCount, dev);
        hipFuncSetAttribute((const void*)fwd_kernel, hipFuncAttributeMaxDynamicSharedMemorySize, LDS_BYTES);
        hipOccupancyMaxActiveBlocksPerMultiprocessor(&per_cu, (const void*)fwd_kernel, NT, LDS_BYTES);
        if (per_cu < 1) { fprintf(stderr, "occupancy query says %d blocks per CU\n", per_cu); per_cu = 1; }
        grid = cus * 1;
        (void)hipGetLastError();
    }
    hipMemsetAsync((char*)d_ws + WS_BAR, 0, 16384, stream);
    Args a{};
    for (int i = 0; i < 26; ++i) a.in[i] = (const float*)d_in[i];
    a.out = (float*)d_out; a.ws = (unsigned char*)d_ws;
    if (N_LAUNCHES == 1) {
        a.ph_lo = 0; a.ph_hi = 11;
        void* args[] = {&a};
        hipError_t e = hipLaunchCooperativeKernel((const void*)fwd_kernel, dim3(grid), dim3(NT), args, LDS_BYTES, stream);
        if (e != hipSuccess) fprintf(stderr, "cooperative launch failed: %s (grid %d)\n", hipGetErrorString(e), grid);
    } else {
        for (int p = 0; p < 11; ++p) { a.ph_lo = p; a.ph_hi = p + 1; hipLaunchKernelGGL(fwd_kernel, dim3(grid), dim3(NT), LDS_BYTES, stream, a); }
    }
}
```

```cpp
#include <hip/hip_runtime.h>
#include <cstdio>
#include <cstdint>
namespace pg8 {
#define PG8_LAS __attribute__((address_space(3)))
typedef unsigned short bf16_t;
typedef short bf16x8 __attribute__((ext_vector_type(8)));
typedef float f32x4 __attribute__((ext_vector_type(4)));
typedef unsigned u32x4 __attribute__((ext_vector_type(4)));
constexpr int BM = 256, BK = 64, HALF = 128, HTB = HALF * BK * 2  , STAGE_BYTES = 8 * HTB, NXCD = 8, WGM = 8;

__host__ __device__ __forceinline__ int lds_byte(int r, int c) { const int st = (r >> 4) * 2 + (c >> 5), rr = r & 15, cc = c & 31, ob = rr * 64 + cc * 2; return st * 1024 + (ob ^ (((ob >> 9) & 1) << 5)); }
__host__ __device__ __forceinline__ void stage_rc(int b, int& R, int& C) { const int st = b / 1024, sb = b % 1024, swz = sb ^ (((sb >> 9) & 1) << 5); R = (st >> 1) * 16 + swz / 64; C = (st & 1) * 32 + (swz % 64) / 2; }
__host__ __device__ __forceinline__ int perm32(int rho) { const int n = rho >> 4, i = rho & 15; return 8 * (i >> 2) + 4 * n + (i & 3); }

struct Unit { int pm, pn, g, par, kh; };
struct Gemm { const bf16_t* A; const bf16_t* Bt; int M, N, K, lda, ldb; size_t gsA, gsB; size_t khA = 0, khB = 0; };

struct StaticOrder {
    int nM, nN, nwg, G, c;
    __host__ __device__ void init(int M, int N, int G_, int c_) { nM = M / BM; nN = N / BM; nwg = nM * nN; G = G_; c = c_; }
    __host__ __device__ bool next(int i, Unit& u) const {
        const long L = (long)i * G + c; if (L >= nwg) return false;
        int wgid = (int)L; { const int q = nwg / NXCD, r = nwg % NXCD, xcd = wgid % NXCD, off = wgid / NXCD; wgid = (xcd < r ? xcd * (q + 1) : r * (q + 1) + (xcd - r) * q) + off; }
        const int nig = WGM * nN, gid = wgid / nig, fm = gid * WGM, gsz = (nM - fm) < WGM ? (nM - fm) : WGM;
        u.pm = fm + ((wgid % nig) % gsz); u.pn = (wgid % nig) / gsz; u.g = 0; u.par = i & 1; u.kh = 0; return true;
    }
    __device__ __forceinline__ void a_ready(const Unit&) const {}
    __device__ __forceinline__ void done(const Unit&) const {}
};

__device__ __forceinline__ unsigned cvt_pk_bf16(float lo, float hi) { unsigned r; asm volatile("v_cvt_pk_bf16_f32 %0, %1, %2" : "=v"(r) : "v"(lo), "v"(hi)); return r; }
typedef float f32x2 __attribute__((ext_vector_type(2)));
__device__ __forceinline__ f32x2 gelu_pk(f32x2 v) {
    const f32x2 av = __builtin_elementwise_abs(v), d = av * 0.2316418882f + 1.0f;
    f32x2 t; t.x = __builtin_amdgcn_rcpf(d.x); t.y = __builtin_amdgcn_rcpf(d.y);
    f32x2 q = t * 0.5307027145f + (-0.7265760135f); q = q * t + 0.7107068705f; q = q * t + (-0.142248368f); q = q * t + 0.127414796f; q = q * t;
    const f32x2 s = (v * v) * (-0.72134752044f);
    f32x2 e; e.x = __builtin_amdgcn_exp2f(s.x); e.y = __builtin_amdgcn_exp2f(s.y);
    const f32x2 m = v * (q * e), r = v - m;
    f32x2 o; o.x = v.x < 0.f ? m.x : r.x; o.y = v.y < 0.f ? m.y : r.y; return o;
}

__device__ __forceinline__ int fresh_tid() { int t; asm volatile("v_mov_b32 %0, %1" : "=v"(t) : "v"((int)threadIdx.x)); return t; }
#define EPI_ROWS_COLS const int rowb = u.pm * BM + wr * 64 + fr; const int colb = wc * 32 + 8 * fq;
__device__ __forceinline__ u32x4 pack8(const f32x4 v0, const f32x4 v1) { u32x4 w; w.x = cvt_pk_bf16(v0[0], v0[1]); w.y = cvt_pk_bf16(v0[2], v0[3]); w.z = cvt_pk_bf16(v1[0], v1[1]); w.w = cvt_pk_bf16(v1[2], v1[3]); return w; }
__device__ __forceinline__ float sum8sq(const f32x4 a, const f32x4 b) { return (a[0] * a[0] + a[1] * a[1]) + (a[2] * a[2] + a[3] * a[3]) + (b[0] * b[0] + b[1] * b[1]) + (b[2] * b[2] + b[3] * b[3]); }

struct EpiInProj {
    static constexpr bool PERM = true, AFTER_DRAIN = false, HAS_MID = false;
    bf16_t* MIX; bf16_t* XBCP; bf16_t* UA; bf16_t* UMETA; float* DTRAW;
    __device__ __forceinline__ void operator()(const f32x4 (&acc)[2][2][4][2], const Unit& u, int wr, int wc, int fr, int fq) const {
        EPI_ROWS_COLS
        const int pn = u.pn;
#pragma unroll
        for (int ai = 0; ai < 2; ++ai)
#pragma unroll
            for (int m = 0; m < 4; ++m) {
                const int r = rowb + ai * HALF + m * 16;
#pragma unroll
                for (int bj = 0; bj < 2; ++bj) {
                    const int c = pn * BM + bj * HALF + colb;
                    const f32x4 v0 = acc[ai][bj][m][0], v1 = acc[ai][bj][m][1];
                    if (pn < 4) { if (r < 16384) *(u32x4*)(MIX + (size_t)r * 2048 + c) = pack8(v0, v1); }
                    else if (pn < 10) { *(u32x4*)(XBCP + (size_t)r * 1536 + (c - 1024)) = pack8(v0, v1); }
                    else if (pn < 14) {
                        const int j = c - 2560, g = j >> 4, h0 = j & 15;
                        if (r < 16384) { const int b = r >> 13, tok = r & 8191, ch = tok >> 4, t = tok & 15;
                            *(u32x4*)(UA + ((size_t)(g * 1024 + b * 512 + ch) * 384 + t * 16 + h0)) = pack8(v0, v1); }
                        else *(u32x4*)(UMETA + (size_t)(r - 16384) * 1024 + j) = pack8(v0, v1);
                    } else {
                        const int j = c - 3584;
                        if (j < 16) { float* d = DTRAW + (size_t)r * 16 + j; *(f32x4*)d = v0; *(f32x4*)(d + 4) = v1; }
                    }
                }
            }
    }
};
struct EpiS5a {
    static constexpr bool PERM = true, AFTER_DRAIN = false, HAS_MID = false;
    float* SEND;
    __device__ __forceinline__ void operator()(const f32x4 (&acc)[2][2][4][2], const Unit& u, int wr, int wc, int fr, int fq) const {
        EPI_ROWS_COLS
#pragma unroll
        for (int ai = 0; ai < 2; ++ai)
#pragma unroll
            for (int m = 0; m < 4; ++m) {
                const int r = rowb + ai * HALF + m * 16;
                float* d = SEND + ((size_t)(u.g * 1024 + r) * 128 + colb);
                *(f32x4*)d = acc[ai][0][m][0]; *(f32x4*)(d + 4) = acc[ai][0][m][1];
            }
    }
};
struct EpiS5b {
    static constexpr bool PERM = true, AFTER_DRAIN = false, HAS_MID = false;
    bf16_t* Y5;
    __device__ __forceinline__ void operator()(const f32x4 (&acc)[2][2][4][2], const Unit& u, int wr, int wc, int fr, int fq) const {
        { const int t2 = fresh_tid(); const int w2 = t2 >> 6, l2 = t2 & 63; wr = w2 >> 2; wc = w2 & 3; fr = l2 & 15; fq = l2 >> 4; }
        const unsigned lane_off = (unsigned)((((u.pm >> 1) * 8192 + (((u.pm & 1) * 256 + wr * 64 + fr) * 16) + (wc * 2 + (fq >> 1))) * 1024 + u.g * 16 + (fq & 1) * 8) * 2);
        char* base = (char*)Y5;
#pragma unroll
        for (int ai = 0; ai < 2; ++ai)
#pragma unroll
            for (int m = 0; m < 4; ++m)
#pragma unroll
                for (int bj = 0; bj < 2; ++bj) {
                    const f32x4 v0 = acc[ai][bj][m][0], v1 = acc[ai][bj][m][1]; u32x4 w;
                    { const f32x2 a = gelu_pk((f32x2){v0[0], v0[1]}); w.x = cvt_pk_bf16(a.x, a.y); } __builtin_amdgcn_sched_barrier(0);
                    { const f32x2 a = gelu_pk((f32x2){v0[2], v0[3]}); w.y = cvt_pk_bf16(a.x, a.y); } __builtin_amdgcn_sched_barrier(0);
                    { const f32x2 a = gelu_pk((f32x2){v1[0], v1[1]}); w.z = cvt_pk_bf16(a.x, a.y); } __builtin_amdgcn_sched_barrier(0);
                    { const f32x2 a = gelu_pk((f32x2){v1[2], v1[3]}); w.w = cvt_pk_bf16(a.x, a.y); } __builtin_amdgcn_sched_barrier(0);
                    const unsigned off = lane_off + (unsigned)(ai * 4194304 + m * 524288 + bj * 16384);
                    *(u32x4*)(base + off) = w;
                }
    }
};
__device__ __forceinline__ float sigm(float x) { return __builtin_amdgcn_rcpf(1.0f + __builtin_amdgcn_exp2f(-1.44269504f * x)); }
struct EpiGlu {
    static constexpr bool PERM = true, AFTER_DRAIN = false, HAS_MID = false;
    bf16_t* MIX; const float* bglu; float* SS5;
    __device__ __forceinline__ void operator()(const f32x4 (&acc)[2][2][4][2], const Unit& u, int wr, int wc, int fr, int fq) const {
        EPI_ROWS_COLS
        const int oc = u.pn * 128 + colb;
        const f32x4 ba0 = *(const f32x4*)(bglu + oc), ba1 = *(const f32x4*)(bglu + oc + 4), bg0 = *(const f32x4*)(bglu + 1024 + oc), bg1 = *(const f32x4*)(bglu + 1024 + oc + 4);
#pragma unroll
        for (int ai = 0; ai < 2; ++ai)
#pragma unroll
            for (int m = 0; m < 4; ++m) {
                const int r = rowb + ai * HALF + m * 16;
                f32x4 a0 = acc[ai][0][m][0] + ba0, a1 = acc[ai][0][m][1] + ba1; const f32x4 g0 = acc[ai][1][m][0] + bg0, g1 = acc[ai][1][m][1] + bg1;
#pragma unroll
                for (int e = 0; e < 4; ++e) { a0[e] *= sigm(g0[e]); a1[e] *= sigm(g1[e]); }
                *(u32x4*)(MIX + (size_t)r * 2048 + 1024 + oc) = pack8(a0, a1);
                float s = sum8sq(a0, a1); s += __shfl_xor(s, 16); s += __shfl_xor(s, 32);
                if (fq == 0) atomicAdd(SS5 + r, s);
            }
    }
};
struct EpiOut {
    static constexpr bool PERM = true, AFTER_DRAIN = false, HAS_MID = true;
    const float* X; float* H1; bf16_t* H1B; const float* SSS; const float* SS5; float* SSM;
    __device__ __forceinline__ void mid(f32x4 (&acc)[2][2][4][2], const Unit& u, int wr, int wc, int fr, int fq) const {
        const int rowb = u.pm * BM + wr * 64 + fr;
#pragma unroll
        for (int ai = 0; ai < 2; ++ai)
#pragma unroll
            for (int m = 0; m < 4; ++m) {
                const int r = rowb + ai * HALF + m * 16;
                const float ratio = sqrtf((SS5[r] * (1.0f / 1024.0f) + 1e-5f) / (SSS[r] * (1.0f / 1024.0f) + 1e-5f));
#pragma unroll
                for (int bj = 0; bj < 2; ++bj)
#pragma unroll
                    for (int n = 0; n < 2; ++n) acc[ai][bj][m][n] *= ratio;
                asm volatile("" ::: "memory");
            }
    }
    __device__ __forceinline__ void operator()(const f32x4 (&acc)[2][2][4][2], const Unit& u, int wr, int wc, int fr, int fq) const {
        EPI_ROWS_COLS
        const unsigned lane_off = (unsigned)(rowb * 1024 + u.pn * BM + colb);
        const char* xb = (const char*)X; char* hb = (char*)H1; char* bb = (char*)H1B;
#pragma unroll
        for (int ai = 0; ai < 2; ++ai)
#pragma unroll
            for (int m = 0; m < 4; ++m) {
                const int r = rowb + ai * HALF + m * 16;
                const float rs = 1.0f / sqrtf(SS5[r] * (1.0f / 1024.0f) + 1e-5f);
                float s = 0.f;
#pragma unroll
                for (int bj = 0; bj < 2; ++bj) {
                    const unsigned off = lane_off + (unsigned)(ai * 131072 + m * 16384 + bj * 128);
                    const f32x4 v0 = *(const f32x4*)(xb + off * 4u) + acc[ai][bj][m][0] * rs, v1 = *(const f32x4*)(xb + off * 4u + 16u) + acc[ai][bj][m][1] * rs;
                    *(u32x4*)(bb + off * 2u) = pack8(v0, v1); s += sum8sq(v0, v1);
                }
                s += __shfl_xor(s, 16); s += __shfl_xor(s, 32);
                if (fq == 0) atomicAdd(SSM + r, s);
                asm volatile("" ::: "memory");
            }
    }
};
struct SplitKOrder {
    StaticOrder base;
    __device__ bool next(int i, Unit& u) const { if (!base.next(i >> 1, u)) return false; u.kh = i & 1; u.par = i & 1; return true; }
    __device__ __forceinline__ void a_ready(const Unit&) const {}
    __device__ __forceinline__ void done(const Unit&) const {}
};
struct EpiUp {
    static constexpr bool PERM = true, AFTER_DRAIN = false, HAS_MID = false;
    bf16_t* HB; const float* SSM;
    __device__ __forceinline__ void operator()(const f32x4 (&acc)[2][2][4][2], const Unit& u, int wr, int wc, int fr, int fq) const {
        EPI_ROWS_COLS
#pragma unroll
        for (int ai = 0; ai < 2; ++ai)
#pragma unroll
            for (int m = 0; m < 4; ++m) {
                const int r = rowb + ai * HALF + m * 16;
                const float rs = 1.0f / sqrtf(SSM[r] * (1.0f / 1024.0f) + 1e-5f);
#pragma unroll
                for (int bj = 0; bj < 2; ++bj) {
                    f32x4 v0 = acc[ai][bj][m][0] * rs, v1 = acc[ai][bj][m][1] * rs;
#pragma unroll
                    for (int e = 0; e < 4; ++e) { const float p = fmaxf(v0[e], 0.f), q = fmaxf(v1[e], 0.f); v0[e] = p * p; v1[e] = q * q; }
                    *(u32x4*)(HB + (size_t)r * 4096 + u.pn * BM + bj * HALF + colb) = pack8(v0, v1);
                }
            }
    }
};
struct EpiDown {
    static constexpr bool PERM = true, AFTER_DRAIN = false, HAS_MID = false;
    float* H; float* SSF; unsigned* pcnt; const float* gfin; int fused; const bf16_t* H1B;
    __device__ __forceinline__ void operator()(const f32x4 (&acc_)[2][2][4][2], const Unit& u, int wr, int wc, int fr, int fq) const {
        f32x4 (&acc)[2][2][4][2] = const_cast<f32x4 (&)[2][2][4][2]>(acc_);
        EPI_ROWS_COLS
        const unsigned lane_off = (unsigned)(rowb * 1024 + u.pn * BM + colb);
        char* hb = (char*)H;
#pragma unroll
        for (int ai = 0; ai < 2; ++ai)
#pragma unroll
            for (int m = 0; m < 4; ++m) {
                const int r = rowb + ai * HALF + m * 16;
                float s = 0.f;
#pragma unroll
                for (int bj = 0; bj < 2; ++bj) {
                    const unsigned off = lane_off + (unsigned)(ai * 131072 + m * 16384 + bj * 128);
                    const u32x4 rw = *(const u32x4*)((const char*)H1B + off * 2u);
                    const f32x4 r0 = (f32x4){__builtin_bit_cast(float, rw.x << 16), __builtin_bit_cast(float, rw.x & 0xffff0000u), __builtin_bit_cast(float, rw.y << 16), __builtin_bit_cast(float, rw.y & 0xffff0000u)};
                    const f32x4 r1 = (f32x4){__builtin_bit_cast(float, rw.z << 16), __builtin_bit_cast(float, rw.z & 0xffff0000u), __builtin_bit_cast(float, rw.w << 16), __builtin_bit_cast(float, rw.w & 0xffff0000u)};
                    const f32x4 v0 = r0 + acc[ai][bj][m][0], v1 = r1 + acc[ai][bj][m][1];
                    if (fused) { acc[ai][bj][m][0] = v0; acc[ai][bj][m][1] = v1; } else { *(f32x4*)(hb + off * 4u) = v0; *(f32x4*)(hb + off * 4u + 16u) = v1; }
                    s += sum8sq(v0, v1);
                }
                s += __shfl_xor(s, 16); s += __shfl_xor(s, 32);
                if (fq == 0) atomicAdd(SSF + r, s);
                asm volatile("" ::: "memory");
            }
        if (!fused) return;
        asm volatile("s_waitcnt vmcnt(0)" ::: "memory");
        unsigned* cw = pcnt + 4 * u.pm;
        if (fr == 0 && fq == 0) __hip_atomic_fetch_add(cw, 1u, __ATOMIC_RELAXED, __HIP_MEMORY_SCOPE_AGENT);
        while (__hip_atomic_load(cw, __ATOMIC_RELAXED, __HIP_MEMORY_SCOPE_AGENT) < 32u) __builtin_amdgcn_s_sleep(4);
        asm volatile("" ::: "memory");
        f32x4 gv[2][2];
#pragma unroll
        for (int bj = 0; bj < 2; ++bj) { gv[bj][0] = *(const f32x4*)(gfin + u.pn * BM + bj * HALF + colb); gv[bj][1] = *(const f32x4*)(gfin + u.pn * BM + bj * HALF + colb + 4); }
#pragma unroll
        for (int ai = 0; ai < 2; ++ai)
#pragma unroll
            for (int m = 0; m < 4; ++m) {
                const int r = rowb + ai * HALF + m * 16;
                const float ssum = __builtin_bit_cast(float, __hip_atomic_load((const unsigned*)(SSF + r), __ATOMIC_RELAXED, __HIP_MEMORY_SCOPE_AGENT));
                const float rs = 1.0f / sqrtf(ssum * (1.0f / 1024.0f) + 1e-5f);
#pragma unroll
                for (int bj = 0; bj < 2; ++bj) {
                    const unsigned off = lane_off + (unsigned)(ai * 131072 + m * 16384 + bj * 128);
                    *(f32x4*)(hb + off * 4u) = acc[ai][bj][m][0] * rs * gv[bj][0]; *(f32x4*)(hb + off * 4u + 16u) = acc[ai][bj][m][1] * rs * gv[bj][1];
                }
            }
    }
};
struct BatchOrder {
    int nU, per_g, Ge, ce;
    __host__ __device__ void init(int nU_, int per_g_, int G, int w0, int c) { nU = nU_; per_g = per_g_; Ge = G - w0; ce = c - w0; }
    __device__ bool next(int i, Unit& u) const {
        if (ce < 0) return false;
        const long L = (long)i * Ge + ce; if (L >= nU) return false;
        u.g = __builtin_amdgcn_readfirstlane((int)L / per_g); u.pm = __builtin_amdgcn_readfirstlane((int)L % per_g); u.pn = 0; u.par = i & 1; u.kh = 0; return true;
    }
    __device__ __forceinline__ void a_ready(const Unit&) const {}
    __device__ __forceinline__ void done(const Unit&) const {}
};
template <class Epi, class Sched, bool ALIGN_EPI = false, bool SP2 = false>
__device__ __forceinline__ void gemm_phase(PG8_LAS unsigned char* lds, const Gemm g, const Sched& S, const Epi& E) {
    const int tid = threadIdx.x, wid = __builtin_amdgcn_readfirstlane(tid >> 6), lane = tid & 63, wr = wid >> 2, wc = wid & 3, fr = lane & 15, fq = lane >> 4;
    const int K = g.K, nt = K / BK;
    unsigned voffA[2], voffB[2];
#pragma unroll
    for (int i = 0; i < 2; ++i) { int R, C; stage_rc(tid * 16 + i * 8192, R, C); const int Rb = Epi::PERM ? ((R & ~31) + perm32(R & 31)) : R;
        voffA[i] = (unsigned)(R * g.lda + C) * 2u; voffB[i] = (unsigned)(Rb * g.ldb + C) * 2u; }
    const size_t kstep = (size_t)(BK * 2);
    const size_t hstepA = (size_t)HALF * g.lda * 2, hstepB = (size_t)HALF * g.ldb * 2;
    const size_t tstepA = 2 * hstepA, tstepB = 2 * hstepB;
    const unsigned ldsw = (unsigned)wid * 1024u;
    const int aoff = lds_byte(wr * 64 + fr, fq * 8), boff = lds_byte(wc * 32 + fr, fq * 8);
#define PG8_SA(b, h) (((b) * 2 + (h)) * HTB)
#define PG8_SB(b, h) ((4 + (b) * 2 + (h)) * HTB)
#define PG8_STAGE(bufoff, gbase, voff) do { _Pragma("unroll") for (int _i = 0; _i < 2; ++_i) \
        __builtin_amdgcn_global_load_lds((const unsigned*)((const char*)(gbase) + (voff)[_i]), (PG8_LAS unsigned*)(lds + (bufoff) + ldsw + _i * 8192), 16, 0, 0); } while (0)
#define PG8_LDA(dst, b, h) do { _Pragma("unroll") for (int m = 0; m < 4; ++m) _Pragma("unroll") for (int k = 0; k < 2; ++k) dst[m][k] = *(const PG8_LAS bf16x8*)(lds + PG8_SA(b, h) + aoff + m * 2048 + k * 1024); } while (0)
#define PG8_LDB(dst, b, h) do { _Pragma("unroll") for (int n = 0; n < 2; ++n) _Pragma("unroll") for (int k = 0; k < 2; ++k) dst[n][k] = *(const PG8_LAS bf16x8*)(lds + PG8_SB(b, h) + boff + n * 2048 + k * 1024); } while (0)
#define PG8_MMA(ai, bj, At, Bt) do { __builtin_amdgcn_s_setprio(1); _Pragma("unroll") for (int m = 0; m < 4; ++m) _Pragma("unroll") for (int n = 0; n < 2; ++n) _Pragma("unroll") for (int k = 0; k < 2; ++k) \
        acc[ai][bj][m][n] = __builtin_amdgcn_mfma_f32_16x16x32_bf16(Bt[n][k], At[m][k], acc[ai][bj][m][n], 0, 0, 0); __builtin_amdgcn_s_setprio(0); } while (0)
#define PG8_WAIT_V(n) asm volatile("s_waitcnt vmcnt(" #n ")" ::: "memory")
#define PG8_WAIT_L(n) asm volatile("s_waitcnt lgkmcnt(" #n ")" ::: "memory")
#define PG8_BAR __builtin_amdgcn_s_barrier()
#define PG8_SCHED __builtin_amdgcn_sched_barrier(0)
    Unit cur, nxt; int ui = 0;
    if (!S.next(0, cur)) return;
    f32x4 acc[2][2][4][2];
#pragma unroll
    for (int a = 0; a < 2; ++a)
#pragma unroll
        for (int b = 0; b < 2; ++b)
#pragma unroll
            for (int m = 0; m < 4; ++m)
#pragma unroll
                for (int n = 0; n < 2; ++n) acc[a][b][m][n] = (f32x4){0.f, 0.f, 0.f, 0.f};
    bf16x8 At[4][2], B0[2][2], B1[2][2];
    const char* cA = (const char*)g.A + (size_t)cur.g * g.gsA + (size_t)cur.pm * tstepA + (size_t)cur.kh * g.khA; const char* cB = (const char*)g.Bt + (size_t)cur.g * g.gsB + (size_t)cur.pn * tstepB + (size_t)cur.kh * g.khB;
    S.a_ready(cur);
    if constexpr (SP2) {
        PG8_STAGE(PG8_SB(0, 0), cB, voffB); PG8_STAGE(PG8_SB(0, 1), cB + hstepB, voffB); PG8_STAGE(PG8_SA(0, 0), cA, voffA); PG8_STAGE(PG8_SA(0, 1), cA + hstepA, voffA);
        if (wr == 1) PG8_BAR;
        PG8_WAIT_V(2); PG8_BAR;
        PG8_STAGE(PG8_SB(1, 0), cB + kstep, voffB); PG8_STAGE(PG8_SA(1, 0), cA + kstep, voffA); PG8_STAGE(PG8_SB(1, 1), cB + hstepB + kstep, voffB);
        PG8_WAIT_V(6); PG8_BAR;
    } else {
        PG8_STAGE(PG8_SB(0, 0), cB, voffB); PG8_STAGE(PG8_SA(0, 0), cA, voffA); PG8_STAGE(PG8_SB(0, 1), cB + hstepB, voffB); PG8_STAGE(PG8_SA(0, 1), cA + hstepA, voffA);
        if (wr == 1) PG8_BAR;
        PG8_WAIT_V(4); PG8_BAR;
        PG8_STAGE(PG8_SB(1, 0), cB + kstep, voffB); PG8_STAGE(PG8_SA(1, 0), cA + kstep, voffA); PG8_STAGE(PG8_SB(1, 1), cB + hstepB + kstep, voffB);
        PG8_WAIT_V(6); PG8_BAR;
    }
    for (;;) {
        const bool has_next = S.next(ui + 1, nxt);
        const char* nA = has_next ? (const char*)g.A + (size_t)nxt.g * g.gsA + (size_t)nxt.pm * tstepA + (size_t)nxt.kh * g.khA : cA; const char* nB = has_next ? (const char*)g.Bt + (size_t)nxt.g * g.gsB + (size_t)nxt.pn * tstepB + (size_t)nxt.kh * g.khB : cB;
        for (int t = 0; t < nt; t += 2) {
            const bool last = (t == nt - 2);
            const char* a1 = cA + (size_t)(t + 1) * kstep;
            const char* a2 = last ? nA : cA + (size_t)(t + 2) * kstep; const char* b2 = last ? nB : cB + (size_t)(t + 2) * kstep;
            const char* a3 = a2 + kstep; const char* b3 = b2 + kstep;
            if (last && has_next) S.a_ready(nxt);
            if constexpr (SP2) {
            PG8_LDB(B0, 0, 0); PG8_LDB(B1, 0, 1); PG8_SCHED; PG8_LDA(At, 0, 0); PG8_STAGE(PG8_SA(1, 1), a1 + hstepA, voffA);
            PG8_WAIT_V(8); PG8_WAIT_L(0); PG8_BAR; PG8_MMA(0, 0, At, B0); PG8_MMA(0, 1, At, B1); PG8_BAR; PG8_SCHED;
            PG8_LDA(At, 0, 1); PG8_STAGE(PG8_SB(0, 0), b2, voffB); PG8_STAGE(PG8_SB(0, 1), b2 + hstepB, voffB); PG8_STAGE(PG8_SA(0, 0), a2, voffA);
            PG8_WAIT_V(8); PG8_WAIT_L(0); PG8_BAR; PG8_MMA(1, 0, At, B0); PG8_MMA(1, 1, At, B1); PG8_BAR; PG8_SCHED;
            PG8_LDB(B0, 1, 0); PG8_LDB(B1, 1, 1); PG8_SCHED; PG8_LDA(At, 1, 0); PG8_STAGE(PG8_SA(0, 1), a2 + hstepA, voffA);
            PG8_WAIT_V(8); PG8_WAIT_L(0); PG8_BAR; PG8_MMA(0, 0, At, B0); PG8_MMA(0, 1, At, B1); PG8_BAR; PG8_SCHED;
            PG8_LDA(At, 1, 1); PG8_STAGE(PG8_SB(1, 0), b3, voffB); PG8_STAGE(PG8_SB(1, 1), b3 + hstepB, voffB); PG8_STAGE(PG8_SA(1, 0), a3, voffA);
            PG8_WAIT_V(8); PG8_WAIT_L(0); PG8_BAR; PG8_MMA(1, 0, At, B0); PG8_MMA(1, 1, At, B1); PG8_BAR; PG8_SCHED;
            } else {
            PG8_LDB(B0, 0, 0); PG8_SCHED; PG8_LDA(At, 0, 0); PG8_STAGE(PG8_SA(1, 1), a1 + hstepA, voffA);
            PG8_WAIT_L(8); PG8_BAR; PG8_WAIT_L(0); PG8_MMA(0, 0, At, B0); PG8_BAR; PG8_SCHED;
            PG8_LDB(B1, 0, 1); PG8_STAGE(PG8_SB(0, 0), b2, voffB);
            PG8_BAR; PG8_WAIT_L(0); PG8_MMA(0, 1, At, B1); PG8_BAR;
            PG8_LDA(At, 0, 1); PG8_STAGE(PG8_SA(0, 0), a2, voffA);
            PG8_BAR; PG8_WAIT_L(0); PG8_MMA(1, 0, At, B0); PG8_BAR; PG8_SCHED;
            PG8_STAGE(PG8_SB(0, 1), b2 + hstepB, voffB);
            PG8_WAIT_V(6); PG8_BAR; PG8_MMA(1, 1, At, B1); PG8_BAR;
            PG8_LDB(B0, 1, 0); PG8_SCHED; PG8_LDA(At, 1, 0); PG8_STAGE(PG8_SA(0, 1), a2 + hstepA, voffA);
            PG8_WAIT_L(8); PG8_BAR; PG8_WAIT_L(0); PG8_MMA(0, 0, At, B0); PG8_BAR; PG8_SCHED;
            PG8_LDB(B1, 1, 1); PG8_STAGE(PG8_SB(1, 0), b3, voffB);
            PG8_BAR; PG8_WAIT_L(0); PG8_MMA(0, 1, At, B1); PG8_BAR;
            PG8_LDA(At, 1, 1); PG8_STAGE(PG8_SA(1, 0), a3, voffA);
            PG8_BAR; PG8_WAIT_L(0); PG8_MMA(1, 0, At, B0); PG8_BAR; PG8_SCHED;
            PG8_STAGE(PG8_SB(1, 1), b3 + hstepB, voffB);
            PG8_WAIT_V(6); PG8_BAR; PG8_MMA(1, 1, At, B1); PG8_BAR;
            }
        }
        if constexpr (ALIGN_EPI) { if (wr == 0) PG8_BAR; }
        bool keep = false;
        if constexpr (Epi::HAS_MID) { if (cur.kh == 0) { E.mid(acc, cur, wr, wc, fr, fq); keep = true; } }
        if (!keep) { if constexpr (!Epi::AFTER_DRAIN) { E(acc, cur, wr, wc, fr, fq); S.done(cur); } }
        if (!has_next) break;
        if (!keep)
#pragma unroll
        for (int a = 0; a < 2; ++a)
#pragma unroll
            for (int b = 0; b < 2; ++b)
#pragma unroll
                for (int m = 0; m < 4; ++m)
#pragma unroll
                    for (int n = 0; n < 2; ++n) acc[a][b][m][n] = (f32x4){0.f, 0.f, 0.f, 0.f};
        cur = nxt; cA = nA; cB = nB; ++ui;
        if constexpr (ALIGN_EPI) { if (wr == 1) PG8_BAR; }
    }
    PG8_WAIT_V(0);
    if constexpr (!ALIGN_EPI) { if (wr == 0) PG8_BAR; }
    PG8_BAR;
    if constexpr (Epi::AFTER_DRAIN) { E.fused(acc, cur, wr, wc, fr, fq, lds, wid, lane); S.done(cur); }
#undef PG8_SA
#undef PG8_SB
#undef PG8_STAGE
#undef PG8_LDA
#undef PG8_LDB
#undef PG8_MMA
#undef PG8_WAIT_V
#undef PG8_WAIT_L
#undef PG8_BAR
#undef PG8_SCHED
}
}

#include <hip/hip_cooperative_groups.h>
namespace cg = cooperative_groups;
typedef unsigned short bf16;
typedef unsigned v4u __attribute__((ext_vector_type(4)));
typedef unsigned v2u __attribute__((ext_vector_type(2)));
typedef float f32x4 __attribute__((ext_vector_type(4)));
typedef float f32x2 __attribute__((ext_vector_type(2)));
typedef short bf16x8 __attribute__((ext_vector_type(8)));

constexpr int NT = 512, NWAVES = 8;
constexpr int MR = 16384, MP = 16640;
constexpr int NIN = 3840;
constexpr int NQ = 65;
constexpr float EPS = 1e-5f;
constexpr size_t MiB = 1u << 20;
constexpr size_t WS_SS    = 0;
constexpr size_t WS_DEC   = 256 * 1024;
constexpr size_t WS_A1    = 288 * 1024;
constexpr size_t WS_A16   = 320 * 1024;
constexpr size_t WS_BAR   = 384 * 1024;
constexpr size_t WS_BBAR  = 512 * 1024;
constexpr size_t WS_UMETA = 1 * MiB;
constexpr size_t WS_DTRAW = 1 * MiB + 512 * 1024;
constexpr size_t WS_DT    = 2 * MiB + 640 * 1024;
constexpr size_t WS_ACS   = 254 * MiB + 512 * 1024;
static_assert(WS_DTRAW + 16640 * 16 * 4 <= WS_DT && WS_DT + 65 * 16 * 256 * 4 <= 4 * MiB && WS_ACS + 65 * 16 * 256 * 4 <= 256 * MiB, "smalls");
constexpr size_t WS_WGLU  = 4 * MiB;
constexpr size_t WS_TB5   = 8 * MiB;
constexpr size_t WS_TE5   = 20 * MiB;
constexpr size_t WS_WIN   = 28 * MiB;
constexpr size_t WS_PREV  = 20 * MiB;
constexpr size_t WS_WOUT  = 8 * MiB, WS_WUP = 12 * MiB, WS_WDN = 20 * MiB;
constexpr size_t WS_MIX   = 36 * MiB;
constexpr size_t WS_UA    = 100 * MiB;
constexpr size_t WS_XBCP  = 148 * MiB;
constexpr size_t WS_SEND  = 148 * MiB;
constexpr size_t WS_ST    = 180 * MiB;
constexpr size_t WS_Y5    = 148 * MiB;
constexpr size_t WS_XN    = 197 * MiB;
constexpr size_t WS_XF    = 197 * MiB;
constexpr size_t WS_H1B   = 197 * MiB;
constexpr size_t WS_CT    = 230 * MiB;
constexpr size_t WS_BTK   = WS_CT + 65 * 65536 * 2;
constexpr size_t WS_BF    = WS_BTK + 65 * 65536 * 2;
constexpr size_t WS_HB    = 36 * MiB;
static_assert(WS_BF + 65 * 65536 * 2 <= WS_ACS, "ws");
constexpr int LDS_BYTES = 155648;

__device__ __forceinline__ unsigned f2bf(float f) { unsigned u = __builtin_bit_cast(unsigned, f); return (u + 0x7fffu + ((u >> 16) & 1u)) >> 16; }
__device__ __forceinline__ unsigned pk2(float lo, float hi) { unsigned r; asm("v_cvt_pk_bf16_f32 %0, %1, %2" : "=v"(r) : "v"(lo), "v"(hi)); return r; }
__device__ __forceinline__ float bf2f(unsigned short h) { return __builtin_bit_cast(float, (unsigned)h << 16); }
__device__ __forceinline__ float bflo(unsigned w) { return __builtin_bit_cast(float, w << 16); }
__device__ __forceinline__ float bfhi(unsigned w) { return __builtin_bit_cast(float, w & 0xffff0000u); }
__device__ __forceinline__ float ex2(float x) { return __builtin_amdgcn_exp2f(x); }
__device__ __forceinline__ float expf_(float x) { return __builtin_amdgcn_exp2f(1.44269504f * x); }
__device__ __forceinline__ float wave_sum(float v) {
#pragma unroll
    for (int o = 1; o < 64; o <<= 1) v += __shfl_xor(v, o);
    return v;
}

#define LAS __attribute__((address_space(3)))
#define XB_TMO      128
#define XB_XCNT(j)  (256  + 64 * (j))
#define XB_XSUB(j)  (1280 + 64 * (j))
#define XB_XGEN(j)  (2304 + 64 * (j))
#define XB_TOP      3328
#define XB_TOPGEN   3392
#define XCD_BAR_WORDS 3456
#define XB_SPIN_CAP (1u << 18)

__device__ __forceinline__ unsigned xb_ld(unsigned* p)              { return __hip_atomic_load(p, __ATOMIC_RELAXED, __HIP_MEMORY_SCOPE_AGENT); }
__device__ __forceinline__ unsigned xb_add(unsigned* p, unsigned v) { return __hip_atomic_fetch_add(p, v, __ATOMIC_RELAXED, __HIP_MEMORY_SCOPE_AGENT); }
__device__ __forceinline__ unsigned xb_xcc_id() { return (unsigned)__builtin_amdgcn_s_getreg((3 << 11) | 20) & 0xFu; }
#define XB_SPIN(cond, bar) do { unsigned _sp = 0; while (cond) { __builtin_amdgcn_s_sleep(1); \
    if ((++_sp & 255u) == 0u) { if (xb_ld(&(bar)[XB_TMO])) break; if (_sp > XB_SPIN_CAP) { atomicAdd(&(bar)[XB_TMO], 1u); break; } } } } while (0)

struct XcdBarrier {
    unsigned* bar; unsigned x;
    volatile LAS unsigned* st;
};

__device__ __forceinline__ XcdBarrier xcd_barrier_post(unsigned* bar, volatile LAS unsigned* st) {
    XcdBarrier b; b.bar = bar; b.x = xb_xcc_id(); b.st = st;
    if (threadIdx.x == 0) (void)xb_add(&bar[XB_XCNT(b.x)], 1u);
    return b;
}
__device__ __forceinline__ void xcd_barrier_complete(unsigned* bar, unsigned x, unsigned& nloc, unsigned& nx) {
    const unsigned G = gridDim.x * gridDim.y * gridDim.z;
    unsigned sum, cnt, mine, sp = 0u;
    for (;;) {
        sum = 0u; cnt = 0u; mine = 0u;
#pragma unroll
        for (unsigned j = 0; j < 16; ++j) { const unsigned c = xb_ld(&bar[XB_XCNT(j)]); sum += c; cnt += (c > 0u) ? 1u : 0u; mine = (j == x) ? c : mine; }
        if (sum == G) break;
        __builtin_amdgcn_s_sleep(1);
        if ((++sp & 255u) == 0u) { if (xb_ld(&bar[XB_TMO])) break; if (sp > XB_SPIN_CAP) { atomicAdd(&bar[XB_TMO], 1u); break; } }
    }
    nloc = mine > 0u ? mine : 1u; nx = cnt > 0u ? cnt : 1u;
}

__device__ __forceinline__ void xcd_barrier(const XcdBarrier& b) {
    asm volatile("s_waitcnt vmcnt(0)" ::: "memory");
    __syncthreads();
    if (threadIdx.x == 0) {
        unsigned* bar = b.bar;
        __builtin_amdgcn_s_waitcnt(0);
        unsigned nloc = b.st[0], nx = b.st[1];
        if (nloc == 0u) { xcd_barrier_complete(bar, b.x, nloc, nx); b.st[0] = nloc; b.st[1] = nx; }
        const unsigned old = xb_add(&bar[XB_XSUB(b.x)], 1u);
        const unsigned gen = old / nloc;
        if (old + 1u == (gen + 1u) * nloc) {
            __builtin_amdgcn_fence(__ATOMIC_RELEASE, "agent");
            asm volatile("s_waitcnt vmcnt(0)" ::: "memory");
            const unsigned og = xb_add(&bar[XB_TOP], 1u);
            const unsigned tg = og / nx;
            if (og + 1u == (tg + 1u) * nx) xb_add(&bar[XB_TOPGEN], 1u);
            else XB_SPIN(xb_ld(&bar[XB_TOPGEN]) == tg, bar);
            __builtin_amdgcn_fence(__ATOMIC_ACQUIRE, "agent");
            xb_add(&bar[XB_XGEN(b.x)], 1u);
            asm volatile("s_waitcnt vmcnt(0)" ::: "memory");
        } else {
            XB_SPIN(xb_ld(&bar[XB_XGEN(b.x)]) == gen, bar);
            __builtin_amdgcn_fence(__ATOMIC_ACQUIRE, "agent");
            asm volatile("s_waitcnt vmcnt(0)" ::: "memory");
        }
    }
    __syncthreads();
}

struct Args {
    const float* in[26]; float* out; unsigned char* ws; int ph_lo, ph_hi;
};
enum { I_X = 0, I_META, I_GMIX, I_WIN, I_CONVW, I_CONVB, I_DTB, I_ALOG, I_DSSD, I_GSSD, I_LRE, I_LIM, I_LSTEP, I_BRE, I_BIM, I_CRE, I_CIM, I_DS5, I_WGLU, I_BGLU, I_GS5, I_WOUT, I_GMLP, I_WUP, I_WDN, I_GFIN };

template <int MODE> __device__ __forceinline__ int colmap(int j) {
    if (MODE == 1) { if (j < 2560) return j; if (j < 3584) return j + 16; if (j < 3600) return j - 1024; return -1; }
    if (MODE == 2) { const int pn = j >> 8, r = j & 255; return r < 128 ? pn * 128 + r : 1024 + pn * 128 + (r - 128); }
    return j;
}
template <int MODE> __device__ __forceinline__ void transpose_item(const float* W, int K, int N, bf16* WT, const float* ks0, const float* ks1, float* scr, int item, int nblk, int lane) {
    const int kb = item / nblk, nb = item % nblk, k0 = 64 * kb, n0 = 32 * nb;
    const int src = colmap<MODE>(n0 + (lane & 31));
#pragma unroll
    for (int i = 0; i < 32; ++i) { const int kk = 2 * i + (lane >> 5); const int k = k0 + kk;
        float v = src >= 0 ? W[(size_t)k * N + src] : 0.f;
        if (ks0) v *= (k < 1024 ? ks0[k] : ks1[k - 1024]);
        scr[kk * 33 + (lane & 31)] = v; }
    asm volatile("s_waitcnt lgkmcnt(0)" ::: "memory");
    const int c = lane & 7;
#pragma unroll
    for (int j = 0; j < 4; ++j) { const int n = (lane >> 3) + 8 * j; const float* s = scr + (8 * c) * 33 + n;
        v4u o; o.x = pk2(s[0 * 33], s[1 * 33]); o.y = pk2(s[2 * 33], s[3 * 33]); o.z = pk2(s[4 * 33], s[5 * 33]); o.w = pk2(s[6 * 33], s[7 * 33]);
        *(v4u*)(WT + (size_t)(n0 + n) * K + k0 + 8 * c) = o; }
    asm volatile("s_waitcnt lgkmcnt(0)" ::: "memory");
}

__device__ __forceinline__ void sincos_d(double th, float& sn, float& cs) {
    const double k = rint(th * 0.15915494309189535); const double r = fma(-k, 6.283185307179586, th);
    const double t = r * 0.125, t2 = t * t;
    double s = t * (1.0 + t2 * (-1.0 / 6 + t2 * (1.0 / 120 + t2 * (-1.0 / 5040 + t2 * (1.0 / 362880 + t2 * (-1.0 / 39916800))))));
    double c = 1.0 + t2 * (-0.5 + t2 * (1.0 / 24 + t2 * (-1.0 / 720 + t2 * (1.0 / 40320 + t2 * (-1.0 / 3628800 + t2 * (1.0 / 479001600))))));
#pragma unroll
    for (int i = 0; i < 3; ++i) { const double s2 = 2.0 * s * c, c2 = 1.0 - 2.0 * s * s; s = s2; c = c2; }
    sn = (float)s; cs = (float)c;
}

__device__ __forceinline__ void s5_tables(const Args& a, int g, unsigned char* lds, int tid) {
    f32x2* pw = (f32x2*)lds;
    f32x2* Cc = pw + 17 * 64;
    f32x2* Bb = Cc + 16 * 64;
    float* Kt = (float*)(Bb + 64 * 16);
    unsigned char* ws = a.ws;
    if (tid < 64) {
        const int p = tid; const float lr = a.in[I_LRE][g * 64 + p], li = a.in[I_LIM][g * 64 + p]; const float st = expf(a.in[I_LSTEP][g]);
        float are = 1.f, aim = 0.f;
        for (int tau = 0; tau <= 16; ++tau) {
            const float mag = expf(lr * st * (float)tau); float sn, cs; sincos_d((double)li * (double)st * (double)tau, sn, cs);
            pw[tau * 64 + p] = (f32x2){mag * cs, mag * sn};
            if (tau == 1) { are = mag * cs; aim = mag * sn; ((f32x2*)(ws + WS_A1))[g * 64 + p] = (f32x2){are, aim}; }
            if (tau == 16) ((f32x2*)(ws + WS_A16))[g * 64 + p] = (f32x2){mag * cs, mag * sn};
        }
        const float den = lr * lr + li * li;
        const float cre = ((are - 1.0f) * lr + aim * li) / den, cim = (aim * lr - (are - 1.0f) * li) / den;
        f32x4 brv[4], biv[4];
#pragma unroll
        for (int h4 = 0; h4 < 4; ++h4) { brv[h4] = *(const f32x4*)(a.in[I_BRE] + (g * 64 + p) * 16 + 4 * h4); biv[h4] = *(const f32x4*)(a.in[I_BIM] + (g * 64 + p) * 16 + 4 * h4); }
#pragma unroll
        for (int h = 0; h < 16; ++h) { const float br = brv[h >> 2][h & 3], bi = biv[h >> 2][h & 3];
            const f32x2 v = (f32x2){cre * br - cim * bi, cre * bi + cim * br}; Bb[p * 16 + h] = v; ((f32x2*)(ws + WS_BBAR))[(g * 64 + p) * 16 + h] = v; }
    }
    for (int e = tid; e < 1024; e += NT) Cc[e] = (f32x2){a.in[I_CRE][g * 1024 + e], a.in[I_CIM][g * 1024 + e]};
    __syncthreads();
    {
        const int tau = tid >> 5, h = (tid >> 1) & 15, h0 = (tid & 1) * 8; float acc[8];
#pragma unroll
        for (int j = 0; j < 8; ++j) acc[j] = 0.f;
        for (int p = 0; p < 64; ++p) { const f32x2 c = Cc[h * 64 + p], w = pw[tau * 64 + p]; const float tr = c.x * w.x - c.y * w.y, ti = c.x * w.y + c.y * w.x;
#pragma unroll
            for (int j = 0; j < 8; ++j) { const f32x2 b = Bb[p * 16 + h0 + j]; acc[j] += tr * b.x - ti * b.y; } }
        if (tau == 0) {
#pragma unroll
            for (int j = 0; j < 8; ++j) if (h0 + j == h) acc[j] += a.in[I_DS5][g * 16 + h];
        }
#pragma unroll
        for (int j = 0; j < 8; ++j) Kt[(tau * 16 + h) * 16 + h0 + j] = acc[j];
    }
    __syncthreads();
    bf16* TB = (bf16*)(ws + WS_TB5) + (size_t)g * 256 * 384;
    for (int pc = tid; pc < 256 * 48; pc += NT) {
        const int row = pc / 48, c8 = (pc % 48) * 8, t = row >> 4, h = row & 15; float v[8];
        if (c8 < 256) { const int s = c8 >> 4, h0 = c8 & 15;
#pragma unroll
            for (int j = 0; j < 8; ++j) v[j] = s <= t ? Kt[((t - s) * 16 + h) * 16 + h0 + j] : 0.f;
        } else { const int p0 = (c8 - 256) >> 1;
#pragma unroll
            for (int j = 0; j < 4; ++j) { const f32x2 c = Cc[h * 64 + p0 + j], w = pw[(t + 1) * 64 + p0 + j]; v[2 * j] = c.x * w.x - c.y * w.y; v[2 * j + 1] = -(c.x * w.y + c.y * w.x); }
        }
        v4u o; o.x = pk2(v[0], v[1]); o.y = pk2(v[2], v[3]); o.z = pk2(v[4], v[5]); o.w = pk2(v[6], v[7]);
        *(v4u*)(TB + (size_t)row * 384 + c8) = o;
    }
    bf16* TE = (bf16*)(ws + WS_TE5) + (size_t)g * 256 * 256;
    for (int pc = tid; pc < 256 * 32; pc += NT) {
        const int row = pc >> 5, c8 = (pc & 31) * 8; float v[8];
        if (row < 128) { const int p = row >> 1, ri = row & 1, s = c8 >> 4, h0 = c8 & 15; const f32x2 w = pw[(15 - s) * 64 + p];
#pragma unroll
            for (int j = 0; j < 8; ++j) { const f32x2 b = Bb[p * 16 + h0 + j]; v[j] = ri ? (w.x * b.y + w.y * b.x) : (w.x * b.x - w.y * b.y); }
        } else {
#pragma unroll
            for (int j = 0; j < 8; ++j) v[j] = 0.f;
        }
        v4u o; o.x = pk2(v[0], v[1]); o.y = pk2(v[2], v[3]); o.z = pk2(v[4], v[5]); o.w = pk2(v[6], v[7]);
        *(v4u*)(TE + (size_t)row * 256 + c8) = o;
    }
    __syncthreads();
}

__device__ __forceinline__ void rms_row_to_bf16(const float* xrow, const float* gain, bf16* orow, int lane) {
    unsigned long long* o8 = (unsigned long long*)orow + lane;
    if (!xrow) {
#pragma unroll
        for (int j = 0; j < 4; ++j) o8[64 * j] = 0ull;
        return; }
    const f32x4* xr = (const f32x4*)xrow + lane; const f32x4* gr = (const f32x4*)gain + lane;
    f32x4 v[4]; float s = 0.f;
#pragma unroll
    for (int j = 0; j < 4; ++j) { v[j] = xr[64 * j]; s += (v[j].x * v[j].x + v[j].y * v[j].y) + (v[j].z * v[j].z + v[j].w * v[j].w); }
    const float rstd = 1.f / sqrtf(wave_sum(s) * (1.f / 1024.f) + EPS);
#pragma unroll
    for (int j = 0; j < 4; ++j) { const f32x4 gg = gr[64 * j]; const f32x4 w = v[j] * rstd * gg; o8[64 * j] = (unsigned long long)pk2(w.x, w.y) | ((unsigned long long)pk2(w.z, w.w) << 32); }
}

__device__ __forceinline__ void p0_prologue(const Args& a, unsigned char* lds, int tid, int G) {
    unsigned char* ws = a.ws; const int lane = tid & 63, wave = tid >> 6;
    const int gw = blockIdx.x * NWAVES + wave, NGW = G * NWAVES;
    for (int i = blockIdx.x * NT + tid; i < 4 * 16384; i += G * NT) ((float*)(ws + WS_SS))[i] = 0.f;
    for (int g = (G - 1 - (int)blockIdx.x); g < 64; g += G) s5_tables(a, g, lds, tid);
    __syncthreads();
    float* scr = (float*)(lds + wave * 16384);
    constexpr int NB_IN = NIN / 32, NB_GL = 2048 / 32;
    constexpr int I_IN = 16 * NB_IN, I_GL = 16 * NB_GL;
    const int nT = (G > 128) ? G - 64 : G;
    if ((int)blockIdx.x < nT) for (int it = gw; it < I_IN + I_GL; it += nT * NWAVES) {
        if (it < I_IN) transpose_item<1>(a.in[I_WIN], 1024, 3600, (bf16*)(ws + WS_WIN), nullptr, nullptr, scr, it, NB_IN, lane);
        else transpose_item<2>(a.in[I_WGLU], 1024, 2048, (bf16*)(ws + WS_WGLU), nullptr, nullptr, scr, it - I_IN, NB_GL, lane);
    }
    for (int m0 = gw; m0 < MR; m0 += 8 * NGW) {
        const f32x4* gr = (const f32x4*)a.in[I_GMIX] + lane; f32x4 v[8][4];
#pragma unroll
        for (int k = 0; k < 8; ++k) { const int m = m0 + k * NGW; const f32x4* xr = (const f32x4*)(a.in[I_X] + (size_t)(m < MR ? m : m0) * 1024) + lane;
#pragma unroll
            for (int j = 0; j < 4; ++j) v[k][j] = xr[64 * j]; }
        f32x4 gg[4];
#pragma unroll
        for (int j = 0; j < 4; ++j) gg[j] = gr[64 * j];
#pragma unroll
        for (int k = 0; k < 8; ++k) { const int m = m0 + k * NGW; float sq = 0.f;
#pragma unroll
            for (int j = 0; j < 4; ++j) sq += (v[k][j].x * v[k][j].x + v[k][j].y * v[k][j].y) + (v[k][j].z * v[k][j].z + v[k][j].w * v[k][j].w);
            const float rstd = 1.f / sqrtf(wave_sum(sq) * (1.f / 1024.f) + EPS);
            if (m < MR) { unsigned long long* o8 = (unsigned long long*)((bf16*)(ws + WS_XN) + (size_t)m * 1024) + lane;
#pragma unroll
                for (int j = 0; j < 4; ++j) { const f32x4 w = v[k][j] * rstd * gg[j]; o8[64 * j] = (unsigned long long)pk2(w.x, w.y) | ((unsigned long long)pk2(w.z, w.w) << 32); } }
        }
    }
    for (int m = MR + gw; m < MP; m += NGW)
        rms_row_to_bf16(m < MR + 16 ? a.in[I_META] + (size_t)(m - MR) * 1024 : nullptr, a.in[I_GMIX], (bf16*)(ws + WS_XN) + (size_t)m * 1024, lane);
}
__device__ __forceinline__ void p6_weights(const Args& a, unsigned char* lds, int tid, int G) {
    unsigned char* ws = a.ws; const int lane = tid & 63, wave = tid >> 6;
    const int gw = blockIdx.x * NWAVES + wave, NGW = G * NWAVES;
    float* scr = (float*)(lds + wave * 16384);
    constexpr int I_O = 32 * 32, I_U = 16 * 128, I_D = 64 * 32;
    for (int it = gw; it < I_O + I_U + I_D; it += NGW) {
        if (it < I_O) transpose_item<0>(a.in[I_WOUT], 2048, 1024, (bf16*)(ws + WS_WOUT), a.in[I_GSSD], a.in[I_GS5], scr, it, 32, lane);
        else if (it < I_O + I_U) transpose_item<0>(a.in[I_WUP], 1024, 4096, (bf16*)(ws + WS_WUP), a.in[I_GMLP], a.in[I_GMLP], scr, it - I_O, 128, lane);
        else transpose_item<0>(a.in[I_WDN], 4096, 1024, (bf16*)(ws + WS_WDN), nullptr, nullptr, scr, it - I_O - I_U, 32, lane);
    }
    __syncthreads();
}

__device__ __forceinline__ int chunk_row(int q, int tok) {
    if (q == 0) return tok < 240 ? -1 : MR + (tok - 240);
    const int b = (q - 1) >> 5, c = (q - 1) & 31;
    if (tok < 0 && c == 0) return MR + 16 + tok;
    return b * 8192 + c * 256 + tok;
}
__device__ __forceinline__ float silu_(float x) { return x * __builtin_amdgcn_rcpf(1.0f + ex2(-1.44269504f * x)); }
__device__ __forceinline__ void p2_conv_unit(const Args& a, int q, int blk, unsigned char* lds, int tid) {
    unsigned char* ws = a.ws;
    bf16* IN = (bf16*)lds;
    bf16* OT = (bf16*)(lds + 40960);
    const bf16* XBCP = (const bf16*)(ws + WS_XBCP);
    const int ch0 = blk * 64;
    for (int pc = tid; pc < 259 * 8; pc += NT) { const int rr = pc >> 3, c8 = (pc & 7) * 8; const int row = chunk_row(q, rr - 3);
        v4u v = (v4u){0u, 0u, 0u, 0u}; if (row >= 0) v = *(const v4u*)(XBCP + (size_t)row * 1536 + ch0 + c8);
        *(v4u*)(IN + rr * 64 + c8) = v; }
    __syncthreads();
    const float* cw = a.in[I_CONVW]; const float* cb = a.in[I_CONVB];
    const bool is_x = blk < 16, is_b = blk >= 16 && blk < 20;
    if (!is_x) {
        bf16* dst = (bf16*)(ws + (is_b ? WS_BTK : WS_CT)) + (size_t)q * 65536 + (is_b ? (blk - 16) : (blk - 20)) * 64;
        const int c8 = (tid & 7) * 8; float wreg[4][8], breg[8];
#pragma unroll
        for (int j = 0; j < 8; ++j) { breg[j] = cb[ch0 + c8 + j];
#pragma unroll
            for (int k = 0; k < 4; ++k) wreg[k][j] = cw[k * 1536 + ch0 + c8 + j]; }
        for (int pc = tid; pc < 256 * 8; pc += NT) { const int tok = pc >> 3; float o[8];
            const bool zero = (q == 0 && tok < 240);
#pragma unroll
            for (int j = 0; j < 8; ++j) o[j] = breg[j];
#pragma unroll
            for (int k = 0; k < 4; ++k) { const v4u v = *(const v4u*)(IN + (tok + k) * 64 + c8); const unsigned w[4] = {v.x, v.y, v.z, v.w};
#pragma unroll
                for (int j = 0; j < 4; ++j) { o[2 * j] += wreg[k][2 * j] * bflo(w[j]); o[2 * j + 1] += wreg[k][2 * j + 1] * bfhi(w[j]); } }
#pragma unroll
            for (int j = 0; j < 8; ++j) o[j] = zero ? 0.f : silu_(o[j]);
            v4u ov; ov.x = pk2(o[0], o[1]); ov.y = pk2(o[2], o[3]); ov.z = pk2(o[4], o[5]); ov.w = pk2(o[6], o[7]);
            *(v4u*)(dst + (size_t)tok * 256 + c8) = ov; }
    }
    if (is_x || is_b) {
        const int ch = tid & 63; float wk[4]; const float bias = cb[ch0 + ch];
#pragma unroll
        for (int k = 0; k < 4; ++k) wk[k] = cw[k * 1536 + ch0 + ch];
        for (int it = tid; it < 64 * 32; it += NT) { const int t0 = (it >> 6) * 8; float in[11], o[8];
#pragma unroll
            for (int j = 0; j < 11; ++j) in[j] = bf2f(IN[(t0 + j) * 64 + ch]);
#pragma unroll
            for (int j = 0; j < 8; ++j) { const float v = bias + wk[0] * in[j] + wk[1] * in[j + 1] + wk[2] * in[j + 2] + wk[3] * in[j + 3]; o[j] = (q == 0 && t0 + j < 240) ? 0.f : silu_(v); }
            v4u ov; ov.x = pk2(o[0], o[1]); ov.y = pk2(o[2], o[3]); ov.z = pk2(o[4], o[5]); ov.w = pk2(o[6], o[7]);
            *(v4u*)(OT + ch * 264 + t0) = ov; }
        __syncthreads();
        bf16* dst = is_x ? (bf16*)(ws + WS_XF) + ((size_t)q * 1024 + ch0) * 256 : (bf16*)(ws + WS_BF) + ((size_t)q * 256 + (blk - 16) * 64) * 256;
        for (int pc = tid; pc < 64 * 32; pc += NT) { const int ch = pc >> 5, t8 = (pc & 31) * 8; *(v4u*)(dst + (size_t)ch * 256 + t8) = *(const v4u*)(OT + ch * 264 + t8); }
    }
    __syncthreads();
}
__device__ __forceinline__ void p2_dt_item(const Args& a, int q, int h, int lane) {
    unsigned char* ws = a.ws; const float* DTRAW = (const float*)(ws + WS_DTRAW);
    const float bias = a.in[I_DTB][h], A = -expf(a.in[I_ALOG][h]);
    float dt[4], cs[4]; float run = 0.f;
    int rows[4]; float raw[4];
#pragma unroll
    for (int j = 0; j < 4; ++j) { rows[j] = chunk_row(q, 4 * lane + j); raw[j] = DTRAW[(size_t)(rows[j] < 0 ? 0 : rows[j]) * 16 + h]; }
#pragma unroll
    for (int j = 0; j < 4; ++j) { const float x = raw[j] + bias; float d = fmaxf(x, 0.f) + __logf(1.0f + expf_(-fabsf(x))); if (rows[j] < 0) d = 0.f;
        dt[j] = d; run += d * A; cs[j] = run; }
    float incl = run;
#pragma unroll
    for (int o = 1; o < 64; o <<= 1) { const float t = __shfl_up(incl, o); if (lane >= o) incl += t; }
    const float excl = incl - run;
    float* DT = (float*)(ws + WS_DT) + ((size_t)q * 16 + h) * 256 + 4 * lane; float* ACS = (float*)(ws + WS_ACS) + ((size_t)q * 16 + h) * 256 + 4 * lane;
    *(f32x4*)DT = (f32x4){dt[0], dt[1], dt[2], dt[3]}; *(f32x4*)ACS = (f32x4){cs[0] + excl, cs[1] + excl, cs[2] + excl, cs[3] + excl};
    if (lane == 63) ((float*)(ws + WS_DEC))[q * 16 + h] = expf_(cs[3] + excl);
}

#define MFMA16(A, B, C) __builtin_amdgcn_mfma_f32_16x16x32_bf16(A, B, C, 0, 0, 0)
__device__ __forceinline__ void p3_states_unit(const Args& a, int q, int g, int nh, int tid) {
    unsigned char* ws = a.ws; const int lane = tid & 63, r = tid >> 6, h = g * 8 + r, fr = lane & 15, fq = lane >> 4;
    const bf16* XF = (const bf16*)(ws + WS_XF) + ((size_t)q * 1024 + h * 64) * 256;
    const bf16* BF = (const bf16*)(ws + WS_BF) + ((size_t)q * 256 + g * 128) * 256;
    const float* DT = (const float*)(ws + WS_DT) + ((size_t)q * 16 + h) * 256; const float* ACS = (const float*)(ws + WS_ACS) + ((size_t)q * 16 + h) * 256;
    const float alast = ACS[255];
    bf16* ST = (bf16*)(ws + WS_ST) + ((size_t)q * 16 + h) * 8192;
    {
        f32x4 acc[4][4];
#pragma unroll
        for (int i = 0; i < 4; ++i)
#pragma unroll
            for (int j = 0; j < 4; ++j) acc[i][j] = (f32x4){0.f, 0.f, 0.f, 0.f};
#pragma unroll 2
        for (int kb = 0; kb < 8; ++kb) {
            const int s0 = kb * 32 + fq * 8;
            float w[8];
            { const f32x4 d0 = *(const f32x4*)(DT + s0), d1 = *(const f32x4*)(DT + s0 + 4), c0 = *(const f32x4*)(ACS + s0), c1 = *(const f32x4*)(ACS + s0 + 4);
#pragma unroll
              for (int j = 0; j < 4; ++j) { w[j] = expf_(alast - c0[j]) * d0[j]; w[4 + j] = expf_(alast - c1[j]) * d1[j]; } }
            bf16x8 Af[4], Bf[4];
#pragma unroll
            for (int i = 0; i < 4; ++i) { const v4u v = *(const v4u*)(XF + (size_t)(i * 16 + fr) * 256 + s0);
                v4u o; o.x = pk2(bflo(v.x) * w[0], bfhi(v.x) * w[1]); o.y = pk2(bflo(v.y) * w[2], bfhi(v.y) * w[3]); o.z = pk2(bflo(v.z) * w[4], bfhi(v.z) * w[5]); o.w = pk2(bflo(v.w) * w[6], bfhi(v.w) * w[7]);
                Af[i] = __builtin_bit_cast(bf16x8, o); }
#pragma unroll
            for (int j = 0; j < 4; ++j) Bf[j] = *(const bf16x8*)(BF + (size_t)((nh * 4 + j) * 16 + fr) * 256 + s0);
#pragma unroll
            for (int i = 0; i < 4; ++i)
#pragma unroll
                for (int j = 0; j < 4; ++j) acc[i][j] = MFMA16(Bf[j], Af[i], acc[i][j]);
        }
#pragma unroll
        for (int i = 0; i < 4; ++i)
#pragma unroll
            for (int j = 0; j < 4; ++j) { v2u o; o.x = pk2(acc[i][j][0], acc[i][j][1]); o.y = pk2(acc[i][j][2], acc[i][j][3]);
                *(v2u*)(ST + (i * 16 + fr) * 128 + (nh * 4 + j) * 16 + fq * 4) = o; }
    }
}

__device__ __forceinline__ void p4_ssd_scan_item(const Args& a, int item, int tid) {
    unsigned char* ws = a.ws; const int e = item * 1024 + tid * 2;
    const int b = e >> 17, hpn = e & 131071, h = hpn >> 13;
    const bf16* ST = (const bf16*)(ws + WS_ST); bf16* PREV = (bf16*)(ws + WS_PREV); const float* DEC = (const float*)(ws + WS_DEC);
    unsigned st[32]; float dec[32];
    st[0] = *(const unsigned*)(ST + hpn); dec[0] = 0.f;
#pragma unroll
    for (int k = 1; k < 32; ++k) { const int q = b * 32 + k; st[k] = *(const unsigned*)(ST + (size_t)q * 131072 + hpn); dec[k] = DEC[q * 16 + h]; }
    float s0 = bflo(st[0]), s1 = bfhi(st[0]);
#pragma unroll
    for (int c = 0; c < 32; ++c) {
        *(unsigned*)(PREV + (size_t)(b * 32 + c) * 131072 + hpn) = pk2(s0, s1);
        if (c < 31) { const float d = dec[c + 1]; const unsigned v = st[c + 1]; s0 = s0 * d + bflo(v); s1 = s1 * d + bfhi(v); }
    }
}
__device__ __forceinline__ void p4_s5_scan_item(const Args& a, int item, unsigned char* lds, int tid) {
    unsigned char* ws = a.ws; const int b = item >> 7, g = (item >> 1) & 63, p = (item & 1) * 32 + (tid & 31), seg = tid >> 5;
    const f32x2 a1 = ((const f32x2*)(ws + WS_A1))[g * 64 + p], a16 = ((const f32x2*)(ws + WS_A16))[g * 64 + p];
    const f32x2* Bb = (const f32x2*)(ws + WS_BBAR) + (size_t)(g * 64 + p) * 16;
    const bf16* UM = (const bf16*)(ws + WS_UMETA);
    const f32x2* SE = (const f32x2*)(ws + WS_SEND) + ((size_t)(g * 1024 + b * 512 + seg * 32) * 64 + p);
    f32x2 se[32];
#pragma unroll
    for (int j = 0; j < 32; ++j) se[j] = SE[(size_t)j * 64];
    float sr = 0.f, si = 0.f;
    f32x2 bbv[16];
#pragma unroll
    for (int h = 0; h < 16; ++h) bbv[h] = Bb[h];
    for (int s = 0; s < 16; ++s) { float br = 0.f, bi = 0.f;
        const v4u u0 = *(const v4u*)(UM + s * 1024 + g * 16), u1 = *(const v4u*)(UM + s * 1024 + g * 16 + 8); const unsigned uw[8] = {u0.x, u0.y, u0.z, u0.w, u1.x, u1.y, u1.z, u1.w};
#pragma unroll
        for (int h = 0; h < 16; ++h) { const float u = (h & 1) ? bfhi(uw[h >> 1]) : bflo(uw[h >> 1]); const f32x2 bb = bbv[h]; br += bb.x * u; bi += bb.y * u; }
        const float nr = a1.x * sr - a1.y * si + br, ni = a1.x * si + a1.y * sr + bi; sr = nr; si = ni; }
    float er = 0.f, ei = 0.f;
#pragma unroll
    for (int j = 0; j < 32; ++j) { const float nr = a16.x * er - a16.y * ei + se[j].x, ni = a16.x * ei + a16.y * er + se[j].y; er = nr; ei = ni; }
    f32x2* EL = (f32x2*)lds;
    EL[seg * 32 + (tid & 31)] = (f32x2){er, ei};
    float pr = a16.x, pi = a16.y;
#pragma unroll
    for (int k = 0; k < 5; ++k) { const float nr = pr * pr - pi * pi, ni = 2.f * pr * pi; pr = nr; pi = ni; }
    __syncthreads();
    for (int k = 0; k < seg; ++k) { const f32x2 ek = EL[k * 32 + (tid & 31)]; const float nr = pr * sr - pi * si + ek.x, ni = pr * si + pi * sr + ek.y; sr = nr; si = ni; }
    unsigned* UA = (unsigned*)((bf16*)(ws + WS_UA) + ((size_t)(g * 1024 + b * 512 + seg * 32) * 384 + 256 + 2 * p));
#pragma unroll
    for (int j = 0; j < 32; ++j) { UA[(size_t)j * 192] = pk2(sr, si);
        const float nr = a16.x * sr - a16.y * si + se[j].x, ni = a16.x * si + a16.y * sr + se[j].y; sr = nr; si = ni; }
    __syncthreads();
}

__device__ __forceinline__ void p5_ssd_out_unit(const Args& a, int q, int g, int half, unsigned char* lds, int tid) {
    unsigned char* ws = a.ws; const int lane = tid & 63, r = tid >> 6, h = g * 8 + r, fr = lane & 15, fq = lane >> 4;
    bf16* CBs = (bf16*)lds;
    float* ACSs = (float*)(lds + 256 * 264 * 2);
    float* DTs = ACSs + 8 * 256;
    const bf16* CT = (const bf16*)(ws + WS_CT) + (size_t)q * 65536 + g * 128;
    const bf16* BTK = (const bf16*)(ws + WS_BTK) + (size_t)q * 65536 + g * 128;
    for (int i = tid; i < 2048; i += NT) { ACSs[i] = ((const float*)(ws + WS_ACS))[((size_t)q * 16 + g * 8) * 256 + i]; DTs[i] = ((const float*)(ws + WS_DT))[((size_t)q * 16 + g * 8) * 256 + i]; }
    {
        int cnt = 0;
#pragma unroll 1
        for (int ti = 0; ti < 8; ++ti) {
            const int lt = half ? 4 + ti : (ti < 4 ? ti : 8 + ti);
#pragma unroll 1
            for (int stl = 0; stl <= lt; ++stl, ++cnt) {
                if ((cnt & 7) != r) continue;
                f32x4 c = (f32x4){0.f, 0.f, 0.f, 0.f};
#pragma unroll
                for (int k = 0; k < 4; ++k) { const bf16x8 Af = *(const bf16x8*)(CT + (size_t)(lt * 16 + fr) * 256 + k * 32 + fq * 8);
                    const bf16x8 Bf = *(const bf16x8*)(BTK + (size_t)(stl * 16 + fr) * 256 + k * 32 + fq * 8); c = MFMA16(Af, Bf, c); }
#pragma unroll
                for (int e = 0; e < 4; ++e) CBs[(lt * 16 + fq * 4 + e) * 264 + stl * 16 + fr] = (bf16)f2bf(c[e]);
            }
        }
    }
    __syncthreads();
    const bf16* XF = (const bf16*)(ws + WS_XF) + ((size_t)q * 1024 + h * 64) * 256;
    const bf16* PREV = (const bf16*)(ws + WS_PREV) + ((size_t)(q - 1) * 16 + h) * 8192;
    const float* acs = ACSs + r * 256; const float* dts = DTs + r * 256;
    const float dsk = a.in[I_DSSD][h];
    const int b = (q - 1) >> 5, c = (q - 1) & 31; const int m0 = b * 8192 + c * 256;
    bf16* MIX = (bf16*)(ws + WS_MIX); float* SSS = (float*)(ws + WS_SS);
#pragma unroll 1
    for (int lbi = 0; lbi < 2; ++lbi) {
        const int lb = half ? 1 + lbi : 3 * lbi;
        f32x4 acc[4][4];
#pragma unroll
        for (int i = 0; i < 4; ++i)
#pragma unroll
            for (int j = 0; j < 4; ++j) acc[i][j] = (f32x4){0.f, 0.f, 0.f, 0.f};
#pragma unroll 2
        for (int k = 0; k < 4; ++k) { bf16x8 Af[4], Bf[4];
#pragma unroll
            for (int i = 0; i < 4; ++i) Af[i] = *(const bf16x8*)(CT + (size_t)(lb * 64 + i * 16 + fr) * 256 + k * 32 + fq * 8);
#pragma unroll
            for (int j = 0; j < 4; ++j) Bf[j] = *(const bf16x8*)(PREV + (size_t)(j * 16 + fr) * 128 + k * 32 + fq * 8);
#pragma unroll
            for (int i = 0; i < 4; ++i)
#pragma unroll
                for (int j = 0; j < 4; ++j) acc[i][j] = MFMA16(Bf[j], Af[i], acc[i][j]); }
#pragma unroll
        for (int i = 0; i < 4; ++i) { const float sc = expf_(acs[lb * 64 + i * 16 + fr]);
#pragma unroll
            for (int j = 0; j < 4; ++j) acc[i][j] *= sc; }
        const int nsb = 2 * lb + 2;
#pragma unroll 1
        for (int sb = 0; sb < nsb; ++sb) {
            const int s0 = sb * 32 + fq * 8;
            bf16x8 Bf[4];
#pragma unroll
            for (int j = 0; j < 4; ++j) Bf[j] = *(const bf16x8*)(XF + (size_t)(j * 16 + fr) * 256 + s0);
            float as[8], ds[8];
#pragma unroll
            for (int j = 0; j < 8; ++j) { as[j] = acs[s0 + j]; ds[j] = dts[s0 + j]; }
            float fs[8];
#pragma unroll
            for (int j = 0; j < 8; ++j) fs[j] = expf_(as[7] - as[j]) * ds[j];
#pragma unroll
            for (int i = 0; i < 4; ++i) {
                const int l = lb * 64 + i * 16 + fr;
                if (sb * 32 > lb * 64 + i * 16 + 15) continue;
                const float al = acs[l];
                const v4u v = *(const v4u*)(CBs + l * 264 + s0); const unsigned w4[4] = {v.x, v.y, v.z, v.w}; float pv[8];
                if (sb * 32 + 31 < lb * 64 + i * 16) {
                    const float gl = expf_(al - as[7]);
#pragma unroll
                    for (int j = 0; j < 4; ++j) { pv[2 * j] = bflo(w4[j]) * (gl * fs[2 * j]); pv[2 * j + 1] = bfhi(w4[j]) * (gl * fs[2 * j + 1]); }
                } else
#pragma unroll
                for (int j = 0; j < 4; ++j) {
                    const float p0 = bflo(w4[j]) * expf_(fminf(al - as[2 * j], 0.f)) * ds[2 * j], p1 = bfhi(w4[j]) * expf_(fminf(al - as[2 * j + 1], 0.f)) * ds[2 * j + 1];
                    const int sa = s0 + 2 * j, sbq = sa + 1;
                    pv[2 * j] = (sa < l) ? p0 : (sa == l ? p0 + dsk : 0.f); pv[2 * j + 1] = (sbq < l) ? p1 : (sbq == l ? p1 + dsk : 0.f); }
                v4u o; o.x = pk2(pv[0], pv[1]); o.y = pk2(pv[2], pv[3]); o.z = pk2(pv[4], pv[5]); o.w = pk2(pv[6], pv[7]);
                const bf16x8 Af = __builtin_bit_cast(bf16x8, o);
#pragma unroll
                for (int j = 0; j < 4; ++j) acc[i][j] = MFMA16(Bf[j], Af, acc[i][j]);
            }
        }
#pragma unroll
        for (int i = 0; i < 4; ++i) {
            const int l = lb * 64 + i * 16 + fr; float ssq = 0.f;
            bf16* zrow = MIX + (size_t)(m0 + l) * 2048 + h * 64 + fq * 4;
#pragma unroll
            for (int j = 0; j < 4; ++j) {
                const v2u zv = *(const v2u*)(zrow + j * 16);
                const float y0 = acc[i][j][0] * silu_(bflo(zv.x)), y1 = acc[i][j][1] * silu_(bfhi(zv.x)), y2 = acc[i][j][2] * silu_(bflo(zv.y)), y3 = acc[i][j][3] * silu_(bfhi(zv.y));
                v2u o; o.x = pk2(y0, y1); o.y = pk2(y2, y3); *(v2u*)(zrow + j * 16) = o;
                ssq += (y0 * y0 + y1 * y1) + (y2 * y2 + y3 * y3);
            }
            ssq += __shfl_xor(ssq, 16); ssq += __shfl_xor(ssq, 32);
            if (fq == 0) atomicAdd(SSS + m0 + l, ssq);
        }
    }
    __syncthreads();
}

__device__ __forceinline__ void p10_final(const Args& a, int tid, int G) {
    const int lane = tid & 63, wave = tid >> 6; const int gw = blockIdx.x * NWAVES + wave, NGW = G * NWAVES;
    const float* SSF = (const float*)(a.ws + WS_SS) + 3 * 16384; const f32x4* gf = (const f32x4*)a.in[I_GFIN] + lane;
    for (int m = gw; m < MR; m += NGW) { f32x4* row = (f32x4*)(a.out + (size_t)m * 1024) + lane; const float rs = 1.0f / sqrtf(SSF[m] * (1.0f / 1024.0f) + EPS);
#pragma unroll
        for (int j = 0; j < 4; ++j) row[64 * j] = row[64 * j] * rs * gf[64 * j]; }
}

__global__ void __launch_bounds__(NT, 2) fwd_kernel(Args args) {
    extern __shared__ __attribute__((aligned(16))) unsigned char lds[];
    cg::grid_group grid = cg::this_grid();
    const int tid = threadIdx.x, G = gridDim.x, bx = blockIdx.x;
    unsigned char* ws = args.ws;
    PG8_LAS unsigned char* ldsl = (PG8_LAS unsigned char*)lds;
    const int lo = args.ph_lo, hi = args.ph_hi;
#ifndef SKIPMASK
#define SKIPMASK 0
#endif
#define IN(k) (!((SKIPMASK >> (k)) & 1) && lo <= (k) && (k) < hi)
    volatile LAS unsigned* bst = (volatile LAS unsigned*)(ldsl + 155136);
    if (tid < 2) bst[tid] = 0u;
    __syncthreads();
    XcdBarrier xbar = xcd_barrier_post((unsigned*)(ws + WS_BAR), bst);
#define SEAM(k) do { if (IN(k) && IN((k) + 1)) { if ((k) == 0) grid.sync(); else xcd_barrier(xbar); } } while (0)
    float* SS = (float*)(ws + WS_SS);
    if (IN(0)) { const int tid = pg8::fresh_tid(); p0_prologue(args, lds, tid, G); }
    SEAM(0);
    if (IN(1)) {
        pg8::Gemm g{(const bf16*)(ws + WS_XN), (const bf16*)(ws + WS_WIN), MP, NIN, 1024, 1024, 1024, 0, 0}; pg8::StaticOrder S; S.init(MP, NIN, G, bx);
        pg8::EpiInProj E{(bf16*)(ws + WS_MIX), (bf16*)(ws + WS_XBCP), (bf16*)(ws + WS_UA), (bf16*)(ws + WS_UMETA), (float*)(ws + WS_DTRAW)};
        pg8::gemm_phase<pg8::EpiInProj, pg8::StaticOrder, true, true>(ldsl, g, S, E);
    }
    SEAM(1);
    if (IN(2)) {
        const int tid = pg8::fresh_tid(), wave = tid >> 6, lane = tid & 63;
        for (int u = bx; u < NQ * 24; u += G) p2_conv_unit(args, u / 24, u % 24, lds, tid);
        for (int it = (G - 1 - bx) * NWAVES + wave; it < NQ * 16; it += G * NWAVES) p2_dt_item(args, it >> 4, it & 15, lane);
    }
    SEAM(2);
    const int nS3 = (G / 2 < 126) ? G / 2 : 126;
    if (IN(3)) {
        const int tid = pg8::fresh_tid();
        for (int u = bx; u < 252; u += G) { const int qi = u >> 2; p3_states_unit(args, qi < 32 ? qi : qi + 1, (u >> 1) & 1, u & 1, tid); }
        pg8::Gemm g{(const bf16*)(ws + WS_UA), (const bf16*)(ws + WS_TE5), 1024, 256, 256, 384, 256, (size_t)1024 * 384 * 2, (size_t)256 * 256 * 2};
        pg8::BatchOrder S; S.init(256, 4, G, 0, bx);
        pg8::EpiS5a E{(float*)(ws + WS_SEND)};
        pg8::gemm_phase<pg8::EpiS5a, pg8::BatchOrder, true, true>(ldsl, g, S, E);
    }
    SEAM(3);
    if (IN(4)) {
        const int tid = pg8::fresh_tid();
        for (int it = bx; it < 512; it += G) { if (it < 256) p4_s5_scan_item(args, it, lds, tid); else p4_ssd_scan_item(args, it - 256, tid); }
    }
    SEAM(4);
    if (IN(5)) {
        const int tid = pg8::fresh_tid();
#ifndef NO_SSDOUT
        for (int u = bx; u < 256; u += G) p5_ssd_out_unit(args, 1 + (u >> 2), (u >> 1) & 1, u & 1, lds, tid);
        __syncthreads();
#endif
        pg8::Gemm g{(const bf16*)(ws + WS_UA), (const bf16*)(ws + WS_TB5), 1024, 256, 384, 384, 384, (size_t)1024 * 384 * 2, (size_t)256 * 384 * 2};
        pg8::BatchOrder S; S.init(256, 4, G, 0, bx);
        pg8::EpiS5b E{(bf16*)(ws + WS_Y5)};
        pg8::gemm_phase<pg8::EpiS5b, pg8::BatchOrder, true, true>(ldsl, g, S, E);
    }
    SEAM(5);
    if (IN(6)) {
        const int tid = pg8::fresh_tid();
        p6_weights(args, lds, tid, G);
        pg8::Gemm g{(const bf16*)(ws + WS_Y5), (const bf16*)(ws + WS_WGLU), MR, 2048, 1024, 1024, 1024, 0, 0}; pg8::StaticOrder S; S.init(MR, 2048, G, bx);
        pg8::EpiGlu E{(bf16*)(ws + WS_MIX), args.in[I_BGLU], SS + 16384};
        pg8::gemm_phase<pg8::EpiGlu, pg8::StaticOrder, true, true>(ldsl, g, S, E);
    }
    SEAM(6);
    if (IN(7)) {
        pg8::Gemm g{(const bf16*)(ws + WS_MIX), (const bf16*)(ws + WS_WOUT), MR, 1024, 1024, 2048, 2048, 0, 0, (size_t)1024 * 2, (size_t)1024 * 2};
        pg8::SplitKOrder S; S.base.init(MR, 1024, G, bx);
        pg8::EpiOut E{args.in[I_X], args.out, (bf16*)(ws + WS_H1B), SS, SS + 16384, SS + 2 * 16384};
        pg8::gemm_phase<pg8::EpiOut, pg8::SplitKOrder, true, true>(ldsl, g, S, E);
    }
    SEAM(7);
    if (IN(8)) {
        pg8::Gemm g{(const bf16*)(ws + WS_H1B), (const bf16*)(ws + WS_WUP), MR, 4096, 1024, 1024, 1024, 0, 0}; pg8::StaticOrder S; S.init(MR, 4096, G, bx);
        pg8::EpiUp E{(bf16*)(ws + WS_HB), SS + 2 * 16384};
        pg8::gemm_phase<pg8::EpiUp, pg8::StaticOrder, true, true>(ldsl, g, S, E);
    }
    SEAM(8);
    const int fused_fin = (G == 256 && lo <= 9 && hi >= 11) ? 1 : 0;
    if (IN(9)) {
        pg8::Gemm g{(const bf16*)(ws + WS_HB), (const bf16*)(ws + WS_WDN), MR, 1024, 4096, 4096, 4096, 0, 0}; pg8::StaticOrder S; S.init(MR, 1024, G, bx);
        pg8::EpiDown E{args.out, SS + 3 * 16384, (unsigned*)(ws + WS_BAR) + 3584, args.in[I_GFIN], fused_fin, (const bf16*)(ws + WS_H1B)};
        pg8::gemm_phase<pg8::EpiDown, pg8::StaticOrder, true, true>(ldsl, g, S, E);
    }
    if (!fused_fin) {
        SEAM(9);
        if (IN(10)) { const int tid = pg8::fresh_tid(); p10_final(args, tid, G); }
    }
#undef IN
#undef SEAM
}

#ifndef N_LAUNCHES
#define N_LAUNCHES 1
#endif
extern "C" void kernel_launch(void* const* d_in, const int* in_sizes, int n_in, void* d_out, int out_size, void* d_ws, size_t ws_size, hipStream_t stream) {
    static int grid = 0;
    if (grid == 0) {
        int dev = 0, cus = 0, per_cu = 0;
        hipGetDevice(&dev); hipDeviceGetAttribute(&cus, hipDeviceAttributeMultiprocessorCount, dev);
        hipFuncSetAttribute((const void*)fwd_kernel, hipFuncAttributeMaxDynamicSharedMemorySize, LDS_BYTES);
        hipOccupancyMaxActiveBlocksPerMultiprocessor(&per_cu, (const void*)fwd_kernel, NT, LDS_BYTES);
        if (per_cu < 1) { fprintf(stderr, "occupancy query says %d blocks per CU\n", per_cu); per_cu = 1; }
        grid = cus * 1;
        (void)hipGetLastError();
    }
    hipMemsetAsync((char*)d_ws + WS_BAR, 0, 16384, stream);
    Args a{};
    for (int i = 0; i < 26; ++i) a.in[i] = (const float*)d_in[i];
    a.out = (float*)d_out; a.ws = (unsigned char*)d_ws;
    if (N_LAUNCHES == 1) {
        a.ph_lo = 0; a.ph_hi = 11;
        void* args[] = {&a};
        hipError_t e = hipLaunchCooperativeKernel((const void*)fwd_kernel, dim3(grid), dim3(NT), args, LDS_BYTES, stream);
        if (e != hipSuccess) fprintf(stderr, "cooperative launch failed: %s (grid %d)\n", hipGetErrorString(e), grid);
    } else {
        for (int p = 0; p < 11; ++p) { a.ph_lo = p; a.ph_hi = p + 1; hipLaunchKernelGGL(fwd_kernel, dim3(grid), dim3(NT), LDS_BYTES, stream, a); }
    }
}
```

```cpp
#include <hip/hip_runtime.h>
#include <cstdio>
#include <cstdint>
namespace pg8 {
#define PG8_LAS __attribute__((address_space(3)))
typedef unsigned short bf16_t;
typedef short bf16x8 __attribute__((ext_vector_type(8)));
typedef float f32x4 __attribute__((ext_vector_type(4)));
typedef unsigned u32x4 __attribute__((ext_vector_type(4)));
constexpr int BM = 256, BK = 64, HALF = 128, HTB = HALF * BK * 2  , STAGE_BYTES = 8 * HTB, NXCD = 8, WGM = 8;

__host__ __device__ __forceinline__ int lds_byte(int r, int c) { const int st = (r >> 4) * 2 + (c >> 5), rr = r & 15, cc = c & 31, ob = rr * 64 + cc * 2; return st * 1024 + (ob ^ (((ob >> 9) & 1) << 5)); }
__host__ __device__ __forceinline__ void stage_rc(int b, int& R, int& C) { const int st = b / 1024, sb = b % 1024, swz = sb ^ (((sb >> 9) & 1) << 5); R = (st >> 1) * 16 + swz / 64; C = (st & 1) * 32 + (swz % 64) / 2; }
__host__ __device__ __forceinline__ int perm32(int rho) { const int n = rho >> 4, i = rho & 15; return 8 * (i >> 2) + 4 * n + (i & 3); }

struct Unit { int pm, pn, g, par, kh; };
struct Gemm { const bf16_t* A; const bf16_t* Bt; int M, N, K, lda, ldb; size_t gsA, gsB; size_t khA = 0, khB = 0; };

struct StaticOrder {
    int nM, nN, nwg, G, c;
    __host__ __device__ void init(int M, int N, int G_, int c_) { nM = M / BM; nN = N / BM; nwg = nM * nN; G = G_; c = c_; }
    __host__ __device__ bool next(int i, Unit& u) const {
        const long L = (long)i * G + c; if (L >= nwg) return false;
        int wgid = (int)L; { const int q = nwg / NXCD, r = nwg % NXCD, xcd = wgid % NXCD, off = wgid / NXCD; wgid = (xcd < r ? xcd * (q + 1) : r * (q + 1) + (xcd - r) * q) + off; }
        const int nig = WGM * nN, gid = wgid / nig, fm = gid * WGM, gsz = (nM - fm) < WGM ? (nM - fm) : WGM;
        u.pm = fm + ((wgid % nig) % gsz); u.pn = (wgid % nig) / gsz; u.g = 0; u.par = i & 1; u.kh = 0; return true;
    }
    __device__ __forceinline__ void a_ready(const Unit&) const {}
    __device__ __forceinline__ void done(const Unit&) const {}
};

__device__ __forceinline__ unsigned cvt_pk_bf16(float lo, float hi) { unsigned r; asm volatile("v_cvt_pk_bf16_f32 %0, %1, %2" : "=v"(r) : "v"(lo), "v"(hi)); return r; }
typedef float f32x2 __attribute__((ext_vector_type(2)));
__device__ __forceinline__ f32x2 gelu_pk(f32x2 v) {
    const f32x2 av = __builtin_elementwise_abs(v), d = av * 0.2316418882f + 1.0f;
    f32x2 t; t.x = __builtin_amdgcn_rcpf(d.x); t.y = __builtin_amdgcn_rcpf(d.y);
    f32x2 q = t * 0.5307027145f + (-0.7265760135f); q = q * t + 0.7107068705f; q = q * t + (-0.142248368f); q = q * t + 0.127414796f; q = q * t;
    const f32x2 s = (v * v) * (-0.72134752044f);
    f32x2 e; e.x = __builtin_amdgcn_exp2f(s.x); e.y = __builtin_amdgcn_exp2f(s.y);
    const f32x2 m = v * (q * e), r = v - m;
    f32x2 o; o.x = v.x < 0.f ? m.x : r.x; o.y = v.y < 0.f ? m.y : r.y; return o;
}

__device__ __forceinline__ int fresh_tid() { int t; asm volatile("v_mov_b32 %0, %1" : "=v"(t) : "v"((int)threadIdx.x)); return t; }
#define EPI_ROWS_COLS const int rowb = u.pm * BM + wr * 64 + fr; const int colb = wc * 32 + 8 * fq;
__device__ __forceinline__ u32x4 pack8(const f32x4 v0, const f32x4 v1) { u32x4 w; w.x = cvt_pk_bf16(v0[0], v0[1]); w.y = cvt_pk_bf16(v0[2], v0[3]); w.z = cvt_pk_bf16(v1[0], v1[1]); w.w = cvt_pk_bf16(v1[2], v1[3]); return w; }
__device__ __forceinline__ float sum8sq(const f32x4 a, const f32x4 b) { return (a[0] * a[0] + a[1] * a[1]) + (a[2] * a[2] + a[3] * a[3]) + (b[0] * b[0] + b[1] * b[1]) + (b[2] * b[2] + b[3] * b[3]); }

struct EpiInProj {
    static constexpr bool PERM = true, AFTER_DRAIN = false, HAS_MID = false;
    bf16_t* MIX; bf16_t* XBCP; bf16_t* UA; bf16_t* UMETA; float* DTRAW;
    __device__ __forceinline__ void operator()(const f32x4 (&acc)[2][2][4][2], const Unit& u, int wr, int wc, int fr, int fq) const {
        EPI_ROWS_COLS
        const int pn = u.pn;
#pragma unroll
        for (int ai = 0; ai < 2; ++ai)
#pragma unroll
            for (int m = 0; m < 4; ++m) {
                const int r = rowb + ai * HALF + m * 16;
#pragma unroll
                for (int bj = 0; bj < 2; ++bj) {
                    const int c = pn * BM + bj * HALF + colb;
                    const f32x4 v0 = acc[ai][bj][m][0], v1 = acc[ai][bj][m][1];
                    if (pn < 4) { if (r < 16384) *(u32x4*)(MIX + (size_t)r * 2048 + c) = pack8(v0, v1); }
                    else if (pn < 10) { *(u32x4*)(XBCP + (size_t)r * 1536 + (c - 1024)) = pack8(v0, v1); }
                    else if (pn < 14) {
                        const int j = c - 2560, g = j >> 4, h0 = j & 15;
                        if (r < 16384) { const int b = r >> 13, tok = r & 8191, ch = tok >> 4, t = tok & 15;
                            *(u32x4*)(UA + ((size_t)(g * 1024 + b * 512 + ch) * 384 + t * 16 + h0)) = pack8(v0, v1); }
                        else *(u32x4*)(UMETA + (size_t)(r - 16384) * 1024 + j) = pack8(v0, v1);
                    } else {
                        const int j = c - 3584;
                        if (j < 16) { float* d = DTRAW + (size_t)r * 16 + j; *(f32x4*)d = v0; *(f32x4*)(d + 4) = v1; }
                    }
                }
            }
    }
};
struct EpiS5a {
    static constexpr bool PERM = true, AFTER_DRAIN = false, HAS_MID = false;
    float* SEND;
    __device__ __forceinline__ void operator()(const f32x4 (&acc)[2][2][4][2], const Unit& u, int wr, int wc, int fr, int fq) const {
        EPI_ROWS_COLS
#pragma unroll
        for (int ai = 0; ai < 2; ++ai)
#pragma unroll
            for (int m = 0; m < 4; ++m) {
                const int r = rowb + ai * HALF + m * 16;
                float* d = SEND + ((size_t)(u.g * 1024 + r) * 128 + colb);
                *(f32x4*)d = acc[ai][0][m][0]; *(f32x4*)(d + 4) = acc[ai][0][m][1];
            }
    }
};
struct EpiS5b {
    static constexpr bool PERM = true, AFTER_DRAIN = false, HAS_MID = false;
    bf16_t* Y5;
    __device__ __forceinline__ void operator()(const f32x4 (&acc)[2][2][4][2], const Unit& u, int wr, int wc, int fr, int fq) const {
        { const int t2 = fresh_tid(); const int w2 = t2 >> 6, l2 = t2 & 63; wr = w2 >> 2; wc = w2 & 3; fr = l2 & 15; fq = l2 >> 4; }
        const unsigned lane_off = (unsigned)((((u.pm >> 1) * 8192 + (((u.pm & 1) * 256 + wr * 64 + fr) * 16) + (wc * 2 + (fq >> 1))) * 1024 + u.g * 16 + (fq & 1) * 8) * 2);
        char* base = (char*)Y5;
#pragma unroll
        for (int ai = 0; ai < 2; ++ai)
#pragma unroll
            for (int m = 0; m < 4; ++m)
#pragma unroll
                for (int bj = 0; bj < 2; ++bj) {
                    const f32x4 v0 = acc[ai][bj][m][0], v1 = acc[ai][bj][m][1]; u32x4 w;
                    { const f32x2 a = gelu_pk((f32x2){v0[0], v0[1]}); w.x = cvt_pk_bf16(a.x, a.y); } __builtin_amdgcn_sched_barrier(0);
                    { const f32x2 a = gelu_pk((f32x2){v0[2], v0[3]}); w.y = cvt_pk_bf16(a.x, a.y); } __builtin_amdgcn_sched_barrier(0);
                    { const f32x2 a = gelu_pk((f32x2){v1[0], v1[1]}); w.z = cvt_pk_bf16(a.x, a.y); } __builtin_amdgcn_sched_barrier(0);
                    { const f32x2 a = gelu_pk((f32x2){v1[2], v1[3]}); w.w = cvt_pk_bf16(a.x, a.y); } __builtin_amdgcn_sched_barrier(0);
                    const unsigned off = lane_off + (unsigned)(ai * 4194304 + m * 524288 + bj * 16384);
                    *(u32x4*)(base + off) = w;
                }
    }
};
__device__ __forceinline__ float sigm(float x) { return __builtin_amdgcn_rcpf(1.0f + __builtin_amdgcn_exp2f(-1.44269504f * x)); }
struct EpiGlu {
    static constexpr bool PERM = true, AFTER_DRAIN = false, HAS_MID = false;
    bf16_t* MIX; const float* bglu; float* SS5;
    __device__ __forceinline__ void operator()(const f32x4 (&acc)[2][2][4][2], const Unit& u, int wr, int wc, int fr, int fq) const {
        EPI_ROWS_COLS
        const int oc = u.pn * 128 + colb;
        const f32x4 ba0 = *(const f32x4*)(bglu + oc), ba1 = *(const f32x4*)(bglu + oc + 4), bg0 = *(const f32x4*)(bglu + 1024 + oc), bg1 = *(const f32x4*)(bglu + 1024 + oc + 4);
#pragma unroll
        for (int ai = 0; ai < 2; ++ai)
#pragma unroll
            for (int m = 0; m < 4; ++m) {
                const int r = rowb + ai * HALF + m * 16;
                f32x4 a0 = acc[ai][0][m][0] + ba0, a1 = acc[ai][0][m][1] + ba1; const f32x4 g0 = acc[ai][1][m][0] + bg0, g1 = acc[ai][1][m][1] + bg1;
#pragma unroll
                for (int e = 0; e < 4; ++e) { a0[e] *= sigm(g0[e]); a1[e] *= sigm(g1[e]); }
                *(u32x4*)(MIX + (size_t)r * 2048 + 1024 + oc) = pack8(a0, a1);
                float s = sum8sq(a0, a1); s += __shfl_xor(s, 16); s += __shfl_xor(s, 32);
                if (fq == 0) atomicAdd(SS5 + r, s);
            }
    }
};
struct EpiOut {
    static constexpr bool PERM = true, AFTER_DRAIN = false, HAS_MID = true;
    const float* X; float* H1; bf16_t* H1B; const float* SSS; const float* SS5; float* SSM;
    __device__ __forceinline__ void mid(f32x4 (&acc)[2][2][4][2], const Unit& u, int wr, int wc, int fr, int fq) const {
        const int rowb = u.pm * BM + wr * 64 + fr;
#pragma unroll
        for (int ai = 0; ai < 2; ++ai)
#pragma unroll
            for (int m = 0; m < 4; ++m) {
                const int r = rowb + ai * HALF + m * 16;
                const float ratio = sqrtf((SS5[r] * (1.0f / 1024.0f) + 1e-5f) / (SSS[r] * (1.0f / 1024.0f) + 1e-5f));
#pragma unroll
                for (int bj = 0; bj < 2; ++bj)
#pragma unroll
                    for (int n = 0; n < 2; ++n) acc[ai][bj][m][n] *= ratio;
                asm volatile("" ::: "memory");
            }
    }
    __device__ __forceinline__ void operator()(const f32x4 (&acc)[2][2][4][2], const Unit& u, int wr, int wc, int fr, int fq) const {
        EPI_ROWS_COLS
        const unsigned lane_off = (unsigned)(rowb * 1024 + u.pn * BM + colb);
        const char* xb = (const char*)X; char* hb = (char*)H1; char* bb = (char*)H1B;
#pragma unroll
        for (int ai = 0; ai < 2; ++ai)
#pragma unroll
            for (int m = 0; m < 4; ++m) {
                const int r = rowb + ai * HALF + m * 16;
                const float rs = 1.0f / sqrtf(SS5[r] * (1.0f / 1024.0f) + 1e-5f);
                float s = 0.f;
#pragma unroll
                for (int bj = 0; bj < 2; ++bj) {
                    const unsigned off = lane_off + (unsigned)(ai * 131072 + m * 16384 + bj * 128);
                    const f32x4 v0 = *(const f32x4*)(xb + off * 4u) + acc[ai][bj][m][0] * rs, v1 = *(const f32x4*)(xb + off * 4u + 16u) + acc[ai][bj][m][1] * rs;
                    *(u32x4*)(bb + off * 2u) = pack8(v0, v1); s += sum8sq(v0, v1);
                }
                s += __shfl_xor(s, 16); s += __shfl_xor(s, 32);
                if (fq == 0) atomicAdd(SSM + r, s);
                asm volatile("" ::: "memory");
            }
    }
};
struct SplitKOrder {
    StaticOrder base;
    __device__ bool next(int i, Unit& u) const { if (!base.next(i >> 1, u)) return false; u.kh = i & 1; u.par = i & 1; return true; }
    __device__ __forceinline__ void a_ready(const Unit&) const {}
    __device__ __forceinline__ void done(const Unit&) const {}
};
struct EpiUp {
    static constexpr bool PERM = true, AFTER_DRAIN = false, HAS_MID = false;
    bf16_t* HB; const float* SSM;
    __device__ __forceinline__ void operator()(const f32x4 (&acc)[2][2][4][2], const Unit& u, int wr, int wc, int fr, int fq) const {
        EPI_ROWS_COLS
#pragma unroll
        for (int ai = 0; ai < 2; ++ai)
#pragma unroll
            for (int m = 0; m < 4; ++m) {
                const int r = rowb + ai * HALF + m * 16;
                const float rs = 1.0f / sqrtf(SSM[r] * (1.0f / 1024.0f) + 1e-5f);
#pragma unroll
                for (int bj = 0; bj < 2; ++bj) {
                    f32x4 v0 = acc[ai][bj][m][0] * rs, v1 = acc[ai][bj][m][1] * rs;
#pragma unroll
                    for (int e = 0; e < 4; ++e) { const float p = fmaxf(v0[e], 0.f), q = fmaxf(v1[e], 0.f); v0[e] = p * p; v1[e] = q * q; }
                    *(u32x4*)(HB + (size_t)r * 4096 + u.pn * BM + bj * HALF + colb) = pack8(v0, v1);
                }
            }
    }
};
struct EpiDown {
    static constexpr bool PERM = true, AFTER_DRAIN = false, HAS_MID = false;
    float* H; float* SSF; unsigned* pcnt; const float* gfin; int fused; const bf16_t* H1B;
    __device__ __forceinline__ void operator()(const f32x4 (&acc_)[2][2][4][2], const Unit& u, int wr, int wc, int fr, int fq) const {
        f32x4 (&acc)[2][2][4][2] = const_cast<f32x4 (&)[2][2][4][2]>(acc_);
        EPI_ROWS_COLS
        const unsigned lane_off = (unsigned)(rowb * 1024 + u.pn * BM + colb);
        char* hb = (char*)H;
#pragma unroll
        for (int ai = 0; ai < 2; ++ai)
#pragma unroll
            for (int m = 0; m < 4; ++m) {
                const int r = rowb + ai * HALF + m * 16;
                float s = 0.f;
#pragma unroll
                for (int bj = 0; bj < 2; ++bj) {
                    const unsigned off = lane_off + (unsigned)(ai * 131072 + m * 16384 + bj * 128);
                    const u32x4 rw = *(const u32x4*)((const char*)H1B + off * 2u);
                    const f32x4 r0 = (f32x4){__builtin_bit_cast(float, rw.x << 16), __builtin_bit_cast(float, rw.x & 0xffff0000u), __builtin_bit_cast(float, rw.y << 16), __builtin_bit_cast(float, rw.y & 0xffff0000u)};
                    const f32x4 r1 = (f32x4){__builtin_bit_cast(float, rw.z << 16), __builtin_bit_cast(float, rw.z & 0xffff0000u), __builtin_bit_cast(float, rw.w << 16), __builtin_bit_cast(float, rw.w & 0xffff0000u)};
                    const f32x4 v0 = r0 + acc[ai][bj][m][0], v1 = r1 + acc[ai][bj][m][1];
                    if (fused) { acc[ai][bj][m][0] = v0; acc[ai][bj][m][1] = v1; } else { *(f32x4*)(hb + off * 4u) = v0; *(f32x4*)(hb + off * 4u + 16u) = v1; }
                    s += sum8sq(v0, v1);
                }
                s += __shfl_xor(s, 16); s += __shfl_xor(s, 32);
                if (fq == 0) atomicAdd(SSF + r, s);
                asm volatile("" ::: "memory");
            }
        if (!fused) return;
        asm volatile("s_waitcnt vmcnt(0)" ::: "memory");
        unsigned* cw = pcnt + 4 * u.pm;
        if (fr == 0 && fq == 0) __hip_atomic_fetch_add(cw, 1u, __ATOMIC_RELAXED, __HIP_MEMORY_SCOPE_AGENT);
        while (__hip_atomic_load(cw, __ATOMIC_RELAXED, __HIP_MEMORY_SCOPE_AGENT) < 32u) __builtin_amdgcn_s_sleep(4);
        asm volatile("" ::: "memory");
        f32x4 gv[2][2];
#pragma unroll
        for (int bj = 0; bj < 2; ++bj) { gv[bj][0] = *(const f32x4*)(gfin + u.pn * BM + bj * HALF + colb); gv[bj][1] = *(const f32x4*)(gfin + u.pn * BM + bj * HALF + colb + 4); }
#pragma unroll
        for (int ai = 0; ai < 2; ++ai)
#pragma unroll
            for (int m = 0; m < 4; ++m) {
                const int r = rowb + ai * HALF + m * 16;
                const float ssum = __builtin_bit_cast(float, __hip_atomic_load((const unsigned*)(SSF + r), __ATOMIC_RELAXED, __HIP_MEMORY_SCOPE_AGENT));
                const float rs = 1.0f / sqrtf(ssum * (1.0f / 1024.0f) + 1e-5f);
#pragma unroll
                for (int bj = 0; bj < 2; ++bj) {
                    const unsigned off = lane_off + (unsigned)(ai * 131072 + m * 16384 + bj * 128);
                    *(f32x4*)(hb + off * 4u) = acc[ai][bj][m][0] * rs * gv[bj][0]; *(f32x4*)(hb + off * 4u + 16u) = acc[ai][bj][m][1] * rs * gv[bj][1];
                }
            }
    }
};
struct BatchOrder {
    int nU, per_g, Ge, ce;
    __host__ __device__ void init(int nU_, int per_g_, int G, int w0, int c) { nU = nU_; per_g = per_g_; Ge = G - w0; ce = c - w0; }
    __device__ bool next(int i, Unit& u) const {
        if (ce < 0) return false;
        const long L = (long)i * Ge + ce; if (L >= nU) return false;
        u.g = __builtin_amdgcn_readfirstlane((int)L / per_g); u.pm = __builtin_amdgcn_readfirstlane((int)L % per_g); u.pn = 0; u.par = i & 1; u.kh = 0; return true;
    }
    __device__ __forceinline__ void a_ready(const Unit&) const {}
    __device__ __forceinline__ void done(const Unit&) const {}
};
template <class Epi, class Sched, bool ALIGN_EPI = false, bool SP2 = false>
__device__ __forceinline__ void gemm_phase(PG8_LAS unsigned char* lds, const Gemm g, const Sched& S, const Epi& E) {
    const int tid = threadIdx.x, wid = __builtin_amdgcn_readfirstlane(tid >> 6), lane = tid & 63, wr = wid >> 2, wc = wid & 3, fr = lane & 15, fq = lane >> 4;
    const int K = g.K, nt = K / BK;
    unsigned voffA[2], voffB[2];
#pragma unroll
    for (int i = 0; i < 2; ++i) { int R, C; stage_rc(tid * 16 + i * 8192, R, C); const int Rb = Epi::PERM ? ((R & ~31) + perm32(R & 31)) : R;
        voffA[i] = (unsigned)(R * g.lda + C) * 2u; voffB[i] = (unsigned)(Rb * g.ldb + C) * 2u; }
    const size_t kstep = (size_t)(BK * 2);
    const size_t hstepA = (size_t)HALF * g.lda * 2, hstepB = (size_t)HALF * g.ldb * 2;
    const size_t tstepA = 2 * hstepA, tstepB = 2 * hstepB;
    const unsigned ldsw = (unsigned)wid * 1024u;
    const int aoff = lds_byte(wr * 64 + fr, fq * 8), boff = lds_byte(wc * 32 + fr, fq * 8);
#define PG8_SA(b, h) (((b) * 2 + (h)) * HTB)
#define PG8_SB(b, h) ((4 + (b) * 2 + (h)) * HTB)
#define PG8_STAGE(bufoff, gbase, voff) do { _Pragma("unroll") for (int _i = 0; _i < 2; ++_i) \
        __builtin_amdgcn_global_load_lds((const unsigned*)((const char*)(gbase) + (voff)[_i]), (PG8_LAS unsigned*)(lds + (bufoff) + ldsw + _i * 8192), 16, 0, 0); } while (0)
#define PG8_LDA(dst, b, h) do { _Pragma("unroll") for (int m = 0; m < 4; ++m) _Pragma("unroll") for (int k = 0; k < 2; ++k) dst[m][k] = *(const PG8_LAS bf16x8*)(lds + PG8_SA(b, h) + aoff + m * 2048 + k * 1024); } while (0)
#define PG8_LDB(dst, b, h) do { _Pragma("unroll") for (int n = 0; n < 2; ++n) _Pragma("unroll") for (int k = 0; k < 2; ++k) dst[n][k] = *(const PG8_LAS bf16x8*)(lds + PG8_SB(b, h) + boff + n * 2048 + k * 1024); } while (0)
#define PG8_MMA(ai, bj, At, Bt) do { __builtin_amdgcn_s_setprio(1); _Pragma("unroll") for (int m = 0; m < 4; ++m) _Pragma("unroll") for (int n = 0; n < 2; ++n) _Pragma("unroll") for (int k = 0; k < 2; ++k) \
        acc[ai][bj][m][n] = __builtin_amdgcn_mfma_f32_16x16x32_bf16(Bt[n][k], At[m][k], acc[ai][bj][m][n], 0, 0, 0); __builtin_amdgcn_s_setprio(0); } while (0)
#define PG8_WAIT_V(n) asm volatile("s_waitcnt vmcnt(" #n ")" ::: "memory")
#define PG8_WAIT_L(n) asm volatile("s_waitcnt lgkmcnt(" #n ")" ::: "memory")
#define PG8_BAR __builtin_amdgcn_s_barrier()
#define PG8_SCHED __builtin_amdgcn_sched_barrier(0)
    Unit cur, nxt; int ui = 0;
    if (!S.next(0, cur)) return;
    f32x4 acc[2][2][4][2];
#pragma unroll
    for (int a = 0; a < 2; ++a)
#pragma unroll
        for (int b = 0; b < 2; ++b)
#pragma unroll
            for (int m = 0; m < 4; ++m)
#pragma unroll
                for (int n = 0; n < 2; ++n) acc[a][b][m][n] = (f32x4){0.f, 0.f, 0.f, 0.f};
    bf16x8 At[4][2], B0[2][2], B1[2][2];
    const char* cA = (const char*)g.A + (size_t)cur.g * g.gsA + (size_t)cur.pm * tstepA + (size_t)cur.kh * g.khA; const char* cB = (const char*)g.Bt + (size_t)cur.g * g.gsB + (size_t)cur.pn * tstepB + (size_t)cur.kh * g.khB;
    S.a_ready(cur);
    if constexpr (SP2) {
        PG8_STAGE(PG8_SB(0, 0), cB, voffB); PG8_STAGE(PG8_SB(0, 1), cB + hstepB, voffB); PG8_STAGE(PG8_SA(0, 0), cA, voffA); PG8_STAGE(PG8_SA(0, 1), cA + hstepA, voffA);
        if (wr == 1) PG8_BAR;
        PG8_WAIT_V(2); PG8_BAR;
        PG8_STAGE(PG8_SB(1, 0), cB + kstep, voffB); PG8_STAGE(PG8_SA(1, 0), cA + kstep, voffA); PG8_STAGE(PG8_SB(1, 1), cB + hstepB + kstep, voffB);
        PG8_WAIT_V(6); PG8_BAR;
    } else {
        PG8_STAGE(PG8_SB(0, 0), cB, voffB); PG8_STAGE(PG8_SA(0, 0), cA, voffA); PG8_STAGE(PG8_SB(0, 1), cB + hstepB, voffB); PG8_STAGE(PG8_SA(0, 1), cA + hstepA, voffA);
        if (wr == 1) PG8_BAR;
        PG8_WAIT_V(4); PG8_BAR;
        PG8_STAGE(PG8_SB(1, 0), cB + kstep, voffB); PG8_STAGE(PG8_SA(1, 0), cA + kstep, voffA); PG8_STAGE(PG8_SB(1, 1), cB + hstepB + kstep, voffB);
        PG8_WAIT_V(6); PG8_BAR;
    }
    for (;;) {
        const bool has_next = S.next(ui + 1, nxt);
        const char* nA = has_next ? (const char*)g.A + (size_t)nxt.g * g.gsA + (size_t)nxt.pm * tstepA + (size_t)nxt.kh * g.khA : cA; const char* nB = has_next ? (const char*)g.Bt + (size_t)nxt.g * g.gsB + (size_t)nxt.pn * tstepB + (size_t)nxt.kh * g.khB : cB;
        for (int t = 0; t < nt; t += 2) {
            const bool last = (t == nt - 2);
            const char* a1 = cA + (size_t)(t + 1) * kstep;
            const char* a2 = last ? nA : cA + (size_t)(t + 2) * kstep; const char* b2 = last ? nB : cB + (size_t)(t + 2) * kstep;
            const char* a3 = a2 + kstep; const char* b3 = b2 + kstep;
            if (last && has_next) S.a_ready(nxt);
            if constexpr (SP2) {
            PG8_LDB(B0, 0, 0); PG8_LDB(B1, 0, 1); PG8_SCHED; PG8_LDA(At, 0, 0); PG8_STAGE(PG8_SA(1, 1), a1 + hstepA, voffA);
            PG8_WAIT_V(8); PG8_WAIT_L(0); PG8_BAR; PG8_MMA(0, 0, At, B0); PG8_MMA(0, 1, At, B1); PG8_BAR; PG8_SCHED;
            PG8_LDA(At, 0, 1); PG8_STAGE(PG8_SB(0, 0), b2, voffB); PG8_STAGE(PG8_SB(0, 1), b2 + hstepB, voffB); PG8_STAGE(PG8_SA(0, 0), a2, voffA);
            PG8_WAIT_V(8); PG8_WAIT_L(0); PG8_BAR; PG8_MMA(1, 0, At, B0); PG8_MMA(1, 1, At, B1); PG8_BAR; PG8_SCHED;
            PG8_LDB(B0, 1, 0); PG8_LDB(B1, 1, 1); PG8_SCHED; PG8_LDA(At, 1, 0); PG8_STAGE(PG8_SA(0, 1), a2 + hstepA, voffA);
            PG8_WAIT_V(8); PG8_WAIT_L(0); PG8_BAR; PG8_MMA(0, 0, At, B0); PG8_MMA(0, 1, At, B1); PG8_BAR; PG8_SCHED;
            PG8_LDA(At, 1, 1); PG8_STAGE(PG8_SB(1, 0), b3, voffB); PG8_STAGE(PG8_SB(1, 1), b3 + hstepB, voffB); PG8_STAGE(PG8_SA(1, 0), a3, voffA);
            PG8_WAIT_V(8); PG8_WAIT_L(0); PG8_BAR; PG8_MMA(1, 0, At, B0); PG8_MMA(1, 1, At, B1); PG8_BAR; PG8_SCHED;
            } else {
            PG8_LDB(B0, 0, 0); PG8_SCHED; PG8_LDA(At, 0, 0); PG8_STAGE(PG8_SA(1, 1), a1 + hstepA, voffA);
            PG8_WAIT_L(8); PG8_BAR; PG8_WAIT_L(0); PG8_MMA(0, 0, At, B0); PG8_BAR; PG8_SCHED;
            PG8_LDB(B1, 0, 1); PG8_STAGE(PG8_SB(0, 0), b2, voffB);
            PG8_BAR; PG8_WAIT_L(0); PG8_MMA(0, 1, At, B1); PG8_BAR;
            PG8_LDA(At, 0, 1); PG8_STAGE(PG8_SA(0, 0), a2, voffA);
            PG8_BAR; PG8_WAIT_L(0); PG8_MMA(1, 0, At, B0); PG8_BAR; PG8_SCHED;
            PG8_STAGE(PG8_SB(0, 1), b2 + hstepB, voffB);
            PG8_WAIT_V(6); PG8_BAR; PG8_MMA(1, 1, At, B1); PG8_BAR;
            PG8_LDB(B0, 1, 0); PG8_SCHED; PG8_LDA(At, 1, 0); PG8_STAGE(PG8_SA(0, 1), a2 + hstepA, voffA);
            PG8_WAIT_L(8); PG8_BAR; PG8_WAIT_L(0); PG8_MMA(0, 0, At, B0); PG8_BAR; PG8_SCHED;
            PG8_LDB(B1, 1, 1); PG8_STAGE(PG8_SB(1, 0), b3, voffB);
            PG8_BAR; PG8_WAIT_L(0); PG8_MMA(0, 1, At, B1); PG8_BAR;
            PG8_LDA(At, 1, 1); PG8_STAGE(PG8_SA(1, 0), a3, voffA);
            PG8_BAR; PG8_WAIT_L(0); PG8_MMA(1, 0, At, B0); PG8_BAR; PG8_SCHED;
            PG8_STAGE(PG8_SB(1, 1), b3 + hstepB, voffB);
            PG8_WAIT_V(6); PG8_BAR; PG8_MMA(1, 1, At, B1); PG8_BAR;
            }
        }
        if constexpr (ALIGN_EPI) { if (wr == 0) PG8_BAR; }
        bool keep = false;
        if constexpr (Epi::HAS_MID) { if (cur.kh == 0) { E.mid(acc, cur, wr, wc, fr, fq); keep = true; } }
        if (!keep) { if constexpr (!Epi::AFTER_DRAIN) { E(acc, cur, wr, wc, fr, fq); S.done(cur); } }
        if (!has_next) break;
        if (!keep)
#pragma unroll
        for (int a = 0; a < 2; ++a)
#pragma unroll
            for (int b = 0; b < 2; ++b)
#pragma unroll
                for (int m = 0; m < 4; ++m)
#pragma unroll
                    for (int n = 0; n < 2; ++n) acc[a][b][m][n] = (f32x4){0.f, 0.f, 0.f, 0.f};
        cur = nxt; cA = nA; cB = nB; ++ui;
        if constexpr (ALIGN_EPI) { if (wr == 1) PG8_BAR; }
    }
    PG8_WAIT_V(0);
    if constexpr (!ALIGN_EPI) { if (wr == 0) PG8_BAR; }
    PG8_BAR;
    if constexpr (Epi::AFTER_DRAIN) { E.fused(acc, cur, wr, wc, fr, fq, lds, wid, lane); S.done(cur); }
#undef PG8_SA
#undef PG8_SB
#undef PG8_STAGE
#undef PG8_LDA
#undef PG8_LDB
#undef PG8_MMA
#undef PG8_WAIT_V
#undef PG8_WAIT_L
#undef PG8_BAR
#undef PG8_SCHED
}
}

#include <hip/hip_cooperative_groups.h>
namespace cg = cooperative_groups;
typedef unsigned short bf16;
typedef unsigned v4u __attribute__((ext_vector_type(4)));
typedef unsigned v2u __attribute__((ext_vector_type(2)));
typedef float f32x4 __attribute__((ext_vector_type(4)));
typedef float f32x2 __attribute__((ext_vector_type(2)));
typedef short bf16x8 __attribute__((ext_vector_type(8)));

constexpr int NT = 512, NWAVES = 8;
constexpr int MR = 16384, MP = 16640;
constexpr int NIN = 3840;
constexpr int NQ = 65;
constexpr float EPS = 1e-5f;
constexpr size_t MiB = 1u << 20;
constexpr size_t WS_SS    = 0;
constexpr size_t WS_DEC   = 256 * 1024;
constexpr size_t WS_A1    = 288 * 1024;
constexpr size_t WS_A16   = 320 * 1024;
constexpr size_t WS_BAR   = 384 * 1024;
constexpr size_t WS_BBAR  = 512 * 1024;
constexpr size_t WS_UMETA = 1 * MiB;
constexpr size_t WS_DTRAW = 1 * MiB + 512 * 1024;
constexpr size_t WS_DT    = 2 * MiB + 640 * 1024;
constexpr size_t WS_ACS   = 254 * MiB + 512 * 1024;
static_assert(WS_DTRAW + 16640 * 16 * 4 <= WS_DT && WS_DT + 65 * 16 * 256 * 4 <= 4 * MiB && WS_ACS + 65 * 16 * 256 * 4 <= 256 * MiB, "smalls");
constexpr size_t WS_WGLU  = 4 * MiB;
constexpr size_t WS_TB5   = 8 * MiB;
constexpr size_t WS_TE5   = 20 * MiB;
constexpr size_t WS_WIN   = 28 * MiB;
constexpr size_t WS_PREV  = 20 * MiB;
constexpr size_t WS_WOUT  = 8 * MiB, WS_WUP = 12 * MiB, WS_WDN = 20 * MiB;
constexpr size_t WS_MIX   = 36 * MiB;
constexpr size_t WS_UA    = 100 * MiB;
constexpr size_t WS_XBCP  = 148 * MiB;
constexpr size_t WS_SEND  = 148 * MiB;
constexpr size_t WS_ST    = 180 * MiB;
constexpr size_t WS_Y5    = 148 * MiB;
constexpr size_t WS_XN    = 197 * MiB;
constexpr size_t WS_XF    = 197 * MiB;
constexpr size_t WS_H1B   = 197 * MiB;
constexpr size_t WS_CT    = 230 * MiB;
constexpr size_t WS_BTK   = WS_CT + 65 * 65536 * 2;
constexpr size_t WS_BF    = WS_BTK + 65 * 65536 * 2;
constexpr size_t WS_HB    = 36 * MiB;
static_assert(WS_BF + 65 * 65536 * 2 <= WS_ACS, "ws");
constexpr int LDS_BYTES = 155648;

__device__ __forceinline__ unsigned f2bf(float f) { unsigned u = __builtin_bit_cast(unsigned, f); return (u + 0x7fffu + ((u >> 16) & 1u)) >> 16; }
__device__ __forceinline__ unsigned pk2(float lo, float hi) { unsigned r; asm("v_cvt_pk_bf16_f32 %0, %1, %2" : "=v"(r) : "v"(lo), "v"(hi)); return r; }
__device__ __forceinline__ float bf2f(unsigned short h) { return __builtin_bit_cast(float, (unsigned)h << 16); }
__device__ __forceinline__ float bflo(unsigned w) { return __builtin_bit_cast(float, w << 16); }
__device__ __forceinline__ float bfhi(unsigned w) { return __builtin_bit_cast(float, w & 0xffff0000u); }
__device__ __forceinline__ float ex2(float x) { return __builtin_amdgcn_exp2f(x); }
__device__ __forceinline__ float expf_(float x) { return __builtin_amdgcn_exp2f(1.44269504f * x); }
__device__ __forceinline__ float wave_sum(float v) {
#pragma unroll
    for (int o = 1; o < 64; o <<= 1) v += __shfl_xor(v, o);
    return v;
}

#define LAS __attribute__((address_space(3)))
#define XB_TMO      128
#define XB_XCNT(j)  (256  + 64 * (j))
#define XB_XSUB(j)  (1280 + 64 * (j))
#define XB_XGEN(j)  (2304 + 64 * (j))
#define XB_TOP      3328
#define XB_TOPGEN   3392
#define XCD_BAR_WORDS 3456
#define XB_SPIN_CAP (1u << 18)

__device__ __forceinline__ unsigned xb_ld(unsigned* p)              { return __hip_atomic_load(p, __ATOMIC_RELAXED, __HIP_MEMORY_SCOPE_AGENT); }
__device__ __forceinline__ unsigned xb_add(unsigned* p, unsigned v) { return __hip_atomic_fetch_add(p, v, __ATOMIC_RELAXED, __HIP_MEMORY_SCOPE_AGENT); }
__device__ __forceinline__ unsigned xb_xcc_id() { return (unsigned)__builtin_amdgcn_s_getreg((3 << 11) | 20) & 0xFu; }
#define XB_SPIN(cond, bar) do { unsigned _sp = 0; while (cond) { __builtin_amdgcn_s_sleep(1); \
    if ((++_sp & 255u) == 0u) { if (xb_ld(&(bar)[XB_TMO])) break; if (_sp > XB_SPIN_CAP) { atomicAdd(&(bar)[XB_TMO], 1u); break; } } } } while (0)

struct XcdBarrier {
    unsigned* bar; unsigned x;
    volatile LAS unsigned* st;
};

__device__ __forceinline__ XcdBarrier xcd_barrier_post(unsigned* bar, volatile LAS unsigned* st) {
    XcdBarrier b; b.bar = bar; b.x = xb_xcc_id(); b.st = st;
    if (threadIdx.x == 0) (void)xb_add(&bar[XB_XCNT(b.x)], 1u);
    return b;
}
__device__ __forceinline__ void xcd_barrier_complete(unsigned* bar, unsigned x, unsigned& nloc, unsigned& nx) {
    const unsigned G = gridDim.x * gridDim.y * gridDim.z;
    unsigned sum, cnt, mine, sp = 0u;
    for (;;) {
        sum = 0u; cnt = 0u; mine = 0u;
#pragma unroll
        for (unsigned j = 0; j < 16; ++j) { const unsigned c = xb_ld(&bar[XB_XCNT(j)]); sum += c; cnt += (c > 0u) ? 1u : 0u; mine = (j == x) ? c : mine; }
        if (sum == G) break;
        __builtin_amdgcn_s_sleep(1);
        if ((++sp & 255u) == 0u) { if (xb_ld(&bar[XB_TMO])) break; if (sp > XB_SPIN_CAP) { atomicAdd(&bar[XB_TMO], 1u); break; } }
    }
    nloc = mine > 0u ? mine : 1u; nx = cnt > 0u ? cnt : 1u;
}

__device__ __forceinline__ void xcd_barrier(const XcdBarrier& b) {
    asm volatile("s_waitcnt vmcnt(0)" ::: "memory");
    __syncthreads();
    if (threadIdx.x == 0) {
        unsigned* bar = b.bar;
        __builtin_amdgcn_s_waitcnt(0);
        unsigned nloc = b.st[0], nx = b.st[1];
        if (nloc == 0u) { xcd_barrier_complete(bar, b.x, nloc, nx); b.st[0] = nloc; b.st[1] = nx; }
        const unsigned old = xb_add(&bar[XB_XSUB(b.x)], 1u);
        const unsigned gen = old / nloc;
        if (old + 1u == (gen + 1u) * nloc) {
            __builtin_amdgcn_fence(__ATOMIC_RELEASE, "agent");
            asm volatile("s_waitcnt vmcnt(0)" ::: "memory");
            const unsigned og = xb_add(&bar[XB_TOP], 1u);
            const unsigned tg = og / nx;
            if (og + 1u == (tg + 1u) * nx) xb_add(&bar[XB_TOPGEN], 1u);
            else XB_SPIN(xb_ld(&bar[XB_TOPGEN]) == tg, bar);
            __builtin_amdgcn_fence(__ATOMIC_ACQUIRE, "agent");
            xb_add(&bar[XB_XGEN(b.x)], 1u);
            asm volatile("s_waitcnt vmcnt(0)" ::: "memory");
        } else {
            XB_SPIN(xb_ld(&bar[XB_XGEN(b.x)]) == gen, bar);
            __builtin_amdgcn_fence(__ATOMIC_ACQUIRE, "agent");
            asm volatile("s_waitcnt vmcnt(0)" ::: "memory");
        }
    }
    __syncthreads();
}

struct Args {
    const float* in[26]; float* out; unsigned char* ws; int ph_lo, ph_hi;
};
enum { I_X = 0, I_META, I_GMIX, I_WIN, I_CONVW, I_CONVB, I_DTB, I_ALOG, I_DSSD, I_GSSD, I_LRE, I_LIM, I_LSTEP, I_BRE, I_BIM, I_CRE, I_CIM, I_DS5, I_WGLU, I_BGLU, I_GS5, I_WOUT, I_GMLP, I_WUP, I_WDN, I_GFIN };

template <int MODE> __device__ __forceinline__ int colmap(int j) {
    if (MODE == 1) { if (j < 2560) return j; if (j < 3584) return j + 16; if (j < 3600) return j - 1024; return -1; }
    if (MODE == 2) { const int pn = j >> 8, r = j & 255; return r < 128 ? pn * 128 + r : 1024 + pn * 128 + (r - 128); }
    return j;
}
template <int MODE> __device__ __forceinline__ void transpose_item(const float* W, int K, int N, bf16* WT, const float* ks0, const float* ks1, float* scr, int item, int nblk, int lane) {
    const int kb = item / nblk, nb = item % nblk, k0 = 64 * kb, n0 = 32 * nb;
    const int src = colmap<MODE>(n0 + (lane & 31));
#pragma unroll
    for (int i = 0; i < 32; ++i) { const int kk = 2 * i + (lane >> 5); const int k = k0 + kk;
        float v = src >= 0 ? W[(size_t)k * N + src] : 0.f;
        if (ks0) v *= (k < 1024 ? ks0[k] : ks1[k - 1024]);
        scr[kk * 33 + (lane & 31)] = v; }
    asm volatile("s_waitcnt lgkmcnt(0)" ::: "memory");
    const int c = lane & 7;
#pragma unroll
    for (int j = 0; j < 4; ++j) { const int n = (lane >> 3) + 8 * j; const float* s = scr + (8 * c) * 33 + n;
        v4u o; o.x = pk2(s[0 * 33], s[1 * 33]); o.y = pk2(s[2 * 33], s[3 * 33]); o.z = pk2(s[4 * 33], s[5 * 33]); o.w = pk2(s[6 * 33], s[7 * 33]);
        *(v4u*)(WT + (size_t)(n0 + n) * K + k0 + 8 * c) = o; }
    asm volatile("s_waitcnt lgkmcnt(0)" ::: "memory");
}

template <int MODE> __device__ __forceinline__ void wg_transpose_item(const float* W, int K, int N, bf16* WT, const float* ks0, const float* ks1, unsigned char* lds, int k0, int n0, int tid) {
    float* T = (float*)lds;
    const int lane = tid & 63, wave = tid >> 6;
    const int src = colmap<MODE>(n0 + 4 * lane);
    f32x4 v[4];
#pragma unroll
    for (int r = 0; r < 4; ++r) { const int k = k0 + wave * 4 + r;
        v[r] = src >= 0 ? *(const f32x4*)(W + (size_t)k * N + src) : (f32x4){0.f, 0.f, 0.f, 0.f};
        if (ks0) v[r] *= (k < 1024 ? ks0[k] : ks1[k - 1024]); }
#pragma unroll
    for (int r = 0; r < 4; ++r) *(f32x4*)(T + (wave * 4 + r) * 260 + 4 * lane) = v[r];
    __syncthreads();
#pragma unroll
    for (int i = 0; i < 2; ++i) { const int pc = tid + i * NT, nn = pc >> 2, c = pc & 3; const float* t = T + (8 * c) * 260 + nn;
        v4u o; o.x = pk2(t[0 * 260], t[1 * 260]); o.y = pk2(t[2 * 260], t[3 * 260]); o.z = pk2(t[4 * 260], t[5 * 260]); o.w = pk2(t[6 * 260], t[7 * 260]);
        *(v4u*)(WT + (size_t)(n0 + nn) * K + k0 + 8 * c) = o; }
    __syncthreads();
}
__device__ __forceinline__ void sincos_d(double th, float& sn, float& cs) {
    const double k = rint(th * 0.15915494309189535); const double r = fma(-k, 6.283185307179586, th);
    const double t = r * 0.125, t2 = t * t;
    double s = t * (1.0 + t2 * (-1.0 / 6 + t2 * (1.0 / 120 + t2 * (-1.0 / 5040 + t2 * (1.0 / 362880 + t2 * (-1.0 / 39916800))))));
    double c = 1.0 + t2 * (-0.5 + t2 * (1.0 / 24 + t2 * (-1.0 / 720 + t2 * (1.0 / 40320 + t2 * (-1.0 / 3628800 + t2 * (1.0 / 479001600))))));
#pragma unroll
    for (int i = 0; i < 3; ++i) { const double s2 = 2.0 * s * c, c2 = 1.0 - 2.0 * s * s; s = s2; c = c2; }
    sn = (float)s; cs = (float)c;
}

__device__ __forceinline__ void s5_tables(const Args& a, int g, unsigned char* lds, int tid) {
    f32x2* pw = (f32x2*)lds;
    f32x2* Cc = pw + 17 * 64;
    f32x2* Bb = Cc + 16 * 64;
    float* Kt = (float*)(Bb + 64 * 16);
    unsigned char* ws = a.ws;
    if (tid < 64) {
        const int p = tid; const float lr = a.in[I_LRE][g * 64 + p], li = a.in[I_LIM][g * 64 + p]; const float st = expf(a.in[I_LSTEP][g]);
        float are = 1.f, aim = 0.f;
        for (int tau = 0; tau <= 16; ++tau) {
            const float mag = expf(lr * st * (float)tau); float sn, cs; sincos_d((double)li * (double)st * (double)tau, sn, cs);
            pw[tau * 64 + p] = (f32x2){mag * cs, mag * sn};
            if (tau == 1) { are = mag * cs; aim = mag * sn; ((f32x2*)(ws + WS_A1))[g * 64 + p] = (f32x2){are, aim}; }
            if (tau == 16) ((f32x2*)(ws + WS_A16))[g * 64 + p] = (f32x2){mag * cs, mag * sn};
        }
        const float den = lr * lr + li * li;
        const float cre = ((are - 1.0f) * lr + aim * li) / den, cim = (aim * lr - (are - 1.0f) * li) / den;
        f32x4 brv[4], biv[4];
#pragma unroll
        for (int h4 = 0; h4 < 4; ++h4) { brv[h4] = *(const f32x4*)(a.in[I_BRE] + (g * 64 + p) * 16 + 4 * h4); biv[h4] = *(const f32x4*)(a.in[I_BIM] + (g * 64 + p) * 16 + 4 * h4); }
#pragma unroll
        for (int h = 0; h < 16; ++h) { const float br = brv[h >> 2][h & 3], bi = biv[h >> 2][h & 3];
            const f32x2 v = (f32x2){cre * br - cim * bi, cre * bi + cim * br}; Bb[p * 16 + h] = v; ((f32x2*)(ws + WS_BBAR))[(g * 64 + p) * 16 + h] = v; }
    }
    for (int e = tid; e < 1024; e += NT) Cc[e] = (f32x2){a.in[I_CRE][g * 1024 + e], a.in[I_CIM][g * 1024 + e]};
    __syncthreads();
    {
        const int tau = tid >> 5, h = (tid >> 1) & 15, h0 = (tid & 1) * 8; float acc[8];
#pragma unroll
        for (int j = 0; j < 8; ++j) acc[j] = 0.f;
        for (int p = 0; p < 64; ++p) { const f32x2 c = Cc[h * 64 + p], w = pw[tau * 64 + p]; const float tr = c.x * w.x - c.y * w.y, ti = c.x * w.y + c.y * w.x;
#pragma unroll
            for (int j = 0; j < 8; ++j) { const f32x2 b = Bb[p * 16 + h0 + j]; acc[j] += tr * b.x - ti * b.y; } }
        if (tau == 0) {
#pragma unroll
            for (int j = 0; j < 8; ++j) if (h0 + j == h) acc[j] += a.in[I_DS5][g * 16 + h];
        }
#pragma unroll
        for (int j = 0; j < 8; ++j) Kt[(tau * 16 + h) * 16 + h0 + j] = acc[j];
    }
    __syncthreads();
    bf16* TB = (bf16*)(ws + WS_TB5) + (size_t)g * 256 * 384;
    for (int pc = tid; pc < 256 * 48; pc += NT) {
        const int row = pc / 48, c8 = (pc % 48) * 8, t = row >> 4, h = row & 15; float v[8];
        if (c8 < 256) { const int s = c8 >> 4, h0 = c8 & 15;
#pragma unroll
            for (int j = 0; j < 8; ++j) v[j] = s <= t ? Kt[((t - s) * 16 + h) * 16 + h0 + j] : 0.f;
        } else { const int p0 = (c8 - 256) >> 1;
#pragma unroll
            for (int j = 0; j < 4; ++j) { const f32x2 c = Cc[h * 64 + p0 + j], w = pw[(t + 1) * 64 + p0 + j]; v[2 * j] = c.x * w.x - c.y * w.y; v[2 * j + 1] = -(c.x * w.y + c.y * w.x); }
        }
        v4u o; o.x = pk2(v[0], v[1]); o.y = pk2(v[2], v[3]); o.z = pk2(v[4], v[5]); o.w = pk2(v[6], v[7]);
        *(v4u*)(TB + (size_t)row * 384 + c8) = o;
    }
    bf16* TE = (bf16*)(ws + WS_TE5) + (size_t)g * 256 * 256;
    for (int pc = tid; pc < 256 * 32; pc += NT) {
        const int row = pc >> 5, c8 = (pc & 31) * 8; float v[8];
        if (row < 128) { const int p = row >> 1, ri = row & 1, s = c8 >> 4, h0 = c8 & 15; const f32x2 w = pw[(15 - s) * 64 + p];
#pragma unroll
            for (int j = 0; j < 8; ++j) { const f32x2 b = Bb[p * 16 + h0 + j]; v[j] = ri ? (w.x * b.y + w.y * b.x) : (w.x * b.x - w.y * b.y); }
        } else {
#pragma unroll
            for (int j = 0; j < 8; ++j) v[j] = 0.f;
        }
        v4u o; o.x = pk2(v[0], v[1]); o.y = pk2(v[2], v[3]); o.z = pk2(v[4], v[5]); o.w = pk2(v[6], v[7]);
        *(v4u*)(TE + (size_t)row * 256 + c8) = o;
    }
    __syncthreads();
}

__device__ __forceinline__ void rms_row_to_bf16(const float* xrow, const float* gain, bf16* orow, int lane) {
    unsigned long long* o8 = (unsigned long long*)orow + lane;
    if (!xrow) {
#pragma unroll
        for (int j = 0; j < 4; ++j) o8[64 * j] = 0ull;
        return; }
    const f32x4* xr = (const f32x4*)xrow + lane; const f32x4* gr = (const f32x4*)gain + lane;
    f32x4 v[4]; float s = 0.f;
#pragma unroll
    for (int j = 0; j < 4; ++j) { v[j] = xr[64 * j]; s += (v[j].x * v[j].x + v[j].y * v[j].y) + (v[j].z * v[j].z + v[j].w * v[j].w); }
    const float rstd = 1.f / sqrtf(wave_sum(s) * (1.f / 1024.f) + EPS);
#pragma unroll
    for (int j = 0; j < 4; ++j) { const f32x4 gg = gr[64 * j]; const f32x4 w = v[j] * rstd * gg; o8[64 * j] = (unsigned long long)pk2(w.x, w.y) | ((unsigned long long)pk2(w.z, w.w) << 32); }
}

__device__ __forceinline__ void p0_prologue(const Args& a, unsigned char* lds, int tid, int G) {
    unsigned char* ws = a.ws; const int lane = tid & 63, wave = tid >> 6;
    const int gw = blockIdx.x * NWAVES + wave, NGW = G * NWAVES;
    for (int i = blockIdx.x * NT + tid; i < 4 * 16384; i += G * NT) ((float*)(ws + WS_SS))[i] = 0.f;
    for (int g = (G - 1 - (int)blockIdx.x); g < 64; g += G) s5_tables(a, g, lds, tid);
    __syncthreads();
    float* scr = (float*)(lds + wave * 16384);
    constexpr int NB_IN = NIN / 32, NB_GL = 2048 / 32;
    constexpr int I_IN = 16 * NB_IN, I_GL = 16 * NB_GL;
    for (int it = blockIdx.x; it < 480 + 256; it += G) {
        if (it < 480) wg_transpose_item<1>(a.in[I_WIN], 1024, 3600, (bf16*)(ws + WS_WIN), nullptr, nullptr, lds, (it / 15) * 32, (it % 15) * 256, tid);
        else { const int j = it - 480; wg_transpose_item<2>(a.in[I_WGLU], 1024, 2048, (bf16*)(ws + WS_WGLU), nullptr, nullptr, lds, (j >> 3) * 32, (j & 7) * 256, tid); }
    }
    for (int m0 = gw; m0 < MR; m0 += 8 * NGW) {
        const f32x4* gr = (const f32x4*)a.in[I_GMIX] + lane; f32x4 v[8][4];
#pragma unroll
        for (int k = 0; k < 8; ++k) { const int m = m0 + k * NGW; const f32x4* xr = (const f32x4*)(a.in[I_X] + (size_t)(m < MR ? m : m0) * 1024) + lane;
#pragma unroll
            for (int j = 0; j < 4; ++j) v[k][j] = xr[64 * j]; }
        f32x4 gg[4];
#pragma unroll
        for (int j = 0; j < 4; ++j) gg[j] = gr[64 * j];
#pragma unroll
        for (int k = 0; k < 8; ++k) { const int m = m0 + k * NGW; float sq = 0.f;
#pragma unroll
            for (int j = 0; j < 4; ++j) sq += (v[k][j].x * v[k][j].x + v[k][j].y * v[k][j].y) + (v[k][j].z * v[k][j].z + v[k][j].w * v[k][j].w);
            const float rstd = 1.f / sqrtf(wave_sum(sq) * (1.f / 1024.f) + EPS);
            if (m < MR) { unsigned long long* o8 = (unsigned long long*)((bf16*)(ws + WS_XN) + (size_t)m * 1024) + lane;
#pragma unroll
                for (int j = 0; j < 4; ++j) { const f32x4 w = v[k][j] * rstd * gg[j]; o8[64 * j] = (unsigned long long)pk2(w.x, w.y) | ((unsigned long long)pk2(w.z, w.w) << 32); } }
        }
    }
    for (int m = MR + gw; m < MP; m += NGW)
        rms_row_to_bf16(m < MR + 16 ? a.in[I_META] + (size_t)(m - MR) * 1024 : nullptr, a.in[I_GMIX], (bf16*)(ws + WS_XN) + (size_t)m * 1024, lane);
}
__device__ __forceinline__ void p6_weights(const Args& a, unsigned char* lds, int tid, int G) {
    unsigned char* ws = a.ws; const int lane = tid & 63, wave = tid >> 6;
    const int gw = blockIdx.x * NWAVES + wave, NGW = G * NWAVES;
    float* scr = (float*)(lds + wave * 16384);
    for (int it = blockIdx.x; it < 1280; it += G) {
        if (it < 256) wg_transpose_item<0>(a.in[I_WOUT], 2048, 1024, (bf16*)(ws + WS_WOUT), a.in[I_GSSD], a.in[I_GS5], lds, (it >> 2) * 32, (it & 3) * 256, tid);
        else if (it < 768) { const int j = it - 256; wg_transpose_item<0>(a.in[I_WUP], 1024, 4096, (bf16*)(ws + WS_WUP), a.in[I_GMLP], a.in[I_GMLP], lds, (j >> 4) * 32, (j & 15) * 256, tid); }
        else { const int j = it - 768; wg_transpose_item<0>(a.in[I_WDN], 4096, 1024, (bf16*)(ws + WS_WDN), nullptr, nullptr, lds, (j >> 2) * 32, (j & 3) * 256, tid); }
    }
    __syncthreads();
}

__device__ __forceinline__ int chunk_row(int q, int tok) {
    if (q == 0) return tok < 240 ? -1 : MR + (tok - 240);
    const int b = (q - 1) >> 5, c = (q - 1) & 31;
    if (tok < 0 && c == 0) return MR + 16 + tok;
    return b * 8192 + c * 256 + tok;
}
__device__ __forceinline__ float silu_(float x) { return x * __builtin_amdgcn_rcpf(1.0f + ex2(-1.44269504f * x)); }
__device__ __forceinline__ void p2_conv_unit(const Args& a, int q, int blk, unsigned char* lds, int tid) {
    unsigned char* ws = a.ws;
    bf16* IN = (bf16*)lds;
    bf16* OT = (bf16*)(lds + 40960);
    const bf16* XBCP = (const bf16*)(ws + WS_XBCP);
    const int ch0 = blk * 64;
    for (int pc = tid; pc < 259 * 8; pc += NT) { const int rr = pc >> 3, c8 = (pc & 7) * 8; const int row = chunk_row(q, rr - 3);
        v4u v = (v4u){0u, 0u, 0u, 0u}; if (row >= 0) v = *(const v4u*)(XBCP + (size_t)row * 1536 + ch0 + c8);
        *(v4u*)(IN + rr * 64 + c8) = v; }
    __syncthreads();
    const float* cw = a.in[I_CONVW]; const float* cb = a.in[I_CONVB];
    const bool is_x = blk < 16, is_b = blk >= 16 && blk < 20;
    if (!is_x) {
        bf16* dst = (bf16*)(ws + (is_b ? WS_BTK : WS_CT)) + (size_t)q * 65536 + (is_b ? (blk - 16) : (blk - 20)) * 64;
        const int c8 = (tid & 7) * 8; float wreg[4][8], breg[8];
#pragma unroll
        for (int j = 0; j < 8; ++j) { breg[j] = cb[ch0 + c8 + j];
#pragma unroll
            for (int k = 0; k < 4; ++k) wreg[k][j] = cw[k * 1536 + ch0 + c8 + j]; }
        for (int pc = tid; pc < 256 * 8; pc += NT) { const int tok = pc >> 3; float o[8];
            const bool zero = (q == 0 && tok < 240);
#pragma unroll
            for (int j = 0; j < 8; ++j) o[j] = breg[j];
#pragma unroll
            for (int k = 0; k < 4; ++k) { const v4u v = *(const v4u*)(IN + (tok + k) * 64 + c8); const unsigned w[4] = {v.x, v.y, v.z, v.w};
#pragma unroll
                for (int j = 0; j < 4; ++j) { o[2 * j] += wreg[k][2 * j] * bflo(w[j]); o[2 * j + 1] += wreg[k][2 * j + 1] * bfhi(w[j]); } }
#pragma unroll
            for (int j = 0; j < 8; ++j) o[j] = zero ? 0.f : silu_(o[j]);
            v4u ov; ov.x = pk2(o[0], o[1]); ov.y = pk2(o[2], o[3]); ov.z = pk2(o[4], o[5]); ov.w = pk2(o[6], o[7]);
            *(v4u*)(dst + (size_t)tok * 256 + c8) = ov; }
    }
    if (is_x || is_b) {
        const int ch = tid & 63; float wk[4]; const float bias = cb[ch0 + ch];
#pragma unroll
        for (int k = 0; k < 4; ++k) wk[k] = cw[k * 1536 + ch0 + ch];
        for (int it = tid; it < 64 * 32; it += NT) { const int t0 = (it >> 6) * 8; float in[11], o[8];
#pragma unroll
            for (int j = 0; j < 11; ++j) in[j] = bf2f(IN[(t0 + j) * 64 + ch]);
#pragma unroll
            for (int j = 0; j < 8; ++j) { const float v = bias + wk[0] * in[j] + wk[1] * in[j + 1] + wk[2] * in[j + 2] + wk[3] * in[j + 3]; o[j] = (q == 0 && t0 + j < 240) ? 0.f : silu_(v); }
            v4u ov; ov.x = pk2(o[0], o[1]); ov.y = pk2(o[2], o[3]); ov.z = pk2(o[4], o[5]); ov.w = pk2(o[6], o[7]);
            *(v4u*)(OT + ch * 264 + t0) = ov; }
        __syncthreads();
        bf16* dst = is_x ? (bf16*)(ws + WS_XF) + ((size_t)q * 1024 + ch0) * 256 : (bf16*)(ws + WS_BF) + ((size_t)q * 256 + (blk - 16) * 64) * 256;
        for (int pc = tid; pc < 64 * 32; pc += NT) { const int ch = pc >> 5, t8 = (pc & 31) * 8; *(v4u*)(dst + (size_t)ch * 256 + t8) = *(const v4u*)(OT + ch * 264 + t8); }
    }
    __syncthreads();
}
__device__ __forceinline__ void p2_dt_item(const Args& a, int q, int h, int lane) {
    unsigned char* ws = a.ws; const float* DTRAW = (const float*)(ws + WS_DTRAW);
    const float bias = a.in[I_DTB][h], A = -expf(a.in[I_ALOG][h]);
    float dt[4], cs[4]; float run = 0.f;
    int rows[4]; float raw[4];
#pragma unroll
    for (int j = 0; j < 4; ++j) { rows[j] = chunk_row(q, 4 * lane + j); raw[j] = DTRAW[(size_t)(rows[j] < 0 ? 0 : rows[j]) * 16 + h]; }
#pragma unroll
    for (int j = 0; j < 4; ++j) { const float x = raw[j] + bias; float d = fmaxf(x, 0.f) + __logf(1.0f + expf_(-fabsf(x))); if (rows[j] < 0) d = 0.f;
        dt[j] = d; run += d * A; cs[j] = run; }
    float incl = run;
#pragma unroll
    for (int o = 1; o < 64; o <<= 1) { const float t = __shfl_up(incl, o); if (lane >= o) incl += t; }
    const float excl = incl - run;
    float* DT = (float*)(ws + WS_DT) + ((size_t)q * 16 + h) * 256 + 4 * lane; float* ACS = (float*)(ws + WS_ACS) + ((size_t)q * 16 + h) * 256 + 4 * lane;
    *(f32x4*)DT = (f32x4){dt[0], dt[1], dt[2], dt[3]}; *(f32x4*)ACS = (f32x4){cs[0] + excl, cs[1] + excl, cs[2] + excl, cs[3] + excl};
    if (lane == 63) ((float*)(ws + WS_DEC))[q * 16 + h] = expf_(cs[3] + excl);
}

#define MFMA16(A, B, C) __builtin_amdgcn_mfma_f32_16x16x32_bf16(A, B, C, 0, 0, 0)
__device__ __forceinline__ void p3_states_unit(const Args& a, int q, int g, int nh, int tid) {
    unsigned char* ws = a.ws; const int lane = tid & 63, r = tid >> 6, h = g * 8 + r, fr = lane & 15, fq = lane >> 4;
    const bf16* XF = (const bf16*)(ws + WS_XF) + ((size_t)q * 1024 + h * 64) * 256;
    const bf16* BF = (const bf16*)(ws + WS_BF) + ((size_t)q * 256 + g * 128) * 256;
    const float* DT = (const float*)(ws + WS_DT) + ((size_t)q * 16 + h) * 256; const float* ACS = (const float*)(ws + WS_ACS) + ((size_t)q * 16 + h) * 256;
    const float alast = ACS[255];
    bf16* ST = (bf16*)(ws + WS_ST) + ((size_t)q * 16 + h) * 8192;
    {
        f32x4 acc[4][4];
#pragma unroll
        for (int i = 0; i < 4; ++i)
#pragma unroll
            for (int j = 0; j < 4; ++j) acc[i][j] = (f32x4){0.f, 0.f, 0.f, 0.f};
#pragma unroll 2
        for (int kb = 0; kb < 8; ++kb) {
            const int s0 = kb * 32 + fq * 8;
            float w[8];
            { const f32x4 d0 = *(const f32x4*)(DT + s0), d1 = *(const f32x4*)(DT + s0 + 4), c0 = *(const f32x4*)(ACS + s0), c1 = *(const f32x4*)(ACS + s0 + 4);
#pragma unroll
              for (int j = 0; j < 4; ++j) { w[j] = expf_(alast - c0[j]) * d0[j]; w[4 + j] = expf_(alast - c1[j]) * d1[j]; } }
            bf16x8 Af[4], Bf[4];
#pragma unroll
            for (int i = 0; i < 4; ++i) { const v4u v = *(const v4u*)(XF + (size_t)(i * 16 + fr) * 256 + s0);
                v4u o; o.x = pk2(bflo(v.x) * w[0], bfhi(v.x) * w[1]); o.y = pk2(bflo(v.y) * w[2], bfhi(v.y) * w[3]); o.z = pk2(bflo(v.z) * w[4], bfhi(v.z) * w[5]); o.w = pk2(bflo(v.w) * w[6], bfhi(v.w) * w[7]);
                Af[i] = __builtin_bit_cast(bf16x8, o); }
#pragma unroll
            for (int j = 0; j < 4; ++j) Bf[j] = *(const bf16x8*)(BF + (size_t)((nh * 4 + j) * 16 + fr) * 256 + s0);
#pragma unroll
            for (int i = 0; i < 4; ++i)
#pragma unroll
                for (int j = 0; j < 4; ++j) acc[i][j] = MFMA16(Bf[j], Af[i], acc[i][j]);
        }
#pragma unroll
        for (int i = 0; i < 4; ++i)
#pragma unroll
            for (int j = 0; j < 4; ++j) { v2u o; o.x = pk2(acc[i][j][0], acc[i][j][1]); o.y = pk2(acc[i][j][2], acc[i][j][3]);
                *(v2u*)(ST + (i * 16 + fr) * 128 + (nh * 4 + j) * 16 + fq * 4) = o; }
    }
}

__device__ __forceinline__ void p4_ssd_scan_item(const Args& a, int item, int tid) {
    unsigned char* ws = a.ws; const int e = item * 1024 + tid * 2;
    const int b = e >> 17, hpn = e & 131071, h = hpn >> 13;
    const bf16* ST = (const bf16*)(ws + WS_ST); bf16* PREV = (bf16*)(ws + WS_PREV); const float* DEC = (const float*)(ws + WS_DEC);
    unsigned st[32]; float dec[32];
    st[0] = *(const unsigned*)(ST + hpn); dec[0] = 0.f;
#pragma unroll
    for (int k = 1; k < 32; ++k) { const int q = b * 32 + k; st[k] = *(const unsigned*)(ST + (size_t)q * 131072 + hpn); dec[k] = DEC[q * 16 + h]; }
    float s0 = bflo(st[0]), s1 = bfhi(st[0]);
#pragma unroll
    for (int c = 0; c < 32; ++c) {
        *(unsigned*)(PREV + (size_t)(b * 32 + c) * 131072 + hpn) = pk2(s0, s1);
        if (c < 31) { const float d = dec[c + 1]; const unsigned v = st[c + 1]; s0 = s0 * d + bflo(v); s1 = s1 * d + bfhi(v); }
    }
}
__device__ __forceinline__ void p4_s5_scan_item(const Args& a, int item, unsigned char* lds, int tid) {
    unsigned char* ws = a.ws; const int b = item >> 7, g = (item >> 1) & 63, p = (item & 1) * 32 + (tid & 31), seg = tid >> 5;
    const f32x2 a1 = ((const f32x2*)(ws + WS_A1))[g * 64 + p], a16 = ((const f32x2*)(ws + WS_A16))[g * 64 + p];
    const f32x2* Bb = (const f32x2*)(ws + WS_BBAR) + (size_t)(g * 64 + p) * 16;
    const bf16* UM = (const bf16*)(ws + WS_UMETA);
    const f32x2* SE = (const f32x2*)(ws + WS_SEND) + ((size_t)(g * 1024 + b * 512 + seg * 32) * 64 + p);
    f32x2 se[32];
#pragma unroll
    for (int j = 0; j < 32; ++j) se[j] = SE[(size_t)j * 64];
    float sr = 0.f, si = 0.f;
    f32x2 bbv[16];
#pragma unroll
    for (int h = 0; h < 16; ++h) bbv[h] = Bb[h];
    for (int s = 0; s < 16; ++s) { float br = 0.f, bi = 0.f;
        const v4u u0 = *(const v4u*)(UM + s * 1024 + g * 16), u1 = *(const v4u*)(UM + s * 1024 + g * 16 + 8); const unsigned uw[8] = {u0.x, u0.y, u0.z, u0.w, u1.x, u1.y, u1.z, u1.w};
#pragma unroll
        for (int h = 0; h < 16; ++h) { const float u = (h & 1) ? bfhi(uw[h >> 1]) : bflo(uw[h >> 1]); const f32x2 bb = bbv[h]; br += bb.x * u; bi += bb.y * u; }
        const float nr = a1.x * sr - a1.y * si + br, ni = a1.x * si + a1.y * sr + bi; sr = nr; si = ni; }
    float er = 0.f, ei = 0.f;
#pragma unroll
    for (int j = 0; j < 32; ++j) { const float nr = a16.x * er - a16.y * ei + se[j].x, ni = a16.x * ei + a16.y * er + se[j].y; er = nr; ei = ni; }
    f32x2* EL = (f32x2*)lds;
    EL[seg * 32 + (tid & 31)] = (f32x2){er, ei};
    float pr = a16.x, pi = a16.y;
#pragma unroll
    for (int k = 0; k < 5; ++k) { const float nr = pr * pr - pi * pi, ni = 2.f * pr * pi; pr = nr; pi = ni; }
    __syncthreads();
    for (int k = 0; k < seg; ++k) { const f32x2 ek = EL[k * 32 + (tid & 31)]; const float nr = pr * sr - pi * si + ek.x, ni = pr * si + pi * sr + ek.y; sr = nr; si = ni; }
    unsigned* UA = (unsigned*)((bf16*)(ws + WS_UA) + ((size_t)(g * 1024 + b * 512 + seg * 32) * 384 + 256 + 2 * p));
#pragma unroll
    for (int j = 0; j < 32; ++j) { UA[(size_t)j * 192] = pk2(sr, si);
        const float nr = a16.x * sr - a16.y * si + se[j].x, ni = a16.x * si + a16.y * sr + se[j].y; sr = nr; si = ni; }
    __syncthreads();
}

__device__ __forceinline__ void p5_ssd_out_unit(const Args& a, int q, int g, int half, unsigned char* lds, int tid) {
    unsigned char* ws = a.ws; const int lane = tid & 63, r = tid >> 6, h = g * 8 + r, fr = lane & 15, fq = lane >> 4;
    bf16* CBs = (bf16*)lds;
    float* ACSs = (float*)(lds + 256 * 264 * 2);
    float* DTs = ACSs + 8 * 256;
    const bf16* CT = (const bf16*)(ws + WS_CT) + (size_t)q * 65536 + g * 128;
    const bf16* BTK = (const bf16*)(ws + WS_BTK) + (size_t)q * 65536 + g * 128;
    for (int i = tid; i < 2048; i += NT) { ACSs[i] = ((const float*)(ws + WS_ACS))[((size_t)q * 16 + g * 8) * 256 + i]; DTs[i] = ((const float*)(ws + WS_DT))[((size_t)q * 16 + g * 8) * 256 + i]; }
    {
        int cnt = 0;
#pragma unroll 1
        for (int ti = 0; ti < 8; ++ti) {
            const int lt = half ? 4 + ti : (ti < 4 ? ti : 8 + ti);
#pragma unroll 1
            for (int stl = 0; stl <= lt; ++stl, ++cnt) {
                if ((cnt & 7) != r) continue;
                f32x4 c = (f32x4){0.f, 0.f, 0.f, 0.f};
#pragma unroll
                for (int k = 0; k < 4; ++k) { const bf16x8 Af = *(const bf16x8*)(CT + (size_t)(lt * 16 + fr) * 256 + k * 32 + fq * 8);
                    const bf16x8 Bf = *(const bf16x8*)(BTK + (size_t)(stl * 16 + fr) * 256 + k * 32 + fq * 8); c = MFMA16(Af, Bf, c); }
#pragma unroll
                for (int e = 0; e < 4; ++e) CBs[(lt * 16 + fq * 4 + e) * 264 + stl * 16 + fr] = (bf16)f2bf(c[e]);
            }
        }
    }
    __syncthreads();
    const bf16* XF = (const bf16*)(ws + WS_XF) + ((size_t)q * 1024 + h * 64) * 256;
    const bf16* PREV = (const bf16*)(ws + WS_PREV) + ((size_t)(q - 1) * 16 + h) * 8192;
    const float* acs = ACSs + r * 256; const float* dts = DTs + r * 256;
    const float dsk = a.in[I_DSSD][h];
    const int b = (q - 1) >> 5, c = (q - 1) & 31; const int m0 = b * 8192 + c * 256;
    bf16* MIX = (bf16*)(ws + WS_MIX); float* SSS = (float*)(ws + WS_SS);
#pragma unroll 1
    for (int lbi = 0; lbi < 2; ++lbi) {
        const int lb = half ? 1 + lbi : 3 * lbi;
        f32x4 acc[4][4];
#pragma unroll
        for (int i = 0; i < 4; ++i)
#pragma unroll
            for (int j = 0; j < 4; ++j) acc[i][j] = (f32x4){0.f, 0.f, 0.f, 0.f};
#pragma unroll 2
        for (int k = 0; k < 4; ++k) { bf16x8 Af[4], Bf[4];
#pragma unroll
            for (int i = 0; i < 4; ++i) Af[i] = *(const bf16x8*)(CT + (size_t)(lb * 64 + i * 16 + fr) * 256 + k * 32 + fq * 8);
#pragma unroll
            for (int j = 0; j < 4; ++j) Bf[j] = *(const bf16x8*)(PREV + (size_t)(j * 16 + fr) * 128 + k * 32 + fq * 8);
#pragma unroll
            for (int i = 0; i < 4; ++i)
#pragma unroll
                for (int j = 0; j < 4; ++j) acc[i][j] = MFMA16(Bf[j], Af[i], acc[i][j]); }
#pragma unroll
        for (int i = 0; i < 4; ++i) { const float sc = expf_(acs[lb * 64 + i * 16 + fr]);
#pragma unroll
            for (int j = 0; j < 4; ++j) acc[i][j] *= sc; }
        const int nsb = 2 * lb + 2;
#pragma unroll 1
        for (int sb = 0; sb < nsb; ++sb) {
            const int s0 = sb * 32 + fq * 8;
            bf16x8 Bf[4];
#pragma unroll
            for (int j = 0; j < 4; ++j) Bf[j] = *(const bf16x8*)(XF + (size_t)(j * 16 + fr) * 256 + s0);
            float as[8], ds[8];
#pragma unroll
            for (int j = 0; j < 8; ++j) { as[j] = acs[s0 + j]; ds[j] = dts[s0 + j]; }
            float fs[8];
#pragma unroll
            for (int j = 0; j < 8; ++j) fs[j] = expf_(as[7] - as[j]) * ds[j];
#pragma unroll
            for (int i = 0; i < 4; ++i) {
                const int l = lb * 64 + i * 16 + fr;
                if (sb * 32 > lb * 64 + i * 16 + 15) continue;
                const float al = acs[l];
                const v4u v = *(const v4u*)(CBs + l * 264 + s0); const unsigned w4[4] = {v.x, v.y, v.z, v.w}; float pv[8];
                if (sb * 32 + 31 < lb * 64 + i * 16) {
                    const float gl = expf_(al - as[7]);
#pragma unroll
                    for (int j = 0; j < 4; ++j) { pv[2 * j] = bflo(w4[j]) * (gl * fs[2 * j]); pv[2 * j + 1] = bfhi(w4[j]) * (gl * fs[2 * j + 1]); }
                } else
#pragma unroll
                for (int j = 0; j < 4; ++j) {
                    const float p0 = bflo(w4[j]) * expf_(fminf(al - as[2 * j], 0.f)) * ds[2 * j], p1 = bfhi(w4[j]) * expf_(fminf(al - as[2 * j + 1], 0.f)) * ds[2 * j + 1];
                    const int sa = s0 + 2 * j, sbq = sa + 1;
                    pv[2 * j] = (sa < l) ? p0 : (sa == l ? p0 + dsk : 0.f); pv[2 * j + 1] = (sbq < l) ? p1 : (sbq == l ? p1 + dsk : 0.f); }
                v4u o; o.x = pk2(pv[0], pv[1]); o.y = pk2(pv[2], pv[3]); o.z = pk2(pv[4], pv[5]); o.w = pk2(pv[6], pv[7]);
                const bf16x8 Af = __builtin_bit_cast(bf16x8, o);
#pragma unroll
                for (int j = 0; j < 4; ++j) acc[i][j] = MFMA16(Bf[j], Af, acc[i][j]);
            }
        }
#pragma unroll
        for (int i = 0; i < 4; ++i) {
            const int l = lb * 64 + i * 16 + fr; float ssq = 0.f;
            bf16* zrow = MIX + (size_t)(m0 + l) * 2048 + h * 64 + fq * 4;
#pragma unroll
            for (int j = 0; j < 4; ++j) {
                const v2u zv = *(const v2u*)(zrow + j * 16);
                const float y0 = acc[i][j][0] * silu_(bflo(zv.x)), y1 = acc[i][j][1] * silu_(bfhi(zv.x)), y2 = acc[i][j][2] * silu_(bflo(zv.y)), y3 = acc[i][j][3] * silu_(bfhi(zv.y));
                v2u o; o.x = pk2(y0, y1); o.y = pk2(y2, y3); *(v2u*)(zrow + j * 16) = o;
                ssq += (y0 * y0 + y1 * y1) + (y2 * y2 + y3 * y3);
            }
            ssq += __shfl_xor(ssq, 16); ssq += __shfl_xor(ssq, 32);
            if (fq == 0) atomicAdd(SSS + m0 + l, ssq);
        }
    }
    __syncthreads();
}

__device__ __forceinline__ void p10_final(const Args& a, int tid, int G) {
    const int lane = tid & 63, wave = tid >> 6; const int gw = blockIdx.x * NWAVES + wave, NGW = G * NWAVES;
    const float* SSF = (const float*)(a.ws + WS_SS) + 3 * 16384; const f32x4* gf = (const f32x4*)a.in[I_GFIN] + lane;
    for (int m = gw; m < MR; m += NGW) { f32x4* row = (f32x4*)(a.out + (size_t)m * 1024) + lane; const float rs = 1.0f / sqrtf(SSF[m] * (1.0f / 1024.0f) + EPS);
#pragma unroll
        for (int j = 0; j < 4; ++j) row[64 * j] = row[64 * j] * rs * gf[64 * j]; }
}

__global__ void __launch_bounds__(NT, 2) fwd_kernel(Args args) {
    extern __shared__ __attribute__((aligned(16))) unsigned char lds[];
    cg::grid_group grid = cg::this_grid();
    const int tid = threadIdx.x, G = gridDim.x, bx = blockIdx.x;
    unsigned char* ws = args.ws;
    PG8_LAS unsigned char* ldsl = (PG8_LAS unsigned char*)lds;
    const int lo = args.ph_lo, hi = args.ph_hi;
#ifndef SKIPMASK
#define SKIPMASK 0
#endif
#define IN(k) (!((SKIPMASK >> (k)) & 1) && lo <= (k) && (k) < hi)
    volatile LAS unsigned* bst = (volatile LAS unsigned*)(ldsl + 155136);
    if (tid < 2) bst[tid] = 0u;
    __syncthreads();
    XcdBarrier xbar = xcd_barrier_post((unsigned*)(ws + WS_BAR), bst);
#define SEAM(k) do { if (IN(k) && IN((k) + 1)) { if ((k) == 0) grid.sync(); else xcd_barrier(xbar); } } while (0)
    float* SS = (float*)(ws + WS_SS);
    if (IN(0)) { const int tid = pg8::fresh_tid(); p0_prologue(args, lds, tid, G); }
    SEAM(0);
    if (IN(1)) {
        pg8::Gemm g{(const bf16*)(ws + WS_XN), (const bf16*)(ws + WS_WIN), MP, NIN, 1024, 1024, 1024, 0, 0}; pg8::StaticOrder S; S.init(MP, NIN, G, bx);
        pg8::EpiInProj E{(bf16*)(ws + WS_MIX), (bf16*)(ws + WS_XBCP), (bf16*)(ws + WS_UA), (bf16*)(ws + WS_UMETA), (float*)(ws + WS_DTRAW)};
        pg8::gemm_phase<pg8::EpiInProj, pg8::StaticOrder, true, true>(ldsl, g, S, E);
    }
    SEAM(1);
    if (IN(2)) {
        const int tid = pg8::fresh_tid(), wave = tid >> 6, lane = tid & 63;
        for (int u = bx; u < NQ * 24; u += G) p2_conv_unit(args, u / 24, u % 24, lds, tid);
        for (int it = (G - 1 - bx) * NWAVES + wave; it < NQ * 16; it += G * NWAVES) p2_dt_item(args, it >> 4, it & 15, lane);
    }
    SEAM(2);
    const int nS3 = (G / 2 < 126) ? G / 2 : 126;
    if (IN(3)) {
        const int tid = pg8::fresh_tid();
        for (int u = bx; u < 252; u += G) { const int qi = u >> 2; p3_states_unit(args, qi < 32 ? qi : qi + 1, (u >> 1) & 1, u & 1, tid); }
        pg8::Gemm g{(const bf16*)(ws + WS_UA), (const bf16*)(ws + WS_TE5), 1024, 256, 256, 384, 256, (size_t)1024 * 384 * 2, (size_t)256 * 256 * 2};
        pg8::BatchOrder S; S.init(256, 4, G, 0, bx);
        pg8::EpiS5a E{(float*)(ws + WS_SEND)};
        pg8::gemm_phase<pg8::EpiS5a, pg8::BatchOrder, true, true>(ldsl, g, S, E);
    }
    SEAM(3);
    if (IN(4)) {
        const int tid = pg8::fresh_tid();
        for (int it = bx; it < 512; it += G) { if (it < 256) p4_s5_scan_item(args, it, lds, tid); else p4_ssd_scan_item(args, it - 256, tid); }
    }
    SEAM(4);
    if (IN(5)) {
        const int tid = pg8::fresh_tid();
#ifndef NO_SSDOUT
        for (int u = bx; u < 256; u += G) p5_ssd_out_unit(args, 1 + (u >> 2), (u >> 1) & 1, u & 1, lds, tid);
        __syncthreads();
#endif
        pg8::Gemm g{(const bf16*)(ws + WS_UA), (const bf16*)(ws + WS_TB5), 1024, 256, 384, 384, 384, (size_t)1024 * 384 * 2, (size_t)256 * 384 * 2};
        pg8::BatchOrder S; S.init(256, 4, G, 0, bx);
        pg8::EpiS5b E{(bf16*)(ws + WS_Y5)};
        pg8::gemm_phase<pg8::EpiS5b, pg8::BatchOrder, true, true>(ldsl, g, S, E);
    }
    SEAM(5);
    if (IN(6)) {
        const int tid = pg8::fresh_tid();
        p6_weights(args, lds, tid, G);
        pg8::Gemm g{(const bf16*)(ws + WS_Y5), (const bf16*)(ws + WS_WGLU), MR, 2048, 1024, 1024, 1024, 0, 0}; pg8::StaticOrder S; S.init(MR, 2048, G, bx);
        pg8::EpiGlu E{(bf16*)(ws + WS_MIX), args.in[I_BGLU], SS + 16384};
        pg8::gemm_phase<pg8::EpiGlu, pg8::StaticOrder, true, true>(ldsl, g, S, E);
    }
    SEAM(6);
    if (IN(7)) {
        pg8::Gemm g{(const bf16*)(ws + WS_MIX), (const bf16*)(ws + WS_WOUT), MR, 1024, 1024, 2048, 2048, 0, 0, (size_t)1024 * 2, (size_t)1024 * 2};
        pg8::SplitKOrder S; S.base.init(MR, 1024, G, bx);
        pg8::EpiOut E{args.in[I_X], args.out, (bf16*)(ws + WS_H1B), SS, SS + 16384, SS + 2 * 16384};
        pg8::gemm_phase<pg8::EpiOut, pg8::SplitKOrder, true, true>(ldsl, g, S, E);
    }
    SEAM(7);
    if (IN(8)) {
        pg8::Gemm g{(const bf16*)(ws + WS_H1B), (const bf16*)(ws + WS_WUP), MR, 4096, 1024, 1024, 1024, 0, 0}; pg8::StaticOrder S; S.init(MR, 4096, G, bx);
        pg8::EpiUp E{(bf16*)(ws + WS_HB), SS + 2 * 16384};
        pg8::gemm_phase<pg8::EpiUp, pg8::StaticOrder, true, true>(ldsl, g, S, E);
    }
    SEAM(8);
    const int fused_fin = (G == 256 && lo <= 9 && hi >= 11) ? 1 : 0;
    if (IN(9)) {
        pg8::Gemm g{(const bf16*)(ws + WS_HB), (const bf16*)(ws + WS_WDN), MR, 1024, 4096, 4096, 4096, 0, 0}; pg8::StaticOrder S; S.init(MR, 1024, G, bx);
        pg8::EpiDown E{args.out, SS + 3 * 16384, (unsigned*)(ws + WS_BAR) + 3584, args.in[I_GFIN], fused_fin, (const bf16*)(ws + WS_H1B)};
        pg8::gemm_phase<pg8::EpiDown, pg8::StaticOrder, true, true>(ldsl, g, S, E);
    }
    if (!fused_fin) {
        SEAM(9);
        if (IN(10)) { const int tid = pg8::fresh_tid(); p10_final(args, tid, G); }
    }
#undef IN
#undef SEAM
}

#ifndef N_LAUNCHES
#define N_LAUNCHES 1
#endif
extern "C" void kernel_launch(void* const* d_in, const int* in_sizes, int n_in, void* d_out, int out_size, void* d_ws, size_t ws_size, hipStream_t stream) {
    static int grid = 0;
    if (grid == 0) {
        int dev = 0, cus = 0, per_cu = 0;
        hipGetDevice(&dev); hipDeviceGetAttribute(&cus, hipDeviceAttributeMultiprocessorCount, dev);
        hipFuncSetAttribute((const void*)fwd_kernel, hipFuncAttributeMaxDynamicSharedMemorySize, LDS_BYTES);
        hipOccupancyMaxActiveBlocksPerMultiprocessor(&per_cu, (const void*)fwd_kernel, NT, LDS_BYTES);
        if (per_cu < 1) { fprintf(stderr, "occupancy query says %d blocks per CU\n", per_cu); per_cu = 1; }
        grid = cus * 1;
        (void)hipGetLastError();
    }
    hipMemsetAsync((char*)d_ws + WS_BAR, 0, 16384, stream);
    Args a{};
    for (int i = 0; i < 26; ++i) a.in[i] = (const float*)d_in[i];
    a.out = (float*)d_out; a.ws = (unsigned char*)d_ws;
    if (N_LAUNCHES == 1) {
        a.ph_lo = 0; a.ph_hi = 11;
        void* args[] = {&a};
        hipError_t e = hipLaunchCooperativeKernel((const void*)fwd_kernel, dim3(grid), dim3(NT), args, LDS_BYTES, stream);
        if (e != hipSuccess) fprintf(stderr, "cooperative launch failed: %s (grid %d)\n", hipGetErrorString(e), grid);
    } else {
        for (int p = 0; p < 11; ++p) { a.ph_lo = p; a.ph_hi = p + 1; hipLaunchKernelGGL(fwd_kernel, dim3(grid), dim3(NT), LDS_BYTES, stream, a); }
    }
}
```

```cpp
#include <hip/hip_runtime.h>
#include <cstdio>
#include <cstdint>
namespace pg8 {
#define PG8_LAS __attribute__((address_space(3)))
typedef unsigned short bf16_t;
typedef short bf16x8 __attribute__((ext_vector_type(8)));
typedef float f32x4 __attribute__((ext_vector_type(4)));
typedef unsigned u32x4 __attribute__((ext_vector_type(4)));
constexpr int BM = 256, BK = 64, HALF = 128, HTB = HALF * BK * 2  , STAGE_BYTES = 8 * HTB, NXCD = 8, WGM = 8;

__host__ __device__ __forceinline__ int lds_byte(int r, int c) { const int st = (r >> 4) * 2 + (c >> 5), rr = r & 15, cc = c & 31, ob = rr * 64 + cc * 2; return st * 1024 + (ob ^ (((ob >> 9) & 1) << 5)); }
__host__ __device__ __forceinline__ void stage_rc(int b, int& R, int& C) { const int st = b / 1024, sb = b % 1024, swz = sb ^ (((sb >> 9) & 1) << 5); R = (st >> 1) * 16 + swz / 64; C = (st & 1) * 32 + (swz % 64) / 2; }
__host__ __device__ __forceinline__ int perm32(int rho) { const int n = rho >> 4, i = rho & 15; return 8 * (i >> 2) + 4 * n + (i & 3); }

struct Unit { int pm, pn, g, par, kh; };
struct Gemm { const bf16_t* A; const bf16_t* Bt; int M, N, K, lda, ldb; size_t gsA, gsB; size_t khA = 0, khB = 0; };

struct StaticOrder {
    int nM, nN, nwg, G, c;
    __host__ __device__ void init(int M, int N, int G_, int c_) { nM = M / BM; nN = N / BM; nwg = nM * nN; G = G_; c = c_; }
    __host__ __device__ bool next(int i, Unit& u) const {
        const long L = (long)i * G + c; if (L >= nwg) return false;
        int wgid = (int)L; { const int q = nwg / NXCD, r = nwg % NXCD, xcd = wgid % NXCD, off = wgid / NXCD; wgid = (xcd < r ? xcd * (q + 1) : r * (q + 1) + (xcd - r) * q) + off; }
        const int nig = WGM * nN, gid = wgid / nig, fm = gid * WGM, gsz = (nM - fm) < WGM ? (nM - fm) : WGM;
        u.pm = fm + ((wgid % nig) % gsz); u.pn = (wgid % nig) / gsz; u.g = 0; u.par = i & 1; u.kh = 0; return true;
    }
    __device__ __forceinline__ void a_ready(const Unit&) const {}
    __device__ __forceinline__ void done(const Unit&) const {}
};

__device__ __forceinline__ unsigned cvt_pk_bf16(float lo, float hi) { unsigned r; asm volatile("v_cvt_pk_bf16_f32 %0, %1, %2" : "=v"(r) : "v"(lo), "v"(hi)); return r; }
typedef float f32x2 __attribute__((ext_vector_type(2)));
__device__ __forceinline__ f32x2 gelu_pk(f32x2 v) {
    const f32x2 av = __builtin_elementwise_abs(v), d = av * 0.2316418882f + 1.0f;
    f32x2 t; t.x = __builtin_amdgcn_rcpf(d.x); t.y = __builtin_amdgcn_rcpf(d.y);
    f32x2 q = t * 0.5307027145f + (-0.7265760135f); q = q * t + 0.7107068705f; q = q * t + (-0.142248368f); q = q * t + 0.127414796f; q = q * t;
    const f32x2 s = (v * v) * (-0.72134752044f);
    f32x2 e; e.x = __builtin_amdgcn_exp2f(s.x); e.y = __builtin_amdgcn_exp2f(s.y);
    const f32x2 m = v * (q * e), r = v - m;
    f32x2 o; o.x = v.x < 0.f ? m.x : r.x; o.y = v.y < 0.f ? m.y : r.y; return o;
}

__device__ __forceinline__ int fresh_tid() { int t; asm volatile("v_mov_b32 %0, %1" : "=v"(t) : "v"((int)threadIdx.x)); return t; }
#define EPI_ROWS_COLS const int rowb = u.pm * BM + wr * 64 + fr; const int colb = wc * 32 + 8 * fq;
__device__ __forceinline__ u32x4 pack8(const f32x4 v0, const f32x4 v1) { u32x4 w; w.x = cvt_pk_bf16(v0[0], v0[1]); w.y = cvt_pk_bf16(v0[2], v0[3]); w.z = cvt_pk_bf16(v1[0], v1[1]); w.w = cvt_pk_bf16(v1[2], v1[3]); return w; }
__device__ __forceinline__ float sum8sq(const f32x4 a, const f32x4 b) { return (a[0] * a[0] + a[1] * a[1]) + (a[2] * a[2] + a[3] * a[3]) + (b[0] * b[0] + b[1] * b[1]) + (b[2] * b[2] + b[3] * b[3]); }

struct EpiInProj {
    static constexpr bool PERM = true, AFTER_DRAIN = false, HAS_MID = false;
    bf16_t* MIX; bf16_t* XBCP; bf16_t* UA; bf16_t* UMETA; float* DTRAW;
    __device__ __forceinline__ void operator()(const f32x4 (&acc)[2][2][4][2], const Unit& u, int wr, int wc, int fr, int fq) const {
        EPI_ROWS_COLS
        const int pn = u.pn;
#pragma unroll
        for (int ai = 0; ai < 2; ++ai)
#pragma unroll
            for (int m = 0; m < 4; ++m) {
                const int r = rowb + ai * HALF + m * 16;
#pragma unroll
                for (int bj = 0; bj < 2; ++bj) {
                    const int c = pn * BM + bj * HALF + colb;
                    const f32x4 v0 = acc[ai][bj][m][0], v1 = acc[ai][bj][m][1];
                    if (pn < 4) { if (r < 16384) *(u32x4*)(MIX + (size_t)r * 2048 + c) = pack8(v0, v1); }
                    else if (pn < 10) { *(u32x4*)(XBCP + (size_t)r * 1536 + (c - 1024)) = pack8(v0, v1); }
                    else if (pn < 14) {
                        const int j = c - 2560, g = j >> 4, h0 = j & 15;
                        if (r < 16384) { const int b = r >> 13, tok = r & 8191, ch = tok >> 4, t = tok & 15;
                            *(u32x4*)(UA + ((size_t)(g * 1024 + b * 512 + ch) * 384 + t * 16 + h0)) = pack8(v0, v1); }
                        else *(u32x4*)(UMETA + (size_t)(r - 16384) * 1024 + j) = pack8(v0, v1);
                    } else {
                        const int j = c - 3584;
                        if (j < 16) { float* d = DTRAW + (size_t)r * 16 + j; *(f32x4*)d = v0; *(f32x4*)(d + 4) = v1; }
                    }
                }
            }
    }
};
struct EpiS5a {
    static constexpr bool PERM = true, AFTER_DRAIN = false, HAS_MID = false;
    float* SEND;
    __device__ __forceinline__ void operator()(const f32x4 (&acc)[2][2][4][2], const Unit& u, int wr, int wc, int fr, int fq) const {
        EPI_ROWS_COLS
#pragma unroll
        for (int ai = 0; ai < 2; ++ai)
#pragma unroll
            for (int m = 0; m < 4; ++m) {
                const int r = rowb + ai * HALF + m * 16;
                float* d = SEND + ((size_t)(u.g * 1024 + r) * 128 + colb);
                *(f32x4*)d = acc[ai][0][m][0]; *(f32x4*)(d + 4) = acc[ai][0][m][1];
            }
    }
};
struct EpiS5b {
    static constexpr bool PERM = true, AFTER_DRAIN = false, HAS_MID = false;
    bf16_t* Y5;
    __device__ __forceinline__ void operator()(const f32x4 (&acc)[2][2][4][2], const Unit& u, int wr, int wc, int fr, int fq) const {
        { const int t2 = fresh_tid(); const int w2 = t2 >> 6, l2 = t2 & 63; wr = w2 >> 2; wc = w2 & 3; fr = l2 & 15; fq = l2 >> 4; }
        const unsigned lane_off = (unsigned)((((u.pm >> 1) * 8192 + (((u.pm & 1) * 256 + wr * 64 + fr) * 16) + (wc * 2 + (fq >> 1))) * 1024 + u.g * 16 + (fq & 1) * 8) * 2);
        char* base = (char*)Y5;
#pragma unroll
        for (int ai = 0; ai < 2; ++ai)
#pragma unroll
            for (int m = 0; m < 4; ++m)
#pragma unroll
                for (int bj = 0; bj < 2; ++bj) {
                    const f32x4 v0 = acc[ai][bj][m][0], v1 = acc[ai][bj][m][1]; u32x4 w;
                    { const f32x2 a = gelu_pk((f32x2){v0[0], v0[1]}); w.x = cvt_pk_bf16(a.x, a.y); } __builtin_amdgcn_sched_barrier(0);
                    { const f32x2 a = gelu_pk((f32x2){v0[2], v0[3]}); w.y = cvt_pk_bf16(a.x, a.y); } __builtin_amdgcn_sched_barrier(0);
                    { const f32x2 a = gelu_pk((f32x2){v1[0], v1[1]}); w.z = cvt_pk_bf16(a.x, a.y); } __builtin_amdgcn_sched_barrier(0);
                    { const f32x2 a = gelu_pk((f32x2){v1[2], v1[3]}); w.w = cvt_pk_bf16(a.x, a.y); } __builtin_amdgcn_sched_barrier(0);
                    const unsigned off = lane_off + (unsigned)(ai * 4194304 + m * 524288 + bj * 16384);
                    *(u32x4*)(base + off) = w;
                }
    }
};
__device__ __forceinline__ float sigm(float x) { return __builtin_amdgcn_rcpf(1.0f + __builtin_amdgcn_exp2f(-1.44269504f * x)); }
struct EpiGlu {
    static constexpr bool PERM = true, AFTER_DRAIN = false, HAS_MID = false;
    bf16_t* MIX; const float* bglu; float* SS5;
    __device__ __forceinline__ void operator()(const f32x4 (&acc)[2][2][4][2], const Unit& u, int wr, int wc, int fr, int fq) const {
        EPI_ROWS_COLS
        const int oc = u.pn * 128 + colb;
        const f32x4 ba0 = *(const f32x4*)(bglu + oc), ba1 = *(const f32x4*)(bglu + oc + 4), bg0 = *(const f32x4*)(bglu + 1024 + oc), bg1 = *(const f32x4*)(bglu + 1024 + oc + 4);
#pragma unroll
        for (int ai = 0; ai < 2; ++ai)
#pragma unroll
            for (int m = 0; m < 4; ++m) {
                const int r = rowb + ai * HALF + m * 16;
                f32x4 a0 = acc[ai][0][m][0] + ba0, a1 = acc[ai][0][m][1] + ba1; const f32x4 g0 = acc[ai][1][m][0] + bg0, g1 = acc[ai][1][m][1] + bg1;
#pragma unroll
                for (int e = 0; e < 4; ++e) { a0[e] *= sigm(g0[e]); a1[e] *= sigm(g1[e]); }
                *(u32x4*)(MIX + (size_t)r * 2048 + 1024 + oc) = pack8(a0, a1);
                float s = sum8sq(a0, a1); s += __shfl_xor(s, 16); s += __shfl_xor(s, 32);
                if (fq == 0) atomicAdd(SS5 + r, s);
            }
    }
};
struct EpiOut {
    static constexpr bool PERM = true, AFTER_DRAIN = false, HAS_MID = true;
    const float* X; float* H1; bf16_t* H1B; const float* SSS; const float* SS5; float* SSM;
    __device__ __forceinline__ void mid(f32x4 (&acc)[2][2][4][2], const Unit& u, int wr, int wc, int fr, int fq) const {
        const int rowb = u.pm * BM + wr * 64 + fr;
#pragma unroll
        for (int ai = 0; ai < 2; ++ai)
#pragma unroll
            for (int m = 0; m < 4; ++m) {
                const int r = rowb + ai * HALF + m * 16;
                const float ratio = sqrtf((SS5[r] * (1.0f / 1024.0f) + 1e-5f) / (SSS[r] * (1.0f / 1024.0f) + 1e-5f));
#pragma unroll
                for (int bj = 0; bj < 2; ++bj)
#pragma unroll
                    for (int n = 0; n < 2; ++n) acc[ai][bj][m][n] *= ratio;
                asm volatile("" ::: "memory");
            }
    }
    __device__ __forceinline__ void operator()(const f32x4 (&acc)[2][2][4][2], const Unit& u, int wr, int wc, int fr, int fq) const {
        EPI_ROWS_COLS
        const unsigned lane_off = (unsigned)(rowb * 1024 + u.pn * BM + colb);
        const char* xb = (const char*)X; char* hb = (char*)H1; char* bb = (char*)H1B;
#pragma unroll
        for (int ai = 0; ai < 2; ++ai)
#pragma unroll
            for (int m = 0; m < 4; ++m) {
                const int r = rowb + ai * HALF + m * 16;
                const float rs = 1.0f / sqrtf(SS5[r] * (1.0f / 1024.0f) + 1e-5f);
                float s = 0.f;
#pragma unroll
                for (int bj = 0; bj < 2; ++bj) {
                    const unsigned off = lane_off + (unsigned)(ai * 131072 + m * 16384 + bj * 128);
                    const f32x4 v0 = *(const f32x4*)(xb + off * 4u) + acc[ai][bj][m][0] * rs, v1 = *(const f32x4*)(xb + off * 4u + 16u) + acc[ai][bj][m][1] * rs;
                    *(u32x4*)(bb + off * 2u) = pack8(v0, v1); s += sum8sq(v0, v1);
                }
                s += __shfl_xor(s, 16); s += __shfl_xor(s, 32);
                if (fq == 0) atomicAdd(SSM + r, s);
                asm volatile("" ::: "memory");
            }
    }
};
struct SplitKOrder {
    StaticOrder base;
    __device__ bool next(int i, Unit& u) const { if (!base.next(i >> 1, u)) return false; u.kh = i & 1; u.par = i & 1; return true; }
    __device__ __forceinline__ void a_ready(const Unit&) const {}
    __device__ __forceinline__ void done(const Unit&) const {}
};
struct EpiUp {
    static constexpr bool PERM = true, AFTER_DRAIN = false, HAS_MID = false;
    bf16_t* HB; const float* SSM;
    __device__ __forceinline__ void operator()(const f32x4 (&acc)[2][2][4][2], const Unit& u, int wr, int wc, int fr, int fq) const {
        EPI_ROWS_COLS
#pragma unroll
        for (int ai = 0; ai < 2; ++ai)
#pragma unroll
            for (int m = 0; m < 4; ++m) {
                const int r = rowb + ai * HALF + m * 16;
                const float rs = 1.0f / sqrtf(SSM[r] * (1.0f / 1024.0f) + 1e-5f);
#pragma unroll
                for (int bj = 0; bj < 2; ++bj) {
                    f32x4 v0 = acc[ai][bj][m][0] * rs, v1 = acc[ai][bj][m][1] * rs;
#pragma unroll
                    for (int e = 0; e < 4; ++e) { const float p = fmaxf(v0[e], 0.f), q = fmaxf(v1[e], 0.f); v0[e] = p * p; v1[e] = q * q; }
                    *(u32x4*)(HB + (size_t)r * 4096 + u.pn * BM + bj * HALF + colb) = pack8(v0, v1);
                }
            }
    }
};
struct EpiDown {
    static constexpr bool PERM = true, AFTER_DRAIN = false, HAS_MID = false;
    float* H; float* SSF; unsigned* pcnt; const float* gfin; int fused; const bf16_t* H1B;
    __device__ __forceinline__ void operator()(const f32x4 (&acc_)[2][2][4][2], const Unit& u, int wr, int wc, int fr, int fq) const {
        f32x4 (&acc)[2][2][4][2] = const_cast<f32x4 (&)[2][2][4][2]>(acc_);
        EPI_ROWS_COLS
        const unsigned lane_off = (unsigned)(rowb * 1024 + u.pn * BM + colb);
        char* hb = (char*)H;
#pragma unroll
        for (int ai = 0; ai < 2; ++ai)
#pragma unroll
            for (int m = 0; m < 4; ++m) {
                const int r = rowb + ai * HALF + m * 16;
                float s = 0.f;
#pragma unroll
                for (int bj = 0; bj < 2; ++bj) {
                    const unsigned off = lane_off + (unsigned)(ai * 131072 + m * 16384 + bj * 128);
                    const u32x4 rw = *(const u32x4*)((const char*)H1B + off * 2u);
                    const f32x4 r0 = (f32x4){__builtin_bit_cast(float, rw.x << 16), __builtin_bit_cast(float, rw.x & 0xffff0000u), __builtin_bit_cast(float, rw.y << 16), __builtin_bit_cast(float, rw.y & 0xffff0000u)};
                    const f32x4 r1 = (f32x4){__builtin_bit_cast(float, rw.z << 16), __builtin_bit_cast(float, rw.z & 0xffff0000u), __builtin_bit_cast(float, rw.w << 16), __builtin_bit_cast(float, rw.w & 0xffff0000u)};
                    const f32x4 v0 = r0 + acc[ai][bj][m][0], v1 = r1 + acc[ai][bj][m][1];
                    if (fused) { acc[ai][bj][m][0] = v0; acc[ai][bj][m][1] = v1; } else { *(f32x4*)(hb + off * 4u) = v0; *(f32x4*)(hb + off * 4u + 16u) = v1; }
                    s += sum8sq(v0, v1);
                }
                s += __shfl_xor(s, 16); s += __shfl_xor(s, 32);
                if (fq == 0) atomicAdd(SSF + r, s);
                asm volatile("" ::: "memory");
            }
        if (!fused) return;
        asm volatile("s_waitcnt vmcnt(0)" ::: "memory");
        unsigned* cw = pcnt + 4 * u.pm;
        if (fr == 0 && fq == 0) __hip_atomic_fetch_add(cw, 1u, __ATOMIC_RELAXED, __HIP_MEMORY_SCOPE_AGENT);
        while (__hip_atomic_load(cw, __ATOMIC_RELAXED, __HIP_MEMORY_SCOPE_AGENT) < 32u) __builtin_amdgcn_s_sleep(4);
        asm volatile("" ::: "memory");
        f32x4 gv[2][2];
#pragma unroll
        for (int bj = 0; bj < 2; ++bj) { gv[bj][0] = *(const f32x4*)(gfin + u.pn * BM + bj * HALF + colb); gv[bj][1] = *(const f32x4*)(gfin + u.pn * BM + bj * HALF + colb + 4); }
#pragma unroll
        for (int ai = 0; ai < 2; ++ai)
#pragma unroll
            for (int m = 0; m < 4; ++m) {
                const int r = rowb + ai * HALF + m * 16;
                const float ssum = __builtin_bit_cast(float, __hip_atomic_load((const unsigned*)(SSF + r), __ATOMIC_RELAXED, __HIP_MEMORY_SCOPE_AGENT));
                const float rs = 1.0f / sqrtf(ssum * (1.0f / 1024.0f) + 1e-5f);
#pragma unroll
                for (int bj = 0; bj < 2; ++bj) {
                    const unsigned off = lane_off + (unsigned)(ai * 131072 + m * 16384 + bj * 128);
                    *(f32x4*)(hb + off * 4u) = acc[ai][bj][m][0] * rs * gv[bj][0]; *(f32x4*)(hb + off * 4u + 16u) = acc[ai][bj][m][1] * rs * gv[bj][1];
                }
            }
    }
};
struct BatchOrder {
    int nU, per_g, Ge, ce;
    __host__ __device__ void init(int nU_, int per_g_, int G, int w0, int c) { nU = nU_; per_g = per_g_; Ge = G - w0; ce = c - w0; }
    __device__ bool next(int i, Unit& u) const {
        if (ce < 0) return false;
        const long L = (long)i * Ge + ce; if (L >= nU) return false;
        u.g = __builtin_amdgcn_readfirstlane((int)L / per_g); u.pm = __builtin_amdgcn_readfirstlane((int)L % per_g); u.pn = 0; u.par = i & 1; u.kh = 0; return true;
    }
    __device__ __forceinline__ void a_ready(const Unit&) const {}
    __device__ __forceinline__ void done(const Unit&) const {}
};
template <class Epi, class Sched, bool ALIGN_EPI = false, bool SP2 = false>
__device__ __forceinline__ void gemm_phase(PG8_LAS unsigned char* lds, const Gemm g, const Sched& S, const Epi& E) {
    const int tid = threadIdx.x, wid = __builtin_amdgcn_readfirstlane(tid >> 6), lane = tid & 63, wr = wid >> 2, wc = wid & 3, fr = lane & 15, fq = lane >> 4;
    const int K = g.K, nt = K / BK;
    unsigned voffA[2], voffB[2];
#pragma unroll
    for (int i = 0; i < 2; ++i) { int R, C; stage_rc(tid * 16 + i * 8192, R, C); const int Rb = Epi::PERM ? ((R & ~31) + perm32(R & 31)) : R;
        voffA[i] = (unsigned)(R * g.lda + C) * 2u; voffB[i] = (unsigned)(Rb * g.ldb + C) * 2u; }
    const size_t kstep = (size_t)(BK * 2);
    const size_t hstepA = (size_t)HALF * g.lda * 2, hstepB = (size_t)HALF * g.ldb * 2;
    const size_t tstepA = 2 * hstepA, tstepB = 2 * hstepB;
    const unsigned ldsw = (unsigned)wid * 1024u;
    const int aoff = lds_byte(wr * 64 + fr, fq * 8), boff = lds_byte(wc * 32 + fr, fq * 8);
#define PG8_SA(b, h) (((b) * 2 + (h)) * HTB)
#define PG8_SB(b, h) ((4 + (b) * 2 + (h)) * HTB)
#define PG8_STAGE(bufoff, gbase, voff) do { _Pragma("unroll") for (int _i = 0; _i < 2; ++_i) \
        __builtin_amdgcn_global_load_lds((const unsigned*)((const char*)(gbase) + (voff)[_i]), (PG8_LAS unsigned*)(lds + (bufoff) + ldsw + _i * 8192), 16, 0, 0); } while (0)
#define PG8_LDA(dst, b, h) do { _Pragma("unroll") for (int m = 0; m < 4; ++m) _Pragma("unroll") for (int k = 0; k < 2; ++k) dst[m][k] = *(const PG8_LAS bf16x8*)(lds + PG8_SA(b, h) + aoff + m * 2048 + k * 1024); } while (0)
#define PG8_LDB(dst, b, h) do { _Pragma("unroll") for (int n = 0; n < 2; ++n) _Pragma("unroll") for (int k = 0; k < 2; ++k) dst[n][k] = *(const PG8_LAS bf16x8*)(lds + PG8_SB(b, h) + boff + n * 2048 + k * 1024); } while (0)
#define PG8_MMA(ai, bj, At, Bt) do { __builtin_amdgcn_s_setprio(1); _Pragma("unroll") for (int m = 0; m < 4; ++m) _Pragma("unroll") for (int n = 0; n < 2; ++n) _Pragma("unroll") for (int k = 0; k < 2; ++k) \
        acc[ai][bj][m][n] = __builtin_amdgcn_mfma_f32_16x16x32_bf16(Bt[n][k], At[m][k], acc[ai][bj][m][n], 0, 0, 0); __builtin_amdgcn_s_setprio(0); } while (0)
#define PG8_WAIT_V(n) asm volatile("s_waitcnt vmcnt(" #n ")" ::: "memory")
#define PG8_WAIT_L(n) asm volatile("s_waitcnt lgkmcnt(" #n ")" ::: "memory")
#define PG8_BAR __builtin_amdgcn_s_barrier()
#define PG8_SCHED __builtin_amdgcn_sched_barrier(0)
    Unit cur, nxt; int ui = 0;
    if (!S.next(0, cur)) return;
    f32x4 acc[2][2][4][2];
#pragma unroll
    for (int a = 0; a < 2; ++a)
#pragma unroll
        for (int b = 0; b < 2; ++b)
#pragma unroll
            for (int m = 0; m < 4; ++m)
#pragma unroll
                for (int n = 0; n < 2; ++n) acc[a][b][m][n] = (f32x4){0.f, 0.f, 0.f, 0.f};
    bf16x8 At[4][2], B0[2][2], B1[2][2];
    const char* cA = (const char*)g.A + (size_t)cur.g * g.gsA + (size_t)cur.pm * tstepA + (size_t)cur.kh * g.khA; const char* cB = (const char*)g.Bt + (size_t)cur.g * g.gsB + (size_t)cur.pn * tstepB + (size_t)cur.kh * g.khB;
    S.a_ready(cur);
    if constexpr (SP2) {
        PG8_STAGE(PG8_SB(0, 0), cB, voffB); PG8_STAGE(PG8_SB(0, 1), cB + hstepB, voffB); PG8_STAGE(PG8_SA(0, 0), cA, voffA); PG8_STAGE(PG8_SA(0, 1), cA + hstepA, voffA);
        if (wr == 1) PG8_BAR;
        PG8_WAIT_V(2); PG8_BAR;
        PG8_STAGE(PG8_SB(1, 0), cB + kstep, voffB); PG8_STAGE(PG8_SA(1, 0), cA + kstep, voffA); PG8_STAGE(PG8_SB(1, 1), cB + hstepB + kstep, voffB);
        PG8_WAIT_V(6); PG8_BAR;
    } else {
        PG8_STAGE(PG8_SB(0, 0), cB, voffB); PG8_STAGE(PG8_SA(0, 0), cA, voffA); PG8_STAGE(PG8_SB(0, 1), cB + hstepB, voffB); PG8_STAGE(PG8_SA(0, 1), cA + hstepA, voffA);
        if (wr == 1) PG8_BAR;
        PG8_WAIT_V(4); PG8_BAR;
        PG8_STAGE(PG8_SB(1, 0), cB + kstep, voffB); PG8_STAGE(PG8_SA(1, 0), cA + kstep, voffA); PG8_STAGE(PG8_SB(1, 1), cB + hstepB + kstep, voffB);
        PG8_WAIT_V(6); PG8_BAR;
    }
    for (;;) {
        const bool has_next = S.next(ui + 1, nxt);
        const char* nA = has_next ? (const char*)g.A + (size_t)nxt.g * g.gsA + (size_t)nxt.pm * tstepA + (size_t)nxt.kh * g.khA : cA; const char* nB = has_next ? (const char*)g.Bt + (size_t)nxt.g * g.gsB + (size_t)nxt.pn * tstepB + (size_t)nxt.kh * g.khB : cB;
        for (int t = 0; t < nt; t += 2) {
            const bool last = (t == nt - 2);
            const char* a1 = cA + (size_t)(t + 1) * kstep;
            const char* a2 = last ? nA : cA + (size_t)(t + 2) * kstep; const char* b2 = last ? nB : cB + (size_t)(t + 2) * kstep;
            const char* a3 = a2 + kstep; const char* b3 = b2 + kstep;
            if (last && has_next) S.a_ready(nxt);
            if constexpr (SP2) {
            PG8_LDB(B0, 0, 0); PG8_LDB(B1, 0, 1); PG8_SCHED; PG8_LDA(At, 0, 0); PG8_STAGE(PG8_SA(1, 1), a1 + hstepA, voffA);
            PG8_WAIT_V(8); PG8_WAIT_L(0); PG8_BAR; PG8_MMA(0, 0, At, B0); PG8_MMA(0, 1, At, B1); PG8_BAR; PG8_SCHED;
            PG8_LDA(At, 0, 1); PG8_STAGE(PG8_SB(0, 0), b2, voffB); PG8_STAGE(PG8_SB(0, 1), b2 + hstepB, voffB); PG8_STAGE(PG8_SA(0, 0), a2, voffA);
            PG8_WAIT_V(8); PG8_WAIT_L(0); PG8_BAR; PG8_MMA(1, 0, At, B0); PG8_MMA(1, 1, At, B1); PG8_BAR; PG8_SCHED;
            PG8_LDB(B0, 1, 0); PG8_LDB(B1, 1, 1); PG8_SCHED; PG8_LDA(At, 1, 0); PG8_STAGE(PG8_SA(0, 1), a2 + hstepA, voffA);
            PG8_WAIT_V(8); PG8_WAIT_L(0); PG8_BAR; PG8_MMA(0, 0, At, B0); PG8_MMA(0, 1, At, B1); PG8_BAR; PG8_SCHED;
            PG8_LDA(At, 1, 1); PG8_STAGE(PG8_SB(1, 0), b3, voffB); PG8_STAGE(PG8_SB(1, 1), b3 + hstepB, voffB); PG8_STAGE(PG8_SA(1, 0), a3, voffA);
            PG8_WAIT_V(8); PG8_WAIT_L(0); PG8_BAR; PG8_MMA(1, 0, At, B0); PG8_MMA(1, 1, At, B1); PG8_BAR; PG8_SCHED;
            } else {
            PG8_LDB(B0, 0, 0); PG8_SCHED; PG8_LDA(At, 0, 0); PG8_STAGE(PG8_SA(1, 1), a1 + hstepA, voffA);
            PG8_WAIT_L(8); PG8_BAR; PG8_WAIT_L(0); PG8_MMA(0, 0, At, B0); PG8_BAR; PG8_SCHED;
            PG8_LDB(B1, 0, 1); PG8_STAGE(PG8_SB(0, 0), b2, voffB);
            PG8_BAR; PG8_WAIT_L(0); PG8_MMA(0, 1, At, B1); PG8_BAR;
            PG8_LDA(At, 0, 1); PG8_STAGE(PG8_SA(0, 0), a2, voffA);
            PG8_BAR; PG8_WAIT_L(0); PG8_MMA(1, 0, At, B0); PG8_BAR; PG8_SCHED;
            PG8_STAGE(PG8_SB(0, 1), b2 + hstepB, voffB);
            PG8_WAIT_V(6); PG8_BAR; PG8_MMA(1, 1, At, B1); PG8_BAR;
            PG8_LDB(B0, 1, 0); PG8_SCHED; PG8_LDA(At, 1, 0); PG8_STAGE(PG8_SA(0, 1), a2 + hstepA, voffA);
            PG8_WAIT_L(8); PG8_BAR; PG8_WAIT_L(0); PG8_MMA(0, 0, At, B0); PG8_BAR; PG8_SCHED;
            PG8_LDB(B1, 1, 1); PG8_STAGE(PG8_SB(1, 0), b3, voffB);
            PG8_BAR; PG8_WAIT_L(0); PG8_MMA(0, 1, At, B1); PG8_BAR;
            PG8_LDA(At, 1, 1); PG8_STAGE(PG8_SA(1, 0), a3, voffA);
            PG8_BAR; PG8_WAIT_L(0); PG8_MMA(1, 0, At, B0); PG8_BAR; PG8_SCHED;
            PG8_STAGE(PG8_SB(1, 1), b3 + hstepB, voffB);
            PG8_WAIT_V(6); PG8_BAR; PG8_MMA(1, 1, At, B1); PG8_BAR;
            }
        }
        if constexpr (ALIGN_EPI) { if (wr == 0) PG8_BAR; }
        bool keep = false;
        if constexpr (Epi::HAS_MID) { if (cur.kh == 0) { E.mid(acc, cur, wr, wc, fr, fq); keep = true; } }
        if (!keep) { if constexpr (!Epi::AFTER_DRAIN) { E(acc, cur, wr, wc, fr, fq); S.done(cur); } }
        if (!has_next) break;
        if (!keep)
#pragma unroll
        for (int a = 0; a < 2; ++a)
#pragma unroll
            for (int b = 0; b < 2; ++b)
#pragma unroll
                for (int m = 0; m < 4; ++m)
#pragma unroll
                    for (int n = 0; n < 2; ++n) acc[a][b][m][n] = (f32x4){0.f, 0.f, 0.f, 0.f};
        cur = nxt; cA = nA; cB = nB; ++ui;
        if constexpr (ALIGN_EPI) { if (wr == 1) PG8_BAR; }
    }
    PG8_WAIT_V(0);
    if constexpr (!ALIGN_EPI) { if (wr == 0) PG8_BAR; }
    PG8_BAR;
    if constexpr (Epi::AFTER_DRAIN) { E.fused(acc, cur, wr, wc, fr, fq, lds, wid, lane); S.done(cur); }
#undef PG8_SA
#undef PG8_SB
#undef PG8_STAGE
#undef PG8_LDA
#undef PG8_LDB
#undef PG8_MMA
#undef PG8_WAIT_V
#undef PG8_WAIT_L
#undef PG8_BAR
#undef PG8_SCHED
}
}

#include <hip/hip_cooperative_groups.h>
namespace cg = cooperative_groups;
typedef unsigned short bf16;
typedef unsigned v4u __attribute__((ext_vector_type(4)));
typedef unsigned v2u __attribute__((ext_vector_type(2)));
typedef float f32x4 __attribute__((ext_vector_type(4)));
typedef float f32x2 __attribute__((ext_vector_type(2)));
typedef short bf16x8 __attribute__((ext_vector_type(8)));

constexpr int NT = 512, NWAVES = 8;
constexpr int MR = 16384, MP = 16640;
constexpr int NIN = 3840;
constexpr int NQ = 65;
constexpr float EPS = 1e-5f;
constexpr size_t MiB = 1u << 20;
constexpr size_t WS_SS    = 0;
constexpr size_t WS_DEC   = 256 * 1024;
constexpr size_t WS_A1    = 288 * 1024;
constexpr size_t WS_A16   = 320 * 1024;
constexpr size_t WS_BAR   = 384 * 1024;
constexpr size_t WS_BBAR  = 512 * 1024;
constexpr size_t WS_UMETA = 1 * MiB;
constexpr size_t WS_DTRAW = 1 * MiB + 512 * 1024;
constexpr size_t WS_DT    = 2 * MiB + 640 * 1024;
constexpr size_t WS_ACS   = 254 * MiB + 512 * 1024;
static_assert(WS_DTRAW + 16640 * 16 * 4 <= WS_DT && WS_DT + 65 * 16 * 256 * 4 <= 4 * MiB && WS_ACS + 65 * 16 * 256 * 4 <= 256 * MiB, "smalls");
constexpr size_t WS_WGLU  = 4 * MiB;
constexpr size_t WS_TB5   = 8 * MiB;
constexpr size_t WS_TE5   = 20 * MiB;
constexpr size_t WS_WIN   = 28 * MiB;
constexpr size_t WS_PREV  = 20 * MiB;
constexpr size_t WS_WOUT  = 8 * MiB, WS_WUP = 12 * MiB, WS_WDN = 20 * MiB;
constexpr size_t WS_MIX   = 36 * MiB;
constexpr size_t WS_UA    = 100 * MiB;
constexpr size_t WS_XBCP  = 148 * MiB;
constexpr size_t WS_SEND  = 148 * MiB;
constexpr size_t WS_ST    = 180 * MiB;
constexpr size_t WS_Y5    = 148 * MiB;
constexpr size_t WS_XN    = 197 * MiB;
constexpr size_t WS_XF    = 197 * MiB;
constexpr size_t WS_H1B   = 197 * MiB;
constexpr size_t WS_CT    = 230 * MiB;
constexpr size_t WS_BTK   = WS_CT + 65 * 65536 * 2;
constexpr size_t WS_BF    = WS_BTK + 65 * 65536 * 2;
constexpr size_t WS_HB    = 36 * MiB;
static_assert(WS_BF + 65 * 65536 * 2 <= WS_ACS, "ws");
constexpr int LDS_BYTES = 155648;

__device__ __forceinline__ unsigned f2bf(float f) { unsigned u = __builtin_bit_cast(unsigned, f); return (u + 0x7fffu + ((u >> 16) & 1u)) >> 16; }
__device__ __forceinline__ unsigned pk2(float lo, float hi) { unsigned r; asm("v_cvt_pk_bf16_f32 %0, %1, %2" : "=v"(r) : "v"(lo), "v"(hi)); return r; }
__device__ __forceinline__ float bf2f(unsigned short h) { return __builtin_bit_cast(float, (unsigned)h << 16); }
__device__ __forceinline__ float bflo(unsigned w) { return __builtin_bit_cast(float, w << 16); }
__device__ __forceinline__ float bfhi(unsigned w) { return __builtin_bit_cast(float, w & 0xffff0000u); }
__device__ __forceinline__ float ex2(float x) { return __builtin_amdgcn_exp2f(x); }
__device__ __forceinline__ float expf_(float x) { return __builtin_amdgcn_exp2f(1.44269504f * x); }
__device__ __forceinline__ float wave_sum(float v) {
#pragma unroll
    for (int o = 1; o < 64; o <<= 1) v += __shfl_xor(v, o);
    return v;
}

#define LAS __attribute__((address_space(3)))
#define XB_TMO      128
#define XB_XCNT(j)  (256  + 64 * (j))
#define XB_XSUB(j)  (1280 + 64 * (j))
#define XB_XGEN(j)  (2304 + 64 * (j))
#define XB_TOP      3328
#define XB_TOPGEN   3392
#define XCD_BAR_WORDS 3456
#define XB_SPIN_CAP (1u << 18)

__device__ __forceinline__ unsigned xb_ld(unsigned* p)              { return __hip_atomic_load(p, __ATOMIC_RELAXED, __HIP_MEMORY_SCOPE_AGENT); }
__device__ __forceinline__ unsigned xb_add(unsigned* p, unsigned v) { return __hip_atomic_fetch_add(p, v, __ATOMIC_RELAXED, __HIP_MEMORY_SCOPE_AGENT); }
__device__ __forceinline__ unsigned xb_xcc_id() { return (unsigned)__builtin_amdgcn_s_getreg((3 << 11) | 20) & 0xFu; }
#define XB_SPIN(cond, bar) do { unsigned _sp = 0; while (cond) { __builtin_amdgcn_s_sleep(1); \
    if ((++_sp & 255u) == 0u) { if (xb_ld(&(bar)[XB_TMO])) break; if (_sp > XB_SPIN_CAP) { atomicAdd(&(bar)[XB_TMO], 1u); break; } } } } while (0)

struct XcdBarrier {
    unsigned* bar; unsigned x;
    volatile LAS unsigned* st;
};

__device__ __forceinline__ XcdBarrier xcd_barrier_post(unsigned* bar, volatile LAS unsigned* st) {
    XcdBarrier b; b.bar = bar; b.x = xb_xcc_id(); b.st = st;
    if (threadIdx.x == 0) (void)xb_add(&bar[XB_XCNT(b.x)], 1u);
    return b;
}
__device__ __forceinline__ void xcd_barrier_complete(unsigned* bar, unsigned x, unsigned& nloc, unsigned& nx) {
    const unsigned G = gridDim.x * gridDim.y * gridDim.z;
    unsigned sum, cnt, mine, sp = 0u;
    for (;;) {
        sum = 0u; cnt = 0u; mine = 0u;
#pragma unroll
        for (unsigned j = 0; j < 16; ++j) { const unsigned c = xb_ld(&bar[XB_XCNT(j)]); sum += c; cnt += (c > 0u) ? 1u : 0u; mine = (j == x) ? c : mine; }
        if (sum == G) break;
        __builtin_amdgcn_s_sleep(1);
        if ((++sp & 255u) == 0u) { if (xb_ld(&bar[XB_TMO])) break; if (sp > XB_SPIN_CAP) { atomicAdd(&bar[XB_TMO], 1u); break; } }
    }
    nloc = mine > 0u ? mine : 1u; nx = cnt > 0u ? cnt : 1u;
}

__device__ __forceinline__ void xcd_barrier(const XcdBarrier& b) {
    asm volatile("s_waitcnt vmcnt(0)" ::: "memory");
    __syncthreads();
    if (threadIdx.x == 0) {
        unsigned* bar = b.bar;
        __builtin_amdgcn_s_waitcnt(0);
        unsigned nloc = b.st[0], nx = b.st[1];
        if (nloc == 0u) { xcd_barrier_complete(bar, b.x, nloc, nx); b.st[0] = nloc; b.st[1] = nx; }
        const unsigned old = xb_add(&bar[XB_XSUB(b.x)], 1u);
        const unsigned gen = old / nloc;
        if (old + 1u == (gen + 1u) * nloc) {
            __builtin_amdgcn_fence(__ATOMIC_RELEASE, "agent");
            asm volatile("s_waitcnt vmcnt(0)" ::: "memory");
            const unsigned og = xb_add(&bar[XB_TOP], 1u);
            const unsigned tg = og / nx;
            if (og + 1u == (tg + 1u) * nx) xb_add(&bar[XB_TOPGEN], 1u);
            else XB_SPIN(xb_ld(&bar[XB_TOPGEN]) == tg, bar);
            __builtin_amdgcn_fence(__ATOMIC_ACQUIRE, "agent");
            xb_add(&bar[XB_XGEN(b.x)], 1u);
            asm volatile("s_waitcnt vmcnt(0)" ::: "memory");
        } else {
            XB_SPIN(xb_ld(&bar[XB_XGEN(b.x)]) == gen, bar);
            __builtin_amdgcn_fence(__ATOMIC_ACQUIRE, "agent");
            asm volatile("s_waitcnt vmcnt(0)" ::: "memory");
        }
    }
    __syncthreads();
}

struct Args {
    const float* in[26]; float* out; unsigned char* ws; int ph_lo, ph_hi;
};
enum { I_X = 0, I_META, I_GMIX, I_WIN, I_CONVW, I_CONVB, I_DTB, I_ALOG, I_DSSD, I_GSSD, I_LRE, I_LIM, I_LSTEP, I_BRE, I_BIM, I_CRE, I_CIM, I_DS5, I_WGLU, I_BGLU, I_GS5, I_WOUT, I_GMLP, I_WUP, I_WDN, I_GFIN };

template <int MODE> __device__ __forceinline__ int colmap(int j) {
    if (MODE == 1) { if (j < 2560) return j; if (j < 3584) return j + 16; if (j < 3600) return j - 1024; return -1; }
    if (MODE == 2) { const int pn = j >> 8, r = j & 255; return r < 128 ? pn * 128 + r : 1024 + pn * 128 + (r - 128); }
    return j;
}
template <int MODE> __device__ __forceinline__ void transpose_item(const float* W, int K, int N, bf16* WT, const float* ks0, const float* ks1, float* scr, int item, int nblk, int lane) {
    const int kb = item / nblk, nb = item % nblk, k0 = 64 * kb, n0 = 32 * nb;
    const int src = colmap<MODE>(n0 + (lane & 31));
#pragma unroll
    for (int i = 0; i < 32; ++i) { const int kk = 2 * i + (lane >> 5); const int k = k0 + kk;
        float v = src >= 0 ? W[(size_t)k * N + src] : 0.f;
        if (ks0) v *= (k < 1024 ? ks0[k] : ks1[k - 1024]);
        scr[kk * 33 + (lane & 31)] = v; }
    asm volatile("s_waitcnt lgkmcnt(0)" ::: "memory");
    const int c = lane & 7;
#pragma unroll
    for (int j = 0; j < 4; ++j) { const int n = (lane >> 3) + 8 * j; const float* s = scr + (8 * c) * 33 + n;
        v4u o; o.x = pk2(s[0 * 33], s[1 * 33]); o.y = pk2(s[2 * 33], s[3 * 33]); o.z = pk2(s[4 * 33], s[5 * 33]); o.w = pk2(s[6 * 33], s[7 * 33]);
        *(v4u*)(WT + (size_t)(n0 + n) * K + k0 + 8 * c) = o; }
    asm volatile("s_waitcnt lgkmcnt(0)" ::: "memory");
}

template <int MODE> __device__ __forceinline__ void wg_transpose_item(const float* W, int K, int N, bf16* WT, const float* ks0, const float* ks1, unsigned char* lds, int k0, int n0, int tid) {
    float* T = (float*)lds;
    const int lane = tid & 63, wave = tid >> 6;
    const int src = colmap<MODE>(n0 + 4 * lane);
    f32x4 v[4];
#pragma unroll
    for (int r = 0; r < 4; ++r) { const int k = k0 + wave * 4 + r;
        v[r] = src >= 0 ? *(const f32x4*)(W + (size_t)k * N + src) : (f32x4){0.f, 0.f, 0.f, 0.f};
        if (ks0) v[r] *= (k < 1024 ? ks0[k] : ks1[k - 1024]); }
#pragma unroll
    for (int r = 0; r < 4; ++r) *(f32x4*)(T + (wave * 4 + r) * 260 + 4 * lane) = v[r];
    __syncthreads();
#pragma unroll
    for (int i = 0; i < 2; ++i) { const int pc = tid + i * NT, nn = pc >> 2, c = pc & 3; const float* t = T + (8 * c) * 260 + nn;
        v4u o; o.x = pk2(t[0 * 260], t[1 * 260]); o.y = pk2(t[2 * 260], t[3 * 260]); o.z = pk2(t[4 * 260], t[5 * 260]); o.w = pk2(t[6 * 260], t[7 * 260]);
        *(v4u*)(WT + (size_t)(n0 + nn) * K + k0 + 8 * c) = o; }
    __syncthreads();
}
__device__ __forceinline__ void sincos_d(double th, float& sn, float& cs) {
    const double k = rint(th * 0.15915494309189535); const double r = fma(-k, 6.283185307179586, th);
    const double t = r * 0.125, t2 = t * t;
    double s = t * (1.0 + t2 * (-1.0 / 6 + t2 * (1.0 / 120 + t2 * (-1.0 / 5040 + t2 * (1.0 / 362880 + t2 * (-1.0 / 39916800))))));
    double c = 1.0 + t2 * (-0.5 + t2 * (1.0 / 24 + t2 * (-1.0 / 720 + t2 * (1.0 / 40320 + t2 * (-1.0 / 3628800 + t2 * (1.0 / 479001600))))));
#pragma unroll
    for (int i = 0; i < 3; ++i) { const double s2 = 2.0 * s * c, c2 = 1.0 - 2.0 * s * s; s = s2; c = c2; }
    sn = (float)s; cs = (float)c;
}

__device__ __forceinline__ void s5_tables(const Args& a, int g, unsigned char* lds, int tid) {
    f32x2* pw = (f32x2*)lds;
    f32x2* Cc = pw + 17 * 64;
    f32x2* Bb = Cc + 16 * 64;
    float* Kt = (float*)(Bb + 64 * 16);
    unsigned char* ws = a.ws;
    if (tid < 64) {
        const int p = tid; const float lr = a.in[I_LRE][g * 64 + p], li = a.in[I_LIM][g * 64 + p]; const float st = expf(a.in[I_LSTEP][g]);
        float are = 1.f, aim = 0.f;
        for (int tau = 0; tau <= 16; ++tau) {
            const float mag = expf(lr * st * (float)tau); float sn, cs; sincos_d((double)li * (double)st * (double)tau, sn, cs);
            pw[tau * 64 + p] = (f32x2){mag * cs, mag * sn};
            if (tau == 1) { are = mag * cs; aim = mag * sn; ((f32x2*)(ws + WS_A1))[g * 64 + p] = (f32x2){are, aim}; }
            if (tau == 16) ((f32x2*)(ws + WS_A16))[g * 64 + p] = (f32x2){mag * cs, mag * sn};
        }
        const float den = lr * lr + li * li;
        const float cre = ((are - 1.0f) * lr + aim * li) / den, cim = (aim * lr - (are - 1.0f) * li) / den;
        f32x4 brv[4], biv[4];
#pragma unroll
        for (int h4 = 0; h4 < 4; ++h4) { brv[h4] = *(const f32x4*)(a.in[I_BRE] + (g * 64 + p) * 16 + 4 * h4); biv[h4] = *(const f32x4*)(a.in[I_BIM] + (g * 64 + p) * 16 + 4 * h4); }
#pragma unroll
        for (int h = 0; h < 16; ++h) { const float br = brv[h >> 2][h & 3], bi = biv[h >> 2][h & 3];
            const f32x2 v = (f32x2){cre * br - cim * bi, cre * bi + cim * br}; Bb[p * 16 + h] = v; ((f32x2*)(ws + WS_BBAR))[(g * 64 + p) * 16 + h] = v; }
    }
    for (int e = tid; e < 1024; e += NT) Cc[e] = (f32x2){a.in[I_CRE][g * 1024 + e], a.in[I_CIM][g * 1024 + e]};
    __syncthreads();
    {
        const int tau = tid >> 5, h = (tid >> 1) & 15, h0 = (tid & 1) * 8; float acc[8];
#pragma unroll
        for (int j = 0; j < 8; ++j) acc[j] = 0.f;
        for (int p = 0; p < 64; ++p) { const f32x2 c = Cc[h * 64 + p], w = pw[tau * 64 + p]; const float tr = c.x * w.x - c.y * w.y, ti = c.x * w.y + c.y * w.x;
#pragma unroll
            for (int j = 0; j < 8; ++j) { const f32x2 b = Bb[p * 16 + h0 + j]; acc[j] += tr * b.x - ti * b.y; } }
        if (tau == 0) {
#pragma unroll
            for (int j = 0; j < 8; ++j) if (h0 + j == h) acc[j] += a.in[I_DS5][g * 16 + h];
        }
#pragma unroll
        for (int j = 0; j < 8; ++j) Kt[(tau * 16 + h) * 16 + h0 + j] = acc[j];
    }
    __syncthreads();
    bf16* TB = (bf16*)(ws + WS_TB5) + (size_t)g * 256 * 384;
    for (int pc = tid; pc < 256 * 48; pc += NT) {
        const int row = pc / 48, c8 = (pc % 48) * 8, t = row >> 4, h = row & 15; float v[8];
        if (c8 < 256) { const int s = c8 >> 4, h0 = c8 & 15;
#pragma unroll
            for (int j = 0; j < 8; ++j) v[j] = s <= t ? Kt[((t - s) * 16 + h) * 16 + h0 + j] : 0.f;
        } else { const int p0 = (c8 - 256) >> 1;
#pragma unroll
            for (int j = 0; j < 4; ++j) { const f32x2 c = Cc[h * 64 + p0 + j], w = pw[(t + 1) * 64 + p0 + j]; v[2 * j] = c.x * w.x - c.y * w.y; v[2 * j + 1] = -(c.x * w.y + c.y * w.x); }
        }
        v4u o; o.x = pk2(v[0], v[1]); o.y = pk2(v[2], v[3]); o.z = pk2(v[4], v[5]); o.w = pk2(v[6], v[7]);
        *(v4u*)(TB + (size_t)row * 384 + c8) = o;
    }
    bf16* TE = (bf16*)(ws + WS_TE5) + (size_t)g * 256 * 256;
    for (int pc = tid; pc < 256 * 32; pc += NT) {
        const int row = pc >> 5, c8 = (pc & 31) * 8; float v[8];
        if (row < 128) { const int p = row >> 1, ri = row & 1, s = c8 >> 4, h0 = c8 & 15; const f32x2 w = pw[(15 - s) * 64 + p];
#pragma unroll
            for (int j = 0; j < 8; ++j) { const f32x2 b = Bb[p * 16 + h0 + j]; v[j] = ri ? (w.x * b.y + w.y * b.x) : (w.x * b.x - w.y * b.y); }
        } else {
#pragma unroll
            for (int j = 0; j < 8; ++j) v[j] = 0.f;
        }
        v4u o; o.x = pk2(v[0], v[1]); o.y = pk2(v[2], v[3]); o.z = pk2(v[4], v[5]); o.w = pk2(v[6], v[7]);
        *(v4u*)(TE + (size_t)row * 256 + c8) = o;
    }
    __syncthreads();
}

__device__ __forceinline__ void rms_row_to_bf16(const float* xrow, const float* gain, bf16* orow, int lane) {
    unsigned long long* o8 = (unsigned long long*)orow + lane;
    if (!xrow) {
#pragma unroll
        for (int j = 0; j < 4; ++j) o8[64 * j] = 0ull;
        return; }
    const f32x4* xr = (const f32x4*)xrow + lane; const f32x4* gr = (const f32x4*)gain + lane;
    f32x4 v[4]; float s = 0.f;
#pragma unroll
    for (int j = 0; j < 4; ++j) { v[j] = xr[64 * j]; s += (v[j].x * v[j].x + v[j].y * v[j].y) + (v[j].z * v[j].z + v[j].w * v[j].w); }
    const float rstd = 1.f / sqrtf(wave_sum(s) * (1.f / 1024.f) + EPS);
#pragma unroll
    for (int j = 0; j < 4; ++j) { const f32x4 gg = gr[64 * j]; const f32x4 w = v[j] * rstd * gg; o8[64 * j] = (unsigned long long)pk2(w.x, w.y) | ((unsigned long long)pk2(w.z, w.w) << 32); }
}

__device__ __forceinline__ void p0_prologue(const Args& a, unsigned char* lds, int tid, int G) {
    unsigned char* ws = a.ws; const int lane = tid & 63, wave = tid >> 6;
    const int gw = blockIdx.x * NWAVES + wave, NGW = G * NWAVES;
    for (int i = blockIdx.x * NT + tid; i < 4 * 16384; i += G * NT) ((float*)(ws + WS_SS))[i] = 0.f;
    for (int g = (G - 1 - (int)blockIdx.x); g < 64; g += G) s5_tables(a, g, lds, tid);
    __syncthreads();
    float* scr = (float*)(lds + wave * 16384);
    constexpr int NB_IN = NIN / 32, NB_GL = 2048 / 32;
    constexpr int I_IN = 16 * NB_IN, I_GL = 16 * NB_GL;
    for (int it = blockIdx.x; it < 480 + 256; it += G) {
        if (it < 480) wg_transpose_item<1>(a.in[I_WIN], 1024, 3600, (bf16*)(ws + WS_WIN), nullptr, nullptr, lds, (it / 15) * 32, (it % 15) * 256, tid);
        else { const int j = it - 480; wg_transpose_item<2>(a.in[I_WGLU], 1024, 2048, (bf16*)(ws + WS_WGLU), nullptr, nullptr, lds, (j >> 3) * 32, (j & 7) * 256, tid); }
    }
    for (int m0 = gw; m0 < MR; m0 += 8 * NGW) {
        const f32x4* gr = (const f32x4*)a.in[I_GMIX] + lane; f32x4 v[8][4];
#pragma unroll
        for (int k = 0; k < 8; ++k) { const int m = m0 + k * NGW; const f32x4* xr = (const f32x4*)(a.in[I_X] + (size_t)(m < MR ? m : m0) * 1024) + lane;
#pragma unroll
            for (int j = 0; j < 4; ++j) v[k][j] = xr[64 * j]; }
        f32x4 gg[4];
#pragma unroll
        for (int j = 0; j < 4; ++j) gg[j] = gr[64 * j];
#pragma unroll
        for (int k = 0; k < 8; ++k) { const int m = m0 + k * NGW; float sq = 0.f;
#pragma unroll
            for (int j = 0; j < 4; ++j) sq += (v[k][j].x * v[k][j].x + v[k][j].y * v[k][j].y) + (v[k][j].z * v[k][j].z + v[k][j].w * v[k][j].w);
            const float rstd = 1.f / sqrtf(wave_sum(sq) * (1.f / 1024.f) + EPS);
            if (m < MR) { unsigned long long* o8 = (unsigned long long*)((bf16*)(ws + WS_XN) + (size_t)m * 1024) + lane;
#pragma unroll
                for (int j = 0; j < 4; ++j) { const f32x4 w = v[k][j] * rstd * gg[j]; o8[64 * j] = (unsigned long long)pk2(w.x, w.y) | ((unsigned long long)pk2(w.z, w.w) << 32); } }
        }
    }
    for (int m = MR + gw; m < MP; m += NGW)
        rms_row_to_bf16(m < MR + 16 ? a.in[I_META] + (size_t)(m - MR) * 1024 : nullptr, a.in[I_GMIX], (bf16*)(ws + WS_XN) + (size_t)m * 1024, lane);
}
__device__ __forceinline__ void p6_weights(const Args& a, unsigned char* lds, int tid, int G) {
    unsigned char* ws = a.ws; const int lane = tid & 63, wave = tid >> 6;
    const int gw = blockIdx.x * NWAVES + wave, NGW = G * NWAVES;
    float* scr = (float*)(lds + wave * 16384);
    for (int it = blockIdx.x; it < 1280; it += G) {
        if (it < 256) wg_transpose_item<0>(a.in[I_WOUT], 2048, 1024, (bf16*)(ws + WS_WOUT), a.in[I_GSSD], a.in[I_GS5], lds, (it >> 2) * 32, (it & 3) * 256, tid);
        else if (it < 768) { const int j = it - 256; wg_transpose_item<0>(a.in[I_WUP], 1024, 4096, (bf16*)(ws + WS_WUP), a.in[I_GMLP], a.in[I_GMLP], lds, (j >> 4) * 32, (j & 15) * 256, tid); }
        else { const int j = it - 768; wg_transpose_item<0>(a.in[I_WDN], 4096, 1024, (bf16*)(ws + WS_WDN), nullptr, nullptr, lds, (j >> 2) * 32, (j & 3) * 256, tid); }
    }
    __syncthreads();
}

__device__ __forceinline__ int chunk_row(int q, int tok) {
    if (q == 0) return tok < 240 ? -1 : MR + (tok - 240);
    const int b = (q - 1) >> 5, c = (q - 1) & 31;
    if (tok < 0 && c == 0) return MR + 16 + tok;
    return b * 8192 + c * 256 + tok;
}
__device__ __forceinline__ float silu_(float x) { return x * __builtin_amdgcn_rcpf(1.0f + ex2(-1.44269504f * x)); }
__device__ __forceinline__ void p2_conv_unit(const Args& a, int q, int blk, unsigned char* lds, int tid) {
    unsigned char* ws = a.ws;
    bf16* IN = (bf16*)lds;
    bf16* OT = (bf16*)(lds + 40960);
    const bf16* XBCP = (const bf16*)(ws + WS_XBCP);
    const int ch0 = blk * 64;
    for (int pc = tid; pc < 259 * 8; pc += NT) { const int rr = pc >> 3, c8 = (pc & 7) * 8; const int row = chunk_row(q, rr - 3);
        v4u v = (v4u){0u, 0u, 0u, 0u}; if (row >= 0) v = *(const v4u*)(XBCP + (size_t)row * 1536 + ch0 + c8);
        *(v4u*)(IN + rr * 64 + c8) = v; }
    __syncthreads();
    const float* cw = a.in[I_CONVW]; const float* cb = a.in[I_CONVB];
    const bool is_x = blk < 16, is_b = blk >= 16 && blk < 20;
    if (!is_x) {
        bf16* dst = (bf16*)(ws + (is_b ? WS_BTK : WS_CT)) + (size_t)q * 65536 + (is_b ? (blk - 16) : (blk - 20)) * 64;
        const int c8 = (tid & 7) * 8; float wreg[4][8], breg[8];
#pragma unroll
        for (int j = 0; j < 8; ++j) { breg[j] = cb[ch0 + c8 + j];
#pragma unroll
            for (int k = 0; k < 4; ++k) wreg[k][j] = cw[k * 1536 + ch0 + c8 + j]; }
        for (int pc = tid; pc < 256 * 8; pc += NT) { const int tok = pc >> 3; float o[8];
            const bool zero = (q == 0 && tok < 240);
#pragma unroll
            for (int j = 0; j < 8; ++j) o[j] = breg[j];
#pragma unroll
            for (int k = 0; k < 4; ++k) { const v4u v = *(const v4u*)(IN + (tok + k) * 64 + c8); const unsigned w[4] = {v.x, v.y, v.z, v.w};
#pragma unroll
                for (int j = 0; j < 4; ++j) { o[2 * j] += wreg[k][2 * j] * bflo(w[j]); o[2 * j + 1] += wreg[k][2 * j + 1] * bfhi(w[j]); } }
#pragma unroll
            for (int j = 0; j < 8; ++j) o[j] = zero ? 0.f : silu_(o[j]);
            v4u ov; ov.x = pk2(o[0], o[1]); ov.y = pk2(o[2], o[3]); ov.z = pk2(o[4], o[5]); ov.w = pk2(o[6], o[7]);
            *(v4u*)(dst + (size_t)tok * 256 + c8) = ov; }
    }
    if (is_x || is_b) {
        const int ch = tid & 63; float wk[4]; const float bias = cb[ch0 + ch];
#pragma unroll
        for (int k = 0; k < 4; ++k) wk[k] = cw[k * 1536 + ch0 + ch];
        for (int it = tid; it < 64 * 32; it += NT) { const int t0 = (it >> 6) * 8; float in[11], o[8];
#pragma unroll
            for (int j = 0; j < 11; ++j) in[j] = bf2f(IN[(t0 + j) * 64 + ch]);
#pragma unroll
            for (int j = 0; j < 8; ++j) { const float v = bias + wk[0] * in[j] + wk[1] * in[j + 1] + wk[2] * in[j + 2] + wk[3] * in[j + 3]; o[j] = (q == 0 && t0 + j < 240) ? 0.f : silu_(v); }
            v4u ov; ov.x = pk2(o[0], o[1]); ov.y = pk2(o[2], o[3]); ov.z = pk2(o[4], o[5]); ov.w = pk2(o[6], o[7]);
            *(v4u*)(OT + ch * 264 + t0) = ov; }
        __syncthreads();
        bf16* dst = is_x ? (bf16*)(ws + WS_XF) + ((size_t)q * 1024 + ch0) * 256 : (bf16*)(ws + WS_BF) + ((size_t)q * 256 + (blk - 16) * 64) * 256;
        for (int pc = tid; pc < 64 * 32; pc += NT) { const int ch = pc >> 5, t8 = (pc & 31) * 8; *(v4u*)(dst + (size_t)ch * 256 + t8) = *(const v4u*)(OT + ch * 264 + t8); }
    }
    __syncthreads();
}
__device__ __forceinline__ void p2_dt_item(const Args& a, int q, int h, int lane) {
    unsigned char* ws = a.ws; const float* DTRAW = (const float*)(ws + WS_DTRAW);
    const float bias = a.in[I_DTB][h], A = -expf(a.in[I_ALOG][h]);
    float dt[4], cs[4]; float run = 0.f;
    int rows[4]; float raw[4];
#pragma unroll
    for (int j = 0; j < 4; ++j) { rows[j] = chunk_row(q, 4 * lane + j); raw[j] = DTRAW[(size_t)(rows[j] < 0 ? 0 : rows[j]) * 16 + h]; }
#pragma unroll
    for (int j = 0; j < 4; ++j) { const float x = raw[j] + bias; float d = fmaxf(x, 0.f) + __logf(1.0f + expf_(-fabsf(x))); if (rows[j] < 0) d = 0.f;
        dt[j] = d; run += d * A; cs[j] = run; }
    float incl = run;
#pragma unroll
    for (int o = 1; o < 64; o <<= 1) { const float t = __shfl_up(incl, o); if (lane >= o) incl += t; }
    const float excl = incl - run;
    float* DT = (float*)(ws + WS_DT) + ((size_t)q * 16 + h) * 256 + 4 * lane; float* ACS = (float*)(ws + WS_ACS) + ((size_t)q * 16 + h) * 256 + 4 * lane;
    *(f32x4*)DT = (f32x4){dt[0], dt[1], dt[2], dt[3]}; *(f32x4*)ACS = (f32x4){cs[0] + excl, cs[1] + excl, cs[2] + excl, cs[3] + excl};
    if (lane == 63) ((float*)(ws + WS_DEC))[q * 16 + h] = expf_(cs[3] + excl);
}

#define MFMA16(A, B, C) __builtin_amdgcn_mfma_f32_16x16x32_bf16(A, B, C, 0, 0, 0)
__device__ __forceinline__ void p3_states_unit(const Args& a, int q, int g, int nh, int tid) {
    unsigned char* ws = a.ws; const int lane = tid & 63, r = __builtin_amdgcn_readfirstlane(tid >> 6), h = g * 8 + r, fr = lane & 15, fq = lane >> 4;
    const bf16* XF = (const bf16*)(ws + WS_XF) + ((size_t)q * 1024 + h * 64) * 256;
    const bf16* BF = (const bf16*)(ws + WS_BF) + ((size_t)q * 256 + g * 128) * 256;
    const float* DT = (const float*)(ws + WS_DT) + ((size_t)q * 16 + h) * 256; const float* ACS = (const float*)(ws + WS_ACS) + ((size_t)q * 16 + h) * 256;
    const float alast = ACS[255];
    bf16* ST = (bf16*)(ws + WS_ST) + ((size_t)q * 16 + h) * 8192;
    {
        f32x4 acc[4][4];
#pragma unroll
        for (int i = 0; i < 4; ++i)
#pragma unroll
            for (int j = 0; j < 4; ++j) acc[i][j] = (f32x4){0.f, 0.f, 0.f, 0.f};
#pragma unroll 2
        for (int kb = 0; kb < 8; ++kb) {
            const int s0 = kb * 32 + fq * 8;
            float w[8];
            { const f32x4 d0 = *(const f32x4*)(DT + s0), d1 = *(const f32x4*)(DT + s0 + 4), c0 = *(const f32x4*)(ACS + s0), c1 = *(const f32x4*)(ACS + s0 + 4);
#pragma unroll
              for (int j = 0; j < 4; ++j) { w[j] = expf_(alast - c0[j]) * d0[j]; w[4 + j] = expf_(alast - c1[j]) * d1[j]; } }
            bf16x8 Af[4], Bf[4];
#pragma unroll
            for (int i = 0; i < 4; ++i) { const v4u v = *(const v4u*)(XF + (size_t)(i * 16 + fr) * 256 + s0);
                v4u o; o.x = pk2(bflo(v.x) * w[0], bfhi(v.x) * w[1]); o.y = pk2(bflo(v.y) * w[2], bfhi(v.y) * w[3]); o.z = pk2(bflo(v.z) * w[4], bfhi(v.z) * w[5]); o.w = pk2(bflo(v.w) * w[6], bfhi(v.w) * w[7]);
                Af[i] = __builtin_bit_cast(bf16x8, o); }
#pragma unroll
            for (int j = 0; j < 4; ++j) Bf[j] = *(const bf16x8*)(BF + (size_t)((nh * 4 + j) * 16 + fr) * 256 + s0);
#pragma unroll
            for (int i = 0; i < 4; ++i)
#pragma unroll
                for (int j = 0; j < 4; ++j) acc[i][j] = MFMA16(Bf[j], Af[i], acc[i][j]);
        }
#pragma unroll
        for (int i = 0; i < 4; ++i)
#pragma unroll
            for (int j = 0; j < 4; ++j) { v2u o; o.x = pk2(acc[i][j][0], acc[i][j][1]); o.y = pk2(acc[i][j][2], acc[i][j][3]);
                *(v2u*)(ST + (i * 16 + fr) * 128 + (nh * 4 + j) * 16 + fq * 4) = o; }
    }
}

__device__ __forceinline__ void p4_ssd_scan_item(const Args& a, int item, int tid) {
    unsigned char* ws = a.ws; const int e = item * 1024 + tid * 2;
    const int b = e >> 17, hpn = e & 131071, h = hpn >> 13;
    const bf16* ST = (const bf16*)(ws + WS_ST); bf16* PREV = (bf16*)(ws + WS_PREV); const float* DEC = (const float*)(ws + WS_DEC);
    unsigned st[32]; float dec[32];
    st[0] = *(const unsigned*)(ST + hpn); dec[0] = 0.f;
#pragma unroll
    for (int k = 1; k < 32; ++k) { const int q = b * 32 + k; st[k] = *(const unsigned*)(ST + (size_t)q * 131072 + hpn); dec[k] = DEC[q * 16 + h]; }
    float s0 = bflo(st[0]), s1 = bfhi(st[0]);
#pragma unroll
    for (int c = 0; c < 32; ++c) {
        *(unsigned*)(PREV + (size_t)(b * 32 + c) * 131072 + hpn) = pk2(s0, s1);
        if (c < 31) { const float d = dec[c + 1]; const unsigned v = st[c + 1]; s0 = s0 * d + bflo(v); s1 = s1 * d + bfhi(v); }
    }
}
__device__ __forceinline__ void p4_s5_scan_item(const Args& a, int item, unsigned char* lds, int tid) {
    unsigned char* ws = a.ws; const int b = item >> 7, g = (item >> 1) & 63, p = (item & 1) * 32 + (tid & 31), seg = tid >> 5;
    const f32x2 a1 = ((const f32x2*)(ws + WS_A1))[g * 64 + p], a16 = ((const f32x2*)(ws + WS_A16))[g * 64 + p];
    const f32x2* Bb = (const f32x2*)(ws + WS_BBAR) + (size_t)(g * 64 + p) * 16;
    const bf16* UM = (const bf16*)(ws + WS_UMETA);
    const f32x2* SE = (const f32x2*)(ws + WS_SEND) + ((size_t)(g * 1024 + b * 512 + seg * 32) * 64 + p);
    f32x2 se[32];
#pragma unroll
    for (int j = 0; j < 32; ++j) se[j] = SE[(size_t)j * 64];
    float sr = 0.f, si = 0.f;
    f32x2 bbv[16];
#pragma unroll
    for (int h = 0; h < 16; ++h) bbv[h] = Bb[h];
    for (int s = 0; s < 16; ++s) { float br = 0.f, bi = 0.f;
        const v4u u0 = *(const v4u*)(UM + s * 1024 + g * 16), u1 = *(const v4u*)(UM + s * 1024 + g * 16 + 8); const unsigned uw[8] = {u0.x, u0.y, u0.z, u0.w, u1.x, u1.y, u1.z, u1.w};
#pragma unroll
        for (int h = 0; h < 16; ++h) { const float u = (h & 1) ? bfhi(uw[h >> 1]) : bflo(uw[h >> 1]); const f32x2 bb = bbv[h]; br += bb.x * u; bi += bb.y * u; }
        const float nr = a1.x * sr - a1.y * si + br, ni = a1.x * si + a1.y * sr + bi; sr = nr; si = ni; }
    float er = 0.f, ei = 0.f;
#pragma unroll
    for (int j = 0; j < 32; ++j) { const float nr = a16.x * er - a16.y * ei + se[j].x, ni = a16.x * ei + a16.y * er + se[j].y; er = nr; ei = ni; }
    f32x2* EL = (f32x2*)lds;
    EL[seg * 32 + (tid & 31)] = (f32x2){er, ei};
    float pr = a16.x, pi = a16.y;
#pragma unroll
    for (int k = 0; k < 5; ++k) { const float nr = pr * pr - pi * pi, ni = 2.f * pr * pi; pr = nr; pi = ni; }
    __syncthreads();
    for (int k = 0; k < seg; ++k) { const f32x2 ek = EL[k * 32 + (tid & 31)]; const float nr = pr * sr - pi * si + ek.x, ni = pr * si + pi * sr + ek.y; sr = nr; si = ni; }
    unsigned* UA = (unsigned*)((bf16*)(ws + WS_UA) + ((size_t)(g * 1024 + b * 512 + seg * 32) * 384 + 256 + 2 * p));
#pragma unroll
    for (int j = 0; j < 32; ++j) { UA[(size_t)j * 192] = pk2(sr, si);
        const float nr = a16.x * sr - a16.y * si + se[j].x, ni = a16.x * si + a16.y * sr + se[j].y; sr = nr; si = ni; }
    __syncthreads();
}

__device__ __forceinline__ void p5_ssd_out_unit(const Args& a, int q, int g, int half, unsigned char* lds, int tid) {
    unsigned char* ws = a.ws; const int lane = tid & 63, r = __builtin_amdgcn_readfirstlane(tid >> 6), h = g * 8 + r, fr = lane & 15, fq = lane >> 4;
    bf16* CBs = (bf16*)lds;
    float* ACSs = (float*)(lds + 256 * 264 * 2);
    float* DTs = ACSs + 8 * 256;
    const bf16* CT = (const bf16*)(ws + WS_CT) + (size_t)q * 65536 + g * 128;
    const bf16* BTK = (const bf16*)(ws + WS_BTK) + (size_t)q * 65536 + g * 128;
    for (int i = tid; i < 2048; i += NT) { ACSs[i] = ((const float*)(ws + WS_ACS))[((size_t)q * 16 + g * 8) * 256 + i]; DTs[i] = ((const float*)(ws + WS_DT))[((size_t)q * 16 + g * 8) * 256 + i]; }
    {
        const int c1 = half ? 5 : 1, c2 = half ? 11 : 3, c3 = half ? 18 : 6, c4 = half ? 26 : 10, c5 = half ? 35 : 23, c6 = half ? 45 : 37, c7 = half ? 56 : 52;
#pragma unroll 3
        for (int mm = 0; mm < 9; ++mm) {
            const int n = r + 8 * mm;
            if (n < 68) {
                const int ti = (n >= c1) + (n >= c2) + (n >= c3) + (n >= c4) + (n >= c5) + (n >= c6) + (n >= c7);
                const int cb = ti == 0 ? 0 : ti == 1 ? c1 : ti == 2 ? c2 : ti == 3 ? c3 : ti == 4 ? c4 : ti == 5 ? c5 : ti == 6 ? c6 : c7;
                const int stl = n - cb, lt = half ? 4 + ti : (ti < 4 ? ti : 8 + ti);
                f32x4 c = (f32x4){0.f, 0.f, 0.f, 0.f};
#pragma unroll
                for (int k = 0; k < 4; ++k) { const bf16x8 Af = *(const bf16x8*)(CT + (size_t)(lt * 16 + fr) * 256 + k * 32 + fq * 8);
                    const bf16x8 Bf = *(const bf16x8*)(BTK + (size_t)(stl * 16 + fr) * 256 + k * 32 + fq * 8); c = MFMA16(Af, Bf, c); }
#pragma unroll
                for (int e = 0; e < 4; ++e) CBs[(lt * 16 + fq * 4 + e) * 264 + stl * 16 + fr] = (bf16)f2bf(c[e]);
            }
        }
    }
    __syncthreads();
    const bf16* XF = (const bf16*)(ws + WS_XF) + ((size_t)q * 1024 + h * 64) * 256;
    const bf16* PREV = (const bf16*)(ws + WS_PREV) + ((size_t)(q - 1) * 16 + h) * 8192;
    const float* acs = ACSs + r * 256; const float* dts = DTs + r * 256;
    const float dsk = a.in[I_DSSD][h];
    const int b = (q - 1) >> 5, c = (q - 1) & 31; const int m0 = b * 8192 + c * 256;
    bf16* MIX = (bf16*)(ws + WS_MIX); float* SSS = (float*)(ws + WS_SS);
#pragma unroll 1
    for (int lbi = 0; lbi < 2; ++lbi) {
        const int lb = half ? 1 + lbi : 3 * lbi;
        f32x4 acc[4][4];
#pragma unroll
        for (int i = 0; i < 4; ++i)
#pragma unroll
            for (int j = 0; j < 4; ++j) acc[i][j] = (f32x4){0.f, 0.f, 0.f, 0.f};
#pragma unroll 2
        for (int k = 0; k < 4; ++k) { bf16x8 Af[4], Bf[4];
#pragma unroll
            for (int i = 0; i < 4; ++i) Af[i] = *(const bf16x8*)(CT + (size_t)(lb * 64 + i * 16 + fr) * 256 + k * 32 + fq * 8);
#pragma unroll
            for (int j = 0; j < 4; ++j) Bf[j] = *(const bf16x8*)(PREV + (size_t)(j * 16 + fr) * 128 + k * 32 + fq * 8);
#pragma unroll
            for (int i = 0; i < 4; ++i)
#pragma unroll
                for (int j = 0; j < 4; ++j) acc[i][j] = MFMA16(Bf[j], Af[i], acc[i][j]); }
#pragma unroll
        for (int i = 0; i < 4; ++i) { const float sc = expf_(acs[lb * 64 + i * 16 + fr]);
#pragma unroll
            for (int j = 0; j < 4; ++j) acc[i][j] *= sc; }
        const int nsb = 2 * lb + 2;
#pragma unroll 1
        for (int sb = 0; sb < nsb; ++sb) {
            const int s0 = sb * 32 + fq * 8;
            bf16x8 Bf[4];
#pragma unroll
            for (int j = 0; j < 4; ++j) Bf[j] = *(const bf16x8*)(XF + (size_t)(j * 16 + fr) * 256 + s0);
            float as[8], ds[8];
#pragma unroll
            for (int j = 0; j < 8; ++j) { as[j] = acs[s0 + j]; ds[j] = dts[s0 + j]; }
            float fs[8];
#pragma unroll
            for (int j = 0; j < 8; ++j) fs[j] = expf_(as[7] - as[j]) * ds[j];
#pragma unroll
            for (int i = 0; i < 4; ++i) {
                const int l = lb * 64 + i * 16 + fr;
                if (sb * 32 > lb * 64 + i * 16 + 15) continue;
                const float al = acs[l];
                const v4u v = *(const v4u*)(CBs + l * 264 + s0); const unsigned w4[4] = {v.x, v.y, v.z, v.w}; float pv[8];
                if (sb * 32 + 31 < lb * 64 + i * 16) {
                    const float gl = expf_(al - as[7]);
#pragma unroll
                    for (int j = 0; j < 4; ++j) { pv[2 * j] = bflo(w4[j]) * (gl * fs[2 * j]); pv[2 * j + 1] = bfhi(w4[j]) * (gl * fs[2 * j + 1]); }
                } else
#pragma unroll
                for (int j = 0; j < 4; ++j) {
                    const float p0 = bflo(w4[j]) * expf_(fminf(al - as[2 * j], 0.f)) * ds[2 * j], p1 = bfhi(w4[j]) * expf_(fminf(al - as[2 * j + 1], 0.f)) * ds[2 * j + 1];
                    const int sa = s0 + 2 * j, sbq = sa + 1;
                    pv[2 * j] = (sa < l) ? p0 : (sa == l ? p0 + dsk : 0.f); pv[2 * j + 1] = (sbq < l) ? p1 : (sbq == l ? p1 + dsk : 0.f); }
                v4u o; o.x = pk2(pv[0], pv[1]); o.y = pk2(pv[2], pv[3]); o.z = pk2(pv[4], pv[5]); o.w = pk2(pv[6], pv[7]);
                const bf16x8 Af = __builtin_bit_cast(bf16x8, o);
#pragma unroll
                for (int j = 0; j < 4; ++j) acc[i][j] = MFMA16(Bf[j], Af, acc[i][j]);
            }
        }
#pragma unroll
        for (int i = 0; i < 4; ++i) {
            const int l = lb * 64 + i * 16 + fr; float ssq = 0.f;
            bf16* zrow = MIX + (size_t)(m0 + l) * 2048 + h * 64 + fq * 4;
#pragma unroll
            for (int j = 0; j < 4; ++j) {
                const v2u zv = *(const v2u*)(zrow + j * 16);
                const float y0 = acc[i][j][0] * silu_(bflo(zv.x)), y1 = acc[i][j][1] * silu_(bfhi(zv.x)), y2 = acc[i][j][2] * silu_(bflo(zv.y)), y3 = acc[i][j][3] * silu_(bfhi(zv.y));
                v2u o; o.x = pk2(y0, y1); o.y = pk2(y2, y3); *(v2u*)(zrow + j * 16) = o;
                ssq += (y0 * y0 + y1 * y1) + (y2 * y2 + y3 * y3);
            }
            ssq += __shfl_xor(ssq, 16); ssq += __shfl_xor(ssq, 32);
            if (fq == 0) atomicAdd(SSS + m0 + l, ssq);
        }
    }
    __syncthreads();
}

__device__ __forceinline__ void p10_final(const Args& a, int tid, int G) {
    const int lane = tid & 63, wave = tid >> 6; const int gw = blockIdx.x * NWAVES + wave, NGW = G * NWAVES;
    const float* SSF = (const float*)(a.ws + WS_SS) + 3 * 16384; const f32x4* gf = (const f32x4*)a.in[I_GFIN] + lane;
    for (int m = gw; m < MR; m += NGW) { f32x4* row = (f32x4*)(a.out + (size_t)m * 1024) + lane; const float rs = 1.0f / sqrtf(SSF[m] * (1.0f / 1024.0f) + EPS);
#pragma unroll
        for (int j = 0; j < 4; ++j) row[64 * j] = row[64 * j] * rs * gf[64 * j]; }
}

__global__ void __launch_bounds__(NT, 2) fwd_kernel(Args args) {
    extern __shared__ __attribute__((aligned(16))) unsigned char lds[];
    cg::grid_group grid = cg::this_grid();
    const int tid = threadIdx.x, G = gridDim.x, bx = blockIdx.x;
    unsigned char* ws = args.ws;
    PG8_LAS unsigned char* ldsl = (PG8_LAS unsigned char*)lds;
    const int lo = args.ph_lo, hi = args.ph_hi;
#ifndef SKIPMASK
#define SKIPMASK 0
#endif
#define IN(k) (!((SKIPMASK >> (k)) & 1) && lo <= (k) && (k) < hi)
    volatile LAS unsigned* bst = (volatile LAS unsigned*)(ldsl + 155136);
    if (tid < 2) bst[tid] = 0u;
    __syncthreads();
    XcdBarrier xbar = xcd_barrier_post((unsigned*)(ws + WS_BAR), bst);
#define SEAM(k) do { if (IN(k) && IN((k) + 1)) { if ((k) == 0) grid.sync(); else xcd_barrier(xbar); } } while (0)
    float* SS = (float*)(ws + WS_SS);
    if (IN(0)) { const int tid = pg8::fresh_tid(); p0_prologue(args, lds, tid, G); }
    SEAM(0);
    if (IN(1)) {
        pg8::Gemm g{(const bf16*)(ws + WS_XN), (const bf16*)(ws + WS_WIN), MP, NIN, 1024, 1024, 1024, 0, 0}; pg8::StaticOrder S; S.init(MP, NIN, G, bx);
        pg8::EpiInProj E{(bf16*)(ws + WS_MIX), (bf16*)(ws + WS_XBCP), (bf16*)(ws + WS_UA), (bf16*)(ws + WS_UMETA), (float*)(ws + WS_DTRAW)};
        pg8::gemm_phase<pg8::EpiInProj, pg8::StaticOrder, true, true>(ldsl, g, S, E);
    }
    SEAM(1);
    if (IN(2)) {
        const int tid = pg8::fresh_tid(), wave = tid >> 6, lane = tid & 63;
        for (int u = bx; u < NQ * 24; u += G) p2_conv_unit(args, u / 24, u % 24, lds, tid);
        for (int it = (G - 1 - bx) * NWAVES + wave; it < NQ * 16; it += G * NWAVES) p2_dt_item(args, it >> 4, it & 15, lane);
    }
    SEAM(2);
    const int nS3 = (G / 2 < 126) ? G / 2 : 126;
    if (IN(3)) {
        const int tid = pg8::fresh_tid();
        for (int u = bx; u < 252; u += G) { const int qi = u >> 2; p3_states_unit(args, qi < 32 ? qi : qi + 1, (u >> 1) & 1, u & 1, tid); }
        pg8::Gemm g{(const bf16*)(ws + WS_UA), (const bf16*)(ws + WS_TE5), 1024, 256, 256, 384, 256, (size_t)1024 * 384 * 2, (size_t)256 * 256 * 2};
        pg8::BatchOrder S; S.init(256, 4, G, 0, bx);
        pg8::EpiS5a E{(float*)(ws + WS_SEND)};
        pg8::gemm_phase<pg8::EpiS5a, pg8::BatchOrder, true, true>(ldsl, g, S, E);
    }
    SEAM(3);
    if (IN(4)) {
        const int tid = pg8::fresh_tid();
        for (int it = bx; it < 512; it += G) { if (it < 256) p4_s5_scan_item(args, it, lds, tid); else p4_ssd_scan_item(args, it - 256, tid); }
    }
    SEAM(4);
    if (IN(5)) {
        const int tid = pg8::fresh_tid();
#ifndef NO_SSDOUT
        for (int u = bx; u < 256; u += G) p5_ssd_out_unit(args, 1 + (u >> 2), (u >> 1) & 1, u & 1, lds, tid);
        __syncthreads();
#endif
        pg8::Gemm g{(const bf16*)(ws + WS_UA), (const bf16*)(ws + WS_TB5), 1024, 256, 384, 384, 384, (size_t)1024 * 384 * 2, (size_t)256 * 384 * 2};
        pg8::BatchOrder S; S.init(256, 4, G, 0, bx);
        pg8::EpiS5b E{(bf16*)(ws + WS_Y5)};
        pg8::gemm_phase<pg8::EpiS5b, pg8::BatchOrder, true, true>(ldsl, g, S, E);
    }
    SEAM(5);
    if (IN(6)) {
        const int tid = pg8::fresh_tid();
        p6_weights(args, lds, tid, G);
        pg8::Gemm g{(const bf16*)(ws + WS_Y5), (const bf16*)(ws + WS_WGLU), MR, 2048, 1024, 1024, 1024, 0, 0}; pg8::StaticOrder S; S.init(MR, 2048, G, bx);
        pg8::EpiGlu E{(bf16*)(ws + WS_MIX), args.in[I_BGLU], SS + 16384};
        pg8::gemm_phase<pg8::EpiGlu, pg8::StaticOrder, true, true>(ldsl, g, S, E);
    }
    SEAM(6);
    if (IN(7)) {
        pg8::Gemm g{(const bf16*)(ws + WS_MIX), (const bf16*)(ws + WS_WOUT), MR, 1024, 1024, 2048, 2048, 0, 0, (size_t)1024 * 2, (size_t)1024 * 2};
        pg8::SplitKOrder S; S.base.init(MR, 1024, G, bx);
        pg8::EpiOut E{args.in[I_X], args.out, (bf16*)(ws + WS_H1B), SS, SS + 16384, SS + 2 * 16384};
        pg8::gemm_phase<pg8::EpiOut, pg8::SplitKOrder, true, true>(ldsl, g, S, E);
    }
    SEAM(7);
    if (IN(8)) {
        pg8::Gemm g{(const bf16*)(ws + WS_H1B), (const bf16*)(ws + WS_WUP), MR, 4096, 1024, 1024, 1024, 0, 0}; pg8::StaticOrder S; S.init(MR, 4096, G, bx);
        pg8::EpiUp E{(bf16*)(ws + WS_HB), SS + 2 * 16384};
        pg8::gemm_phase<pg8::EpiUp, pg8::StaticOrder, true, true>(ldsl, g, S, E);
    }
    SEAM(8);
    const int fused_fin = (G == 256 && lo <= 9 && hi >= 11) ? 1 : 0;
    if (IN(9)) {
        pg8::Gemm g{(const bf16*)(ws + WS_HB), (const bf16*)(ws + WS_WDN), MR, 1024, 4096, 4096, 4096, 0, 0}; pg8::StaticOrder S; S.init(MR, 1024, G, bx);
        pg8::EpiDown E{args.out, SS + 3 * 16384, (unsigned*)(ws + WS_BAR) + 3584, args.in[I_GFIN], fused_fin, (const bf16*)(ws + WS_H1B)};
        pg8::gemm_phase<pg8::EpiDown, pg8::StaticOrder, true, true>(ldsl, g, S, E);
    }
    if (!fused_fin) {
        SEAM(9);
        if (IN(10)) { const int tid = pg8::fresh_tid(); p10_final(args, tid, G); }
    }
#undef IN
#undef SEAM
}

#ifndef N_LAUNCHES
#define N_LAUNCHES 1
#endif
extern "C" void kernel_launch(void* const* d_in, const int* in_sizes, int n_in, void* d_out, int out_size, void* d_ws, size_t ws_size, hipStream_t stream) {
    static int grid = 0;
    if (grid == 0) {
        int dev = 0, cus = 0, per_cu = 0;
        hipGetDevice(&dev); hipDeviceGetAttribute(&cus, hipDeviceAttributeMultiprocessorCount, dev);
        hipFuncSetAttribute((const void*)fwd_kernel, hipFuncAttributeMaxDynamicSharedMemorySize, LDS_BYTES);
        hipOccupancyMaxActiveBlocksPerMultiprocessor(&per_cu, (const void*)fwd_kernel, NT, LDS_BYTES);
        if (per_cu < 1) { fprintf(stderr, "occupancy query says %d blocks per CU\n", per_cu); per_cu = 1; }
        grid = cus * 1;
        (void)hipGetLastError();
    }
    hipMemsetAsync((char*)d_ws + WS_BAR, 0, 16384, stream);
    Args a{};
    for (int i = 0; i < 26; ++i) a.in[i] = (const float*)d_in[i];
    a.out = (float*)d_out; a.ws = (unsigned char*)d_ws;
    if (N_LAUNCHES == 1) {
        a.ph_lo = 0; a.ph_hi = 11;
        void* args[] = {&a};
        hipError_t e = hipLaunchCooperativeKernel((const void*)fwd_kernel, dim3(grid), dim3(NT), args, LDS_BYTES, stream);
        if (e != hipSuccess) fprintf(stderr, "cooperative launch failed: %s (grid %d)\n", hipGetErrorString(e), grid);
    } else {
        for (int p = 0; p < 11; ++p) { a.ph_lo = p; a.ph_hi = p + 1; hipLaunchKernelGGL(fwd_kernel, dim3(grid), dim3(NT), LDS_BYTES, stream, a); }
    }
}
```
